# Optimizing an MI355X kernel written in HIP

```python
import math
import jax, jax.numpy as jnp
from jax import lax
import numpy as np

D_MODEL = 2048
BATCH = 2
SEQ = 8192
DEPTH = 1

DIFF_HEADS = 8
DIFF_D = 64
NSA_HEADS = 8
NSA_KV = 2
NSA_GROUP = NSA_HEADS // NSA_KV
NSA_DK = 128
NSA_DV = 128
CMP_LEN = 32
CMP_STRIDE = 16
CMP_HIDDEN = 256
SLC_LEN = 64
SLC_TOPK = 16
WINDOW = 512
N_BUCKETS = 32
MAX_DISTANCE = 128
D_FF = 5632
CONV_W = 3
Q_BLOCK = 128
EPS = 1e-6
NEG = -1e30
FORCE = 1e30
TINY = 1e-30

DIFF_QK = DIFF_HEADS * 2 * DIFF_D
DIFF_V = DIFF_HEADS * 2 * DIFF_D
NSA_Q = NSA_HEADS * NSA_DK
NSA_K = NSA_KV * NSA_DK
NSA_V = NSA_KV * NSA_DV
N_GATES = NSA_HEADS * 3
SPLIT_SIZES = (DIFF_QK, DIFF_QK, DIFF_V, NSA_Q, NSA_K, NSA_V, NSA_K, NSA_V, NSA_K, NSA_V, N_GATES)
IN_COLS = 2 * DIFF_QK + DIFF_V + NSA_Q + 3 * (NSA_K + NSA_V) + N_GATES
MIX_WIDTH = DIFF_HEADS * 2 * DIFF_D + NSA_HEADS * NSA_DV

kernel_name = 'hybrid_diffattn_nsa_convglu_block'


def rms_norm(x, g):
    xf = x.astype(jnp.float32)
    y = xf * lax.rsqrt(jnp.mean(xf * xf, axis=-1, keepdims=True) + EPS)
    return (y * g.astype(jnp.float32)).astype(x.dtype)


def rel_bucket(delta):
    n = jnp.maximum(delta, 0)
    max_exact = N_BUCKETS // 2
    nf = jnp.maximum(n, 1).astype(jnp.float32)
    large = max_exact + (jnp.log(nf / max_exact) / math.log(MAX_DISTANCE / max_exact)
                         * (N_BUCKETS - max_exact)).astype(jnp.int32)
    large = jnp.minimum(large, N_BUCKETS - 1)
    return jnp.where(n < max_exact, n, large)


def masked_softmax(s, mask):
    s = jnp.where(mask, s, NEG)
    m = jnp.max(s, axis=-1, keepdims=True)
    p = jnp.exp(s - m) * mask
    return p / jnp.maximum(jnp.sum(p, axis=-1, keepdims=True), TINY)


def selection_map(nb, nc):
    r = SLC_LEN // CMP_STRIDE
    j = np.arange(nb)[:, None, None]
    m = np.arange(r)[None, :, None]
    n = np.arange(CMP_LEN // CMP_STRIDE)[None, None, :]
    c = r * j - m - n
    jj = np.broadcast_to(j, c.shape)
    valid = (c >= 0) & (c < nc)
    out = np.zeros((nb, nc), np.float32)
    np.add.at(out, (jj[valid], c[valid]), 1.0)
    return out


def compress(k, pos_emb, w1, w2):
    B, S, G, d = k.shape
    nc = (S - CMP_LEN) // CMP_STRIDE + 1
    idx = jnp.arange(nc)[:, None] * CMP_STRIDE + jnp.arange(CMP_LEN)[None, :]
    blocks = k[:, idx] + pos_emb[:, None, :]
    blocks = jnp.transpose(blocks, (0, 3, 1, 2, 4)).reshape(B, G, nc, CMP_LEN * d)
    return jax.nn.gelu(blocks @ w1, approximate=True) @ w2


def diff_attention(q, k, v, lam, lam_init, subln, bias_tab):
    B, H, S, _, d = q.shape
    nblk = S // Q_BLOCK
    kpos = jnp.arange(S)
    scale = d ** -0.5

    def block(i):
        s0 = i * Q_BLOCK
        qb = lax.dynamic_slice_in_dim(q, s0, Q_BLOCK, axis=2)
        qpos = s0 + jnp.arange(Q_BLOCK)
        delta = qpos[:, None] - kpos[None, :]
        bias = jnp.transpose(bias_tab[rel_bucket(delta)], (2, 0, 1))
        logits = jnp.einsum('bhqmd,bhkmd->bhmqk', qb, k).astype(jnp.float32) * scale + bias[None, :, None]
        p = masked_softmax(logits, (delta >= 0)[None, None, None])
        a = p[:, :, 0] - lam * p[:, :, 1]
        return jnp.einsum('bhqk,bhke->bhqe', a.astype(v.dtype), v)

    o = lax.map(block, jnp.arange(nblk))
    o = jnp.transpose(o, (1, 2, 0, 3, 4)).reshape(B, H, S, 2 * d)
    return rms_norm(o, subln) * (1.0 - lam_init)


def nsa_attention(q, k_cmp, v_cmp, k_slc, v_slc, k_win, v_win, gates, bias_nsa):
    B, G, Hg, S, dk = q.shape
    nc = k_cmp.shape[2]
    nb = S // SLC_LEN
    topk = min(SLC_TOPK, nb)
    nsel = topk * SLC_LEN
    scale = dk ** -0.5
    sel_map = jnp.asarray(selection_map(nb, nc))
    cmp_end = jnp.arange(nc) * CMP_STRIDE + (CMP_LEN - 1)
    ks_blk = k_slc.reshape(B, G, nb, SLC_LEN, dk)
    vs_blk = v_slc.reshape(B, G, nb, SLC_LEN, -1)
    pad = ((0, 0), (0, 0), (WINDOW, 0), (0, 0))
    kw_pad = jnp.pad(k_win, pad)
    vw_pad = jnp.pad(v_win, pad)
    table_g = jnp.transpose(bias_nsa, (1, 0, 2))
    bi = jnp.arange(B)[:, None, None, None]
    gi = jnp.arange(G)[None, :, None, None]
    blk = jnp.arange(nb)

    def block(i):
        s0 = i * Q_BLOCK
        qb = lax.dynamic_slice_in_dim(q, s0, Q_BLOCK, axis=3)
        gb = lax.dynamic_slice_in_dim(gates, s0, Q_BLOCK, axis=3)
        qpos = s0 + jnp.arange(Q_BLOCK)
        lc = jnp.einsum('bghqd,bgcd->bghqc', qb, k_cmp).astype(jnp.float32) * scale
        pc = masked_softmax(lc, cmp_end[None, :] <= qpos[:, None])
        o_cmp = jnp.einsum('bghqc,bgcd->bghqd', pc.astype(v_cmp.dtype), v_cmp)
        imp = jnp.einsum('bgqc,jc->bgqj', jnp.sum(pc, axis=2), sel_map)
        cur = (qpos // SLC_LEN)[:, None]
        forced = (blk[None] == 0) | (blk[None] == cur) | (blk[None] == cur - 1)
        imp = jnp.where(forced, FORCE, jnp.where(blk[None] <= cur, imp, NEG))
        _, idx = lax.top_k(imp, topk)
        k_sel = ks_blk[bi, gi, idx].reshape(B, G, Q_BLOCK, nsel, dk)
        v_sel = vs_blk[bi, gi, idx].reshape(B, G, Q_BLOCK, nsel, -1)
        kpos_sel = (idx[..., None] * SLC_LEN + jnp.arange(SLC_LEN)).reshape(B, G, Q_BLOCK, nsel)
        d_sel = qpos[:, None] - kpos_sel
        b_sel = jnp.transpose(table_g[gi, rel_bucket(d_sel)], (0, 1, 4, 2, 3))
        ls = jnp.einsum('bghqd,bgqkd->bghqk', qb, k_sel).astype(jnp.float32) * scale + b_sel
        ps = masked_softmax(ls, (d_sel >= 0)[:, :, None])
        o_slc = jnp.einsum('bghqk,bgqkd->bghqd', ps.astype(v_sel.dtype), v_sel)
        kwb = lax.dynamic_slice_in_dim(kw_pad, s0, Q_BLOCK + WINDOW, axis=2)
        vwb = lax.dynamic_slice_in_dim(vw_pad, s0, Q_BLOCK + WINDOW, axis=2)
        kpos_w = s0 - WINDOW + jnp.arange(Q_BLOCK + WINDOW)
        d_w = qpos[:, None] - kpos_w[None, :]
        wmask = (d_w >= 0) & (d_w < WINDOW) & (kpos_w[None, :] >= 0)
        b_w = jnp.transpose(bias_nsa[rel_bucket(d_w)], (2, 3, 0, 1))
        lw = jnp.einsum('bghqd,bgkd->bghqk', qb, kwb).astype(jnp.float32) * scale + b_w
        pw = masked_softmax(lw, wmask)
        o_win = jnp.einsum('bghqk,bgkd->bghqd', pw.astype(vwb.dtype), vwb)
        return gb[..., 0:1] * o_cmp + gb[..., 1:2] * o_slc + gb[..., 2:3] * o_win

    o = lax.map(block, jnp.arange(S // Q_BLOCK))
    return jnp.transpose(o, (1, 2, 3, 0, 4, 5)).reshape(B, G, Hg, S, -1)


def causal_dwconv(u, w, b):
    S = u.shape[1]
    up = jnp.pad(u, ((0, 0), (CONV_W - 1, 0), (0, 0)))
    y = b
    for j in range(CONV_W):
        y = y + w[j] * up[:, j:j + S]
    return y


def setup_inputs(seed: int = 0) -> dict:
    key = jax.random.key(seed)
    ks = jax.random.split(key, 24)
    f32 = jnp.float32

    def nrm(k, shape, scale):
        return jax.random.normal(k, shape, f32) * scale

    def gain(k, shape):
        return 1.0 + 0.05 * jax.random.normal(k, shape, f32)

    return {
        'x': nrm(ks[0], (BATCH, SEQ, D_MODEL), 1.0),
        'pre_mix_norm': gain(ks[1], (DEPTH, D_MODEL)),
        'w_in': nrm(ks[2], (DEPTH, D_MODEL, IN_COLS), D_MODEL ** -0.5),
        'lambda_q1': nrm(ks[3], (DEPTH, DIFF_D), 0.1),
        'lambda_k1': nrm(ks[4], (DEPTH, DIFF_D), 0.1),
        'lambda_q2': nrm(ks[5], (DEPTH, DIFF_D), 0.1),
        'lambda_k2': nrm(ks[6], (DEPTH, DIFF_D), 0.1),
        'diff_subln': gain(ks[7], (DEPTH, 2 * DIFF_D)),
        'cmp_pos_k': nrm(ks[8], (DEPTH, CMP_LEN, NSA_DK), 0.1),
        'cmp_pos_v': nrm(ks[9], (DEPTH, CMP_LEN, NSA_DV), 0.1),
        'cmp_k_w1': nrm(ks[10], (DEPTH, CMP_LEN * NSA_DK, CMP_HIDDEN), (CMP_LEN * NSA_DK) ** -0.5),
        'cmp_k_w2': nrm(ks[11], (DEPTH, CMP_HIDDEN, NSA_DK), CMP_HIDDEN ** -0.5),
        'cmp_v_w1': nrm(ks[12], (DEPTH, CMP_LEN * NSA_DV, CMP_HIDDEN), (CMP_LEN * NSA_DV) ** -0.5),
        'cmp_v_w2': nrm(ks[13], (DEPTH, CMP_HIDDEN, NSA_DV), CMP_HIDDEN ** -0.5),
        'rel_bias': nrm(ks[14], (N_BUCKETS, DIFF_HEADS + NSA_HEADS), 0.5),
        'w_out': nrm(ks[15], (DEPTH, MIX_WIDTH, D_MODEL), MIX_WIDTH ** -0.5),
        'post_mix_norm': gain(ks[16], (DEPTH, D_MODEL)),
        'pre_ffn_norm': gain(ks[17], (DEPTH, D_MODEL)),
        'w_up': nrm(ks[18], (DEPTH, D_MODEL, 2 * D_FF), D_MODEL ** -0.5),
        'conv_w': nrm(ks[19], (DEPTH, CONV_W, 2 * D_FF), CONV_W ** -0.5),
        'conv_b': nrm(ks[20], (DEPTH, 2 * D_FF), 0.01),
        'w_down': nrm(ks[21], (DEPTH, D_FF, D_MODEL), D_FF ** -0.5),
        'post_ffn_norm': gain(ks[22], (DEPTH, D_MODEL)),
    }


def reference(x, pre_mix_norm, w_in, lambda_q1, lambda_k1, lambda_q2, lambda_k2, diff_subln,
              cmp_pos_k, cmp_pos_v, cmp_k_w1, cmp_k_w2, cmp_v_w1, cmp_v_w2, rel_bias, w_out,
              post_mix_norm, pre_ffn_norm, w_up, conv_w, conv_b, w_down, post_ffn_norm):
    B, S, _ = x.shape
    f32 = jnp.float32
    offsets = np.cumsum(SPLIT_SIZES)[:-1].tolist()
    bias_diff = rel_bias[:, :DIFF_HEADS]
    bias_nsa = rel_bias[:, DIFF_HEADS:].reshape(N_BUCKETS, NSA_KV, NSA_GROUP)
    for l in range(DEPTH):
        h = rms_norm(x, pre_mix_norm[l])
        proj = h @ w_in[l]
        (dq, dk, dv, nq, kc, vc, ksl, vsl, kwn, vwn, g) = jnp.split(proj, offsets, axis=-1)
        q_d = dq.reshape(B, S, DIFF_HEADS, 2, DIFF_D).transpose(0, 2, 1, 3, 4)
        k_d = dk.reshape(B, S, DIFF_HEADS, 2, DIFF_D).transpose(0, 2, 1, 3, 4)
        v_d = dv.reshape(B, S, DIFF_HEADS, 2 * DIFF_D).transpose(0, 2, 1, 3)
        lam_init = 0.8 - 0.6 * math.exp(-0.3 * l)
        lam = (jnp.exp(jnp.sum(lambda_q1[l].astype(f32) * lambda_k1[l].astype(f32)))
               - jnp.exp(jnp.sum(lambda_q2[l].astype(f32) * lambda_k2[l].astype(f32))) + lam_init)
        o_diff = diff_attention(q_d, k_d, v_d, lam, lam_init, diff_subln[l], bias_diff)
        q_n = nq.reshape(B, S, NSA_KV, NSA_GROUP, NSA_DK).transpose(0, 2, 3, 1, 4)
        k_c = compress(kc.reshape(B, S, NSA_KV, NSA_DK), cmp_pos_k[l], cmp_k_w1[l], cmp_k_w2[l])
        v_c = compress(vc.reshape(B, S, NSA_KV, NSA_DV), cmp_pos_v[l], cmp_v_w1[l], cmp_v_w2[l])
        k_s = ksl.reshape(B, S, NSA_KV, NSA_DK).transpose(0, 2, 1, 3)
        v_s = vsl.reshape(B, S, NSA_KV, NSA_DV).transpose(0, 2, 1, 3)
        k_w = kwn.reshape(B, S, NSA_KV, NSA_DK).transpose(0, 2, 1, 3)
        v_w = vwn.reshape(B, S, NSA_KV, NSA_DV).transpose(0, 2, 1, 3)
        gates = jax.nn.sigmoid(g.reshape(B, S, NSA_KV, NSA_GROUP, 3)).transpose(0, 2, 3, 1, 4)
        o_nsa = nsa_attention(q_n, k_c, v_c, k_s, v_s, k_w, v_w, gates, bias_nsa)
        mix = jnp.concatenate([o_diff.transpose(0, 2, 1, 3).reshape(B, S, -1),
                               o_nsa.transpose(0, 3, 1, 2, 4).reshape(B, S, -1)], axis=-1)
        x = x + rms_norm(mix @ w_out[l], post_mix_norm[l])
        h = rms_norm(x, pre_ffn_norm[l])
        u = causal_dwconv(h @ w_up[l], conv_w[l], conv_b[l])
        gate, up = jnp.split(u, 2, axis=-1)
        y = (jax.nn.gelu(gate, approximate=True) * up) @ w_down[l]
        x = x + rms_norm(y, post_ffn_norm[l])
    return x
```

```cpp
#include <hip/hip_runtime.h>
#include <hip/hip_bf16.h>
#include <cstdio>
#include <cstdint>
namespace pg8 {
#define PG8_LAS __attribute__((address_space(3)))
typedef unsigned short bf16_t;
typedef short bf16x8 __attribute__((ext_vector_type(8)));
typedef float f32x4 __attribute__((ext_vector_type(4)));
typedef unsigned u32x4 __attribute__((ext_vector_type(4)));
constexpr int BM = 256, BK = 64, HALF = 128, HTB = HALF * BK * 2  , STAGE_BYTES = 8 * HTB, NXCD = 8, WGM = 8;

__host__ __device__ __forceinline__ int lds_byte(int r, int c) { const int st = (r >> 4) * 2 + (c >> 5), rr = r & 15, cc = c & 31, ob = rr * 64 + cc * 2; return st * 1024 + (ob ^ (((ob >> 9) & 1) << 5)); }
__host__ __device__ __forceinline__ void stage_rc(int b, int& R, int& C) { const int st = b / 1024, sb = b % 1024, swz = sb ^ (((sb >> 9) & 1) << 5); R = (st >> 1) * 16 + swz / 64; C = (st & 1) * 32 + (swz % 64) / 2; }
__host__ __device__ __forceinline__ int perm32(int rho) { const int n = rho >> 4, i = rho & 15; return 8 * (i >> 2) + 4 * n + (i & 3); }

struct Unit { int pm, pn; };
struct Gemm { const bf16_t* A; const bf16_t* Bt; int M, N, K; };

struct StaticOrder {
    int nM, nN, nwg, G, c;
    __host__ __device__ void init(int M, int N, int G_, int c_) { nM = M / BM; nN = N / BM; nwg = nM * nN; G = G_; c = c_; }
    __host__ __device__ bool next(int i, Unit& u) const {
        const long L = (long)i * G + c; if (L >= nwg) return false;
        int wgid = (int)L; { const int q = nwg / NXCD, r = nwg % NXCD, xcd = wgid % NXCD, off = wgid / NXCD; wgid = (xcd < r ? xcd * (q + 1) : r * (q + 1) + (xcd - r) * q) + off; }
        const int nig = WGM * nN, gid = wgid / nig, fm = gid * WGM, gsz = (nM - fm) < WGM ? (nM - fm) : WGM;
        u.pm = fm + ((wgid % nig) % gsz); u.pn = (wgid % nig) / gsz; return true;
    }
    __device__ __forceinline__ void a_ready(const Unit&) const {}
    __device__ __forceinline__ void done(const Unit&) const {}
};


__device__ __forceinline__ unsigned cvt_pk_bf16(float lo, float hi) { unsigned r; asm volatile("v_cvt_pk_bf16_f32 %0, %1, %2" : "=v"(r) : "v"(lo), "v"(hi)); return r; }
__device__ __forceinline__ float fast_sigmoid(float v) { return __builtin_amdgcn_rcpf(1.0f + __builtin_amdgcn_exp2f(-1.4426950408889634f * v)); }
__device__ __forceinline__ float gelu_tanh(float v) { const float z2 = 1.5957691216f * (v + 0.044715f * v * v * v); return v * __builtin_amdgcn_rcpf(1.0f + __builtin_amdgcn_exp2f(-1.4426950408889634f * z2)); }

struct EpiF32 {
    static constexpr bool PERM = false, AFTER_DRAIN = false;
    float* C; int ldc;
    __device__ __forceinline__ void operator()(const f32x4 (&acc)[2][2][4][2], const Unit& u, int wr, int wc, int fr, int fq) const {
        const int row0 = u.pm * BM + wr * 64 + fr, col0 = u.pn * BM + wc * 32 + 4 * fq;
#pragma unroll
        for (int ai = 0; ai < 2; ++ai)
#pragma unroll
            for (int m = 0; m < 4; ++m) { float* rowp = C + (size_t)(row0 + ai * HALF + m * 16) * ldc + col0;
#pragma unroll
                for (int bj = 0; bj < 2; ++bj)
#pragma unroll
                    for (int n = 0; n < 2; ++n) *(f32x4*)(rowp + bj * HALF + n * 16) = acc[ai][bj][m][n]; }
    }
};
struct EpiProj {
    static constexpr bool PERM = true, AFTER_DRAIN = false;
    bf16_t* O; int ldc; float* gates; float c2d, c2n;
    __device__ __forceinline__ void operator()(const f32x4 (&acc)[2][2][4][2], const Unit& u, int wr, int wc, int fr, int fq) const {
        const int pn = u.pn; const int row0 = u.pm * BM + wr * 64 + fr;
        if (pn == 22) {
            if (wc == 0) {
#pragma unroll
                for (int ai = 0; ai < 2; ++ai)
#pragma unroll
                    for (int m = 0; m < 4; ++m) { float* gp = gates + (size_t)(row0 + ai * HALF + m * 16) * 32 + 8 * fq;
#pragma unroll
                        for (int n = 0; n < 2; ++n) { const f32x4 v = acc[ai][0][m][n]; f32x4 s; s[0] = fast_sigmoid(v[0]); s[1] = fast_sigmoid(v[1]); s[2] = fast_sigmoid(v[2]); s[3] = fast_sigmoid(v[3]); *(f32x4*)(gp + 4 * n) = s; } }
            }
            return;
        }
        const float sc = (pn < 4) ? c2d : ((pn >= 12 && pn < 16) ? c2n : 1.0f);
        const int col0 = pn * BM + wc * 32 + 8 * fq;
#pragma unroll
        for (int ai = 0; ai < 2; ++ai)
#pragma unroll
            for (int m = 0; m < 4; ++m) { bf16_t* rowp = O + (size_t)(row0 + ai * HALF + m * 16) * ldc + col0;
#pragma unroll
                for (int bj = 0; bj < 2; ++bj) { const f32x4 v0 = acc[ai][bj][m][0] * sc, v1 = acc[ai][bj][m][1] * sc;
                    u32x4 w; w.x = cvt_pk_bf16(v0[0], v0[1]); w.y = cvt_pk_bf16(v0[2], v0[3]); w.z = cvt_pk_bf16(v1[0], v1[1]); w.w = cvt_pk_bf16(v1[2], v1[3]);
                    *(u32x4*)(rowp + bj * HALF) = w; } }
    }
};
__device__ __forceinline__ float dpp_shr1(float v) { return __builtin_bit_cast(float, __builtin_amdgcn_update_dpp(0, __builtin_bit_cast(int, v), 0x111, 0xF, 0xF, true)); }
__device__ __forceinline__ float dpp_shr2(float v) { return __builtin_bit_cast(float, __builtin_amdgcn_update_dpp(0, __builtin_bit_cast(int, v), 0x112, 0xF, 0xF, true)); }
__device__ __forceinline__ float dpp_shl15(float v) { return __builtin_bit_cast(float, __builtin_amdgcn_update_dpp(0, __builtin_bit_cast(int, v), 0x10F, 0xF, 0xF, true)); }
__device__ __forceinline__ float dpp_shl14(float v) { return __builtin_bit_cast(float, __builtin_amdgcn_update_dpp(0, __builtin_bit_cast(int, v), 0x10E, 0xF, 0xF, true)); }
struct EpiUpGlu {
    static constexpr bool PERM = true, AFTER_DRAIN = false;
    bf16_t* act; float* halo; const float* cw; const float* cb; int dff;
    __device__ __forceinline__ void operator()(const f32x4 (&acc)[2][2][4][2], const Unit& u, int wr, int wc, int fr, int fq) const {
        typedef unsigned u32x2 __attribute__((ext_vector_type(2)));
        const int nu = 2 * dff;
#pragma unroll
        for (int n = 0; n < 2; ++n) {
            const int cc = u.pn * HALF + wc * 32 + 8 * fq + 4 * n;
            const f32x4 wg0 = *(const f32x4*)(cw + cc), wg1 = *(const f32x4*)(cw + (size_t)nu + cc), wg2 = *(const f32x4*)(cw + (size_t)2 * nu + cc), bg = *(const f32x4*)(cb + cc);
            const f32x4 wu0 = *(const f32x4*)(cw + dff + cc), wu1 = *(const f32x4*)(cw + (size_t)nu + dff + cc), wu2 = *(const f32x4*)(cw + (size_t)2 * nu + dff + cc), bu = *(const f32x4*)(cb + dff + cc);
#pragma unroll
            for (int ai = 0; ai < 2; ++ai) {
                const int strip = 4 * u.pm + 2 * ai + wr; const int rowb = u.pm * BM + ai * HALF + wr * 64 + fr;
#pragma unroll
                for (int m = 0; m < 4; ++m) {
                    const f32x4 g = acc[ai][0][m][n], up = acc[ai][1][m][n]; f32x4 g1, g2, u1, u2;
#pragma unroll
                    for (int e = 0; e < 4; ++e) { g1[e] = dpp_shr1(g[e]); g2[e] = dpp_shr2(g[e]); u1[e] = dpp_shr1(up[e]); u2[e] = dpp_shr2(up[e]); }
                    if (m > 0) { const f32x4 gp = acc[ai][0][m > 0 ? m - 1 : 0][n], upp = acc[ai][1][m > 0 ? m - 1 : 0][n];
#pragma unroll
                        for (int e = 0; e < 4; ++e) { g1[e] += dpp_shl15(gp[e]); g2[e] += dpp_shl14(gp[e]); u1[e] += dpp_shl15(upp[e]); u2[e] += dpp_shl14(upp[e]); } }
                    const f32x4 yg = bg + wg0 * g2 + wg1 * g1 + wg2 * g;
                    const f32x4 yu = bu + wu0 * u2 + wu1 * u1 + wu2 * up;
                    if (m == 0 && fr < 2) { float* hp = halo + ((size_t)strip * 4 + fr) * nu + cc; *(f32x4*)hp = g; *(f32x4*)(hp + dff) = up; }
                    if (m == 3 && fr >= 14) { float* hp = halo + ((size_t)strip * 4 + 2 + (fr - 14)) * nu + cc; *(f32x4*)hp = g; *(f32x4*)(hp + dff) = up; }
                    if (m > 0 || fr >= 2) { u32x2 w; w.x = cvt_pk_bf16(gelu_tanh(yg[0]) * yu[0], gelu_tanh(yg[1]) * yu[1]); w.y = cvt_pk_bf16(gelu_tanh(yg[2]) * yu[2], gelu_tanh(yg[3]) * yu[3]);
                        *(u32x2*)(act + (size_t)(rowb + m * 16) * dff + cc) = w; }
                }
            }
        }
    }
};
template <class Epi, class Sched, bool ALIGN_EPI = false, bool SP2 = false>
__device__ __forceinline__ void gemm_phase(PG8_LAS unsigned char* lds, const Gemm g, const Sched& S, const Epi& E) {
    const int tid = threadIdx.x, wid = __builtin_amdgcn_readfirstlane(tid >> 6), lane = tid & 63, wr = wid >> 2, wc = wid & 3, fr = lane & 15, fq = lane >> 4;
    const int K = g.K, nt = K / BK;
    unsigned voffA[2], voffB[2];
#pragma unroll
    for (int i = 0; i < 2; ++i) { int R, C; stage_rc(tid * 16 + i * 8192, R, C); const int Rb = Epi::PERM ? ((R & ~31) + perm32(R & 31)) : R;
        voffA[i] = (unsigned)(R * K + C) * 2u; voffB[i] = (unsigned)(Rb * K + C) * 2u; }
    const size_t kstep = (size_t)(BK * 2);
    const size_t hstep = (size_t)HALF * K * 2;
    const size_t tstep = 2 * hstep;
    const unsigned ldsw = (unsigned)wid * 1024u;
    const int aoff = lds_byte(wr * 64 + fr, fq * 8), boff = lds_byte(wc * 32 + fr, fq * 8);
#define PG8_SA(b, h) (((b) * 2 + (h)) * HTB)
#define PG8_SB(b, h) ((4 + (b) * 2 + (h)) * HTB)
#define PG8_STAGE(bufoff, gbase, voff) do { _Pragma("unroll") for (int _i = 0; _i < 2; ++_i) \
        __builtin_amdgcn_global_load_lds((const unsigned*)((const char*)(gbase) + (voff)[_i]), (PG8_LAS unsigned*)(lds + (bufoff) + ldsw + _i * 8192), 16, 0, 0); } while (0)
#define PG8_LDA(dst, b, h) do { _Pragma("unroll") for (int m = 0; m < 4; ++m) _Pragma("unroll") for (int k = 0; k < 2; ++k) dst[m][k] = *(const PG8_LAS bf16x8*)(lds + PG8_SA(b, h) + aoff + m * 2048 + k * 1024); } while (0)
#define PG8_LDB(dst, b, h) do { _Pragma("unroll") for (int n = 0; n < 2; ++n) _Pragma("unroll") for (int k = 0; k < 2; ++k) dst[n][k] = *(const PG8_LAS bf16x8*)(lds + PG8_SB(b, h) + boff + n * 2048 + k * 1024); } while (0)
#define PG8_MMA(ai, bj, At, Bt) do { __builtin_amdgcn_s_setprio(1); _Pragma("unroll") for (int m = 0; m < 4; ++m) _Pragma("unroll") for (int n = 0; n < 2; ++n) _Pragma("unroll") for (int k = 0; k < 2; ++k) \
        acc[ai][bj][m][n] = __builtin_amdgcn_mfma_f32_16x16x32_bf16(Bt[n][k], At[m][k], acc[ai][bj][m][n], 0, 0, 0); __builtin_amdgcn_s_setprio(0); } while (0)
#define PG8_WAIT_V(n) asm volatile("s_waitcnt vmcnt(" #n ")" ::: "memory")
#define PG8_WAIT_L(n) asm volatile("s_waitcnt lgkmcnt(" #n ")" ::: "memory")
#define PG8_BAR __builtin_amdgcn_s_barrier()
#define PG8_SCHED __builtin_amdgcn_sched_barrier(0)
    Unit cur, nxt; int ui = 0;
    if (!S.next(0, cur)) return;
    f32x4 acc[2][2][4][2];
#pragma unroll
    for (int a = 0; a < 2; ++a)
#pragma unroll
        for (int b = 0; b < 2; ++b)
#pragma unroll
            for (int m = 0; m < 4; ++m)
#pragma unroll
                for (int n = 0; n < 2; ++n) acc[a][b][m][n] = (f32x4){0.f, 0.f, 0.f, 0.f};
    bf16x8 At[4][2], B0[2][2], B1[2][2];
    const char* cA = (const char*)g.A + (size_t)cur.pm * tstep; const char* cB = (const char*)g.Bt + (size_t)cur.pn * tstep;
    S.a_ready(cur);
    if constexpr (SP2) {
        PG8_STAGE(PG8_SB(0, 0), cB, voffB); PG8_STAGE(PG8_SB(0, 1), cB + hstep, voffB); PG8_STAGE(PG8_SA(0, 0), cA, voffA); PG8_STAGE(PG8_SA(0, 1), cA + hstep, voffA);
        if (wr == 1) PG8_BAR;
        PG8_WAIT_V(2); PG8_BAR;
        PG8_STAGE(PG8_SB(1, 0), cB + kstep, voffB); PG8_STAGE(PG8_SA(1, 0), cA + kstep, voffA); PG8_STAGE(PG8_SB(1, 1), cB + hstep + kstep, voffB);
        PG8_WAIT_V(6); PG8_BAR;
    } else {
        PG8_STAGE(PG8_SB(0, 0), cB, voffB); PG8_STAGE(PG8_SA(0, 0), cA, voffA); PG8_STAGE(PG8_SB(0, 1), cB + hstep, voffB); PG8_STAGE(PG8_SA(0, 1), cA + hstep, voffA);
        if (wr == 1) PG8_BAR;
        PG8_WAIT_V(4); PG8_BAR;
        PG8_STAGE(PG8_SB(1, 0), cB + kstep, voffB); PG8_STAGE(PG8_SA(1, 0), cA + kstep, voffA); PG8_STAGE(PG8_SB(1, 1), cB + hstep + kstep, voffB);
        PG8_WAIT_V(6); PG8_BAR;
    }
    for (;;) {
        const bool has_next = S.next(ui + 1, nxt);
        const char* nA = has_next ? (const char*)g.A + (size_t)nxt.pm * tstep : cA; const char* nB = has_next ? (const char*)g.Bt + (size_t)nxt.pn * tstep : cB;
        for (int t = 0; t < nt; t += 2) {
            const bool last = (t == nt - 2);
            const char* a1 = cA + (size_t)(t + 1) * kstep;
            const char* a2 = last ? nA : cA + (size_t)(t + 2) * kstep; const char* b2 = last ? nB : cB + (size_t)(t + 2) * kstep;
            const char* a3 = a2 + kstep; const char* b3 = b2 + kstep;
            if (last && has_next) S.a_ready(nxt);
            if constexpr (SP2) {
            PG8_LDB(B0, 0, 0); PG8_LDB(B1, 0, 1); PG8_SCHED; PG8_LDA(At, 0, 0); PG8_STAGE(PG8_SA(1, 1), a1 + hstep, voffA);
            PG8_WAIT_V(8); PG8_WAIT_L(0); PG8_BAR; PG8_MMA(0, 0, At, B0); PG8_MMA(0, 1, At, B1); PG8_BAR; PG8_SCHED;
            PG8_LDA(At, 0, 1); PG8_STAGE(PG8_SB(0, 0), b2, voffB); PG8_STAGE(PG8_SB(0, 1), b2 + hstep, voffB); PG8_STAGE(PG8_SA(0, 0), a2, voffA);
            PG8_WAIT_V(8); PG8_WAIT_L(0); PG8_BAR; PG8_MMA(1, 0, At, B0); PG8_MMA(1, 1, At, B1); PG8_BAR; PG8_SCHED;
            PG8_LDB(B0, 1, 0); PG8_LDB(B1, 1, 1); PG8_SCHED; PG8_LDA(At, 1, 0); PG8_STAGE(PG8_SA(0, 1), a2 + hstep, voffA);
            PG8_WAIT_V(8); PG8_WAIT_L(0); PG8_BAR; PG8_MMA(0, 0, At, B0); PG8_MMA(0, 1, At, B1); PG8_BAR; PG8_SCHED;
            PG8_LDA(At, 1, 1); PG8_STAGE(PG8_SB(1, 0), b3, voffB); PG8_STAGE(PG8_SB(1, 1), b3 + hstep, voffB); PG8_STAGE(PG8_SA(1, 0), a3, voffA);
            PG8_WAIT_V(8); PG8_WAIT_L(0); PG8_BAR; PG8_MMA(1, 0, At, B0); PG8_MMA(1, 1, At, B1); PG8_BAR; PG8_SCHED;
            } else {
            PG8_LDB(B0, 0, 0); PG8_SCHED; PG8_LDA(At, 0, 0); PG8_STAGE(PG8_SA(1, 1), a1 + hstep, voffA);
            PG8_WAIT_L(8); PG8_BAR; PG8_WAIT_L(0); PG8_MMA(0, 0, At, B0); PG8_BAR; PG8_SCHED;
            PG8_LDB(B1, 0, 1); PG8_STAGE(PG8_SB(0, 0), b2, voffB);
            PG8_BAR; PG8_WAIT_L(0); PG8_MMA(0, 1, At, B1); PG8_BAR;
            PG8_LDA(At, 0, 1); PG8_STAGE(PG8_SA(0, 0), a2, voffA);
            PG8_BAR; PG8_WAIT_L(0); PG8_MMA(1, 0, At, B0); PG8_BAR; PG8_SCHED;
            PG8_STAGE(PG8_SB(0, 1), b2 + hstep, voffB);
            PG8_WAIT_V(6); PG8_BAR; PG8_MMA(1, 1, At, B1); PG8_BAR;
            PG8_LDB(B0, 1, 0); PG8_SCHED; PG8_LDA(At, 1, 0); PG8_STAGE(PG8_SA(0, 1), a2 + hstep, voffA);
            PG8_WAIT_L(8); PG8_BAR; PG8_WAIT_L(0); PG8_MMA(0, 0, At, B0); PG8_BAR; PG8_SCHED;
            PG8_LDB(B1, 1, 1); PG8_STAGE(PG8_SB(1, 0), b3, voffB);
            PG8_BAR; PG8_WAIT_L(0); PG8_MMA(0, 1, At, B1); PG8_BAR;
            PG8_LDA(At, 1, 1); PG8_STAGE(PG8_SA(1, 0), a3, voffA);
            PG8_BAR; PG8_WAIT_L(0); PG8_MMA(1, 0, At, B0); PG8_BAR; PG8_SCHED;
            PG8_STAGE(PG8_SB(1, 1), b3 + hstep, voffB);
            PG8_WAIT_V(6); PG8_BAR; PG8_MMA(1, 1, At, B1); PG8_BAR;
            }
        }
        if constexpr (ALIGN_EPI) { if (wr == 0) PG8_BAR; }
        if constexpr (!Epi::AFTER_DRAIN) { E(acc, cur, wr, wc, fr, fq); S.done(cur); }
        if (!has_next) break;
#pragma unroll
        for (int a = 0; a < 2; ++a)
#pragma unroll
            for (int b = 0; b < 2; ++b)
#pragma unroll
                for (int m = 0; m < 4; ++m)
#pragma unroll
                    for (int n = 0; n < 2; ++n) acc[a][b][m][n] = (f32x4){0.f, 0.f, 0.f, 0.f};
        cur = nxt; cA = nA; cB = nB; ++ui;
        if constexpr (ALIGN_EPI) { if (wr == 1) PG8_BAR; }
    }
    PG8_WAIT_V(0);
    if constexpr (!ALIGN_EPI) { if (wr == 0) PG8_BAR; }
    PG8_BAR;
    if constexpr (Epi::AFTER_DRAIN) { E.fused(acc, cur, wr, wc, fr, fq, lds, wid, lane); S.done(cur); }
#undef PG8_SA
#undef PG8_SB
#undef PG8_STAGE
#undef PG8_LDA
#undef PG8_LDB
#undef PG8_MMA
#undef PG8_WAIT_V
#undef PG8_WAIT_L
#undef PG8_BAR
#undef PG8_SCHED
}
}
namespace att {
#define ALAS __attribute__((address_space(3)))
typedef unsigned short bf16_t;
typedef short bf16x8 __attribute__((ext_vector_type(8)));
typedef short s16x4 __attribute__((ext_vector_type(4)));
typedef float f32x16 __attribute__((ext_vector_type(16)));
typedef float f32x4 __attribute__((ext_vector_type(4)));
typedef unsigned u32x4 __attribute__((ext_vector_type(4)));
typedef ALAS char lchar;
constexpr int KVBLK = 64, SHM_K = 16384, SHM_V = 16384;
constexpr int LUTX = 320, LUT0 = 96;
constexpr int L_V = 0, L_K = 2 * SHM_V, L_WS = L_K + 2 * SHM_K, L_LUT = L_WS + 2048, L_IMP = L_LUT + 4 * LUTX * 4, IMP_LD = 132, L_SEL = L_IMP + 64 * IMP_LD * 4, L_UN = L_SEL + 1024, L_LIST = L_UN + 64, L_END = L_LIST + 512;
constexpr float THR = 8.0f;
enum { M_DIFF = 0, M_CMP = 1, M_SLC = 2, M_WIN = 3 };
#define KSWZ(row, colB) ((row) * 256 + ((colB) ^ (((row) & 7) << 4)))
#define SBAR() __builtin_amdgcn_sched_barrier(0)
__device__ __forceinline__ int v_st(int k, int c) { const int kk = (k & ~0xC) | ((k & 4) << 1) | ((k & 8) >> 1); return ((kk >> 3) * 4 + (c >> 5)) * 512 + ((kk & 7) * 32 + (c & 31)) * 2; }
__device__ __forceinline__ int v_rd_base(int lane) { return ((lane & 3) << 3) | (((lane >> 2) & 3) << 6) | (((lane >> 4) & 1) << 5) | (((lane >> 5) & 1) << 8); }
constexpr int v_rd_off(int d0, int ks, int half) { return d0 * 512 + ks * 4096 + half * 2048; }
__device__ __forceinline__ int crow(int r, int hi) { return (r & 3) + 8 * (r >> 2) + 4 * hi; }
__device__ __forceinline__ unsigned cvtpk(float lo, float hi) { unsigned r; asm volatile("v_cvt_pk_bf16_f32 %0, %1, %2" : "=v"(r) : "v"(lo), "v"(hi)); return r; }
__device__ __forceinline__ unsigned lds_addr(const lchar* p) { return (unsigned)(uintptr_t)p; }

struct Lane {
    int qpos;
    int qlo, qhi;
    unsigned lut;
};
template <int MODE>
__device__ __forceinline__ void mask_sel(f32x16& p0, f32x16& p1, int key0, int tj, const Lane L, int hi, bool cross, unsigned sw0, unsigned sw1, unsigned sw2, unsigned sw3) {
    const float NEG = -__builtin_inff();
    if constexpr (MODE == M_CMP) {
        const int lim = ((L.qpos - 31) >> 4) - key0 - 4 * hi;
#pragma unroll
        for (int r = 0; r < 16; ++r) { const int c = (r & 3) + 8 * (r >> 2); if (c > lim) p0[r] = NEG; if (c + 32 > lim) p1[r] = NEG; }
    } else {
        if constexpr (MODE == M_SLC) {
            const unsigned w = tj < 64 ? (tj < 32 ? sw0 : sw1) : (tj < 96 ? sw2 : sw3);
            if (((w >> (tj & 31)) & 1u) == 0u) {
#pragma unroll
                for (int r = 0; r < 16; ++r) { p0[r] = NEG; p1[r] = NEG; } }
        }
        if (cross) {
            const int dq = L.qpos - key0 - 4 * hi;
#pragma unroll
            for (int r = 0; r < 16; ++r) {
                const int c = (r & 3) + 8 * (r >> 2);
                if constexpr (MODE == M_WIN) { if ((unsigned)(dq - c) >= 512u) p0[r] = NEG; if ((unsigned)(dq - c - 32) >= 512u) p1[r] = NEG; }
                else { if (dq - c < 0) p0[r] = NEG; if (dq - c - 32 < 0) p1[r] = NEG; }
            }
        }
    }
}
__device__ __forceinline__ void partialSM(f32x16& p0, f32x16& p1, float& m_reg, float& alpha) {
    float pmax = p0[0];
#pragma unroll
    for (int r = 1; r < 16; ++r) pmax = fmaxf(pmax, p0[r]);
#pragma unroll
    for (int r = 0; r < 16; ++r) pmax = fmaxf(pmax, p1[r]);
    { auto rr = __builtin_amdgcn_permlane32_swap(__float_as_uint(pmax), __float_as_uint(pmax), false, false);
      pmax = fmaxf(__uint_as_float(rr[0]), __uint_as_float(rr[1])); }
    if (__builtin_expect(__all(pmax - m_reg <= THR), 1)) { alpha = 1.f; }
    else { const float mn = fmaxf(m_reg, pmax); alpha = __builtin_amdgcn_exp2f(m_reg - mn); m_reg = mn; }
    const float mm = m_reg;
#pragma unroll
    for (int r = 0; r < 16; ++r) { p0[r] = p0[r] - mm; p1[r] = p1[r] - mm; }
#pragma unroll
    for (int r = 0; r < 16; ++r) p0[r] = __builtin_amdgcn_exp2f(p0[r]);
}
__device__ __forceinline__ void finishSM(f32x16& p0, f32x16& p1, float alpha, float& l_reg, bf16x8& pa0, bf16x8& pa1, bf16x8& pa2, bf16x8& pa3) {
#pragma unroll
    for (int r = 0; r < 16; ++r) p1[r] = __builtin_amdgcn_exp2f(p1[r]);
    float ps = 0;
#pragma unroll
    for (int r = 0; r < 16; ++r) ps += p0[r];
#pragma unroll
    for (int r = 0; r < 16; ++r) ps += p1[r];
    { auto rr = __builtin_amdgcn_permlane32_swap(__float_as_uint(ps), __float_as_uint(ps), false, false);
      ps = __uint_as_float(rr[0]) + __uint_as_float(rr[1]); }
    l_reg = l_reg * alpha + ps;
#define PK4(P, B_, OUT) do { unsigned a0 = cvtpk(P[B_+0], P[B_+1]), a1 = cvtpk(P[B_+2], P[B_+3]);                          \
        unsigned b0 = cvtpk(P[B_+4], P[B_+5]), b1 = cvtpk(P[B_+6], P[B_+7]);                                             \
        auto r0 = __builtin_amdgcn_permlane32_swap(a0, b0, false, false); auto r1 = __builtin_amdgcn_permlane32_swap(a1, b1, false, false); \
        u32x4 w = {r0[0], r1[0], r0[1], r1[1]}; OUT = __builtin_bit_cast(bf16x8, w); } while (0)
    PK4(p0, 0, pa0); PK4(p0, 8, pa1); PK4(p1, 0, pa2); PK4(p1, 8, pa3);
#undef PK4
}
template <int KB, int DQK>
__device__ __forceinline__ void qkt(f32x16& p0, f32x16& p1, const lchar* K_lds, int koff, int r32, int hi, const bf16x8* qr, bool act, bool nearb, unsigned bb) {
    if (!act) { const float NEG = -__builtin_inff();
#pragma unroll
        for (int r = 0; r < 16; ++r) { p0[r] = NEG; p1[r] = NEG; } return; }
    if (nearb) {
#pragma unroll
        for (int r = 0; r < 16; ++r) { const int c = (r & 3) + 8 * (r >> 2);
            p0[r] = *(const ALAS float*)(uintptr_t)(bb + 4u * (unsigned)(59 - c)); p1[r] = *(const ALAS float*)(uintptr_t)(bb + 4u * (unsigned)(27 - c)); }
    } else { p0 = f32x16{}; p1 = f32x16{}; }
    const lchar* kb[4];
#pragma unroll
    for (int dd = 0; dd < 4; ++dd) kb[dd] = K_lds + KB * SHM_K + KSWZ(r32, (dd * 16 + hi * 8) * 2) + koff;
#pragma unroll
    for (int d0 = 0; d0 < DQK / 16; ++d0) { const lchar* a = kb[d0 & 3] + (d0 >> 2) * 128;
        const bf16x8 b0 = *reinterpret_cast<const ALAS bf16x8*>(a);
        const bf16x8 b1 = *reinterpret_cast<const ALAS bf16x8*>(a + 32 * 256);
        p0 = __builtin_amdgcn_mfma_f32_32x32x16_bf16(b0, qr[d0], p0, 0, 0, 0);
        p1 = __builtin_amdgcn_mfma_f32_32x32x16_bf16(b1, qr[d0], p1, 0, 0, 0); }
}
template <int VB>
__device__ __forceinline__ void pv_tile(f32x16* o, unsigned vb0, bf16x8 pa0, bf16x8 pa1, bf16x8 pa2, bf16x8 pa3, bool act) {
    if (!act) return;
#define TRRD(dst, off) asm volatile("ds_read_b64_tr_b16 %0, %1 offset:%2" : "=&v"(dst) : "v"(vb0), "i"(off) : "memory")
#define PV_D0(d0) do { s16x4 l0, l1, l2, l3, h0, h1, h2, h3; constexpr int b_ = VB * SHM_V + v_rd_off(d0, 0, 0);   \
        TRRD(l0, b_); TRRD(h0, b_ + 2048); TRRD(l1, b_ + 4096); TRRD(h1, b_ + 6144); TRRD(l2, b_ + 8192); TRRD(h2, b_ + 10240); TRRD(l3, b_ + 12288); TRRD(h3, b_ + 14336); \
        asm volatile("s_waitcnt lgkmcnt(0)" ::: "memory"); SBAR();   \
        o[d0] = __builtin_amdgcn_mfma_f32_32x32x16_bf16(pa0, (bf16x8){l0[0], l0[1], l0[2], l0[3], h0[0], h0[1], h0[2], h0[3]}, o[d0], 0, 0, 0);   \
        o[d0] = __builtin_amdgcn_mfma_f32_32x32x16_bf16(pa1, (bf16x8){l1[0], l1[1], l1[2], l1[3], h1[0], h1[1], h1[2], h1[3]}, o[d0], 0, 0, 0);   \
        o[d0] = __builtin_amdgcn_mfma_f32_32x32x16_bf16(pa2, (bf16x8){l2[0], l2[1], l2[2], l2[3], h2[0], h2[1], h2[2], h2[3]}, o[d0], 0, 0, 0);   \
        o[d0] = __builtin_amdgcn_mfma_f32_32x32x16_bf16(pa3, (bf16x8){l3[0], l3[1], l3[2], l3[3], h3[0], h3[1], h3[2], h3[3]}, o[d0], 0, 0, 0); } while (0)
    PV_D0(0); PV_D0(1); PV_D0(2); PV_D0(3);
#undef PV_D0
#undef TRRD
}
template <int MODE> __device__ __forceinline__ bool tile_act(int key0, int tj, const Lane L, unsigned sw0, unsigned sw1, unsigned sw2, unsigned sw3) {
    if constexpr (MODE == M_DIFF) return key0 <= L.qhi;
    else if constexpr (MODE == M_CMP) return 16 * key0 + 31 <= L.qhi;
    else if constexpr (MODE == M_WIN) return key0 <= L.qhi && key0 + 63 >= L.qlo - 511;
    else { const unsigned w = tj < 64 ? (tj < 32 ? sw0 : sw1) : (tj < 96 ? sw2 : sw3); return __any((int)((w >> (tj & 31)) & 1u)) != 0; }
}
template <int MODE> __device__ __forceinline__ bool tile_near(int key0, const Lane L) {
    if constexpr (MODE == M_CMP) return false; else return key0 + 63 > L.qlo - 113;
}
template <int MODE> __device__ __forceinline__ void tile_mask(f32x16& p0, f32x16& p1, int key0, int tj, const Lane L, int hi, bool act, unsigned sw0, unsigned sw1, unsigned sw2, unsigned sw3) {
    if (!act) return;
    if constexpr (MODE == M_DIFF) { if (key0 + 63 > L.qlo) mask_sel<MODE>(p0, p1, key0, tj, L, hi, true, sw0, sw1, sw2, sw3); }
    else if constexpr (MODE == M_CMP) { if (16 * (key0 + 63) + 31 > L.qlo) mask_sel<MODE>(p0, p1, key0, tj, L, hi, true, sw0, sw1, sw2, sw3); }
    else if constexpr (MODE == M_WIN) { if (key0 + 63 > L.qlo || key0 <= L.qhi - 512) mask_sel<MODE>(p0, p1, key0, tj, L, hi, true, sw0, sw1, sw2, sw3); }
    else { mask_sel<MODE>(p0, p1, key0, tj, L, hi, key0 + 63 > L.qlo, sw0, sw1, sw2, sw3); }
}
template <int MODE, int DQK>
__device__ __forceinline__ void attn_tiles(lchar* lds, const bf16_t* __restrict__ Kg, const bf16_t* __restrict__ Vg, int ld, int j_lo, int NT, const ALAS int* list,
                                           const bf16x8* qr, int koff, const Lane L, unsigned sw0, unsigned sw1, unsigned sw2, unsigned sw3, f32x16* o, float& m_reg, float& l_reg) {
    int tid = threadIdx.x; asm volatile("" : "+v"(tid));
    const int wid = __builtin_amdgcn_readfirstlane(tid >> 6), lane = tid & 63, r32 = lane & 31, hi = lane >> 5;
    lchar* V_lds = lds + L_V; lchar* K_lds = lds + L_K;
    ALAS float* al_l = (ALAS float*)(lds + L_WS) + wid * 64 + 32;
    m_reg = -1e30f; l_reg = 0.f; o[0] = f32x16{}; o[1] = f32x16{}; o[2] = f32x16{}; o[3] = f32x16{};
    const int sr = tid >> 4, sc = (tid & 15) * 8, vst0 = v_st(sr, sc), vst1 = v_st(32 + sr, sc), kws = KSWZ(sr, sc * 2);
    const unsigned vb0 = lds_addr(V_lds) + (unsigned)v_rd_base(lane);
    bf16x8 st_v0, st_v1, st_k0, st_k1;
#define TIDX(t) ((MODE == M_SLC) ? __builtin_amdgcn_readfirstlane(list[(t)]) : (j_lo + (t)))
#define SLOAD(t) do { const size_t k0_ = (size_t)TIDX(t) * KVBLK; st_v0 = *(const bf16x8*)(Vg + (k0_ + sr) * ld + sc); st_v1 = *(const bf16x8*)(Vg + (k0_ + 32 + sr) * ld + sc); \
                      st_k0 = *(const bf16x8*)(Kg + (k0_ + sr) * ld + sc); st_k1 = *(const bf16x8*)(Kg + (k0_ + 32 + sr) * ld + sc); } while (0)
#define SWRITE(bf) do { *(ALAS bf16x8*)(V_lds + (bf) * SHM_V + vst0) = st_v0; *(ALAS bf16x8*)(V_lds + (bf) * SHM_V + vst1) = st_v1; \
                        *(ALAS bf16x8*)(K_lds + (bf) * SHM_K + kws) = st_k0; *(ALAS bf16x8*)(K_lds + (bf) * SHM_K + kws + 32 * 256) = st_k1; } while (0)
#define VMW() asm volatile("s_waitcnt vmcnt(0)" ::: "memory")
#define RESC(a) do { if (__any((a) < 1.f)) { if (hi == 0) al_l[r32] = (a); asm volatile("s_waitcnt lgkmcnt(0)" ::: "memory");              \
                     _Pragma("unroll") for (int d_ = 0; d_ < 4; ++d_) _Pragma("unroll") for (int r = 0; r < 16; ++r) o[d_][r] *= al_l[crow(r, hi)]; } } while (0)
#define ACT(t) tile_act<MODE>(TIDX(t) * KVBLK, TIDX(t), L, sw0, sw1, sw2, sw3)
#define NEARB(t) tile_near<MODE>(TIDX(t) * KVBLK, L)
#define BB(t) (L.lut + 4u * (unsigned)(L.qpos - TIDX(t) * KVBLK - 4 * hi + LUT0 - 59))
#define MASKT(P0_, P1_, t, a_) tile_mask<MODE>(P0_, P1_, TIDX(t) * KVBLK, TIDX(t), L, hi, a_, sw0, sw1, sw2, sw3)
    f32x16 p0, p1; float al = 1.f; bf16x8 pa0, pa1, pa2, pa3;
    SLOAD(0); VMW(); SWRITE(0); SBAR();
    if (NT > 1) SLOAD(1);
    __syncthreads();
#define STEP(t, BF) do {                                                                                                  \
        const bool a_ = ACT(t);                                                                                           \
        SBAR(); qkt<BF, DQK>(p0, p1, K_lds, koff, r32, hi, qr, a_, NEARB(t), BB(t));                                      \
        MASKT(p0, p1, (t), a_); partialSM(p0, p1, m_reg, al); RESC(al);                                                   \
        finishSM(p0, p1, al, l_reg, pa0, pa1, pa2, pa3); SBAR();                                                          \
        if ((t) + 1 < NT) { VMW(); SWRITE((BF) ^ 1); SBAR(); if ((t) + 2 < NT) { SLOAD((t) + 2); SBAR(); } }              \
        pv_tile<BF>(o, vb0, pa0, pa1, pa2, pa3, a_);                                                                      \
        __syncthreads(); } while (0)
    int t = 0;
    for (; t + 1 < NT; t += 2) { STEP(t, 0); STEP(t + 1, 1); }
    if (t < NT) STEP(t, 0);
#undef STEP
#undef TIDX
#undef SLOAD
#undef SWRITE
#undef VMW
#undef RESC
#undef ACT
#undef NEARB
#undef BB
#undef MASKT
}
}
constexpr int NWAVES = 8;
#ifndef MK_N_LAUNCHES
#define MK_N_LAUNCHES 10
#endif
constexpr int N_LAUNCHES = MK_N_LAUNCHES;
constexpr int PER_PHASE = 10;
static_assert(N_LAUNCHES == 1 || N_LAUNCHES == PER_PHASE, "MK_N_LAUNCHES is 1 or 10");
constexpr int BATCH = 2, SEQ = 8192, TOK = BATCH * SEQ, DM = 2048, NPROJ = 5656, LDP = 5888, DFF = 5632, NUP = 2 * DFF, NIN = 23;
constexpr float EPS = 1e-6f, LOG2E = 1.4426950408889634f;
constexpr float C2D = 0.125f * LOG2E, C2N = 0.08838834764831845f * LOG2E;
constexpr int C_DQ = 0, C_DK = 1024, C_DV = 2048, C_NQ = 3072, C_KC = 4096, C_VC = 4352, C_KS = 4608, C_VS = 4864, C_KW = 5120, C_VW = 5376;
constexpr size_t MiB = 1u << 20, KiB = 1u << 10;
constexpr size_t WS_CTL = 0, CTL_ZERO_BYTES = 1 * MiB;
constexpr size_t WS_WDN = 1 * MiB;
constexpr size_t WS_CW1K = 23 * MiB, WS_CW1V = 25 * MiB;
constexpr size_t WS_CW2K = 27 * MiB, WS_CW2V = 27 * MiB + 64 * KiB;
constexpr size_t WS_MISC = 27 * MiB + 128 * KiB;
constexpr size_t WS_KCMP = 28 * MiB, WS_VCMP = 28 * MiB + 512 * KiB;
constexpr size_t WS_WIN = 29 * MiB;
constexpr size_t WS_WOUT = 52 * MiB;
constexpr size_t WS_WUP = 60 * MiB;
constexpr size_t WS_H = 104 * MiB;
constexpr size_t WS_Y2 = 29 * MiB;
constexpr size_t WS_PROJ = 168 * MiB;
constexpr size_t WS_ACT = 168 * MiB;
constexpr size_t WS_MIX = 352 * MiB;
constexpr size_t WS_HALO = 352 * MiB;
constexpr size_t WS_GATES = 416 * MiB;
constexpr size_t WS_NSAACC = 418 * MiB;
constexpr size_t WS_END = 450 * MiB;
constexpr int MISC_LAM = 0, MISC_B1 = 64, MISC_LUT = 8192;
constexpr int CW_BAR = 4096;
constexpr int RING_OFF = 0, RING_BYTES = 131072;
constexpr int LDSCTL_OFF = RING_BYTES, MISC_OFF = LDSCTL_OFF + 320;
constexpr int LDS_BYTES = 147456;
static_assert(att::L_END <= RING_BYTES && MISC_OFF + 128 <= LDS_BYTES, "LDS map");

#define GAS __attribute__((address_space(1)))
#define LAS __attribute__((address_space(3)))
typedef unsigned short bf16;
typedef unsigned v4u __attribute__((ext_vector_type(4)));
typedef unsigned v2u __attribute__((ext_vector_type(2)));
typedef float f32x4 __attribute__((ext_vector_type(4)));
typedef short bf16x8 __attribute__((ext_vector_type(8)));
typedef GAS unsigned gu32;
#define RLX_AGENT __ATOMIC_RELAXED, __HIP_MEMORY_SCOPE_AGENT
#define LDS_WAIT() asm volatile("s_waitcnt lgkmcnt(0)" ::: "memory")
#define VM_WAIT() asm volatile("s_waitcnt vmcnt(0)" ::: "memory")
__device__ __forceinline__ unsigned f2bf(float f) { unsigned u = __builtin_bit_cast(unsigned, f); return (u + 0x7fffu + ((u >> 16) & 1u)) >> 16; }
__device__ __forceinline__ unsigned pk2(float lo, float hi) { return f2bf(lo) | (f2bf(hi) << 16); }
__device__ __forceinline__ float gelu_tanh_f(float v) { const float z2 = 1.5957691216f * (v + 0.044715f * v * v * v); return v * __builtin_amdgcn_rcpf(1.0f + __builtin_amdgcn_exp2f(-1.4426950408889634f * z2)); }
#define XB_TMO      128
#define XB_XCNT(j)  (256  + 64 * (j))
#define XB_XSUB(j)  (1280 + 64 * (j))
#define XB_XGEN(j)  (2304 + 64 * (j))
#define XB_TOP      3328
#define XB_TOPGEN   3392
#define XCD_BAR_WORDS 3456
#define XB_SPIN_CAP (1u << 18)

__device__ __forceinline__ unsigned xb_ld(unsigned* p)              { return __hip_atomic_load(p, __ATOMIC_RELAXED, __HIP_MEMORY_SCOPE_AGENT); }
__device__ __forceinline__ unsigned xb_add(unsigned* p, unsigned v) { return __hip_atomic_fetch_add(p, v, __ATOMIC_RELAXED, __HIP_MEMORY_SCOPE_AGENT); }
__device__ __forceinline__ unsigned xb_xcc_id() { return (unsigned)__builtin_amdgcn_s_getreg((3 << 11) | 20) & 0xFu; }
#define XB_SPIN(cond, bar) do { unsigned _sp = 0; while (cond) { __builtin_amdgcn_s_sleep(1); \
    if ((++_sp & 255u) == 0u) { if (xb_ld(&(bar)[XB_TMO])) break; if (_sp > XB_SPIN_CAP) { atomicAdd(&(bar)[XB_TMO], 1u); break; } } } } while (0)

struct XcdBarrier {
    unsigned* bar; unsigned x;
    volatile LAS unsigned* st;
};

__device__ __forceinline__ XcdBarrier xcd_barrier_post(unsigned* bar, volatile LAS unsigned* st) {
    XcdBarrier b; b.bar = bar; b.x = xb_xcc_id(); b.st = st;
    if (threadIdx.x == 0) (void)xb_add(&bar[XB_XCNT(b.x)], 1u);
    return b;
}
__device__ __forceinline__ void xcd_barrier_complete(unsigned* bar, unsigned x, unsigned& nloc, unsigned& nx) {
    const unsigned G = gridDim.x * gridDim.y * gridDim.z;
    unsigned sum, cnt, mine, sp = 0u;
    for (;;) {
        sum = 0u; cnt = 0u; mine = 0u;
#pragma unroll
        for (unsigned j = 0; j < 16; ++j) { const unsigned c = xb_ld(&bar[XB_XCNT(j)]); sum += c; cnt += (c > 0u) ? 1u : 0u; mine = (j == x) ? c : mine; }
        if (sum == G) break;
        __builtin_amdgcn_s_sleep(1);
        if ((++sp & 255u) == 0u) { if (xb_ld(&bar[XB_TMO])) break; if (sp > XB_SPIN_CAP) { atomicAdd(&bar[XB_TMO], 1u); break; } }
    }
    nloc = mine > 0u ? mine : 1u; nx = cnt > 0u ? cnt : 1u;
}

__device__ __forceinline__ void xcd_barrier(const XcdBarrier& b) {
    asm volatile("s_waitcnt vmcnt(0)" ::: "memory");
    __syncthreads();
    if (threadIdx.x == 0) {
        unsigned* bar = b.bar;
        __builtin_amdgcn_s_waitcnt(0);
        unsigned nloc = b.st[0], nx = b.st[1];
        if (nloc == 0u) { xcd_barrier_complete(bar, b.x, nloc, nx); b.st[0] = nloc; b.st[1] = nx; }
        const unsigned old = xb_add(&bar[XB_XSUB(b.x)], 1u);
        const unsigned gen = old / nloc;
        if (old + 1u == (gen + 1u) * nloc) {
            __builtin_amdgcn_fence(__ATOMIC_RELEASE, "agent");
            asm volatile("s_waitcnt vmcnt(0)" ::: "memory");
            const unsigned og = xb_add(&bar[XB_TOP], 1u);
            const unsigned tg = og / nx;
            if (og + 1u == (tg + 1u) * nx) xb_add(&bar[XB_TOPGEN], 1u);
            else XB_SPIN(xb_ld(&bar[XB_TOPGEN]) == tg, bar);
            __builtin_amdgcn_fence(__ATOMIC_ACQUIRE, "agent");
            xb_add(&bar[XB_XGEN(b.x)], 1u);
            asm volatile("s_waitcnt vmcnt(0)" ::: "memory");
        } else {
            XB_SPIN(xb_ld(&bar[XB_XGEN(b.x)]) == gen, bar);
            __builtin_amdgcn_fence(__ATOMIC_ACQUIRE, "agent");
            asm volatile("s_waitcnt vmcnt(0)" ::: "memory");
        }
    }
    __syncthreads();
}
__device__ __forceinline__ float wave_sum(float v) {
#pragma unroll
    for (int o = 1; o < 64; o <<= 1) v += __shfl_xor(v, o);
    return v;
}
__device__ __forceinline__ void transpose_item(const float* __restrict__ W, int K, int N, int nblk, bf16* WT, int mode, LAS float* scr, int item, int lane) {
    const int kb = item / nblk, nb = item - kb * nblk, k0 = 64 * kb, n0 = 32 * nb;
    const int ncol = n0 + (lane & 31);
#pragma unroll 8
    for (int i = 0; i < 32; ++i) { const int kk = 2 * i + (lane >> 5); scr[kk * 33 + (lane & 31)] = (ncol < N) ? W[(size_t)(k0 + kk) * N + ncol] : 0.f; }
    LDS_WAIT(); asm volatile("" ::: "memory");
    int orow0 = n0;
    if (mode == 1) { const int bj = n0 / DFF, rem = n0 - bj * DFF; orow0 = (rem >> 7) * 256 + bj * 128 + (rem & 127); }
    const int c = lane & 7;
#pragma unroll
    for (int j = 0; j < 4; ++j) { const int n = (lane >> 3) + 8 * j; const LAS float* s = scr + (8 * c) * 33 + n;
        v4u o; o.x = pk2(s[0 * 33], s[1 * 33]); o.y = pk2(s[2 * 33], s[3 * 33]); o.z = pk2(s[4 * 33], s[5 * 33]); o.w = pk2(s[6 * 33], s[7 * 33]);
        *(v4u*)(WT + (size_t)(orow0 + n) * K + k0 + 8 * c) = o; }
    LDS_WAIT(); asm volatile("" ::: "memory");
}
__device__ __forceinline__ int t5_bucket(int d) {
    if (d < 16) return d;
    return 16 + (d >= 19) + (d >= 21) + (d >= 24) + (d >= 27) + (d >= 31) + (d >= 35) + (d >= 40) + (d >= 46) + (d >= 52) + (d >= 59) + (d >= 67) + (d >= 77) + (d >= 87) + (d >= 99) + (d >= 113);
}
__device__ __forceinline__ void rms_row_bf16(const float* xrow, const float* g, bf16* orow, int lane) {
    const f32x4* xr = (const f32x4*)xrow + lane; const f32x4* gr = (const f32x4*)g + lane;
    f32x4 v[8]; float s = 0.f;
#pragma unroll
    for (int j = 0; j < 8; ++j) { v[j] = xr[64 * j]; s += (v[j].x * v[j].x + v[j].y * v[j].y) + (v[j].z * v[j].z + v[j].w * v[j].w); }
    const float r = 1.0f / sqrtf(wave_sum(s) * (1.0f / DM) + EPS);
    v2u* o8 = (v2u*)orow + lane;
#pragma unroll
    for (int j = 0; j < 8; ++j) { const f32x4 gv = gr[64 * j]; v2u w; w.x = pk2(v[j].x * r * gv.x, v[j].y * r * gv.y); w.y = pk2(v[j].z * r * gv.z, v[j].w * r * gv.w); o8[64 * j] = w; }
}

struct Ptrs {
    const float* in[NIN]; float* out; unsigned char* ws;
};

__device__ __forceinline__ void p0_prologue(const Ptrs& P, LAS unsigned char* lds, int vcu, int G, int tid, int lane, int wave) {
    LAS float* scr = (LAS float*)(lds + RING_OFF + wave * 16384);
    const int gw = vcu * NWAVES + wave, NGW = G * NWAVES;
    constexpr int I_IN = 32 * 184, I_OUT = 32 * 64, I_UP = 32 * 352, I_DN = 88 * 64, I_C1 = 64 * 8, I_C2 = 4 * 4;
    constexpr int NITEMS = I_IN + I_OUT + I_UP + I_DN + 2 * I_C1 + 2 * I_C2;
    unsigned char* ws = P.ws;
    for (int it = gw; it < NITEMS; it += NGW) {
        int r = it;
        if (r < I_IN) { transpose_item(P.in[2], DM, NPROJ, 184, (bf16*)(ws + WS_WIN), 0, scr, r, lane); continue; } r -= I_IN;
        if (r < I_OUT) { transpose_item(P.in[15], DM, DM, 64, (bf16*)(ws + WS_WOUT), 0, scr, r, lane); continue; } r -= I_OUT;
        if (r < I_UP) { transpose_item(P.in[18], DM, NUP, 352, (bf16*)(ws + WS_WUP), 1, scr, r, lane); continue; } r -= I_UP;
        if (r < I_DN) { transpose_item(P.in[21], DFF, DM, 64, (bf16*)(ws + WS_WDN), 0, scr, r, lane); continue; } r -= I_DN;
        if (r < I_C1) { transpose_item(P.in[10], 4096, 256, 8, (bf16*)(ws + WS_CW1K), 0, scr, r, lane); continue; } r -= I_C1;
        if (r < I_C1) { transpose_item(P.in[12], 4096, 256, 8, (bf16*)(ws + WS_CW1V), 0, scr, r, lane); continue; } r -= I_C1;
        if (r < I_C2) { transpose_item(P.in[11], 256, 128, 4, (bf16*)(ws + WS_CW2K), 0, scr, r, lane); continue; } r -= I_C2;
        transpose_item(P.in[13], 256, 128, 4, (bf16*)(ws + WS_CW2V), 0, scr, r, lane);
    }
    for (int m = gw; m < TOK; m += NGW) rms_row_bf16(P.in[0] + (size_t)m * DM, P.in[1], (bf16*)(ws + WS_H) + (size_t)m * DM, lane);
    float* misc = (float*)(ws + WS_MISC);
    const int gt = vcu * (NWAVES * 64) + tid;
    if (gt < 2048) {
        const int h = gt >> 7, d = gt & 127; const float* rb = P.in[14];
        misc[MISC_LUT + gt] = (d < 113) ? (rb[t5_bucket(d) * 16 + h] - rb[31 * 16 + h]) * LOG2E : 0.f;
    }
    if (gt == 2048) {
        float s1 = 0.f, s2 = 0.f;
        for (int i = 0; i < 64; ++i) { s1 += P.in[3][i] * P.in[4][i]; s2 += P.in[5][i] * P.in[6][i]; }
        misc[MISC_LAM] = expf(s1) - expf(s2) + 0.2f;
    }
    if (gt >= 4096 && gt < 8192) {
        const int q = gt - 4096, which = q >> 11, kc = (q >> 8) & 7, n = q & 255;
        const float* pos = which ? P.in[9] : P.in[8]; const float* w1 = which ? P.in[12] : P.in[10];
        float s = 0.f;
        for (int k = 512 * kc; k < 512 * kc + 512; ++k) s += pos[k] * w1[(size_t)k * 256 + n];
        misc[MISC_B1 + (which * 8 + kc) * 256 + n] = s;
    }
}

__device__ __forceinline__ void cmp_unit(const Ptrs& P, LAS unsigned char* lds, int u, int tid, int lane, int wave) {
    typedef float f32x4_ __attribute__((ext_vector_type(4)));
    unsigned char* ws = P.ws;
    const int which = u >> 7, bg = (u >> 5) & 3, blk = u & 31, b = bg >> 1, g = bg & 1;
    const bf16* proj = (const bf16*)(ws + WS_PROJ);
    const bf16* w1T = (const bf16*)(ws + (which ? WS_CW1V : WS_CW1K));
    const bf16* w2T = (const bf16*)(ws + (which ? WS_CW2V : WS_CW2K));
    bf16* outp = (bf16*)(ws + (which ? WS_VCMP : WS_KCMP));
    const float* b1p = (const float*)(ws + WS_MISC) + MISC_B1 + which * 8 * 256;
    const int i = lane & 15, kq = lane >> 4;
    const int c = blk * 16 + i;
    const int srccol = (which ? C_VC : C_KC) + g * 128;
    const bf16* arow = proj + (size_t)b * SEQ * LDP + srccol + 8 * kq;
    const bf16* brow0 = w1T + (size_t)(32 * wave + i) * 4096 + 8 * kq;
    const bf16* brow1 = brow0 + (size_t)16 * 4096;
    f32x4_ acc0 = {0.f, 0.f, 0.f, 0.f}, acc1 = {0.f, 0.f, 0.f, 0.f};
#pragma unroll 4
    for (int ks = 0; ks < 128; ++ks) {
        int tok = 16 * c + (ks >> 2); tok = tok > SEQ - 1 ? SEQ - 1 : tok;
        const bf16x8 a = *(const bf16x8*)(arow + (size_t)tok * LDP + 32 * (ks & 3));
        const bf16x8 w0 = *(const bf16x8*)(brow0 + 32 * ks), w1 = *(const bf16x8*)(brow1 + 32 * ks);
        acc0 = __builtin_amdgcn_mfma_f32_16x16x32_bf16(a, w0, acc0, 0, 0, 0);
        acc1 = __builtin_amdgcn_mfma_f32_16x16x32_bf16(a, w1, acc1, 0, 0, 0);
    }
    LAS bf16* hid = (LAS bf16*)(lds + RING_OFF);
    __syncthreads();
#pragma unroll
    for (int nb = 0; nb < 2; ++nb) { const int n = 32 * wave + 16 * nb + i; float bs = 0.f;
#pragma unroll
        for (int kc = 0; kc < 8; ++kc) bs += b1p[kc * 256 + n];
#pragma unroll
        for (int r = 0; r < 4; ++r) { const float v = (nb ? acc1[r] : acc0[r]) + bs; hid[(4 * kq + r) * 264 + n] = (bf16)f2bf(gelu_tanh_f(v)); } }
    __syncthreads();
    f32x4_ acc2 = {0.f, 0.f, 0.f, 0.f};
    const bf16* b2row = w2T + (size_t)(16 * wave + i) * 256 + 8 * kq;
#pragma unroll
    for (int ks = 0; ks < 8; ++ks) {
        const bf16x8 a = *(const LAS bf16x8*)(hid + i * 264 + 32 * ks + 8 * kq);
        const bf16x8 w = *(const bf16x8*)(b2row + 32 * ks);
        acc2 = __builtin_amdgcn_mfma_f32_16x16x32_bf16(a, w, acc2, 0, 0, 0);
    }
#pragma unroll
    for (int r = 0; r < 4; ++r) { const int cc = blk * 16 + 4 * kq + r; outp[((size_t)bg * 512 + cc) * 128 + 16 * wave + i] = (cc >= 511) ? (bf16)0 : (bf16)f2bf(acc2[r]); }
    __syncthreads();
}

__device__ __forceinline__ void diff_unit(const Ptrs& P, LAS unsigned char* ldsb, int b, int h, int qb) {
    using namespace att;
    lchar* lds = (lchar*)ldsb;
    unsigned char* ws = P.ws;
    const bf16_t* proj = (const bf16_t*)(ws + WS_PROJ); bf16_t* mix = (bf16_t*)(ws + WS_MIX);
    const float* misc = (const float*)(ws + WS_MISC);
    int tid = threadIdx.x; asm volatile("" : "+v"(tid));
    const int wid = __builtin_amdgcn_readfirstlane(tid >> 6), lane = tid & 63, r32 = lane & 31, hi = lane >> 5;
    const int map = wid >> 2, wq = wid & 3, q0 = 128 * qb + 32 * wq;
    const size_t tokb = (size_t)b * SEQ;
    __syncthreads();
    if (tid < LUTX) { const int d = tid - LUT0; ((ALAS float*)(lds + L_LUT))[tid] = (d >= 0 && d < 113) ? misc[MISC_LUT + h * 128 + d] : 0.f; }
    const bf16_t* qp = proj + (tokb + q0 + r32) * LDP + C_DQ + h * 128 + map * 64 + hi * 8;
    bf16x8 qr[4];
#pragma unroll
    for (int d0 = 0; d0 < 4; ++d0) qr[d0] = *(const bf16x8*)(qp + d0 * 16);
    Lane L; L.qpos = q0 + r32; L.qlo = q0; L.qhi = q0 + 31; L.lut = lds_addr(lds + L_LUT);
    f32x16 o[4]; float m_reg, l_reg;
    attn_tiles<M_DIFF, 64>(lds, proj + tokb * LDP + C_DK + h * 128, proj + tokb * LDP + C_DV + h * 128, LDP, 0, 2 * (qb + 1), nullptr, qr, map * 128, L, 0u, 0u, 0u, 0u, o, m_reg, l_reg);
    ALAS float* li_l = (ALAS float*)(lds + L_WS) + wid * 64;
    if (hi == 0) li_l[r32] = l_reg;
    asm volatile("s_waitcnt lgkmcnt(0)" ::: "memory");
    float rli[16];
#pragma unroll
    for (int r = 0; r < 16; ++r) rli[r] = 1.0f / li_l[crow(r, hi)];
    ALAS float* X = (ALAS float*)(lds + L_V);
    if (map == 1) {
#pragma unroll
        for (int d0 = 0; d0 < 4; ++d0)
#pragma unroll
            for (int r = 0; r < 16; ++r) X[(wq * 64 + d0 * 16 + r) * 64 + lane] = o[d0][r] * rli[r];
    }
    __syncthreads();
    if (map == 0) {
        const float lam = misc[MISC_LAM]; const float* subln = P.in[7];
        float ss[16];
#pragma unroll
        for (int r = 0; r < 16; ++r) ss[r] = 0.f;
#pragma unroll
        for (int d0 = 0; d0 < 4; ++d0)
#pragma unroll
            for (int r = 0; r < 16; ++r) { const float o2 = X[(wq * 64 + d0 * 16 + r) * 64 + lane]; const float d = o[d0][r] * rli[r] - lam * o2; o[d0][r] = d; ss[r] += d * d; }
#pragma unroll
        for (int r = 0; r < 16; ++r) { float s = ss[r]; s += __shfl_xor(s, 1); s += __shfl_xor(s, 2); s += __shfl_xor(s, 4); s += __shfl_xor(s, 8); s += __shfl_xor(s, 16);
            ss[r] = 0.8f / sqrtf(s * (1.0f / 128.0f) + EPS); }
#pragma unroll
        for (int d0 = 0; d0 < 4; ++d0) { const float gsub = subln[32 * d0 + r32];
#pragma unroll
            for (int r = 0; r < 16; ++r) { const float v = o[d0][r] * ss[r] * gsub; const float vn = __shfl_xor(v, 1);
                if ((r32 & 1) == 0) *(unsigned*)(mix + (tokb + q0 + crow(r, hi)) * DM + h * 128 + 32 * d0 + r32) = cvtpk(v, vn); } }
    }
}

__device__ __forceinline__ void nsa_unit(const Ptrs& P, LAS unsigned char* ldsb, int bg, int qb) {
    using namespace att;
    lchar* lds = (lchar*)ldsb;
    unsigned char* ws = P.ws;
    const bf16_t* proj = (const bf16_t*)(ws + WS_PROJ); bf16_t* mix = (bf16_t*)(ws + WS_MIX);
    const bf16_t* kcmp = (const bf16_t*)(ws + WS_KCMP) + (size_t)bg * 512 * 128; const bf16_t* vcmp = (const bf16_t*)(ws + WS_VCMP) + (size_t)bg * 512 * 128;
    const float* misc = (const float*)(ws + WS_MISC); const float* gates = (const float*)(ws + WS_GATES);
    int tid = threadIdx.x; asm volatile("" : "+v"(tid));
    const int wid = __builtin_amdgcn_readfirstlane(tid >> 6), lane = tid & 63, r32 = lane & 31, hi = lane >> 5;
    const int b = bg >> 1, g = bg & 1, t0 = 64 * qb; const size_t tokb = (size_t)b * SEQ;
    const int ql = 8 * wid + (r32 >> 2), hg = r32 & 3;
    ALAS unsigned* imp = (ALAS unsigned*)(lds + L_IMP); ALAS unsigned* selm = (ALAS unsigned*)(lds + L_SEL); ALAS unsigned* un = (ALAS unsigned*)(lds + L_UN); ALAS int* list = (ALAS int*)(lds + L_LIST);
    ALAS float* li_l = (ALAS float*)(lds + L_WS) + wid * 64;
    __syncthreads();
    for (int i = tid; i < 64 * IMP_LD; i += NWAVES * 64) imp[i] = 0u;
    if (tid < 4) un[tid] = 0u;
    for (int i = tid; i < 4 * LUTX; i += NWAVES * 64) { const int hh = i / LUTX, d = i - hh * LUTX - LUT0; ((ALAS float*)(lds + L_LUT))[i] = (d >= 0 && d < 113) ? misc[MISC_LUT + (8 + g * 4 + hh) * 128 + d] : 0.f; }
    const bf16_t* qp = proj + (tokb + t0 + ql) * LDP + C_NQ + g * 512 + hg * 128 + hi * 8;
    bf16x8 qr[8];
#pragma unroll
    for (int d0 = 0; d0 < 8; ++d0) qr[d0] = *(const bf16x8*)(qp + d0 * 16);
    Lane L; L.qpos = t0 + ql; L.qlo = t0 + 8 * wid; L.qhi = L.qlo + 7; L.lut = lds_addr(lds + L_LUT) + (unsigned)hg * (LUTX * 4u);
    const float* gp = gates + (tokb + t0 + ql) * 32 + g * 12 + hg * 3;
    const float g_cmp = gp[0], g_slc = gp[1], g_win = gp[2];
    float* accp = (float*)(ws + WS_NSAACC) + ((size_t)blockIdx.x * NWAVES + wid) * 4096 + lane;
    f32x16 o[4]; float m_c, l_c, m_x, l_x;
    const int NTc = (((t0 + 63 - 31) >> 4) >> 6) + 1;
#ifndef NSA_PARTS
#define NSA_PARTS 31
#endif
    if (NSA_PARTS & 1) attn_tiles<M_CMP, 128>(lds, kcmp, vcmp, 128, 0, NTc, nullptr, qr, 0, L, 0u, 0u, 0u, 0u, o, m_c, l_c); else { m_c = 0.f; l_c = 1.f; o[0] = o[1] = o[2] = o[3] = f32x16{}; }
    { const float sc = l_c > 0.f ? g_cmp / l_c : 0.f; if (hi == 0) li_l[r32] = sc; asm volatile("s_waitcnt lgkmcnt(0)" ::: "memory");
      float* ap = accp;
#pragma unroll
      for (int d0 = 0; d0 < 4; ++d0)
#pragma unroll
          for (int r = 0; r < 16; ++r) { *ap = o[d0][r] * li_l[crow(r, hi)]; ap += 64; asm volatile("" : "+v"(ap)); } }
    if (NSA_PARTS & 2) { const float fx = (l_c > 0.f ? 1.0f / l_c : 0.f) * 268435456.0f;
      const int sr = tid >> 4, sc = (tid & 15) * 8, kws = KSWZ(sr, sc * 2);
      lchar* K_lds = lds + L_K;
      for (int t = 0; t < NTc; ++t) {
          const bf16x8 k0 = *(const bf16x8*)(kcmp + (size_t)(64 * t + sr) * 128 + sc), k1 = *(const bf16x8*)(kcmp + (size_t)(64 * t + 32 + sr) * 128 + sc);
          *(ALAS bf16x8*)(K_lds + kws) = k0; *(ALAS bf16x8*)(K_lds + kws + 32 * 256) = k1;
          __syncthreads();
          const bool act = 16 * (64 * t) + 31 <= L.qhi;
          if (act) {
              f32x16 p0, p1;
              qkt<0, 128>(p0, p1, K_lds, 0, r32, hi, qr, true, false, 0u);
              tile_mask<M_CMP>(p0, p1, 64 * t, t, L, hi, true, 0u, 0u, 0u, 0u);
#pragma unroll
              for (int r = 0; r < 16; ++r) { p0[r] = __builtin_amdgcn_exp2f(p0[r] - m_c) * fx; p1[r] = __builtin_amdgcn_exp2f(p1[r] - m_c) * fx; }
              ALAS unsigned* ir = imp + ql * IMP_LD + 16 * t + hi;
#pragma unroll
              for (int gi = 0; gi < 4; ++gi) {
                  const float a0 = p0[4 * gi], b0 = a0 + 2.0f * (p0[4 * gi + 1] + p0[4 * gi + 2] + p0[4 * gi + 3]);
                  const float a1 = p1[4 * gi], b1 = a1 + 2.0f * (p1[4 * gi + 1] + p1[4 * gi + 2] + p1[4 * gi + 3]);
                  __hip_atomic_fetch_add(ir + 2 * gi, (unsigned)a0, __ATOMIC_RELAXED, __HIP_MEMORY_SCOPE_WORKGROUP);
                  __hip_atomic_fetch_add(ir + 2 * gi + 1, (unsigned)b0, __ATOMIC_RELAXED, __HIP_MEMORY_SCOPE_WORKGROUP);
                  __hip_atomic_fetch_add(ir + 8 + 2 * gi, (unsigned)a1, __ATOMIC_RELAXED, __HIP_MEMORY_SCOPE_WORKGROUP);
                  __hip_atomic_fetch_add(ir + 8 + 2 * gi + 1, (unsigned)b1, __ATOMIC_RELAXED, __HIP_MEMORY_SCOPE_WORKGROUP);
              }
          }
          __syncthreads();
      }
    }
    if (NSA_PARTS & 4) { const int cur = qb;
      for (int qi = 0; qi < 8; ++qi) {
          const int qq = 8 * wid + qi; const int j0 = lane, j1 = lane + 64;
          unsigned k0, k1;
          { const unsigned v = imp[qq * IMP_LD + j0]; k0 = (j0 > cur) ? 0u : ((j0 == 0 || j0 == cur || j0 + 1 == cur) ? (0xFFFFFF80u | (unsigned)(127 - j0)) : ((v & ~127u) | (unsigned)(127 - j0))); }
          { const unsigned v = imp[qq * IMP_LD + j1]; k1 = (j1 > cur) ? 0u : ((j1 == cur || j1 + 1 == cur) ? (0xFFFFFF80u | (unsigned)(127 - j1)) : ((v & ~127u) | (unsigned)(127 - j1))); }
          unsigned thr = 0u;
          for (int bit = 31; bit >= 0; --bit) { const unsigned cand = thr | (1u << bit);
              const int cnt = __popcll(__ballot(k0 >= cand)) + __popcll(__ballot(k1 >= cand)); if (cnt >= 16) thr = cand; }
          const unsigned long long m0 = __ballot(k0 >= thr && k0 != 0u), m1 = __ballot(k1 >= thr && k1 != 0u);
          if (lane == 0) { selm[qq * 4 + 0] = (unsigned)m0; selm[qq * 4 + 1] = (unsigned)(m0 >> 32); selm[qq * 4 + 2] = (unsigned)m1; selm[qq * 4 + 3] = (unsigned)(m1 >> 32);
              __hip_atomic_fetch_or(un + 0, (unsigned)m0, __ATOMIC_RELAXED, __HIP_MEMORY_SCOPE_WORKGROUP); __hip_atomic_fetch_or(un + 1, (unsigned)(m0 >> 32), __ATOMIC_RELAXED, __HIP_MEMORY_SCOPE_WORKGROUP);
              __hip_atomic_fetch_or(un + 2, (unsigned)m1, __ATOMIC_RELAXED, __HIP_MEMORY_SCOPE_WORKGROUP); __hip_atomic_fetch_or(un + 3, (unsigned)(m1 >> 32), __ATOMIC_RELAXED, __HIP_MEMORY_SCOPE_WORKGROUP); }
      }
    }
    __syncthreads();
    int NTs; unsigned sw0, sw1, sw2, sw3;
    { const unsigned u0 = un[0], u1 = un[1], u2 = un[2], u3 = un[3];
      NTs = __popc(u0) + __popc(u1) + __popc(u2) + __popc(u3);
      if (tid < 128) { const int wsel = tid >> 5, bpos = tid & 31; const unsigned w = wsel == 0 ? u0 : (wsel == 1 ? u1 : (wsel == 2 ? u2 : u3));
          if ((w >> bpos) & 1u) { const int below = (wsel > 0 ? __popc(u0) : 0) + (wsel > 1 ? __popc(u1) : 0) + (wsel > 2 ? __popc(u2) : 0) + __popc(w & ((1u << bpos) - 1u)); list[below] = tid; } }
      sw0 = selm[ql * 4 + 0]; sw1 = selm[ql * 4 + 1]; sw2 = selm[ql * 4 + 2]; sw3 = selm[ql * 4 + 3]; }
    __syncthreads();
    m_x = 0.f; l_x = 1.f;
    if (NSA_PARTS & 8) attn_tiles<M_SLC, 128>(lds, proj + tokb * LDP + C_KS + g * 128, proj + tokb * LDP + C_VS + g * 128, LDP, 0, NTs, list, qr, 0, L, sw0, sw1, sw2, sw3, o, m_x, l_x);
    { const float sc = g_slc / l_x; if (hi == 0) li_l[r32] = sc; asm volatile("s_waitcnt lgkmcnt(0)" ::: "memory");
      float* ap = accp;
#pragma unroll
      for (int d0 = 0; d0 < 4; ++d0)
#pragma unroll
          for (int r = 0; r < 16; ++r) { *ap += o[d0][r] * li_l[crow(r, hi)]; ap += 64; asm volatile("" : "+v"(ap)); } }
    if (NSA_PARTS & 16) { const int jlo = qb > 8 ? qb - 8 : 0;
      attn_tiles<M_WIN, 128>(lds, proj + tokb * LDP + C_KW + g * 128, proj + tokb * LDP + C_VW + g * 128, LDP, jlo, qb - jlo + 1, nullptr, qr, 0, L, 0u, 0u, 0u, 0u, o, m_x, l_x); }
    { const float sc = g_win / l_x; if (hi == 0) li_l[r32] = sc; asm volatile("s_waitcnt lgkmcnt(0)" ::: "memory");
      float* ap = accp;
#pragma unroll
      for (int d0 = 0; d0 < 4; ++d0)
#pragma unroll
          for (int r = 0; r < 16; ++r) { const int rho = crow(r, hi); const float v = *ap + o[d0][r] * li_l[rho]; ap += 64; asm volatile("" : "+v"(ap)); const float vn = __shfl_xor(v, 1);
              if ((r32 & 1) == 0) *(unsigned*)(mix + (tokb + t0 + 8 * wid + (rho >> 2)) * DM + 1024 + g * 512 + (rho & 3) * 128 + 32 * d0 + r32) = cvtpk(v, vn); } }
}

__device__ __forceinline__ void p5_row(const float* xrow, float* yrow, const float* g1, const float* g2, bf16* hrow, int lane) {
    const f32x4* xr = (const f32x4*)xrow + lane; f32x4* yr = (f32x4*)yrow + lane; const f32x4* g1r = (const f32x4*)g1 + lane; const f32x4* g2r = (const f32x4*)g2 + lane;
    f32x4 v[8]; float s = 0.f;
#pragma unroll
    for (int j = 0; j < 8; ++j) { v[j] = yr[64 * j]; s += (v[j].x * v[j].x + v[j].y * v[j].y) + (v[j].z * v[j].z + v[j].w * v[j].w); }
    const float r1 = 1.0f / sqrtf(wave_sum(s) * (1.0f / DM) + EPS);
    float s2 = 0.f;
#pragma unroll
    for (int j = 0; j < 8; ++j) { const f32x4 xv = xr[64 * j], gv = g1r[64 * j]; v[j] = xv + v[j] * r1 * gv; yr[64 * j] = v[j]; s2 += (v[j].x * v[j].x + v[j].y * v[j].y) + (v[j].z * v[j].z + v[j].w * v[j].w); }
    const float r2 = 1.0f / sqrtf(wave_sum(s2) * (1.0f / DM) + EPS);
    v2u* o8 = (v2u*)hrow + lane;
#pragma unroll
    for (int j = 0; j < 8; ++j) { const f32x4 gv = g2r[64 * j]; v2u w; w.x = pk2(v[j].x * r2 * gv.x, v[j].y * r2 * gv.y); w.y = pk2(v[j].z * r2 * gv.z, v[j].w * r2 * gv.w); o8[64 * j] = w; }
}
__device__ __forceinline__ void p9_row(float* orow, const float* yrow, const float* g, int lane) {
    f32x4* xr = (f32x4*)orow + lane; const f32x4* yr = (const f32x4*)yrow + lane; const f32x4* gr = (const f32x4*)g + lane;
    f32x4 v[8]; float s = 0.f;
#pragma unroll
    for (int j = 0; j < 8; ++j) { v[j] = yr[64 * j]; s += (v[j].x * v[j].x + v[j].y * v[j].y) + (v[j].z * v[j].z + v[j].w * v[j].w); }
    const float r1 = 1.0f / sqrtf(wave_sum(s) * (1.0f / DM) + EPS);
#pragma unroll
    for (int j = 0; j < 8; ++j) { const f32x4 xv = xr[64 * j], gv = gr[64 * j]; xr[64 * j] = xv + v[j] * r1 * gv; }
}
__device__ __forceinline__ void p7_halo(const Ptrs& P, int gt, int NGT) {
    unsigned char* ws = P.ws; const float* halo = (const float*)(ws + WS_HALO); bf16* act = (bf16*)(ws + WS_ACT);
    const float* cw = P.in[19]; const float* cb = P.in[20];
    constexpr int C4 = DFF / 4;
    for (int it = gt; it < 256 * 2 * C4; it += NGT) {
        const int c4 = it % C4, i = (it / C4) & 1, s = it / (2 * C4), c = 4 * c4;
        const bool first = (s & 127) == 0;
        const f32x4 z = {0.f, 0.f, 0.f, 0.f};
        const float* hc = halo + ((size_t)s * 4 + i) * NUP + c;
        const int sp = first ? s : s - 1;
        const float* hp3 = halo + ((size_t)sp * 4 + 3) * NUP + c; const float* hp2 = halo + ((size_t)sp * 4 + 2) * NUP + c; const float* h0 = halo + ((size_t)s * 4 + 0) * NUP + c;
        const f32x4 cg = *(const f32x4*)hc, cu = *(const f32x4*)(hc + DFF);
        f32x4 g1, g2, u1, u2;
        if (i == 1) { g1 = *(const f32x4*)h0; u1 = *(const f32x4*)(h0 + DFF); if (first) { g2 = z; u2 = z; } else { g2 = *(const f32x4*)hp3; u2 = *(const f32x4*)(hp3 + DFF); } }
        else { if (first) { g1 = z; u1 = z; g2 = z; u2 = z; } else { g1 = *(const f32x4*)hp3; u1 = *(const f32x4*)(hp3 + DFF); g2 = *(const f32x4*)hp2; u2 = *(const f32x4*)(hp2 + DFF); } }
        const f32x4 wg0 = *(const f32x4*)(cw + c), wg1 = *(const f32x4*)(cw + NUP + c), wg2 = *(const f32x4*)(cw + 2 * NUP + c), bg = *(const f32x4*)(cb + c);
        const f32x4 wu0 = *(const f32x4*)(cw + DFF + c), wu1 = *(const f32x4*)(cw + NUP + DFF + c), wu2 = *(const f32x4*)(cw + 2 * NUP + DFF + c), bu = *(const f32x4*)(cb + DFF + c);
        const f32x4 yg = bg + wg0 * g2 + wg1 * g1 + wg2 * cg, yu = bu + wu0 * u2 + wu1 * u1 + wu2 * cu;
        v2u w; w.x = pk2(gelu_tanh_f(yg.x) * yu.x, gelu_tanh_f(yg.y) * yu.y); w.y = pk2(gelu_tanh_f(yg.z) * yu.z, gelu_tanh_f(yg.w) * yu.w);
        *(v2u*)(act + (size_t)(64 * s + i) * DFF + c) = w;
    }
}
struct Args { const float* in[NIN]; float* out; unsigned char* ws; int ph_lo, ph_hi; };
__global__ void __launch_bounds__(NWAVES * 64, 2) hybrid_fwd(Args args) {
    extern __shared__ __attribute__((aligned(16))) unsigned char lds_raw[];
    LAS unsigned char* lds = (LAS unsigned char*)lds_raw;
    volatile LAS unsigned* MISCW = (volatile LAS unsigned*)(lds + MISC_OFF);
    const int tid = threadIdx.x, lane = tid & 63, wave = __builtin_amdgcn_readfirstlane(tid >> 6);
    const int G = gridDim.x; const int bx = blockIdx.x; const int vcu = (G % 8 == 0) ? (bx % 8) * (G / 8) + bx / 8 : bx;
    Ptrs P;
#pragma unroll
    for (int i = 0; i < NIN; ++i) P.in[i] = args.in[i];
    P.out = args.out; P.ws = args.ws;
    unsigned char* ws = args.ws;
    gu32* ctl = (gu32*)(ws + WS_CTL);
    for (int u = tid; u < (LDS_BYTES - LDSCTL_OFF) / 4; u += NWAVES * 64) ((LAS unsigned*)(lds + LDSCTL_OFF))[u] = 0u;
    __syncthreads();
    XcdBarrier bar; bar.bar = (unsigned*)(ctl + CW_BAR); bar.x = 0; bar.st = nullptr;
    if (N_LAUNCHES == 1) bar = xcd_barrier_post((unsigned*)(ctl + CW_BAR), MISCW + 8);
#define GRID_BAR() do { if (N_LAUNCHES == 1) xcd_barrier(bar); } while (0)
    const int lo = args.ph_lo, hi = args.ph_hi;
#ifndef PH_MASK
#define PH_MASK 0x3ff
#endif
#define IN(k) (((PH_MASK >> (k)) & 1) && lo <= (k) && (k) < hi)
#define BOTH(k) (IN(k) && IN((k) + 1))
    const int gw = vcu * NWAVES + wave, NGW = G * NWAVES;

    if (IN(0)) { p0_prologue(P, lds, vcu, G, tid, lane, wave); if (BOTH(0)) GRID_BAR(); }

    if (IN(1)) {
        pg8::Gemm g{(const pg8::bf16_t*)(ws + WS_H), (const pg8::bf16_t*)(ws + WS_WIN), TOK, LDP, DM}; pg8::StaticOrder S; S.init(TOK, LDP, G, bx);
        pg8::EpiProj E{(pg8::bf16_t*)(ws + WS_PROJ), LDP, (float*)(ws + WS_GATES), C2D, C2N};
        pg8::gemm_phase<pg8::EpiProj, pg8::StaticOrder, true, true>(lds + RING_OFF, g, S, E);
        if (BOTH(1)) GRID_BAR();
    }

    if (IN(2)) {
        for (int u = vcu; u < 256; u += G) cmp_unit(P, lds, u, tid, lane, wave);
        for (int L = vcu; L < 256; L += G) {
            const int bh = L >> 4, s = L & 15;
#pragma unroll 1
            for (int i = 0; i < 4; ++i) { const int qb = (i == 0) ? 63 - s : (i == 1) ? 32 + s : (i == 2) ? 31 - s : s; diff_unit(P, lds, bh >> 3, bh & 7, qb); }
        }
        if (BOTH(2)) GRID_BAR();
    }

    if (IN(3)) {
        for (int L = vcu; L < 256; L += G) { const int bg = L >> 6, s = L & 63;
#pragma unroll 1
            for (int i = 0; i < 2; ++i) nsa_unit(P, lds, bg, i ? s : 127 - s); }
        if (BOTH(3)) GRID_BAR();
    }

    if (IN(4)) {
        __syncthreads();
        pg8::Gemm g{(const pg8::bf16_t*)(ws + WS_MIX), (const pg8::bf16_t*)(ws + WS_WOUT), TOK, DM, DM}; pg8::StaticOrder S; S.init(TOK, DM, G, bx);
        pg8::EpiF32 E{P.out, DM};
        pg8::gemm_phase<pg8::EpiF32, pg8::StaticOrder, true, true>(lds + RING_OFF, g, S, E);
        if (BOTH(4)) GRID_BAR();
    }

    if (IN(5)) {
        for (int m = gw; m < TOK; m += NGW) p5_row(P.in[0] + (size_t)m * DM, P.out + (size_t)m * DM, P.in[16], P.in[17], (bf16*)(ws + WS_H) + (size_t)m * DM, lane);
        if (BOTH(5)) GRID_BAR();
    }

    if (IN(6)) {
        pg8::Gemm g{(const pg8::bf16_t*)(ws + WS_H), (const pg8::bf16_t*)(ws + WS_WUP), TOK, NUP, DM}; pg8::StaticOrder S; S.init(TOK, NUP, G, bx);
        pg8::EpiUpGlu E{(pg8::bf16_t*)(ws + WS_ACT), (float*)(ws + WS_HALO), P.in[19], P.in[20], DFF};
        pg8::gemm_phase<pg8::EpiUpGlu, pg8::StaticOrder, true, true>(lds + RING_OFF, g, S, E);
        if (BOTH(6)) GRID_BAR();
    }

    if (IN(7)) { p7_halo(P, vcu * (NWAVES * 64) + tid, G * NWAVES * 64); if (BOTH(7)) GRID_BAR(); }

    if (IN(8)) {
        pg8::Gemm g{(const pg8::bf16_t*)(ws + WS_ACT), (const pg8::bf16_t*)(ws + WS_WDN), TOK, DM, DFF}; pg8::StaticOrder S; S.init(TOK, DM, G, bx);
        pg8::EpiF32 E{(float*)(ws + WS_Y2), DM};
        pg8::gemm_phase<pg8::EpiF32, pg8::StaticOrder, true, true>(lds + RING_OFF, g, S, E);
        if (BOTH(8)) GRID_BAR();
    }

    if (IN(9)) {
        for (int m = gw; m < TOK; m += NGW) p9_row(P.out + (size_t)m * DM, (const float*)(ws + WS_Y2) + (size_t)m * DM, P.in[22], lane);
    }
#undef IN
#undef BOTH
#undef GRID_BAR
}

extern "C" void kernel_launch(void* const* d_in, const int* in_sizes, int n_in, void* d_out, int out_size, void* d_ws, size_t ws_size, hipStream_t stream) {
    static int grid = 0;
    if (grid == 0) {
        if (n_in != NIN || in_sizes[0] != TOK * DM || out_size != TOK * DM || ws_size < WS_END) {
            fprintf(stderr, "kernel_launch: shape mismatch (n_in %d, in0 %d, out %d, ws %zu; need %zu bytes of workspace); nothing launched\n", n_in, n_in > 0 ? in_sizes[0] : -1, out_size, ws_size, (size_t)WS_END); grid = -1; return; }
        int dev = 0, cus = 0, per_cu = 0;
        if (hipGetDevice(&dev) != hipSuccess || hipDeviceGetAttribute(&cus, hipDeviceAttributeMultiprocessorCount, dev) != hipSuccess) { fprintf(stderr, "kernel_launch: device query failed\n"); grid = -1; return; }
        if (hipFuncSetAttribute((const void*)hybrid_fwd, hipFuncAttributeMaxDynamicSharedMemorySize, LDS_BYTES) != hipSuccess) { fprintf(stderr, "kernel_launch: hipFuncSetAttribute failed\n"); grid = -1; return; }
        if (hipOccupancyMaxActiveBlocksPerMultiprocessor(&per_cu, (const void*)hybrid_fwd, NWAVES * 64, LDS_BYTES) != hipSuccess || per_cu < 1)
            fprintf(stderr, "kernel_launch: note: occupancy query reports %d workgroups per CU\n", per_cu);
        (void)hipGetLastError();
        grid = cus;
    }
    if (grid < 0) return;
    if (hipMemsetAsync((char*)d_ws + WS_CTL, 0, CTL_ZERO_BYTES, stream) != hipSuccess) { fprintf(stderr, "kernel_launch: hipMemsetAsync failed\n"); return; }
    Args a{};
    for (int i = 0; i < NIN; ++i) a.in[i] = (const float*)d_in[i];
    a.out = (float*)d_out; a.ws = (unsigned char*)d_ws;
    for (int li = 0; li < N_LAUNCHES; ++li) {
        a.ph_lo = (N_LAUNCHES == PER_PHASE) ? li : 0; a.ph_hi = (N_LAUNCHES == PER_PHASE) ? li + 1 : PER_PHASE;
        hipLaunchKernelGGL(hybrid_fwd, dim3(grid), dim3(NWAVES * 64), LDS_BYTES, stream, a);
        const hipError_t le = hipPeekAtLastError();
        if (le != hipSuccess) { fprintf(stderr, "kernel_launch: launch %d failed: %s\n", li, hipGetErrorName(le)); break; }
    }
}
```

```cpp
#include <hip/hip_runtime.h>
#include <hip/hip_bf16.h>
#include <cstdio>
#include <cstdint>
namespace pg8 {
#define PG8_LAS __attribute__((address_space(3)))
typedef unsigned short bf16_t;
typedef short bf16x8 __attribute__((ext_vector_type(8)));
typedef float f32x4 __attribute__((ext_vector_type(4)));
typedef unsigned u32x4 __attribute__((ext_vector_type(4)));
constexpr int BM = 256, BK = 64, HALF = 128, HTB = HALF * BK * 2  , STAGE_BYTES = 8 * HTB, NXCD = 8, WGM = 8;

__host__ __device__ __forceinline__ int lds_byte(int r, int c) { const int st = (r >> 4) * 2 + (c >> 5), rr = r & 15, cc = c & 31, ob = rr * 64 + cc * 2; return st * 1024 + (ob ^ (((ob >> 9) & 1) << 5)); }
__host__ __device__ __forceinline__ void stage_rc(int b, int& R, int& C) { const int st = b / 1024, sb = b % 1024, swz = sb ^ (((sb >> 9) & 1) << 5); R = (st >> 1) * 16 + swz / 64; C = (st & 1) * 32 + (swz % 64) / 2; }
__host__ __device__ __forceinline__ int perm32(int rho) { const int n = rho >> 4, i = rho & 15; return 8 * (i >> 2) + 4 * n + (i & 3); }

struct Unit { int pm, pn; };
struct Gemm { const bf16_t* A; const bf16_t* Bt; int M, N, K; };

struct StaticOrder {
    int nM, nN, nwg, G, c;
    __host__ __device__ void init(int M, int N, int G_, int c_) { nM = M / BM; nN = N / BM; nwg = nM * nN; G = G_; c = c_; }
    __host__ __device__ bool next(int i, Unit& u) const {
        const long L = (long)i * G + c; if (L >= nwg) return false;
        int wgid = (int)L; { const int q = nwg / NXCD, r = nwg % NXCD, xcd = wgid % NXCD, off = wgid / NXCD; wgid = (xcd < r ? xcd * (q + 1) : r * (q + 1) + (xcd - r) * q) + off; }
        const int nig = WGM * nN, gid = wgid / nig, fm = gid * WGM, gsz = (nM - fm) < WGM ? (nM - fm) : WGM;
        u.pm = fm + ((wgid % nig) % gsz); u.pn = (wgid % nig) / gsz; return true;
    }
    __device__ __forceinline__ void a_ready(const Unit&) const {}
    __device__ __forceinline__ void done(const Unit&) const {}
};


__device__ __forceinline__ unsigned cvt_pk_bf16(float lo, float hi) { unsigned r; asm volatile("v_cvt_pk_bf16_f32 %0, %1, %2" : "=v"(r) : "v"(lo), "v"(hi)); return r; }
__device__ __forceinline__ float fast_sigmoid(float v) { return __builtin_amdgcn_rcpf(1.0f + __builtin_amdgcn_exp2f(-1.4426950408889634f * v)); }
__device__ __forceinline__ float gelu_tanh(float v) { const float z2 = 1.5957691216f * (v + 0.044715f * v * v * v); return v * __builtin_amdgcn_rcpf(1.0f + __builtin_amdgcn_exp2f(-1.4426950408889634f * z2)); }

struct EpiF32 {
    static constexpr bool PERM = false, AFTER_DRAIN = false;
    float* C; int ldc;
    __device__ __forceinline__ void operator()(const f32x4 (&acc)[2][2][4][2], const Unit& u, int wr, int wc, int fr, int fq) const {
        const int row0 = u.pm * BM + wr * 64 + fr, col0 = u.pn * BM + wc * 32 + 4 * fq;
#pragma unroll
        for (int ai = 0; ai < 2; ++ai)
#pragma unroll
            for (int m = 0; m < 4; ++m) { float* rowp = C + (size_t)(row0 + ai * HALF + m * 16) * ldc + col0;
#pragma unroll
                for (int bj = 0; bj < 2; ++bj)
#pragma unroll
                    for (int n = 0; n < 2; ++n) *(f32x4*)(rowp + bj * HALF + n * 16) = acc[ai][bj][m][n]; }
    }
};
struct EpiProj {
    static constexpr bool PERM = true, AFTER_DRAIN = false;
    bf16_t* O; int ldc; float* gates; float c2d, c2n;
    __device__ __forceinline__ void operator()(const f32x4 (&acc)[2][2][4][2], const Unit& u, int wr, int wc, int fr, int fq) const {
        const int pn = u.pn; const int row0 = u.pm * BM + wr * 64 + fr;
        if (pn == 22) {
            if (wc == 0) {
#pragma unroll
                for (int ai = 0; ai < 2; ++ai)
#pragma unroll
                    for (int m = 0; m < 4; ++m) { float* gp = gates + (size_t)(row0 + ai * HALF + m * 16) * 32 + 8 * fq;
#pragma unroll
                        for (int n = 0; n < 2; ++n) { const f32x4 v = acc[ai][0][m][n]; f32x4 s; s[0] = fast_sigmoid(v[0]); s[1] = fast_sigmoid(v[1]); s[2] = fast_sigmoid(v[2]); s[3] = fast_sigmoid(v[3]); *(f32x4*)(gp + 4 * n) = s; } }
            }
            return;
        }
        const float sc = (pn < 4) ? c2d : ((pn >= 12 && pn < 16) ? c2n : 1.0f);
        const int col0 = pn * BM + wc * 32 + 8 * fq;
#pragma unroll
        for (int ai = 0; ai < 2; ++ai)
#pragma unroll
            for (int m = 0; m < 4; ++m) { bf16_t* rowp = O + (size_t)(row0 + ai * HALF + m * 16) * ldc + col0;
#pragma unroll
                for (int bj = 0; bj < 2; ++bj) { const f32x4 v0 = acc[ai][bj][m][0] * sc, v1 = acc[ai][bj][m][1] * sc;
                    u32x4 w; w.x = cvt_pk_bf16(v0[0], v0[1]); w.y = cvt_pk_bf16(v0[2], v0[3]); w.z = cvt_pk_bf16(v1[0], v1[1]); w.w = cvt_pk_bf16(v1[2], v1[3]);
                    *(u32x4*)(rowp + bj * HALF) = w; } }
    }
};
__device__ __forceinline__ float dpp_shr1(float v) { return __builtin_bit_cast(float, __builtin_amdgcn_update_dpp(0, __builtin_bit_cast(int, v), 0x111, 0xF, 0xF, true)); }
__device__ __forceinline__ float dpp_shr2(float v) { return __builtin_bit_cast(float, __builtin_amdgcn_update_dpp(0, __builtin_bit_cast(int, v), 0x112, 0xF, 0xF, true)); }
__device__ __forceinline__ float dpp_shl15(float v) { return __builtin_bit_cast(float, __builtin_amdgcn_update_dpp(0, __builtin_bit_cast(int, v), 0x10F, 0xF, 0xF, true)); }
__device__ __forceinline__ float dpp_shl14(float v) { return __builtin_bit_cast(float, __builtin_amdgcn_update_dpp(0, __builtin_bit_cast(int, v), 0x10E, 0xF, 0xF, true)); }
struct EpiUpGlu {
    static constexpr bool PERM = true, AFTER_DRAIN = false;
    bf16_t* act; float* halo; const float* cw; const float* cb; int dff;
    __device__ __forceinline__ void operator()(const f32x4 (&acc)[2][2][4][2], const Unit& u, int wr, int wc, int fr, int fq) const {
        typedef unsigned u32x2 __attribute__((ext_vector_type(2)));
        const int nu = 2 * dff;
#pragma unroll
        for (int n = 0; n < 2; ++n) {
            const int cc = u.pn * HALF + wc * 32 + 8 * fq + 4 * n;
            const f32x4 wg0 = *(const f32x4*)(cw + cc), wg1 = *(const f32x4*)(cw + (size_t)nu + cc), wg2 = *(const f32x4*)(cw + (size_t)2 * nu + cc), bg = *(const f32x4*)(cb + cc);
            const f32x4 wu0 = *(const f32x4*)(cw + dff + cc), wu1 = *(const f32x4*)(cw + (size_t)nu + dff + cc), wu2 = *(const f32x4*)(cw + (size_t)2 * nu + dff + cc), bu = *(const f32x4*)(cb + dff + cc);
#pragma unroll
            for (int ai = 0; ai < 2; ++ai) {
                const int strip = 4 * u.pm + 2 * ai + wr; const int rowb = u.pm * BM + ai * HALF + wr * 64 + fr;
#pragma unroll
                for (int m = 0; m < 4; ++m) {
                    const f32x4 g = acc[ai][0][m][n], up = acc[ai][1][m][n]; f32x4 g1, g2, u1, u2;
#pragma unroll
                    for (int e = 0; e < 4; ++e) { g1[e] = dpp_shr1(g[e]); g2[e] = dpp_shr2(g[e]); u1[e] = dpp_shr1(up[e]); u2[e] = dpp_shr2(up[e]); }
                    if (m > 0) { const f32x4 gp = acc[ai][0][m > 0 ? m - 1 : 0][n], upp = acc[ai][1][m > 0 ? m - 1 : 0][n];
#pragma unroll
                        for (int e = 0; e < 4; ++e) { g1[e] += dpp_shl15(gp[e]); g2[e] += dpp_shl14(gp[e]); u1[e] += dpp_shl15(upp[e]); u2[e] += dpp_shl14(upp[e]); } }
                    const f32x4 yg = bg + wg0 * g2 + wg1 * g1 + wg2 * g;
                    const f32x4 yu = bu + wu0 * u2 + wu1 * u1 + wu2 * up;
                    if (m == 0 && fr < 2) { float* hp = halo + ((size_t)strip * 4 + fr) * nu + cc; *(f32x4*)hp = g; *(f32x4*)(hp + dff) = up; }
                    if (m == 3 && fr >= 14) { float* hp = halo + ((size_t)strip * 4 + 2 + (fr - 14)) * nu + cc; *(f32x4*)hp = g; *(f32x4*)(hp + dff) = up; }
                    if (m > 0 || fr >= 2) { u32x2 w; w.x = cvt_pk_bf16(gelu_tanh(yg[0]) * yu[0], gelu_tanh(yg[1]) * yu[1]); w.y = cvt_pk_bf16(gelu_tanh(yg[2]) * yu[2], gelu_tanh(yg[3]) * yu[3]);
                        *(u32x2*)(act + (size_t)(rowb + m * 16) * dff + cc) = w; }
                }
            }
        }
    }
};
template <class Epi, class Sched, bool ALIGN_EPI = false, bool SP2 = false>
__device__ __forceinline__ void gemm_phase(PG8_LAS unsigned char* lds, const Gemm g, const Sched& S, const Epi& E) {
    const int tid = threadIdx.x, wid = __builtin_amdgcn_readfirstlane(tid >> 6), lane = tid & 63, wr = wid >> 2, wc = wid & 3, fr = lane & 15, fq = lane >> 4;
    const int K = g.K, nt = K / BK;
    unsigned voffA[2], voffB[2];
#pragma unroll
    for (int i = 0; i < 2; ++i) { int R, C; stage_rc(tid * 16 + i * 8192, R, C); const int Rb = Epi::PERM ? ((R & ~31) + perm32(R & 31)) : R;
        voffA[i] = (unsigned)(R * K + C) * 2u; voffB[i] = (unsigned)(Rb * K + C) * 2u; }
    const size_t kstep = (size_t)(BK * 2);
    const size_t hstep = (size_t)HALF * K * 2;
    const size_t tstep = 2 * hstep;
    const unsigned ldsw = (unsigned)wid * 1024u;
    const int aoff = lds_byte(wr * 64 + fr, fq * 8), boff = lds_byte(wc * 32 + fr, fq * 8);
#define PG8_SA(b, h) (((b) * 2 + (h)) * HTB)
#define PG8_SB(b, h) ((4 + (b) * 2 + (h)) * HTB)
#define PG8_STAGE(bufoff, gbase, voff) do { _Pragma("unroll") for (int _i = 0; _i < 2; ++_i) \
        __builtin_amdgcn_global_load_lds((const unsigned*)((const char*)(gbase) + (voff)[_i]), (PG8_LAS unsigned*)(lds + (bufoff) + ldsw + _i * 8192), 16, 0, 0); } while (0)
#define PG8_LDA(dst, b, h) do { _Pragma("unroll") for (int m = 0; m < 4; ++m) _Pragma("unroll") for (int k = 0; k < 2; ++k) dst[m][k] = *(const PG8_LAS bf16x8*)(lds + PG8_SA(b, h) + aoff + m * 2048 + k * 1024); } while (0)
#define PG8_LDB(dst, b, h) do { _Pragma("unroll") for (int n = 0; n < 2; ++n) _Pragma("unroll") for (int k = 0; k < 2; ++k) dst[n][k] = *(const PG8_LAS bf16x8*)(lds + PG8_SB(b, h) + boff + n * 2048 + k * 1024); } while (0)
#define PG8_MMA(ai, bj, At, Bt) do { __builtin_amdgcn_s_setprio(1); _Pragma("unroll") for (int m = 0; m < 4; ++m) _Pragma("unroll") for (int n = 0; n < 2; ++n) _Pragma("unroll") for (int k = 0; k < 2; ++k) \
        acc[ai][bj][m][n] = __builtin_amdgcn_mfma_f32_16x16x32_bf16(Bt[n][k], At[m][k], acc[ai][bj][m][n], 0, 0, 0); __builtin_amdgcn_s_setprio(0); } while (0)
#define PG8_WAIT_V(n) asm volatile("s_waitcnt vmcnt(" #n ")" ::: "memory")
#define PG8_WAIT_L(n) asm volatile("s_waitcnt lgkmcnt(" #n ")" ::: "memory")
#define PG8_BAR __builtin_amdgcn_s_barrier()
#define PG8_SCHED __builtin_amdgcn_sched_barrier(0)
    Unit cur, nxt; int ui = 0;
    if (!S.next(0, cur)) return;
    f32x4 acc[2][2][4][2];
#pragma unroll
    for (int a = 0; a < 2; ++a)
#pragma unroll
        for (int b = 0; b < 2; ++b)
#pragma unroll
            for (int m = 0; m < 4; ++m)
#pragma unroll
                for (int n = 0; n < 2; ++n) acc[a][b][m][n] = (f32x4){0.f, 0.f, 0.f, 0.f};
    bf16x8 At[4][2], B0[2][2], B1[2][2];
    const char* cA = (const char*)g.A + (size_t)cur.pm * tstep; const char* cB = (const char*)g.Bt + (size_t)cur.pn * tstep;
    S.a_ready(cur);
    if constexpr (SP2) {
        PG8_STAGE(PG8_SB(0, 0), cB, voffB); PG8_STAGE(PG8_SB(0, 1), cB + hstep, voffB); PG8_STAGE(PG8_SA(0, 0), cA, voffA); PG8_STAGE(PG8_SA(0, 1), cA + hstep, voffA);
        if (wr == 1) PG8_BAR;
        PG8_WAIT_V(2); PG8_BAR;
        PG8_STAGE(PG8_SB(1, 0), cB + kstep, voffB); PG8_STAGE(PG8_SA(1, 0), cA + kstep, voffA); PG8_STAGE(PG8_SB(1, 1), cB + hstep + kstep, voffB);
        PG8_WAIT_V(6); PG8_BAR;
    } else {
        PG8_STAGE(PG8_SB(0, 0), cB, voffB); PG8_STAGE(PG8_SA(0, 0), cA, voffA); PG8_STAGE(PG8_SB(0, 1), cB + hstep, voffB); PG8_STAGE(PG8_SA(0, 1), cA + hstep, voffA);
        if (wr == 1) PG8_BAR;
        PG8_WAIT_V(4); PG8_BAR;
        PG8_STAGE(PG8_SB(1, 0), cB + kstep, voffB); PG8_STAGE(PG8_SA(1, 0), cA + kstep, voffA); PG8_STAGE(PG8_SB(1, 1), cB + hstep + kstep, voffB);
        PG8_WAIT_V(6); PG8_BAR;
    }
    for (;;) {
        const bool has_next = S.next(ui + 1, nxt);
        const char* nA = has_next ? (const char*)g.A + (size_t)nxt.pm * tstep : cA; const char* nB = has_next ? (const char*)g.Bt + (size_t)nxt.pn * tstep : cB;
        for (int t = 0; t < nt; t += 2) {
            const bool last = (t == nt - 2);
            const char* a1 = cA + (size_t)(t + 1) * kstep;
            const char* a2 = last ? nA : cA + (size_t)(t + 2) * kstep; const char* b2 = last ? nB : cB + (size_t)(t + 2) * kstep;
            const char* a3 = a2 + kstep; const char* b3 = b2 + kstep;
            if (last && has_next) S.a_ready(nxt);
            if constexpr (SP2) {
            PG8_LDB(B0, 0, 0); PG8_LDB(B1, 0, 1); PG8_SCHED; PG8_LDA(At, 0, 0); PG8_STAGE(PG8_SA(1, 1), a1 + hstep, voffA);
            PG8_WAIT_V(8); PG8_WAIT_L(0); PG8_BAR; PG8_MMA(0, 0, At, B0); PG8_MMA(0, 1, At, B1); PG8_BAR; PG8_SCHED;
            PG8_LDA(At, 0, 1); PG8_STAGE(PG8_SB(0, 0), b2, voffB); PG8_STAGE(PG8_SB(0, 1), b2 + hstep, voffB); PG8_STAGE(PG8_SA(0, 0), a2, voffA);
            PG8_WAIT_V(8); PG8_WAIT_L(0); PG8_BAR; PG8_MMA(1, 0, At, B0); PG8_MMA(1, 1, At, B1); PG8_BAR; PG8_SCHED;
            PG8_LDB(B0, 1, 0); PG8_LDB(B1, 1, 1); PG8_SCHED; PG8_LDA(At, 1, 0); PG8_STAGE(PG8_SA(0, 1), a2 + hstep, voffA);
            PG8_WAIT_V(8); PG8_WAIT_L(0); PG8_BAR; PG8_MMA(0, 0, At, B0); PG8_MMA(0, 1, At, B1); PG8_BAR; PG8_SCHED;
            PG8_LDA(At, 1, 1); PG8_STAGE(PG8_SB(1, 0), b3, voffB); PG8_STAGE(PG8_SB(1, 1), b3 + hstep, voffB); PG8_STAGE(PG8_SA(1, 0), a3, voffA);
            PG8_WAIT_V(8); PG8_WAIT_L(0); PG8_BAR; PG8_MMA(1, 0, At, B0); PG8_MMA(1, 1, At, B1); PG8_BAR; PG8_SCHED;
            } else {
            PG8_LDB(B0, 0, 0); PG8_SCHED; PG8_LDA(At, 0, 0); PG8_STAGE(PG8_SA(1, 1), a1 + hstep, voffA);
            PG8_WAIT_L(8); PG8_BAR; PG8_WAIT_L(0); PG8_MMA(0, 0, At, B0); PG8_BAR; PG8_SCHED;
            PG8_LDB(B1, 0, 1); PG8_STAGE(PG8_SB(0, 0), b2, voffB);
            PG8_BAR; PG8_WAIT_L(0); PG8_MMA(0, 1, At, B1); PG8_BAR;
            PG8_LDA(At, 0, 1); PG8_STAGE(PG8_SA(0, 0), a2, voffA);
            PG8_BAR; PG8_WAIT_L(0); PG8_MMA(1, 0, At, B0); PG8_BAR; PG8_SCHED;
            PG8_STAGE(PG8_SB(0, 1), b2 + hstep, voffB);
            PG8_WAIT_V(6); PG8_BAR; PG8_MMA(1, 1, At, B1); PG8_BAR;
            PG8_LDB(B0, 1, 0); PG8_SCHED; PG8_LDA(At, 1, 0); PG8_STAGE(PG8_SA(0, 1), a2 + hstep, voffA);
            PG8_WAIT_L(8); PG8_BAR; PG8_WAIT_L(0); PG8_MMA(0, 0, At, B0); PG8_BAR; PG8_SCHED;
            PG8_LDB(B1, 1, 1); PG8_STAGE(PG8_SB(1, 0), b3, voffB);
            PG8_BAR; PG8_WAIT_L(0); PG8_MMA(0, 1, At, B1); PG8_BAR;
            PG8_LDA(At, 1, 1); PG8_STAGE(PG8_SA(1, 0), a3, voffA);
            PG8_BAR; PG8_WAIT_L(0); PG8_MMA(1, 0, At, B0); PG8_BAR; PG8_SCHED;
            PG8_STAGE(PG8_SB(1, 1), b3 + hstep, voffB);
            PG8_WAIT_V(6); PG8_BAR; PG8_MMA(1, 1, At, B1); PG8_BAR;
            }
        }
        if constexpr (ALIGN_EPI) { if (wr == 0) PG8_BAR; }
        if constexpr (!Epi::AFTER_DRAIN) { E(acc, cur, wr, wc, fr, fq); S.done(cur); }
        if (!has_next) break;
#pragma unroll
        for (int a = 0; a < 2; ++a)
#pragma unroll
            for (int b = 0; b < 2; ++b)
#pragma unroll
                for (int m = 0; m < 4; ++m)
#pragma unroll
                    for (int n = 0; n < 2; ++n) acc[a][b][m][n] = (f32x4){0.f, 0.f, 0.f, 0.f};
        cur = nxt; cA = nA; cB = nB; ++ui;
        if constexpr (ALIGN_EPI) { if (wr == 1) PG8_BAR; }
    }
    PG8_WAIT_V(0);
    if constexpr (!ALIGN_EPI) { if (wr == 0) PG8_BAR; }
    PG8_BAR;
    if constexpr (Epi::AFTER_DRAIN) { E.fused(acc, cur, wr, wc, fr, fq, lds, wid, lane); S.done(cur); }
#undef PG8_SA
#undef PG8_SB
#undef PG8_STAGE
#undef PG8_LDA
#undef PG8_LDB
#undef PG8_MMA
#undef PG8_WAIT_V
#undef PG8_WAIT_L
#undef PG8_BAR
#undef PG8_SCHED
}
}
namespace att {
#define ALAS __attribute__((address_space(3)))
typedef unsigned short bf16_t;
typedef short bf16x8 __attribute__((ext_vector_type(8)));
typedef short s16x4 __attribute__((ext_vector_type(4)));
typedef float f32x16 __attribute__((ext_vector_type(16)));
typedef float f32x4 __attribute__((ext_vector_type(4)));
typedef unsigned u32x4 __attribute__((ext_vector_type(4)));
typedef ALAS char lchar;
constexpr int KVBLK = 64, SHM_K = 16384, SHM_V = 16384;
constexpr int LUTX = 320, LUT0 = 96;
constexpr int L_V = 0, L_K = 2 * SHM_V, L_WS = L_K + 2 * SHM_K, L_LUT = L_WS + 2048, L_IMP = L_LUT + 4 * LUTX * 4, IMP_LD = 132, L_SEL = L_IMP + 64 * IMP_LD * 4, L_UN = L_SEL + 1024, L_LIST = L_UN + 64, L_END = L_LIST + 512;
constexpr float THR = 8.0f;
enum { M_DIFF = 0, M_CMP = 1, M_SLC = 2, M_WIN = 3 };
#define KSWZ(row, colB) ((row) * 256 + ((colB) ^ (((row) & 7) << 4)))
#define SBAR() __builtin_amdgcn_sched_barrier(0)
__device__ __forceinline__ int v_st(int k, int c) { const int kk = (k & ~0xC) | ((k & 4) << 1) | ((k & 8) >> 1); return ((kk >> 3) * 4 + (c >> 5)) * 512 + ((kk & 7) * 32 + (c & 31)) * 2; }
__device__ __forceinline__ int v_rd_base(int lane) { return ((lane & 3) << 3) | (((lane >> 2) & 3) << 6) | (((lane >> 4) & 1) << 5) | (((lane >> 5) & 1) << 8); }
constexpr int v_rd_off(int d0, int ks, int half) { return d0 * 512 + ks * 4096 + half * 2048; }
__device__ __forceinline__ int crow(int r, int hi) { return (r & 3) + 8 * (r >> 2) + 4 * hi; }
__device__ __forceinline__ unsigned cvtpk(float lo, float hi) { unsigned r; asm volatile("v_cvt_pk_bf16_f32 %0, %1, %2" : "=v"(r) : "v"(lo), "v"(hi)); return r; }
__device__ __forceinline__ unsigned lds_addr(const lchar* p) { return (unsigned)(uintptr_t)p; }

struct Lane {
    int qpos;
    int qlo, qhi;
    unsigned lut;
};
template <int MODE>
__device__ __forceinline__ void mask_sel(f32x16& p0, f32x16& p1, int key0, int tj, const Lane L, int hi, bool cross, unsigned sw0, unsigned sw1, unsigned sw2, unsigned sw3) {
    const float NEG = -__builtin_inff();
    if constexpr (MODE == M_CMP) {
        const int lim = ((L.qpos - 31) >> 4) - key0 - 4 * hi;
#pragma unroll
        for (int r = 0; r < 16; ++r) { const int c = (r & 3) + 8 * (r >> 2); if (c > lim) p0[r] = NEG; if (c + 32 > lim) p1[r] = NEG; }
    } else {
        if constexpr (MODE == M_SLC) {
            const unsigned w = tj < 64 ? (tj < 32 ? sw0 : sw1) : (tj < 96 ? sw2 : sw3);
            if (((w >> (tj & 31)) & 1u) == 0u) {
#pragma unroll
                for (int r = 0; r < 16; ++r) { p0[r] = NEG; p1[r] = NEG; } }
        }
        if (cross) {
            const int dq = L.qpos - key0 - 4 * hi;
#pragma unroll
            for (int r = 0; r < 16; ++r) {
                const int c = (r & 3) + 8 * (r >> 2);
                if constexpr (MODE == M_WIN) { if ((unsigned)(dq - c) >= 512u) p0[r] = NEG; if ((unsigned)(dq - c - 32) >= 512u) p1[r] = NEG; }
                else { if (dq - c < 0) p0[r] = NEG; if (dq - c - 32 < 0) p1[r] = NEG; }
            }
        }
    }
}
__device__ __forceinline__ void partialSM(f32x16& p0, f32x16& p1, float& m_reg, float& alpha) {
    float pmax = p0[0];
#pragma unroll
    for (int r = 1; r < 16; ++r) pmax = fmaxf(pmax, p0[r]);
#pragma unroll
    for (int r = 0; r < 16; ++r) pmax = fmaxf(pmax, p1[r]);
    { auto rr = __builtin_amdgcn_permlane32_swap(__float_as_uint(pmax), __float_as_uint(pmax), false, false);
      pmax = fmaxf(__uint_as_float(rr[0]), __uint_as_float(rr[1])); }
    if (__builtin_expect(__all(pmax - m_reg <= THR), 1)) { alpha = 1.f; }
    else { const float mn = fmaxf(m_reg, pmax); alpha = __builtin_amdgcn_exp2f(m_reg - mn); m_reg = mn; }
    const float mm = m_reg;
#pragma unroll
    for (int r = 0; r < 16; ++r) { p0[r] = p0[r] - mm; p1[r] = p1[r] - mm; }
#pragma unroll
    for (int r = 0; r < 16; ++r) p0[r] = __builtin_amdgcn_exp2f(p0[r]);
}
__device__ __forceinline__ void finishSM(f32x16& p0, f32x16& p1, float alpha, float& l_reg, bf16x8& pa0, bf16x8& pa1, bf16x8& pa2, bf16x8& pa3) {
#pragma unroll
    for (int r = 0; r < 16; ++r) p1[r] = __builtin_amdgcn_exp2f(p1[r]);
    float ps = 0;
#pragma unroll
    for (int r = 0; r < 16; ++r) ps += p0[r];
#pragma unroll
    for (int r = 0; r < 16; ++r) ps += p1[r];
    { auto rr = __builtin_amdgcn_permlane32_swap(__float_as_uint(ps), __float_as_uint(ps), false, false);
      ps = __uint_as_float(rr[0]) + __uint_as_float(rr[1]); }
    l_reg = l_reg * alpha + ps;
#define PK4(P, B_, OUT) do { unsigned a0 = cvtpk(P[B_+0], P[B_+1]), a1 = cvtpk(P[B_+2], P[B_+3]);                          \
        unsigned b0 = cvtpk(P[B_+4], P[B_+5]), b1 = cvtpk(P[B_+6], P[B_+7]);                                             \
        auto r0 = __builtin_amdgcn_permlane32_swap(a0, b0, false, false); auto r1 = __builtin_amdgcn_permlane32_swap(a1, b1, false, false); \
        u32x4 w = {r0[0], r1[0], r0[1], r1[1]}; OUT = __builtin_bit_cast(bf16x8, w); } while (0)
    PK4(p0, 0, pa0); PK4(p0, 8, pa1); PK4(p1, 0, pa2); PK4(p1, 8, pa3);
#undef PK4
}
template <int KB, int DQK>
__device__ __forceinline__ void qkt(f32x16& p0, f32x16& p1, const lchar* K_lds, int koff, int r32, int hi, const bf16x8* qr, bool act, bool nearb, unsigned bb) {
    if (!act) { const float NEG = -__builtin_inff();
#pragma unroll
        for (int r = 0; r < 16; ++r) { p0[r] = NEG; p1[r] = NEG; } return; }
    if (nearb) {
#pragma unroll
        for (int r = 0; r < 16; ++r) { const int c = (r & 3) + 8 * (r >> 2);
            p0[r] = *(const ALAS float*)(uintptr_t)(bb + 4u * (unsigned)(59 - c)); p1[r] = *(const ALAS float*)(uintptr_t)(bb + 4u * (unsigned)(27 - c)); }
    } else { p0 = f32x16{}; p1 = f32x16{}; }
    const lchar* kb[4];
#pragma unroll
    for (int dd = 0; dd < 4; ++dd) kb[dd] = K_lds + KB * SHM_K + KSWZ(r32, (dd * 16 + hi * 8) * 2) + koff;
#pragma unroll
    for (int d0 = 0; d0 < DQK / 16; ++d0) { const lchar* a = kb[d0 & 3] + (d0 >> 2) * 128;
        const bf16x8 b0 = *reinterpret_cast<const ALAS bf16x8*>(a);
        const bf16x8 b1 = *reinterpret_cast<const ALAS bf16x8*>(a + 32 * 256);
        p0 = __builtin_amdgcn_mfma_f32_32x32x16_bf16(b0, qr[d0], p0, 0, 0, 0);
        p1 = __builtin_amdgcn_mfma_f32_32x32x16_bf16(b1, qr[d0], p1, 0, 0, 0); }
}
template <int VB>
__device__ __forceinline__ void pv_tile(f32x16* o, unsigned vb0, bf16x8 pa0, bf16x8 pa1, bf16x8 pa2, bf16x8 pa3, bool act) {
    if (!act) return;
#define TRRD(dst, off) asm volatile("ds_read_b64_tr_b16 %0, %1 offset:%2" : "=&v"(dst) : "v"(vb0), "i"(off) : "memory")
#define PV_D0(d0) do { s16x4 l0, l1, l2, l3, h0, h1, h2, h3; constexpr int b_ = VB * SHM_V + v_rd_off(d0, 0, 0);   \
        TRRD(l0, b_); TRRD(h0, b_ + 2048); TRRD(l1, b_ + 4096); TRRD(h1, b_ + 6144); TRRD(l2, b_ + 8192); TRRD(h2, b_ + 10240); TRRD(l3, b_ + 12288); TRRD(h3, b_ + 14336); \
        asm volatile("s_waitcnt lgkmcnt(0)" ::: "memory"); SBAR();   \
        o[d0] = __builtin_amdgcn_mfma_f32_32x32x16_bf16(pa0, (bf16x8){l0[0], l0[1], l0[2], l0[3], h0[0], h0[1], h0[2], h0[3]}, o[d0], 0, 0, 0);   \
        o[d0] = __builtin_amdgcn_mfma_f32_32x32x16_bf16(pa1, (bf16x8){l1[0], l1[1], l1[2], l1[3], h1[0], h1[1], h1[2], h1[3]}, o[d0], 0, 0, 0);   \
        o[d0] = __builtin_amdgcn_mfma_f32_32x32x16_bf16(pa2, (bf16x8){l2[0], l2[1], l2[2], l2[3], h2[0], h2[1], h2[2], h2[3]}, o[d0], 0, 0, 0);   \
        o[d0] = __builtin_amdgcn_mfma_f32_32x32x16_bf16(pa3, (bf16x8){l3[0], l3[1], l3[2], l3[3], h3[0], h3[1], h3[2], h3[3]}, o[d0], 0, 0, 0); } while (0)
    PV_D0(0); PV_D0(1); PV_D0(2); PV_D0(3);
#undef PV_D0
#undef TRRD
}
template <int MODE> __device__ __forceinline__ bool tile_act(int key0, int tj, const Lane L, unsigned sw0, unsigned sw1, unsigned sw2, unsigned sw3) {
    if constexpr (MODE == M_DIFF) return key0 <= L.qhi;
    else if constexpr (MODE == M_CMP) return 16 * key0 + 31 <= L.qhi;
    else if constexpr (MODE == M_WIN) return key0 <= L.qhi && key0 + 63 >= L.qlo - 511;
    else { const unsigned w = tj < 64 ? (tj < 32 ? sw0 : sw1) : (tj < 96 ? sw2 : sw3); return __any((int)((w >> (tj & 31)) & 1u)) != 0; }
}
template <int MODE> __device__ __forceinline__ bool tile_near(int key0, const Lane L) {
    if constexpr (MODE == M_CMP) return false; else return key0 + 63 > L.qlo - 113;
}
template <int MODE> __device__ __forceinline__ void tile_mask(f32x16& p0, f32x16& p1, int key0, int tj, const Lane L, int hi, bool act, unsigned sw0, unsigned sw1, unsigned sw2, unsigned sw3) {
    if (!act) return;
    if constexpr (MODE == M_DIFF) { if (key0 + 63 > L.qlo) mask_sel<MODE>(p0, p1, key0, tj, L, hi, true, sw0, sw1, sw2, sw3); }
    else if constexpr (MODE == M_CMP) { if (16 * (key0 + 63) + 31 > L.qlo) mask_sel<MODE>(p0, p1, key0, tj, L, hi, true, sw0, sw1, sw2, sw3); }
    else if constexpr (MODE == M_WIN) { if (key0 + 63 > L.qlo || key0 <= L.qhi - 512) mask_sel<MODE>(p0, p1, key0, tj, L, hi, true, sw0, sw1, sw2, sw3); }
    else { mask_sel<MODE>(p0, p1, key0, tj, L, hi, key0 + 63 > L.qlo, sw0, sw1, sw2, sw3); }
}
template <int MODE, int DQK>
__device__ __forceinline__ void attn_tiles(lchar* lds, const bf16_t* __restrict__ Kg, const bf16_t* __restrict__ Vg, int ld, int j_lo, int NT, const ALAS int* list,
                                           const bf16x8* qr, int koff, const Lane L, unsigned sw0, unsigned sw1, unsigned sw2, unsigned sw3, f32x16* o, float& m_reg, float& l_reg) {
    int tid = threadIdx.x; asm volatile("" : "+v"(tid));
    const int wid = __builtin_amdgcn_readfirstlane(tid >> 6), lane = tid & 63, r32 = lane & 31, hi = lane >> 5;
    lchar* V_lds = lds + L_V; lchar* K_lds = lds + L_K;
    ALAS float* al_l = (ALAS float*)(lds + L_WS) + wid * 64 + 32;
    m_reg = -1e30f; l_reg = 0.f; o[0] = f32x16{}; o[1] = f32x16{}; o[2] = f32x16{}; o[3] = f32x16{};
    const int sr = tid >> 4, sc = (tid & 15) * 8, vst0 = v_st(sr, sc), vst1 = v_st(32 + sr, sc), kws = KSWZ(sr, sc * 2);
    const unsigned vb0 = lds_addr(V_lds) + (unsigned)v_rd_base(lane);
    bf16x8 st_v0, st_v1, st_k0, st_k1;
#define TIDX(t) ((MODE == M_SLC) ? __builtin_amdgcn_readfirstlane(list[(t)]) : (j_lo + (t)))
#define SLOAD(t) do { const size_t k0_ = (size_t)TIDX(t) * KVBLK; st_v0 = *(const bf16x8*)(Vg + (k0_ + sr) * ld + sc); st_v1 = *(const bf16x8*)(Vg + (k0_ + 32 + sr) * ld + sc); \
                      st_k0 = *(const bf16x8*)(Kg + (k0_ + sr) * ld + sc); st_k1 = *(const bf16x8*)(Kg + (k0_ + 32 + sr) * ld + sc); } while (0)
#define SWRITE(bf) do { *(ALAS bf16x8*)(V_lds + (bf) * SHM_V + vst0) = st_v0; *(ALAS bf16x8*)(V_lds + (bf) * SHM_V + vst1) = st_v1; \
                        *(ALAS bf16x8*)(K_lds + (bf) * SHM_K + kws) = st_k0; *(ALAS bf16x8*)(K_lds + (bf) * SHM_K + kws + 32 * 256) = st_k1; } while (0)
#define VMW() asm volatile("s_waitcnt vmcnt(0)" ::: "memory")
#define RESC(a) do { if (__any((a) < 1.f)) { if (hi == 0) al_l[r32] = (a); asm volatile("s_waitcnt lgkmcnt(0)" ::: "memory");              \
                     _Pragma("unroll") for (int d_ = 0; d_ < 4; ++d_) _Pragma("unroll") for (int r = 0; r < 16; ++r) o[d_][r] *= al_l[crow(r, hi)]; } } while (0)
#define ACT(t) tile_act<MODE>(TIDX(t) * KVBLK, TIDX(t), L, sw0, sw1, sw2, sw3)
#define NEARB(t) tile_near<MODE>(TIDX(t) * KVBLK, L)
#define BB(t) (L.lut + 4u * (unsigned)(L.qpos - TIDX(t) * KVBLK - 4 * hi + LUT0 - 59))
#define MASKT(P0_, P1_, t, a_) tile_mask<MODE>(P0_, P1_, TIDX(t) * KVBLK, TIDX(t), L, hi, a_, sw0, sw1, sw2, sw3)
    f32x16 p0, p1; float al = 1.f; bf16x8 pa0, pa1, pa2, pa3;
    SLOAD(0); VMW(); SWRITE(0); SBAR();
    if (NT > 1) SLOAD(1);
    __syncthreads();
#define STEP(t, BF) do {                                                                                                  \
        const bool a_ = ACT(t);                                                                                           \
        SBAR(); qkt<BF, DQK>(p0, p1, K_lds, koff, r32, hi, qr, a_, NEARB(t), BB(t));                                      \
        MASKT(p0, p1, (t), a_); partialSM(p0, p1, m_reg, al); RESC(al);                                                   \
        finishSM(p0, p1, al, l_reg, pa0, pa1, pa2, pa3); SBAR();                                                          \
        if ((t) + 1 < NT) { VMW(); SWRITE((BF) ^ 1); SBAR(); if ((t) + 2 < NT) { SLOAD((t) + 2); SBAR(); } }              \
        pv_tile<BF>(o, vb0, pa0, pa1, pa2, pa3, a_);                                                                      \
        __syncthreads(); } while (0)
    int t = 0;
    for (; t + 1 < NT; t += 2) { STEP(t, 0); STEP(t + 1, 1); }
    if (t < NT) STEP(t, 0);
#undef STEP
#undef TIDX
#undef SLOAD
#undef SWRITE
#undef VMW
#undef RESC
#undef ACT
#undef NEARB
#undef BB
#undef MASKT
}
}
constexpr int NWAVES = 8;
#ifndef MK_N_LAUNCHES
#define MK_N_LAUNCHES 1
#endif
constexpr int N_LAUNCHES = MK_N_LAUNCHES;
constexpr int PER_PHASE = 10;
static_assert(N_LAUNCHES == 1 || N_LAUNCHES == PER_PHASE, "MK_N_LAUNCHES is 1 or 10");
constexpr int BATCH = 2, SEQ = 8192, TOK = BATCH * SEQ, DM = 2048, NPROJ = 5656, LDP = 5888, DFF = 5632, NUP = 2 * DFF, NIN = 23;
constexpr float EPS = 1e-6f, LOG2E = 1.4426950408889634f;
constexpr float C2D = 0.125f * LOG2E, C2N = 0.08838834764831845f * LOG2E;
constexpr int C_DQ = 0, C_DK = 1024, C_DV = 2048, C_NQ = 3072, C_KC = 4096, C_VC = 4352, C_KS = 4608, C_VS = 4864, C_KW = 5120, C_VW = 5376;
constexpr size_t MiB = 1u << 20, KiB = 1u << 10;
constexpr size_t WS_CTL = 0, CTL_ZERO_BYTES = 1 * MiB;
constexpr size_t WS_WDN = 1 * MiB;
constexpr size_t WS_CW1K = 23 * MiB, WS_CW1V = 25 * MiB;
constexpr size_t WS_CW2K = 27 * MiB, WS_CW2V = 27 * MiB + 64 * KiB;
constexpr size_t WS_MISC = 27 * MiB + 128 * KiB;
constexpr size_t WS_KCMP = 28 * MiB, WS_VCMP = 28 * MiB + 512 * KiB;
constexpr size_t WS_WIN = 29 * MiB;
constexpr size_t WS_WOUT = 52 * MiB;
constexpr size_t WS_WUP = 60 * MiB;
constexpr size_t WS_H = 104 * MiB;
constexpr size_t WS_Y2 = 29 * MiB;
constexpr size_t WS_PROJ = 168 * MiB;
constexpr size_t WS_ACT = 168 * MiB;
constexpr size_t WS_MIX = 352 * MiB;
constexpr size_t WS_HALO = 352 * MiB;
constexpr size_t WS_GATES = 416 * MiB;
constexpr size_t WS_NSAACC = 418 * MiB;
constexpr size_t WS_END = 450 * MiB;
constexpr int MISC_LAM = 0, MISC_B1 = 64, MISC_LUT = 8192;
constexpr int CW_BAR = 4096;
constexpr int RING_OFF = 0, RING_BYTES = 131072;
constexpr int LDSCTL_OFF = RING_BYTES, MISC_OFF = LDSCTL_OFF + 320;
constexpr int LDS_BYTES = 147456;
static_assert(att::L_END <= RING_BYTES && MISC_OFF + 128 <= LDS_BYTES, "LDS map");

#define GAS __attribute__((address_space(1)))
#define LAS __attribute__((address_space(3)))
typedef unsigned short bf16;
typedef unsigned v4u __attribute__((ext_vector_type(4)));
typedef unsigned v2u __attribute__((ext_vector_type(2)));
typedef float f32x4 __attribute__((ext_vector_type(4)));
typedef short bf16x8 __attribute__((ext_vector_type(8)));
typedef GAS unsigned gu32;
#define RLX_AGENT __ATOMIC_RELAXED, __HIP_MEMORY_SCOPE_AGENT
#define LDS_WAIT() asm volatile("s_waitcnt lgkmcnt(0)" ::: "memory")
#define VM_WAIT() asm volatile("s_waitcnt vmcnt(0)" ::: "memory")
__device__ __forceinline__ unsigned f2bf(float f) { unsigned u = __builtin_bit_cast(unsigned, f); return (u + 0x7fffu + ((u >> 16) & 1u)) >> 16; }
__device__ __forceinline__ unsigned pk2(float lo, float hi) { return f2bf(lo) | (f2bf(hi) << 16); }
__device__ __forceinline__ float gelu_tanh_f(float v) { const float z2 = 1.5957691216f * (v + 0.044715f * v * v * v); return v * __builtin_amdgcn_rcpf(1.0f + __builtin_amdgcn_exp2f(-1.4426950408889634f * z2)); }
#define XB_TMO      128
#define XB_XCNT(j)  (256  + 64 * (j))
#define XB_XSUB(j)  (1280 + 64 * (j))
#define XB_XGEN(j)  (2304 + 64 * (j))
#define XB_TOP      3328
#define XB_TOPGEN   3392
#define XCD_BAR_WORDS 3456
#define XB_SPIN_CAP (1u << 18)

__device__ __forceinline__ unsigned xb_ld(unsigned* p)              { return __hip_atomic_load(p, __ATOMIC_RELAXED, __HIP_MEMORY_SCOPE_AGENT); }
__device__ __forceinline__ unsigned xb_add(unsigned* p, unsigned v) { return __hip_atomic_fetch_add(p, v, __ATOMIC_RELAXED, __HIP_MEMORY_SCOPE_AGENT); }
__device__ __forceinline__ unsigned xb_xcc_id() { return (unsigned)__builtin_amdgcn_s_getreg((3 << 11) | 20) & 0xFu; }
#define XB_SPIN(cond, bar) do { unsigned _sp = 0; while (cond) { __builtin_amdgcn_s_sleep(1); \
    if ((++_sp & 255u) == 0u) { if (xb_ld(&(bar)[XB_TMO])) break; if (_sp > XB_SPIN_CAP) { atomicAdd(&(bar)[XB_TMO], 1u); break; } } } } while (0)

struct XcdBarrier {
    unsigned* bar; unsigned x;
    volatile LAS unsigned* st;
};

__device__ __forceinline__ XcdBarrier xcd_barrier_post(unsigned* bar, volatile LAS unsigned* st) {
    XcdBarrier b; b.bar = bar; b.x = xb_xcc_id(); b.st = st;
    if (threadIdx.x == 0) (void)xb_add(&bar[XB_XCNT(b.x)], 1u);
    return b;
}
__device__ __forceinline__ void xcd_barrier_complete(unsigned* bar, unsigned x, unsigned& nloc, unsigned& nx) {
    const unsigned G = gridDim.x * gridDim.y * gridDim.z;
    unsigned sum, cnt, mine, sp = 0u;
    for (;;) {
        sum = 0u; cnt = 0u; mine = 0u;
#pragma unroll
        for (unsigned j = 0; j < 16; ++j) { const unsigned c = xb_ld(&bar[XB_XCNT(j)]); sum += c; cnt += (c > 0u) ? 1u : 0u; mine = (j == x) ? c : mine; }
        if (sum == G) break;
        __builtin_amdgcn_s_sleep(1);
        if ((++sp & 255u) == 0u) { if (xb_ld(&bar[XB_TMO])) break; if (sp > XB_SPIN_CAP) { atomicAdd(&bar[XB_TMO], 1u); break; } }
    }
    nloc = mine > 0u ? mine : 1u; nx = cnt > 0u ? cnt : 1u;
}

__device__ __forceinline__ void xcd_barrier(const XcdBarrier& b) {
    asm volatile("s_waitcnt vmcnt(0)" ::: "memory");
    __syncthreads();
    if (threadIdx.x == 0) {
        unsigned* bar = b.bar;
        __builtin_amdgcn_s_waitcnt(0);
        unsigned nloc = b.st[0], nx = b.st[1];
        if (nloc == 0u) { xcd_barrier_complete(bar, b.x, nloc, nx); b.st[0] = nloc; b.st[1] = nx; }
        const unsigned old = xb_add(&bar[XB_XSUB(b.x)], 1u);
        const unsigned gen = old / nloc;
        if (old + 1u == (gen + 1u) * nloc) {
            __builtin_amdgcn_fence(__ATOMIC_RELEASE, "agent");
            asm volatile("s_waitcnt vmcnt(0)" ::: "memory");
            const unsigned og = xb_add(&bar[XB_TOP], 1u);
            const unsigned tg = og / nx;
            if (og + 1u == (tg + 1u) * nx) xb_add(&bar[XB_TOPGEN], 1u);
            else XB_SPIN(xb_ld(&bar[XB_TOPGEN]) == tg, bar);
            __builtin_amdgcn_fence(__ATOMIC_ACQUIRE, "agent");
            xb_add(&bar[XB_XGEN(b.x)], 1u);
            asm volatile("s_waitcnt vmcnt(0)" ::: "memory");
        } else {
            XB_SPIN(xb_ld(&bar[XB_XGEN(b.x)]) == gen, bar);
            __builtin_amdgcn_fence(__ATOMIC_ACQUIRE, "agent");
            asm volatile("s_waitcnt vmcnt(0)" ::: "memory");
        }
    }
    __syncthreads();
}
__device__ __forceinline__ float wave_sum(float v) {
#pragma unroll
    for (int o = 1; o < 64; o <<= 1) v += __shfl_xor(v, o);
    return v;
}
__device__ __forceinline__ void transpose_item(const float* __restrict__ W, int K, int N, int nblk, bf16* WT, int mode, LAS float* scr, int item, int lane) {
    const int kb = item / nblk, nb = item - kb * nblk, k0 = 64 * kb, n0 = 32 * nb;
    const int ncol = n0 + (lane & 31);
#pragma unroll 8
    for (int i = 0; i < 32; ++i) { const int kk = 2 * i + (lane >> 5); scr[kk * 33 + (lane & 31)] = (ncol < N) ? W[(size_t)(k0 + kk) * N + ncol] : 0.f; }
    LDS_WAIT(); asm volatile("" ::: "memory");
    int orow0 = n0;
    if (mode == 1) { const int bj = n0 / DFF, rem = n0 - bj * DFF; orow0 = (rem >> 7) * 256 + bj * 128 + (rem & 127); }
    const int c = lane & 7;
#pragma unroll
    for (int j = 0; j < 4; ++j) { const int n = (lane >> 3) + 8 * j; const LAS float* s = scr + (8 * c) * 33 + n;
        v4u o; o.x = pk2(s[0 * 33], s[1 * 33]); o.y = pk2(s[2 * 33], s[3 * 33]); o.z = pk2(s[4 * 33], s[5 * 33]); o.w = pk2(s[6 * 33], s[7 * 33]);
        *(v4u*)(WT + (size_t)(orow0 + n) * K + k0 + 8 * c) = o; }
    LDS_WAIT(); asm volatile("" ::: "memory");
}
__device__ __forceinline__ int t5_bucket(int d) {
    if (d < 16) return d;
    return 16 + (d >= 19) + (d >= 21) + (d >= 24) + (d >= 27) + (d >= 31) + (d >= 35) + (d >= 40) + (d >= 46) + (d >= 52) + (d >= 59) + (d >= 67) + (d >= 77) + (d >= 87) + (d >= 99) + (d >= 113);
}
__device__ __forceinline__ void rms_row_bf16(const float* xrow, const float* g, bf16* orow, int lane) {
    const f32x4* xr = (const f32x4*)xrow + lane; const f32x4* gr = (const f32x4*)g + lane;
    f32x4 v[8]; float s = 0.f;
#pragma unroll
    for (int j = 0; j < 8; ++j) { v[j] = xr[64 * j]; s += (v[j].x * v[j].x + v[j].y * v[j].y) + (v[j].z * v[j].z + v[j].w * v[j].w); }
    const float r = 1.0f / sqrtf(wave_sum(s) * (1.0f / DM) + EPS);
    v2u* o8 = (v2u*)orow + lane;
#pragma unroll
    for (int j = 0; j < 8; ++j) { const f32x4 gv = gr[64 * j]; v2u w; w.x = pk2(v[j].x * r * gv.x, v[j].y * r * gv.y); w.y = pk2(v[j].z * r * gv.z, v[j].w * r * gv.w); o8[64 * j] = w; }
}

struct Ptrs {
    const float* in[NIN]; float* out; unsigned char* ws;
};

__device__ __forceinline__ void p0_prologue(const Ptrs& P, LAS unsigned char* lds, int vcu, int G, int tid, int lane, int wave) {
    LAS float* scr = (LAS float*)(lds + RING_OFF + wave * 16384);
    const int gw = vcu * NWAVES + wave, NGW = G * NWAVES;
    constexpr int I_IN = 32 * 184, I_OUT = 32 * 64, I_UP = 32 * 352, I_DN = 88 * 64, I_C1 = 64 * 8, I_C2 = 4 * 4;
    constexpr int NITEMS = I_IN + I_OUT + I_UP + I_DN + 2 * I_C1 + 2 * I_C2;
    unsigned char* ws = P.ws;
    for (int it = gw; it < NITEMS; it += NGW) {
        int r = it;
        if (r < I_IN) { transpose_item(P.in[2], DM, NPROJ, 184, (bf16*)(ws + WS_WIN), 0, scr, r, lane); continue; } r -= I_IN;
        if (r < I_OUT) { transpose_item(P.in[15], DM, DM, 64, (bf16*)(ws + WS_WOUT), 0, scr, r, lane); continue; } r -= I_OUT;
        if (r < I_UP) { transpose_item(P.in[18], DM, NUP, 352, (bf16*)(ws + WS_WUP), 1, scr, r, lane); continue; } r -= I_UP;
        if (r < I_DN) { transpose_item(P.in[21], DFF, DM, 64, (bf16*)(ws + WS_WDN), 0, scr, r, lane); continue; } r -= I_DN;
        if (r < I_C1) { transpose_item(P.in[10], 4096, 256, 8, (bf16*)(ws + WS_CW1K), 0, scr, r, lane); continue; } r -= I_C1;
        if (r < I_C1) { transpose_item(P.in[12], 4096, 256, 8, (bf16*)(ws + WS_CW1V), 0, scr, r, lane); continue; } r -= I_C1;
        if (r < I_C2) { transpose_item(P.in[11], 256, 128, 4, (bf16*)(ws + WS_CW2K), 0, scr, r, lane); continue; } r -= I_C2;
        transpose_item(P.in[13], 256, 128, 4, (bf16*)(ws + WS_CW2V), 0, scr, r, lane);
    }
    for (int m = gw; m < TOK; m += NGW) rms_row_bf16(P.in[0] + (size_t)m * DM, P.in[1], (bf16*)(ws + WS_H) + (size_t)m * DM, lane);
    float* misc = (float*)(ws + WS_MISC);
    const int gt = vcu * (NWAVES * 64) + tid;
    if (gt < 2048) {
        const int h = gt >> 7, d = gt & 127; const float* rb = P.in[14];
        misc[MISC_LUT + gt] = (d < 113) ? (rb[t5_bucket(d) * 16 + h] - rb[31 * 16 + h]) * LOG2E : 0.f;
    }
    if (gt == 2048) {
        float s1 = 0.f, s2 = 0.f;
        for (int i = 0; i < 64; ++i) { s1 += P.in[3][i] * P.in[4][i]; s2 += P.in[5][i] * P.in[6][i]; }
        misc[MISC_LAM] = expf(s1) - expf(s2) + 0.2f;
    }
    if (gt >= 4096 && gt < 8192) {
        const int q = gt - 4096, which = q >> 11, kc = (q >> 8) & 7, n = q & 255;
        const float* pos = which ? P.in[9] : P.in[8]; const float* w1 = which ? P.in[12] : P.in[10];
        float s = 0.f;
        for (int k = 512 * kc; k < 512 * kc + 512; ++k) s += pos[k] * w1[(size_t)k * 256 + n];
        misc[MISC_B1 + (which * 8 + kc) * 256 + n] = s;
    }
}

__device__ __forceinline__ void cmp_unit(const Ptrs& P, LAS unsigned char* lds, int u, int tid, int lane, int wave) {
    typedef float f32x4_ __attribute__((ext_vector_type(4)));
    unsigned char* ws = P.ws;
    const int which = u >> 7, bg = (u >> 5) & 3, blk = u & 31, b = bg >> 1, g = bg & 1;
    const bf16* proj = (const bf16*)(ws + WS_PROJ);
    const bf16* w1T = (const bf16*)(ws + (which ? WS_CW1V : WS_CW1K));
    const bf16* w2T = (const bf16*)(ws + (which ? WS_CW2V : WS_CW2K));
    bf16* outp = (bf16*)(ws + (which ? WS_VCMP : WS_KCMP));
    const float* b1p = (const float*)(ws + WS_MISC) + MISC_B1 + which * 8 * 256;
    const int i = lane & 15, kq = lane >> 4;
    const int c = blk * 16 + i;
    const int srccol = (which ? C_VC : C_KC) + g * 128;
    const bf16* arow = proj + (size_t)b * SEQ * LDP + srccol + 8 * kq;
    const bf16* brow0 = w1T + (size_t)(32 * wave + i) * 4096 + 8 * kq;
    const bf16* brow1 = brow0 + (size_t)16 * 4096;
    f32x4_ acc0 = {0.f, 0.f, 0.f, 0.f}, acc1 = {0.f, 0.f, 0.f, 0.f};
#pragma unroll 4
    for (int ks = 0; ks < 128; ++ks) {
        int tok = 16 * c + (ks >> 2); tok = tok > SEQ - 1 ? SEQ - 1 : tok;
        const bf16x8 a = *(const bf16x8*)(arow + (size_t)tok * LDP + 32 * (ks & 3));
        const bf16x8 w0 = *(const bf16x8*)(brow0 + 32 * ks), w1 = *(const bf16x8*)(brow1 + 32 * ks);
        acc0 = __builtin_amdgcn_mfma_f32_16x16x32_bf16(a, w0, acc0, 0, 0, 0);
        acc1 = __builtin_amdgcn_mfma_f32_16x16x32_bf16(a, w1, acc1, 0, 0, 0);
    }
    LAS bf16* hid = (LAS bf16*)(lds + RING_OFF);
    __syncthreads();
#pragma unroll
    for (int nb = 0; nb < 2; ++nb) { const int n = 32 * wave + 16 * nb + i; float bs = 0.f;
#pragma unroll
        for (int kc = 0; kc < 8; ++kc) bs += b1p[kc * 256 + n];
#pragma unroll
        for (int r = 0; r < 4; ++r) { const float v = (nb ? acc1[r] : acc0[r]) + bs; hid[(4 * kq + r) * 264 + n] = (bf16)f2bf(gelu_tanh_f(v)); } }
    __syncthreads();
    f32x4_ acc2 = {0.f, 0.f, 0.f, 0.f};
    const bf16* b2row = w2T + (size_t)(16 * wave + i) * 256 + 8 * kq;
#pragma unroll
    for (int ks = 0; ks < 8; ++ks) {
        const bf16x8 a = *(const LAS bf16x8*)(hid + i * 264 + 32 * ks + 8 * kq);
        const bf16x8 w = *(const bf16x8*)(b2row + 32 * ks);
        acc2 = __builtin_amdgcn_mfma_f32_16x16x32_bf16(a, w, acc2, 0, 0, 0);
    }
#pragma unroll
    for (int r = 0; r < 4; ++r) { const int cc = blk * 16 + 4 * kq + r; outp[((size_t)bg * 512 + cc) * 128 + 16 * wave + i] = (cc >= 511) ? (bf16)0 : (bf16)f2bf(acc2[r]); }
    __syncthreads();
}

__device__ __forceinline__ void diff_unit(const Ptrs& P, LAS unsigned char* ldsb, int b, int h, int qb) {
    using namespace att;
    lchar* lds = (lchar*)ldsb;
    unsigned char* ws = P.ws;
    const bf16_t* proj = (const bf16_t*)(ws + WS_PROJ); bf16_t* mix = (bf16_t*)(ws + WS_MIX);
    const float* misc = (const float*)(ws + WS_MISC);
    int tid = threadIdx.x; asm volatile("" : "+v"(tid));
    const int wid = __builtin_amdgcn_readfirstlane(tid >> 6), lane = tid & 63, r32 = lane & 31, hi = lane >> 5;
    const int map = wid >> 2, wq = wid & 3, q0 = 128 * qb + 32 * wq;
    const size_t tokb = (size_t)b * SEQ;
    __syncthreads();
    if (tid < LUTX) { const int d = tid - LUT0; ((ALAS float*)(lds + L_LUT))[tid] = (d >= 0 && d < 113) ? misc[MISC_LUT + h * 128 + d] : 0.f; }
    const bf16_t* qp = proj + (tokb + q0 + r32) * LDP + C_DQ + h * 128 + map * 64 + hi * 8;
    bf16x8 qr[4];
#pragma unroll
    for (int d0 = 0; d0 < 4; ++d0) qr[d0] = *(const bf16x8*)(qp + d0 * 16);
    Lane L; L.qpos = q0 + r32; L.qlo = q0; L.qhi = q0 + 31; L.lut = lds_addr(lds + L_LUT);
    f32x16 o[4]; float m_reg, l_reg;
    attn_tiles<M_DIFF, 64>(lds, proj + tokb * LDP + C_DK + h * 128, proj + tokb * LDP + C_DV + h * 128, LDP, 0, 2 * (qb + 1), nullptr, qr, map * 128, L, 0u, 0u, 0u, 0u, o, m_reg, l_reg);
    ALAS float* li_l = (ALAS float*)(lds + L_WS) + wid * 64;
    if (hi == 0) li_l[r32] = l_reg;
    asm volatile("s_waitcnt lgkmcnt(0)" ::: "memory");
    float rli[16];
#pragma unroll
    for (int r = 0; r < 16; ++r) rli[r] = 1.0f / li_l[crow(r, hi)];
    ALAS float* X = (ALAS float*)(lds + L_V);
    if (map == 1) {
#pragma unroll
        for (int d0 = 0; d0 < 4; ++d0)
#pragma unroll
            for (int r = 0; r < 16; ++r) X[(wq * 64 + d0 * 16 + r) * 64 + lane] = o[d0][r] * rli[r];
    }
    __syncthreads();
    if (map == 0) {
        const float lam = misc[MISC_LAM]; const float* subln = P.in[7];
        float ss[16];
#pragma unroll
        for (int r = 0; r < 16; ++r) ss[r] = 0.f;
#pragma unroll
        for (int d0 = 0; d0 < 4; ++d0)
#pragma unroll
            for (int r = 0; r < 16; ++r) { const float o2 = X[(wq * 64 + d0 * 16 + r) * 64 + lane]; const float d = o[d0][r] * rli[r] - lam * o2; o[d0][r] = d; ss[r] += d * d; }
#pragma unroll
        for (int r = 0; r < 16; ++r) { float s = ss[r]; s += __shfl_xor(s, 1); s += __shfl_xor(s, 2); s += __shfl_xor(s, 4); s += __shfl_xor(s, 8); s += __shfl_xor(s, 16);
            ss[r] = 0.8f / sqrtf(s * (1.0f / 128.0f) + EPS); }
#pragma unroll
        for (int d0 = 0; d0 < 4; ++d0) { const float gsub = subln[32 * d0 + r32];
#pragma unroll
            for (int r = 0; r < 16; ++r) { const float v = o[d0][r] * ss[r] * gsub; const float vn = __shfl_xor(v, 1);
                if ((r32 & 1) == 0) *(unsigned*)(mix + (tokb + q0 + crow(r, hi)) * DM + h * 128 + 32 * d0 + r32) = cvtpk(v, vn); } }
    }
}

__device__ __forceinline__ void nsa_unit(const Ptrs& P, LAS unsigned char* ldsb, int bg, int qb) {
    using namespace att;
    lchar* lds = (lchar*)ldsb;
    unsigned char* ws = P.ws;
    const bf16_t* proj = (const bf16_t*)(ws + WS_PROJ); bf16_t* mix = (bf16_t*)(ws + WS_MIX);
    const bf16_t* kcmp = (const bf16_t*)(ws + WS_KCMP) + (size_t)bg * 512 * 128; const bf16_t* vcmp = (const bf16_t*)(ws + WS_VCMP) + (size_t)bg * 512 * 128;
    const float* misc = (const float*)(ws + WS_MISC); const float* gates = (const float*)(ws + WS_GATES);
    int tid = threadIdx.x; asm volatile("" : "+v"(tid));
    const int wid = __builtin_amdgcn_readfirstlane(tid >> 6), lane = tid & 63, r32 = lane & 31, hi = lane >> 5;
    const int b = bg >> 1, g = bg & 1, t0 = 64 * qb; const size_t tokb = (size_t)b * SEQ;
    const int ql = 8 * wid + (r32 >> 2), hg = r32 & 3;
    ALAS unsigned* imp = (ALAS unsigned*)(lds + L_IMP); ALAS unsigned* selm = (ALAS unsigned*)(lds + L_SEL); ALAS unsigned* un = (ALAS unsigned*)(lds + L_UN); ALAS int* list = (ALAS int*)(lds + L_LIST);
    ALAS float* li_l = (ALAS float*)(lds + L_WS) + wid * 64;
    __syncthreads();
    for (int i = tid; i < 64 * IMP_LD; i += NWAVES * 64) imp[i] = 0u;
    if (tid < 4) un[tid] = 0u;
    for (int i = tid; i < 4 * LUTX; i += NWAVES * 64) { const int hh = i / LUTX, d = i - hh * LUTX - LUT0; ((ALAS float*)(lds + L_LUT))[i] = (d >= 0 && d < 113) ? misc[MISC_LUT + (8 + g * 4 + hh) * 128 + d] : 0.f; }
    const bf16_t* qp = proj + (tokb + t0 + ql) * LDP + C_NQ + g * 512 + hg * 128 + hi * 8;
    bf16x8 qr[8];
#pragma unroll
    for (int d0 = 0; d0 < 8; ++d0) qr[d0] = *(const bf16x8*)(qp + d0 * 16);
    Lane L; L.qpos = t0 + ql; L.qlo = t0 + 8 * wid; L.qhi = L.qlo + 7; L.lut = lds_addr(lds + L_LUT) + (unsigned)hg * (LUTX * 4u);
    const float* gp = gates + (tokb + t0 + ql) * 32 + g * 12 + hg * 3;
    const float g_cmp = gp[0], g_slc = gp[1], g_win = gp[2];
    float* accp = (float*)(ws + WS_NSAACC) + ((size_t)blockIdx.x * NWAVES + wid) * 4096 + lane;
    f32x16 o[4]; float m_c, l_c, m_x, l_x;
    const int NTc = (((t0 + 63 - 31) >> 4) >> 6) + 1;
#ifndef NSA_PARTS
#define NSA_PARTS 31
#endif
    if (NSA_PARTS & 1) attn_tiles<M_CMP, 128>(lds, kcmp, vcmp, 128, 0, NTc, nullptr, qr, 0, L, 0u, 0u, 0u, 0u, o, m_c, l_c); else { m_c = 0.f; l_c = 1.f; o[0] = o[1] = o[2] = o[3] = f32x16{}; }
    { const float sc = l_c > 0.f ? g_cmp / l_c : 0.f; if (hi == 0) li_l[r32] = sc; asm volatile("s_waitcnt lgkmcnt(0)" ::: "memory");
      float* ap = accp;
#pragma unroll
      for (int d0 = 0; d0 < 4; ++d0)
#pragma unroll
          for (int r = 0; r < 16; ++r) { *ap = o[d0][r] * li_l[crow(r, hi)]; ap += 64; asm volatile("" : "+v"(ap)); } }
    if (NSA_PARTS & 2) { const float fx = (l_c > 0.f ? 1.0f / l_c : 0.f) * 268435456.0f;
      const int sr = tid >> 4, sc = (tid & 15) * 8, kws = KSWZ(sr, sc * 2);
      lchar* K_lds = lds + L_K;
      for (int t = 0; t < NTc; ++t) {
          const bf16x8 k0 = *(const bf16x8*)(kcmp + (size_t)(64 * t + sr) * 128 + sc), k1 = *(const bf16x8*)(kcmp + (size_t)(64 * t + 32 + sr) * 128 + sc);
          *(ALAS bf16x8*)(K_lds + kws) = k0; *(ALAS bf16x8*)(K_lds + kws + 32 * 256) = k1;
          __syncthreads();
          const bool act = 16 * (64 * t) + 31 <= L.qhi;
          if (act) {
              f32x16 p0, p1;
              qkt<0, 128>(p0, p1, K_lds, 0, r32, hi, qr, true, false, 0u);
              tile_mask<M_CMP>(p0, p1, 64 * t, t, L, hi, true, 0u, 0u, 0u, 0u);
#pragma unroll
              for (int r = 0; r < 16; ++r) { p0[r] = __builtin_amdgcn_exp2f(p0[r] - m_c) * fx; p1[r] = __builtin_amdgcn_exp2f(p1[r] - m_c) * fx; }
              ALAS unsigned* ir = imp + ql * IMP_LD + 16 * t + hi;
#pragma unroll
              for (int gi = 0; gi < 4; ++gi) {
                  const float a0 = p0[4 * gi], b0 = a0 + 2.0f * (p0[4 * gi + 1] + p0[4 * gi + 2] + p0[4 * gi + 3]);
                  const float a1 = p1[4 * gi], b1 = a1 + 2.0f * (p1[4 * gi + 1] + p1[4 * gi + 2] + p1[4 * gi + 3]);
                  __hip_atomic_fetch_add(ir + 2 * gi, (unsigned)a0, __ATOMIC_RELAXED, __HIP_MEMORY_SCOPE_WORKGROUP);
                  __hip_atomic_fetch_add(ir + 2 * gi + 1, (unsigned)b0, __ATOMIC_RELAXED, __HIP_MEMORY_SCOPE_WORKGROUP);
                  __hip_atomic_fetch_add(ir + 8 + 2 * gi, (unsigned)a1, __ATOMIC_RELAXED, __HIP_MEMORY_SCOPE_WORKGROUP);
                  __hip_atomic_fetch_add(ir + 8 + 2 * gi + 1, (unsigned)b1, __ATOMIC_RELAXED, __HIP_MEMORY_SCOPE_WORKGROUP);
              }
          }
          __syncthreads();
      }
    }
    if (NSA_PARTS & 4) { const int cur = qb;
      for (int qi = 0; qi < 8; ++qi) {
          const int qq = 8 * wid + qi; const int j0 = lane, j1 = lane + 64;
          unsigned k0, k1;
          { const unsigned v = imp[qq * IMP_LD + j0]; k0 = (j0 > cur) ? 0u : ((j0 == 0 || j0 == cur || j0 + 1 == cur) ? (0xFFFFFF80u | (unsigned)(127 - j0)) : ((v & ~127u) | (unsigned)(127 - j0))); }
          { const unsigned v = imp[qq * IMP_LD + j1]; k1 = (j1 > cur) ? 0u : ((j1 == cur || j1 + 1 == cur) ? (0xFFFFFF80u | (unsigned)(127 - j1)) : ((v & ~127u) | (unsigned)(127 - j1))); }
          unsigned thr = 0u;
          for (int bit = 31; bit >= 0; --bit) { const unsigned cand = thr | (1u << bit);
              const int cnt = __popcll(__ballot(k0 >= cand)) + __popcll(__ballot(k1 >= cand)); if (cnt >= 16) thr = cand; }
          const unsigned long long m0 = __ballot(k0 >= thr && k0 != 0u), m1 = __ballot(k1 >= thr && k1 != 0u);
          if (lane == 0) { selm[qq * 4 + 0] = (unsigned)m0; selm[qq * 4 + 1] = (unsigned)(m0 >> 32); selm[qq * 4 + 2] = (unsigned)m1; selm[qq * 4 + 3] = (unsigned)(m1 >> 32);
              __hip_atomic_fetch_or(un + 0, (unsigned)m0, __ATOMIC_RELAXED, __HIP_MEMORY_SCOPE_WORKGROUP); __hip_atomic_fetch_or(un + 1, (unsigned)(m0 >> 32), __ATOMIC_RELAXED, __HIP_MEMORY_SCOPE_WORKGROUP);
              __hip_atomic_fetch_or(un + 2, (unsigned)m1, __ATOMIC_RELAXED, __HIP_MEMORY_SCOPE_WORKGROUP); __hip_atomic_fetch_or(un + 3, (unsigned)(m1 >> 32), __ATOMIC_RELAXED, __HIP_MEMORY_SCOPE_WORKGROUP); }
      }
    }
    __syncthreads();
    int NTs; unsigned sw0, sw1, sw2, sw3;
    { const unsigned u0 = un[0], u1 = un[1], u2 = un[2], u3 = un[3];
      NTs = __popc(u0) + __popc(u1) + __popc(u2) + __popc(u3);
      if (tid < 128) { const int wsel = tid >> 5, bpos = tid & 31; const unsigned w = wsel == 0 ? u0 : (wsel == 1 ? u1 : (wsel == 2 ? u2 : u3));
          if ((w >> bpos) & 1u) { const int below = (wsel > 0 ? __popc(u0) : 0) + (wsel > 1 ? __popc(u1) : 0) + (wsel > 2 ? __popc(u2) : 0) + __popc(w & ((1u << bpos) - 1u)); list[below] = tid; } }
      sw0 = selm[ql * 4 + 0]; sw1 = selm[ql * 4 + 1]; sw2 = selm[ql * 4 + 2]; sw3 = selm[ql * 4 + 3]; }
    __syncthreads();
    m_x = 0.f; l_x = 1.f;
    if (NSA_PARTS & 8) attn_tiles<M_SLC, 128>(lds, proj + tokb * LDP + C_KS + g * 128, proj + tokb * LDP + C_VS + g * 128, LDP, 0, NTs, list, qr, 0, L, sw0, sw1, sw2, sw3, o, m_x, l_x);
    { const float sc = g_slc / l_x; if (hi == 0) li_l[r32] = sc; asm volatile("s_waitcnt lgkmcnt(0)" ::: "memory");
      float* ap = accp;
#pragma unroll
      for (int d0 = 0; d0 < 4; ++d0)
#pragma unroll
          for (int r = 0; r < 16; ++r) { *ap += o[d0][r] * li_l[crow(r, hi)]; ap += 64; asm volatile("" : "+v"(ap)); } }
    if (NSA_PARTS & 16) { const int jlo = qb > 8 ? qb - 8 : 0;
      attn_tiles<M_WIN, 128>(lds, proj + tokb * LDP + C_KW + g * 128, proj + tokb * LDP + C_VW + g * 128, LDP, jlo, qb - jlo + 1, nullptr, qr, 0, L, 0u, 0u, 0u, 0u, o, m_x, l_x); }
    { const float sc = g_win / l_x; if (hi == 0) li_l[r32] = sc; asm volatile("s_waitcnt lgkmcnt(0)" ::: "memory");
      float* ap = accp;
#pragma unroll
      for (int d0 = 0; d0 < 4; ++d0)
#pragma unroll
          for (int r = 0; r < 16; ++r) { const int rho = crow(r, hi); const float v = *ap + o[d0][r] * li_l[rho]; ap += 64; asm volatile("" : "+v"(ap)); const float vn = __shfl_xor(v, 1);
              if ((r32 & 1) == 0) *(unsigned*)(mix + (tokb + t0 + 8 * wid + (rho >> 2)) * DM + 1024 + g * 512 + (rho & 3) * 128 + 32 * d0 + r32) = cvtpk(v, vn); } }
}

__device__ __forceinline__ void p5_row(const float* xrow, float* yrow, const float* g1, const float* g2, bf16* hrow, int lane) {
    const f32x4* xr = (const f32x4*)xrow + lane; f32x4* yr = (f32x4*)yrow + lane; const f32x4* g1r = (const f32x4*)g1 + lane; const f32x4* g2r = (const f32x4*)g2 + lane;
    f32x4 v[8]; float s = 0.f;
#pragma unroll
    for (int j = 0; j < 8; ++j) { v[j] = yr[64 * j]; s += (v[j].x * v[j].x + v[j].y * v[j].y) + (v[j].z * v[j].z + v[j].w * v[j].w); }
    const float r1 = 1.0f / sqrtf(wave_sum(s) * (1.0f / DM) + EPS);
    float s2 = 0.f;
#pragma unroll
    for (int j = 0; j < 8; ++j) { const f32x4 xv = xr[64 * j], gv = g1r[64 * j]; v[j] = xv + v[j] * r1 * gv; yr[64 * j] = v[j]; s2 += (v[j].x * v[j].x + v[j].y * v[j].y) + (v[j].z * v[j].z + v[j].w * v[j].w); }
    const float r2 = 1.0f / sqrtf(wave_sum(s2) * (1.0f / DM) + EPS);
    v2u* o8 = (v2u*)hrow + lane;
#pragma unroll
    for (int j = 0; j < 8; ++j) { const f32x4 gv = g2r[64 * j]; v2u w; w.x = pk2(v[j].x * r2 * gv.x, v[j].y * r2 * gv.y); w.y = pk2(v[j].z * r2 * gv.z, v[j].w * r2 * gv.w); o8[64 * j] = w; }
}
__device__ __forceinline__ void p9_row(float* orow, const float* yrow, const float* g, int lane) {
    f32x4* xr = (f32x4*)orow + lane; const f32x4* yr = (const f32x4*)yrow + lane; const f32x4* gr = (const f32x4*)g + lane;
    f32x4 v[8]; float s = 0.f;
#pragma unroll
    for (int j = 0; j < 8; ++j) { v[j] = yr[64 * j]; s += (v[j].x * v[j].x + v[j].y * v[j].y) + (v[j].z * v[j].z + v[j].w * v[j].w); }
    const float r1 = 1.0f / sqrtf(wave_sum(s) * (1.0f / DM) + EPS);
#pragma unroll
    for (int j = 0; j < 8; ++j) { const f32x4 xv = xr[64 * j], gv = gr[64 * j]; xr[64 * j] = xv + v[j] * r1 * gv; }
}
__device__ __forceinline__ void p7_halo(const Ptrs& P, int gt, int NGT) {
    unsigned char* ws = P.ws; const float* halo = (const float*)(ws + WS_HALO); bf16* act = (bf16*)(ws + WS_ACT);
    const float* cw = P.in[19]; const float* cb = P.in[20];
    constexpr int C4 = DFF / 4;
    for (int it = gt; it < 256 * 2 * C4; it += NGT) {
        const int c4 = it % C4, i = (it / C4) & 1, s = it / (2 * C4), c = 4 * c4;
        const bool first = (s & 127) == 0;
        const f32x4 z = {0.f, 0.f, 0.f, 0.f};
        const float* hc = halo + ((size_t)s * 4 + i) * NUP + c;
        const int sp = first ? s : s - 1;
        const float* hp3 = halo + ((size_t)sp * 4 + 3) * NUP + c; const float* hp2 = halo + ((size_t)sp * 4 + 2) * NUP + c; const float* h0 = halo + ((size_t)s * 4 + 0) * NUP + c;
        const f32x4 cg = *(const f32x4*)hc, cu = *(const f32x4*)(hc + DFF);
        f32x4 g1, g2, u1, u2;
        if (i == 1) { g1 = *(const f32x4*)h0; u1 = *(const f32x4*)(h0 + DFF); if (first) { g2 = z; u2 = z; } else { g2 = *(const f32x4*)hp3; u2 = *(const f32x4*)(hp3 + DFF); } }
        else { if (first) { g1 = z; u1 = z; g2 = z; u2 = z; } else { g1 = *(const f32x4*)hp3; u1 = *(const f32x4*)(hp3 + DFF); g2 = *(const f32x4*)hp2; u2 = *(const f32x4*)(hp2 + DFF); } }
        const f32x4 wg0 = *(const f32x4*)(cw + c), wg1 = *(const f32x4*)(cw + NUP + c), wg2 = *(const f32x4*)(cw + 2 * NUP + c), bg = *(const f32x4*)(cb + c);
        const f32x4 wu0 = *(const f32x4*)(cw + DFF + c), wu1 = *(const f32x4*)(cw + NUP + DFF + c), wu2 = *(const f32x4*)(cw + 2 * NUP + DFF + c), bu = *(const f32x4*)(cb + DFF + c);
        const f32x4 yg = bg + wg0 * g2 + wg1 * g1 + wg2 * cg, yu = bu + wu0 * u2 + wu1 * u1 + wu2 * cu;
        v2u w; w.x = pk2(gelu_tanh_f(yg.x) * yu.x, gelu_tanh_f(yg.y) * yu.y); w.y = pk2(gelu_tanh_f(yg.z) * yu.z, gelu_tanh_f(yg.w) * yu.w);
        *(v2u*)(act + (size_t)(64 * s + i) * DFF + c) = w;
    }
}
struct Args { const float* in[NIN]; float* out; unsigned char* ws; int ph_lo, ph_hi; };
__global__ void __launch_bounds__(NWAVES * 64, 2) hybrid_fwd(Args args) {
    extern __shared__ __attribute__((aligned(16))) unsigned char lds_raw[];
    LAS unsigned char* lds = (LAS unsigned char*)lds_raw;
    volatile LAS unsigned* MISCW = (volatile LAS unsigned*)(lds + MISC_OFF);
    const int tid = threadIdx.x, lane = tid & 63, wave = __builtin_amdgcn_readfirstlane(tid >> 6);
    const int G = gridDim.x; const int bx = blockIdx.x; const int vcu = (G % 8 == 0) ? (bx % 8) * (G / 8) + bx / 8 : bx;
    Ptrs P;
#pragma unroll
    for (int i = 0; i < NIN; ++i) P.in[i] = args.in[i];
    P.out = args.out; P.ws = args.ws;
    unsigned char* ws = args.ws;
    gu32* ctl = (gu32*)(ws + WS_CTL);
    for (int u = tid; u < (LDS_BYTES - LDSCTL_OFF) / 4; u += NWAVES * 64) ((LAS unsigned*)(lds + LDSCTL_OFF))[u] = 0u;
    __syncthreads();
    XcdBarrier bar; bar.bar = (unsigned*)(ctl + CW_BAR); bar.x = 0; bar.st = nullptr;
    if (N_LAUNCHES == 1) bar = xcd_barrier_post((unsigned*)(ctl + CW_BAR), MISCW + 8);
#define GRID_BAR() do { if (N_LAUNCHES == 1) xcd_barrier(bar); } while (0)
    const int lo = args.ph_lo, hi = args.ph_hi;
#ifndef PH_MASK
#define PH_MASK 0x3ff
#endif
#define IN(k) (((PH_MASK >> (k)) & 1) && lo <= (k) && (k) < hi)
#define BOTH(k) (IN(k) && IN((k) + 1))
    const int gw = vcu * NWAVES + wave, NGW = G * NWAVES;

    if (IN(0)) { p0_prologue(P, lds, vcu, G, tid, lane, wave); if (BOTH(0)) GRID_BAR(); }

    if (IN(1)) {
        pg8::Gemm g{(const pg8::bf16_t*)(ws + WS_H), (const pg8::bf16_t*)(ws + WS_WIN), TOK, LDP, DM}; pg8::StaticOrder S; S.init(TOK, LDP, G, bx);
        pg8::EpiProj E{(pg8::bf16_t*)(ws + WS_PROJ), LDP, (float*)(ws + WS_GATES), C2D, C2N};
        pg8::gemm_phase<pg8::EpiProj, pg8::StaticOrder, true, true>(lds + RING_OFF, g, S, E);
        if (BOTH(1)) GRID_BAR();
    }

    if (IN(2)) {
        for (int u = vcu; u < 256; u += G) cmp_unit(P, lds, u, tid, lane, wave);
        for (int L = vcu; L < 256; L += G) {
            const int bh = L >> 4, s = L & 15;
#pragma unroll 1
            for (int i = 0; i < 4; ++i) { const int qb = (i == 0) ? 63 - s : (i == 1) ? 32 + s : (i == 2) ? 31 - s : s; diff_unit(P, lds, bh >> 3, bh & 7, qb); }
        }
        if (BOTH(2)) GRID_BAR();
    }

    if (IN(3)) {
        for (int L = vcu; L < 256; L += G) { const int bg = L >> 6, s = L & 63;
#pragma unroll 1
            for (int i = 0; i < 2; ++i) nsa_unit(P, lds, bg, i ? s : 127 - s); }
        if (BOTH(3)) GRID_BAR();
    }

    if (IN(4)) {
        __syncthreads();
        pg8::Gemm g{(const pg8::bf16_t*)(ws + WS_MIX), (const pg8::bf16_t*)(ws + WS_WOUT), TOK, DM, DM}; pg8::StaticOrder S; S.init(TOK, DM, G, bx);
        pg8::EpiF32 E{P.out, DM};
        pg8::gemm_phase<pg8::EpiF32, pg8::StaticOrder, true, true>(lds + RING_OFF, g, S, E);
        if (BOTH(4)) GRID_BAR();
    }

    if (IN(5)) {
        for (int m = gw; m < TOK; m += NGW) p5_row(P.in[0] + (size_t)m * DM, P.out + (size_t)m * DM, P.in[16], P.in[17], (bf16*)(ws + WS_H) + (size_t)m * DM, lane);
        if (BOTH(5)) GRID_BAR();
    }

    if (IN(6)) {
        pg8::Gemm g{(const pg8::bf16_t*)(ws + WS_H), (const pg8::bf16_t*)(ws + WS_WUP), TOK, NUP, DM}; pg8::StaticOrder S; S.init(TOK, NUP, G, bx);
        pg8::EpiUpGlu E{(pg8::bf16_t*)(ws + WS_ACT), (float*)(ws + WS_HALO), P.in[19], P.in[20], DFF};
        pg8::gemm_phase<pg8::EpiUpGlu, pg8::StaticOrder, true, true>(lds + RING_OFF, g, S, E);
        if (BOTH(6)) GRID_BAR();
    }

    if (IN(7)) { p7_halo(P, vcu * (NWAVES * 64) + tid, G * NWAVES * 64); if (BOTH(7)) GRID_BAR(); }

    if (IN(8)) {
        pg8::Gemm g{(const pg8::bf16_t*)(ws + WS_ACT), (const pg8::bf16_t*)(ws + WS_WDN), TOK, DM, DFF}; pg8::StaticOrder S; S.init(TOK, DM, G, bx);
        pg8::EpiF32 E{(float*)(ws + WS_Y2), DM};
        pg8::gemm_phase<pg8::EpiF32, pg8::StaticOrder, true, true>(lds + RING_OFF, g, S, E);
        if (BOTH(8)) GRID_BAR();
    }

    if (IN(9)) {
        for (int m = gw; m < TOK; m += NGW) p9_row(P.out + (size_t)m * DM, (const float*)(ws + WS_Y2) + (size_t)m * DM, P.in[22], lane);
    }
#undef IN
#undef BOTH
#undef GRID_BAR
}

extern "C" void kernel_launch(void* const* d_in, const int* in_sizes, int n_in, void* d_out, int out_size, void* d_ws, size_t ws_size, hipStream_t stream) {
    static int grid = 0;
    if (grid == 0) {
        if (n_in != NIN || in_sizes[0] != TOK * DM || out_size != TOK * DM || ws_size < WS_END) {
            fprintf(stderr, "kernel_launch: shape mismatch (n_in %d, in0 %d, out %d, ws %zu; need %zu bytes of workspace); nothing launched\n", n_in, n_in > 0 ? in_sizes[0] : -1, out_size, ws_size, (size_t)WS_END); grid = -1; return; }
        int dev = 0, cus = 0, per_cu = 0;
        if (hipGetDevice(&dev) != hipSuccess || hipDeviceGetAttribute(&cus, hipDeviceAttributeMultiprocessorCount, dev) != hipSuccess) { fprintf(stderr, "kernel_launch: device query failed\n"); grid = -1; return; }
        if (hipFuncSetAttribute((const void*)hybrid_fwd, hipFuncAttributeMaxDynamicSharedMemorySize, LDS_BYTES) != hipSuccess) { fprintf(stderr, "kernel_launch: hipFuncSetAttribute failed\n"); grid = -1; return; }
        if (hipOccupancyMaxActiveBlocksPerMultiprocessor(&per_cu, (const void*)hybrid_fwd, NWAVES * 64, LDS_BYTES) != hipSuccess || per_cu < 1)
            fprintf(stderr, "kernel_launch: note: occupancy query reports %d workgroups per CU\n", per_cu);
        (void)hipGetLastError();
        grid = cus;
    }
    if (grid < 0) return;
    if (hipMemsetAsync((char*)d_ws + WS_CTL, 0, CTL_ZERO_BYTES, stream) != hipSuccess) { fprintf(stderr, "kernel_launch: hipMemsetAsync failed\n"); return; }
    Args a{};
    for (int i = 0; i < NIN; ++i) a.in[i] = (const float*)d_in[i];
    a.out = (float*)d_out; a.ws = (unsigned char*)d_ws;
    for (int li = 0; li < N_LAUNCHES; ++li) {
        a.ph_lo = (N_LAUNCHES == PER_PHASE) ? li : 0; a.ph_hi = (N_LAUNCHES == PER_PHASE) ? li + 1 : PER_PHASE;
        hipLaunchKernelGGL(hybrid_fwd, dim3(grid), dim3(NWAVES * 64), LDS_BYTES, stream, a);
        const hipError_t le = hipPeekAtLastError();
        if (le != hipSuccess) { fprintf(stderr, "kernel_launch: launch %d failed: %s\n", li, hipGetErrorName(le)); break; }
    }
}
```

```cpp
#include <hip/hip_runtime.h>
#include <hip/hip_bf16.h>
#include <cstdio>
#include <cstdint>
namespace pg8 {
#define PG8_LAS __attribute__((address_space(3)))
typedef unsigned short bf16_t;
typedef short bf16x8 __attribute__((ext_vector_type(8)));
typedef float f32x4 __attribute__((ext_vector_type(4)));
typedef unsigned u32x4 __attribute__((ext_vector_type(4)));
constexpr int BM = 256, BK = 64, HALF = 128, HTB = HALF * BK * 2  , STAGE_BYTES = 8 * HTB, NXCD = 8, WGM = 8;

__host__ __device__ __forceinline__ int lds_byte(int r, int c) { const int st = (r >> 4) * 2 + (c >> 5), rr = r & 15, cc = c & 31, ob = rr * 64 + cc * 2; return st * 1024 + (ob ^ (((ob >> 9) & 1) << 5)); }
__host__ __device__ __forceinline__ void stage_rc(int b, int& R, int& C) { const int st = b / 1024, sb = b % 1024, swz = sb ^ (((sb >> 9) & 1) << 5); R = (st >> 1) * 16 + swz / 64; C = (st & 1) * 32 + (swz % 64) / 2; }
__host__ __device__ __forceinline__ int perm32(int rho) { const int n = rho >> 4, i = rho & 15; return 8 * (i >> 2) + 4 * n + (i & 3); }

struct Unit { int pm, pn; };
struct Gemm { const bf16_t* A; const bf16_t* Bt; int M, N, K; };

struct StaticOrder {
    int nM, nN, nwg, G, c;
    __host__ __device__ void init(int M, int N, int G_, int c_) { nM = M / BM; nN = N / BM; nwg = nM * nN; G = G_; c = c_; }
    __host__ __device__ bool next(int i, Unit& u) const {
        const long L = (long)i * G + c; if (L >= nwg) return false;
        int wgid = (int)L; { const int q = nwg / NXCD, r = nwg % NXCD, xcd = wgid % NXCD, off = wgid / NXCD; wgid = (xcd < r ? xcd * (q + 1) : r * (q + 1) + (xcd - r) * q) + off; }
        const int nig = WGM * nN, gid = wgid / nig, fm = gid * WGM, gsz = (nM - fm) < WGM ? (nM - fm) : WGM;
        u.pm = fm + ((wgid % nig) % gsz); u.pn = (wgid % nig) / gsz; return true;
    }
    __device__ __forceinline__ void a_ready(const Unit&) const {}
    __device__ __forceinline__ void done(const Unit&) const {}
};


__device__ __forceinline__ unsigned cvt_pk_bf16(float lo, float hi) { unsigned r; asm volatile("v_cvt_pk_bf16_f32 %0, %1, %2" : "=v"(r) : "v"(lo), "v"(hi)); return r; }
__device__ __forceinline__ float fast_sigmoid(float v) { return __builtin_amdgcn_rcpf(1.0f + __builtin_amdgcn_exp2f(-1.4426950408889634f * v)); }
__device__ __forceinline__ float gelu_tanh(float v) { const float z2 = 1.5957691216f * (v + 0.044715f * v * v * v); return v * __builtin_amdgcn_rcpf(1.0f + __builtin_amdgcn_exp2f(-1.4426950408889634f * z2)); }

struct EpiF32 {
    static constexpr bool PERM = false, AFTER_DRAIN = false;
    float* C; int ldc;
    __device__ __forceinline__ void operator()(const f32x4 (&acc)[2][2][4][2], const Unit& u, int wr, int wc, int fr, int fq) const {
        const int row0 = u.pm * BM + wr * 64 + fr, col0 = u.pn * BM + wc * 32 + 4 * fq;
#pragma unroll
        for (int ai = 0; ai < 2; ++ai)
#pragma unroll
            for (int m = 0; m < 4; ++m) { float* rowp = C + (size_t)(row0 + ai * HALF + m * 16) * ldc + col0;
#pragma unroll
                for (int bj = 0; bj < 2; ++bj)
#pragma unroll
                    for (int n = 0; n < 2; ++n) *(f32x4*)(rowp + bj * HALF + n * 16) = acc[ai][bj][m][n]; }
    }
};
struct EpiBf16Plain {
    static constexpr bool PERM = true, AFTER_DRAIN = false;
    bf16_t* O; int ldc;
    __device__ __forceinline__ void operator()(const f32x4 (&acc)[2][2][4][2], const Unit& u, int wr, int wc, int fr, int fq) const {
        const int row0 = u.pm * BM + wr * 64 + fr, col0 = u.pn * BM + wc * 32 + 8 * fq;
#pragma unroll
        for (int ai = 0; ai < 2; ++ai)
#pragma unroll
            for (int m = 0; m < 4; ++m) { bf16_t* rowp = O + (size_t)(row0 + ai * HALF + m * 16) * ldc + col0;
#pragma unroll
                for (int bj = 0; bj < 2; ++bj) { const f32x4 v0 = acc[ai][bj][m][0], v1 = acc[ai][bj][m][1];
                    u32x4 w; w.x = cvt_pk_bf16(v0[0], v0[1]); w.y = cvt_pk_bf16(v0[2], v0[3]); w.z = cvt_pk_bf16(v1[0], v1[1]); w.w = cvt_pk_bf16(v1[2], v1[3]);
                    *(u32x4*)(rowp + bj * HALF) = w; } }
    }
};
struct EpiProj {
    static constexpr bool PERM = true, AFTER_DRAIN = false;
    bf16_t* O; int ldc; float* gates; float c2d, c2n;
    __device__ __forceinline__ void operator()(const f32x4 (&acc)[2][2][4][2], const Unit& u, int wr, int wc, int fr, int fq) const {
        const int pn = u.pn; const int row0 = u.pm * BM + wr * 64 + fr;
        if (pn == 22) {
            if (wc == 0) {
#pragma unroll
                for (int ai = 0; ai < 2; ++ai)
#pragma unroll
                    for (int m = 0; m < 4; ++m) { float* gp = gates + (size_t)(row0 + ai * HALF + m * 16) * 32 + 8 * fq;
#pragma unroll
                        for (int n = 0; n < 2; ++n) { const f32x4 v = acc[ai][0][m][n]; f32x4 s; s[0] = fast_sigmoid(v[0]); s[1] = fast_sigmoid(v[1]); s[2] = fast_sigmoid(v[2]); s[3] = fast_sigmoid(v[3]); *(f32x4*)(gp + 4 * n) = s; } }
            }
            return;
        }
        const float sc = (pn < 4) ? c2d : ((pn >= 12 && pn < 16) ? c2n : 1.0f);
        const int col0 = pn * BM + wc * 32 + 8 * fq;
#pragma unroll
        for (int ai = 0; ai < 2; ++ai)
#pragma unroll
            for (int m = 0; m < 4; ++m) { bf16_t* rowp = O + (size_t)(row0 + ai * HALF + m * 16) * ldc + col0;
#pragma unroll
                for (int bj = 0; bj < 2; ++bj) { const f32x4 v0 = acc[ai][bj][m][0] * sc, v1 = acc[ai][bj][m][1] * sc;
                    u32x4 w; w.x = cvt_pk_bf16(v0[0], v0[1]); w.y = cvt_pk_bf16(v0[2], v0[3]); w.z = cvt_pk_bf16(v1[0], v1[1]); w.w = cvt_pk_bf16(v1[2], v1[3]);
                    *(u32x4*)(rowp + bj * HALF) = w; } }
    }
};
typedef float f32x2p __attribute__((ext_vector_type(2)));
__device__ __forceinline__ f32x2p glu_pk(f32x2p g, f32x2p u) {
    const f32x2p g2 = g * g;
    const f32x2p t = (g2 * 0.044715f + 1.0f) * g;
    const f32x2p a = t * (-1.4426950408889634f * 1.5957691216f);
    f32x2p e; e.x = __builtin_amdgcn_exp2f(a.x); e.y = __builtin_amdgcn_exp2f(a.y);
    const f32x2p d = e + 1.0f;
    f32x2p r; r.x = __builtin_amdgcn_rcpf(d.x); r.y = __builtin_amdgcn_rcpf(d.y);
    return (g * u) * r;
}
__device__ __forceinline__ float dpp_shr1(float v) { return __builtin_bit_cast(float, __builtin_amdgcn_update_dpp(0, __builtin_bit_cast(int, v), 0x111, 0xF, 0xF, true)); }
__device__ __forceinline__ float dpp_shr2(float v) { return __builtin_bit_cast(float, __builtin_amdgcn_update_dpp(0, __builtin_bit_cast(int, v), 0x112, 0xF, 0xF, true)); }
__device__ __forceinline__ float dpp_shl15(float v) { return __builtin_bit_cast(float, __builtin_amdgcn_update_dpp(0, __builtin_bit_cast(int, v), 0x10F, 0xF, 0xF, true)); }
__device__ __forceinline__ float dpp_shl14(float v) { return __builtin_bit_cast(float, __builtin_amdgcn_update_dpp(0, __builtin_bit_cast(int, v), 0x10E, 0xF, 0xF, true)); }
struct EpiUpGlu {
    static constexpr bool PERM = true, AFTER_DRAIN = false;
    bf16_t* act; bf16_t* halo; const float* cw; const float* cb; int dff;
    __device__ __forceinline__ void operator()(const f32x4 (&acc)[2][2][4][2], const Unit& u, int wr, int wc, int fr, int fq) const {
        typedef unsigned u32x2 __attribute__((ext_vector_type(2)));
        const int nu = 2 * dff;
#pragma unroll
        for (int n = 0; n < 2; ++n) {
            const int cc = u.pn * HALF + wc * 32 + 8 * fq + 4 * n;
            const f32x4 wg0 = *(const f32x4*)(cw + cc), wg1 = *(const f32x4*)(cw + (size_t)nu + cc), wg2 = *(const f32x4*)(cw + (size_t)2 * nu + cc), bg = *(const f32x4*)(cb + cc);
            const f32x4 wu0 = *(const f32x4*)(cw + dff + cc), wu1 = *(const f32x4*)(cw + (size_t)nu + dff + cc), wu2 = *(const f32x4*)(cw + (size_t)2 * nu + dff + cc), bu = *(const f32x4*)(cb + dff + cc);
#pragma unroll
            for (int ai = 0; ai < 2; ++ai) {
                const int strip = 4 * u.pm + 2 * ai + wr; const int rowb = u.pm * BM + ai * HALF + wr * 64 + fr;
#pragma unroll
                for (int m = 0; m < 4; ++m) {
                    const f32x4 g = acc[ai][0][m][n], up = acc[ai][1][m][n]; f32x4 g1, g2, u1, u2;
#pragma unroll
                    for (int e = 0; e < 4; ++e) { g1[e] = dpp_shr1(g[e]); g2[e] = dpp_shr2(g[e]); u1[e] = dpp_shr1(up[e]); u2[e] = dpp_shr2(up[e]); }
                    if (m > 0) { const f32x4 gp = acc[ai][0][m > 0 ? m - 1 : 0][n], upp = acc[ai][1][m > 0 ? m - 1 : 0][n];
#pragma unroll
                        for (int e = 0; e < 4; ++e) { g1[e] += dpp_shl15(gp[e]); g2[e] += dpp_shl14(gp[e]); u1[e] += dpp_shl15(upp[e]); u2[e] += dpp_shl14(upp[e]); } }
                    const f32x4 yg = bg + wg0 * g2 + wg1 * g1 + wg2 * g;
                    const f32x4 yu = bu + wu0 * u2 + wu1 * u1 + wu2 * up;
                    if ((m == 0 && fr < 2) || (m == 3 && fr >= 14)) { bf16_t* hp = halo + ((size_t)strip * 4 + (m == 0 ? fr : fr - 12)) * nu + cc;
                        u32x2 wg_; wg_.x = cvt_pk_bf16(g[0], g[1]); wg_.y = cvt_pk_bf16(g[2], g[3]); *(u32x2*)hp = wg_; u32x2 wu_; wu_.x = cvt_pk_bf16(up[0], up[1]); wu_.y = cvt_pk_bf16(up[2], up[3]); *(u32x2*)(hp + dff) = wu_; }
                    if (m > 0 || fr >= 2) { const f32x2p o01 = glu_pk((f32x2p){yg[0], yg[1]}, (f32x2p){yu[0], yu[1]}), o23 = glu_pk((f32x2p){yg[2], yg[3]}, (f32x2p){yu[2], yu[3]});
                        u32x2 w; w.x = cvt_pk_bf16(o01.x, o01.y); w.y = cvt_pk_bf16(o23.x, o23.y);
                        *(u32x2*)(act + (size_t)(rowb + m * 16) * dff + cc) = w; }
                }
            }
        }
    }
};
template <class Epi, class Sched, bool ALIGN_EPI = false, bool SP2 = false>
__device__ __forceinline__ void gemm_phase(PG8_LAS unsigned char* lds, const Gemm g, const Sched& S, const Epi& E) {
    int tid = threadIdx.x; asm volatile("" : "+v"(tid));
    const int wid = __builtin_amdgcn_readfirstlane(tid >> 6), lane = tid & 63, wr = wid >> 2, wc = wid & 3, fr = lane & 15, fq = lane >> 4;
    const int K = g.K, nt = K / BK;
    unsigned voffA[2], voffB[2];
#pragma unroll
    for (int i = 0; i < 2; ++i) { int R, C; stage_rc(tid * 16 + i * 8192, R, C); const int Rb = Epi::PERM ? ((R & ~31) + perm32(R & 31)) : R;
        voffA[i] = (unsigned)(R * K + C) * 2u; voffB[i] = (unsigned)(Rb * K + C) * 2u; }
    const size_t kstep = (size_t)(BK * 2);
    const size_t hstep = (size_t)HALF * K * 2;
    const size_t tstep = 2 * hstep;
    const unsigned ldsw = (unsigned)wid * 1024u;
    const int aoff = lds_byte(wr * 64 + fr, fq * 8), boff = lds_byte(wc * 32 + fr, fq * 8);
#define PG8_SA(b, h) (((b) * 2 + (h)) * HTB)
#define PG8_SB(b, h) ((4 + (b) * 2 + (h)) * HTB)
#define PG8_STAGE(bufoff, gbase, voff) do { _Pragma("unroll") for (int _i = 0; _i < 2; ++_i) \
        __builtin_amdgcn_global_load_lds((const unsigned*)((const char*)(gbase) + (voff)[_i]), (PG8_LAS unsigned*)(lds + (bufoff) + ldsw + _i * 8192), 16, 0, 0); } while (0)
#define PG8_LDA(dst, b, h) do { _Pragma("unroll") for (int m = 0; m < 4; ++m) _Pragma("unroll") for (int k = 0; k < 2; ++k) dst[m][k] = *(const PG8_LAS bf16x8*)(lds + PG8_SA(b, h) + aoff + m * 2048 + k * 1024); } while (0)
#define PG8_LDB(dst, b, h) do { _Pragma("unroll") for (int n = 0; n < 2; ++n) _Pragma("unroll") for (int k = 0; k < 2; ++k) dst[n][k] = *(const PG8_LAS bf16x8*)(lds + PG8_SB(b, h) + boff + n * 2048 + k * 1024); } while (0)
#define PG8_MMA(ai, bj, At, Bt) do { __builtin_amdgcn_s_setprio(1); _Pragma("unroll") for (int m = 0; m < 4; ++m) _Pragma("unroll") for (int n = 0; n < 2; ++n) _Pragma("unroll") for (int k = 0; k < 2; ++k) \
        acc[ai][bj][m][n] = __builtin_amdgcn_mfma_f32_16x16x32_bf16(Bt[n][k], At[m][k], acc[ai][bj][m][n], 0, 0, 0); __builtin_amdgcn_s_setprio(0); } while (0)
#define PG8_WAIT_V(n) asm volatile("s_waitcnt vmcnt(" #n ")" ::: "memory")
#define PG8_WAIT_L(n) asm volatile("s_waitcnt lgkmcnt(" #n ")" ::: "memory")
#define PG8_BAR __builtin_amdgcn_s_barrier()
#define PG8_SCHED __builtin_amdgcn_sched_barrier(0)
    Unit cur, nxt; int ui = 0;
    if (!S.next(0, cur)) return;
    f32x4 acc[2][2][4][2];
#pragma unroll
    for (int a = 0; a < 2; ++a)
#pragma unroll
        for (int b = 0; b < 2; ++b)
#pragma unroll
            for (int m = 0; m < 4; ++m)
#pragma unroll
                for (int n = 0; n < 2; ++n) acc[a][b][m][n] = (f32x4){0.f, 0.f, 0.f, 0.f};
    bf16x8 At[4][2], B0[2][2], B1[2][2];
    const char* cA = (const char*)g.A + (size_t)cur.pm * tstep; const char* cB = (const char*)g.Bt + (size_t)cur.pn * tstep;
    S.a_ready(cur);
    if constexpr (SP2) {
        PG8_STAGE(PG8_SB(0, 0), cB, voffB); PG8_STAGE(PG8_SB(0, 1), cB + hstep, voffB); PG8_STAGE(PG8_SA(0, 0), cA, voffA); PG8_STAGE(PG8_SA(0, 1), cA + hstep, voffA);
        if (wr == 1) PG8_BAR;
        PG8_WAIT_V(2); PG8_BAR;
        PG8_STAGE(PG8_SB(1, 0), cB + kstep, voffB); PG8_STAGE(PG8_SA(1, 0), cA + kstep, voffA); PG8_STAGE(PG8_SB(1, 1), cB + hstep + kstep, voffB);
        PG8_WAIT_V(6); PG8_BAR;
    } else {
        PG8_STAGE(PG8_SB(0, 0), cB, voffB); PG8_STAGE(PG8_SA(0, 0), cA, voffA); PG8_STAGE(PG8_SB(0, 1), cB + hstep, voffB); PG8_STAGE(PG8_SA(0, 1), cA + hstep, voffA);
        if (wr == 1) PG8_BAR;
        PG8_WAIT_V(4); PG8_BAR;
        PG8_STAGE(PG8_SB(1, 0), cB + kstep, voffB); PG8_STAGE(PG8_SA(1, 0), cA + kstep, voffA); PG8_STAGE(PG8_SB(1, 1), cB + hstep + kstep, voffB);
        PG8_WAIT_V(6); PG8_BAR;
    }
    for (;;) {
        const bool has_next = S.next(ui + 1, nxt);
        const char* nA = has_next ? (const char*)g.A + (size_t)nxt.pm * tstep : cA; const char* nB = has_next ? (const char*)g.Bt + (size_t)nxt.pn * tstep : cB;
        for (int t = 0; t < nt; t += 2) {
            const bool last = (t == nt - 2);
            const char* a1 = cA + (size_t)(t + 1) * kstep;
            const char* a2 = last ? nA : cA + (size_t)(t + 2) * kstep; const char* b2 = last ? nB : cB + (size_t)(t + 2) * kstep;
            const char* a3 = a2 + kstep; const char* b3 = b2 + kstep;
            if (last && has_next) S.a_ready(nxt);
            if constexpr (SP2) {
            PG8_LDB(B0, 0, 0); PG8_LDB(B1, 0, 1); PG8_SCHED; PG8_LDA(At, 0, 0); PG8_STAGE(PG8_SA(1, 1), a1 + hstep, voffA);
            PG8_WAIT_V(8); PG8_WAIT_L(0); PG8_BAR; PG8_MMA(0, 0, At, B0); PG8_MMA(0, 1, At, B1); PG8_BAR; PG8_SCHED;
            PG8_LDA(At, 0, 1); PG8_STAGE(PG8_SB(0, 0), b2, voffB); PG8_STAGE(PG8_SB(0, 1), b2 + hstep, voffB); PG8_STAGE(PG8_SA(0, 0), a2, voffA);
            PG8_WAIT_V(8); PG8_WAIT_L(0); PG8_BAR; PG8_MMA(1, 0, At, B0); PG8_MMA(1, 1, At, B1); PG8_BAR; PG8_SCHED;
            PG8_LDB(B0, 1, 0); PG8_LDB(B1, 1, 1); PG8_SCHED; PG8_LDA(At, 1, 0); PG8_STAGE(PG8_SA(0, 1), a2 + hstep, voffA);
            PG8_WAIT_V(8); PG8_WAIT_L(0); PG8_BAR; PG8_MMA(0, 0, At, B0); PG8_MMA(0, 1, At, B1); PG8_BAR; PG8_SCHED;
            PG8_LDA(At, 1, 1); PG8_STAGE(PG8_SB(1, 0), b3, voffB); PG8_STAGE(PG8_SB(1, 1), b3 + hstep, voffB); PG8_STAGE(PG8_SA(1, 0), a3, voffA);
            PG8_WAIT_V(8); PG8_WAIT_L(0); PG8_BAR; PG8_MMA(1, 0, At, B0); PG8_MMA(1, 1, At, B1); PG8_BAR; PG8_SCHED;
            } else {
            PG8_LDB(B0, 0, 0); PG8_SCHED; PG8_LDA(At, 0, 0); PG8_STAGE(PG8_SA(1, 1), a1 + hstep, voffA);
            PG8_WAIT_L(8); PG8_BAR; PG8_WAIT_L(0); PG8_MMA(0, 0, At, B0); PG8_BAR; PG8_SCHED;
            PG8_LDB(B1, 0, 1); PG8_STAGE(PG8_SB(0, 0), b2, voffB);
            PG8_BAR; PG8_WAIT_L(0); PG8_MMA(0, 1, At, B1); PG8_BAR;
            PG8_LDA(At, 0, 1); PG8_STAGE(PG8_SA(0, 0), a2, voffA);
            PG8_BAR; PG8_WAIT_L(0); PG8_MMA(1, 0, At, B0); PG8_BAR; PG8_SCHED;
            PG8_STAGE(PG8_SB(0, 1), b2 + hstep, voffB);
            PG8_WAIT_V(6); PG8_BAR; PG8_MMA(1, 1, At, B1); PG8_BAR;
            PG8_LDB(B0, 1, 0); PG8_SCHED; PG8_LDA(At, 1, 0); PG8_STAGE(PG8_SA(0, 1), a2 + hstep, voffA);
            PG8_WAIT_L(8); PG8_BAR; PG8_WAIT_L(0); PG8_MMA(0, 0, At, B0); PG8_BAR; PG8_SCHED;
            PG8_LDB(B1, 1, 1); PG8_STAGE(PG8_SB(1, 0), b3, voffB);
            PG8_BAR; PG8_WAIT_L(0); PG8_MMA(0, 1, At, B1); PG8_BAR;
            PG8_LDA(At, 1, 1); PG8_STAGE(PG8_SA(1, 0), a3, voffA);
            PG8_BAR; PG8_WAIT_L(0); PG8_MMA(1, 0, At, B0); PG8_BAR; PG8_SCHED;
            PG8_STAGE(PG8_SB(1, 1), b3 + hstep, voffB);
            PG8_WAIT_V(6); PG8_BAR; PG8_MMA(1, 1, At, B1); PG8_BAR;
            }
        }
        if constexpr (ALIGN_EPI) { if (wr == 0) PG8_BAR; }
        if constexpr (!Epi::AFTER_DRAIN) { E(acc, cur, wr, wc, fr, fq); S.done(cur); }
        if (!has_next) break;
#pragma unroll
        for (int a = 0; a < 2; ++a)
#pragma unroll
            for (int b = 0; b < 2; ++b)
#pragma unroll
                for (int m = 0; m < 4; ++m)
#pragma unroll
                    for (int n = 0; n < 2; ++n) acc[a][b][m][n] = (f32x4){0.f, 0.f, 0.f, 0.f};
        cur = nxt; cA = nA; cB = nB; ++ui;
        if constexpr (ALIGN_EPI) { if (wr == 1) PG8_BAR; }
    }
    PG8_WAIT_V(0);
    if constexpr (!ALIGN_EPI) { if (wr == 0) PG8_BAR; }
    PG8_BAR;
    if constexpr (Epi::AFTER_DRAIN) { E.fused(acc, cur, wr, wc, fr, fq, lds, wid, lane); S.done(cur); }
#undef PG8_SA
#undef PG8_SB
#undef PG8_STAGE
#undef PG8_LDA
#undef PG8_LDB
#undef PG8_MMA
#undef PG8_WAIT_V
#undef PG8_WAIT_L
#undef PG8_BAR
#undef PG8_SCHED
}
}
namespace att {
#define ALAS __attribute__((address_space(3)))
typedef unsigned short bf16_t;
typedef short bf16x8 __attribute__((ext_vector_type(8)));
typedef short s16x4 __attribute__((ext_vector_type(4)));
typedef float f32x16 __attribute__((ext_vector_type(16)));
typedef float f32x4 __attribute__((ext_vector_type(4)));
typedef unsigned u32x4 __attribute__((ext_vector_type(4)));
typedef ALAS char lchar;
constexpr int KVBLK = 64, SHM_K = 16384, SHM_V = 16384;
constexpr int LUTX = 328, LUT0 = 96;
constexpr int NVB = 4;
constexpr int SLOT = 2 * SHM_K;
constexpr int L_LUT = 0, L_V = 5632, L_K = L_V + NVB * SHM_V, L_WS = L_K + NVB * SHM_K, IMP_LD = 132, L_IMP = L_V, L_SEL = L_WS + 2048, L_UN = L_SEL + 1024, L_LIST = L_UN + 64, L_END = L_LIST + 512;
static_assert(64 * IMP_LD * 4 <= NVB * SHM_V, "importance table overlays the V ring");
constexpr float THR = 8.0f;
enum { M_DIFF = 0, M_CMP = 1, M_SLC = 2, M_WIN = 3 };
#define KSWZ(row, colB) ((row) * 256 + ((colB) ^ (((row) & 7) << 4)))
#define SBAR() __builtin_amdgcn_sched_barrier(0)
__device__ __forceinline__ int v_st(int k, int c) { const int kk = (k & ~0xC) | ((k & 4) << 1) | ((k & 8) >> 1); return ((kk >> 3) * 4 + (c >> 5)) * 512 + ((kk & 7) * 32 + (c & 31)) * 2; }
__device__ __forceinline__ int v_rd_base(int lane) { return ((lane & 3) << 3) | (((lane >> 2) & 3) << 6) | (((lane >> 4) & 1) << 5) | (((lane >> 5) & 1) << 8); }
constexpr int v_rd_off(int d0, int ks, int half) { return d0 * 512 + ks * 4096 + half * 2048; }
__device__ __forceinline__ int crow(int r, int hi) { return (r & 3) + 8 * (r >> 2) + 4 * hi; }
__device__ __forceinline__ unsigned cvtpk(float lo, float hi) { unsigned r; asm volatile("v_cvt_pk_bf16_f32 %0, %1, %2" : "=v"(r) : "v"(lo), "v"(hi)); return r; }
__device__ __forceinline__ unsigned lds_addr(const lchar* p) { return (unsigned)(uintptr_t)p; }

struct Lane {
    int qpos;
    int qlo, qhi;
    unsigned lut;
#ifdef TPROBE_SEC
    unsigned long long* tpw;
#endif
};
template <int MODE>
__device__ __forceinline__ void mask_sel(f32x16& p0, f32x16& p1, int key0, int tj, const Lane L, int hi, bool cross, unsigned sw0, unsigned sw1, unsigned sw2, unsigned sw3) {
    const float NEG = -__builtin_inff();
    if constexpr (MODE == M_CMP) {
        const int lim = ((L.qpos - 31) >> 4) - key0 - 4 * hi;
#pragma unroll
        for (int r = 0; r < 16; ++r) { const int c = (r & 3) + 8 * (r >> 2); if (c > lim) p0[r] = NEG; if (c + 32 > lim) p1[r] = NEG; }
    } else {
        if constexpr (MODE == M_SLC) {
            const unsigned w = tj < 64 ? (tj < 32 ? sw0 : sw1) : (tj < 96 ? sw2 : sw3);
            if (((w >> (tj & 31)) & 1u) == 0u) {
#pragma unroll
                for (int r = 0; r < 16; ++r) { p0[r] = NEG; p1[r] = NEG; } }
        }
        if (cross) {
            const int dq = L.qpos - key0 - 4 * hi;
#pragma unroll
            for (int r = 0; r < 16; ++r) {
                const int c = (r & 3) + 8 * (r >> 2);
                if constexpr (MODE == M_WIN) { if ((unsigned)(dq - c) >= 512u) p0[r] = NEG; if ((unsigned)(dq - c - 32) >= 512u) p1[r] = NEG; }
                else { if (dq - c < 0) p0[r] = NEG; if (dq - c - 32 < 0) p1[r] = NEG; }
            }
        }
    }
}
__device__ __forceinline__ void partialSM(f32x16& p0, f32x16& p1, float& m_reg, float& alpha) {
    float pmax = p0[0];
#pragma unroll
    for (int r = 1; r < 16; ++r) pmax = fmaxf(pmax, p0[r]);
#pragma unroll
    for (int r = 0; r < 16; ++r) pmax = fmaxf(pmax, p1[r]);
    { auto rr = __builtin_amdgcn_permlane32_swap(__float_as_uint(pmax), __float_as_uint(pmax), false, false);
      pmax = fmaxf(__uint_as_float(rr[0]), __uint_as_float(rr[1])); }
    if (__builtin_expect(__all(pmax - m_reg <= THR), 1)) { alpha = 1.f; }
    else { const float mn = fmaxf(m_reg, pmax); alpha = __builtin_amdgcn_exp2f(m_reg - mn); m_reg = mn; }
    const float mm = m_reg;
#pragma unroll
    for (int r = 0; r < 16; ++r) { p0[r] = p0[r] - mm; p1[r] = p1[r] - mm; }
#pragma unroll
    for (int r = 0; r < 16; ++r) p0[r] = __builtin_amdgcn_exp2f(p0[r]);
}
__device__ __forceinline__ void finishSM_direct(f32x16& p0, f32x16& p1, float alpha, float& l_reg, bf16x8& pa0, bf16x8& pa1, bf16x8& pa2, bf16x8& pa3) {
#pragma unroll
    for (int r = 0; r < 16; ++r) p1[r] = __builtin_amdgcn_exp2f(p1[r]);
    float ps = 0;
#pragma unroll
    for (int r = 0; r < 16; ++r) ps += p0[r];
#pragma unroll
    for (int r = 0; r < 16; ++r) ps += p1[r];
    { auto rr = __builtin_amdgcn_permlane32_swap(__float_as_uint(ps), __float_as_uint(ps), false, false);
      ps = __uint_as_float(rr[0]) + __uint_as_float(rr[1]); }
    l_reg = l_reg * alpha + ps;
#define PKD(P, B_, OUT) do { u32x4 w = {cvtpk(P[B_+0], P[B_+1]), cvtpk(P[B_+2], P[B_+3]), cvtpk(P[B_+4], P[B_+5]), cvtpk(P[B_+6], P[B_+7])}; OUT = __builtin_bit_cast(bf16x8, w); } while (0)
    PKD(p0, 0, pa0); PKD(p0, 8, pa1); PKD(p1, 0, pa2); PKD(p1, 8, pa3);
#undef PKD
}
__device__ __forceinline__ void partialSM_fix(f32x16& p0, f32x16& p1, float mref) {
#pragma unroll
    for (int r = 0; r < 16; ++r) { p0[r] = p0[r] - mref; p1[r] = p1[r] - mref; }
#pragma unroll
    for (int r = 0; r < 16; ++r) p0[r] = __builtin_amdgcn_exp2f(p0[r]);
}
__device__ __forceinline__ void finishSM(f32x16& p0, f32x16& p1, float alpha, float& l_reg, bf16x8& pa0, bf16x8& pa1, bf16x8& pa2, bf16x8& pa3) {
#pragma unroll
    for (int r = 0; r < 16; ++r) p1[r] = __builtin_amdgcn_exp2f(p1[r]);
    float ps = 0;
#pragma unroll
    for (int r = 0; r < 16; ++r) ps += p0[r];
#pragma unroll
    for (int r = 0; r < 16; ++r) ps += p1[r];
    { auto rr = __builtin_amdgcn_permlane32_swap(__float_as_uint(ps), __float_as_uint(ps), false, false);
      ps = __uint_as_float(rr[0]) + __uint_as_float(rr[1]); }
    l_reg = l_reg * alpha + ps;
#define PK4(P, B_, OUT) do { unsigned a0 = cvtpk(P[B_+0], P[B_+1]), a1 = cvtpk(P[B_+2], P[B_+3]);                          \
        unsigned b0 = cvtpk(P[B_+4], P[B_+5]), b1 = cvtpk(P[B_+6], P[B_+7]);                                             \
        auto r0 = __builtin_amdgcn_permlane32_swap(a0, b0, false, false); auto r1 = __builtin_amdgcn_permlane32_swap(a1, b1, false, false); \
        u32x4 w = {r0[0], r1[0], r0[1], r1[1]}; OUT = __builtin_bit_cast(bf16x8, w); } while (0)
    PK4(p0, 0, pa0); PK4(p0, 8, pa1); PK4(p1, 0, pa2); PK4(p1, 8, pa3);
#undef PK4
}
template <int KB, int DQK>
__device__ __forceinline__ void qkt(f32x16& p0, f32x16& p1, const lchar* K_lds, int koff, int r32, int hi, const bf16x8* qr, bool act, bool nearb, unsigned bb) {
    if (!act) { const float NEG = -__builtin_inff();
#pragma unroll
        for (int r = 0; r < 16; ++r) { p0[r] = NEG; p1[r] = NEG; } return; }
    if (nearb) {
#pragma unroll
        for (int r = 0; r < 16; ++r) { const int c = (r & 3) + 8 * (r >> 2);
            p0[r] = *(const ALAS float*)(uintptr_t)(bb + 4u * (unsigned)(59 - c)); p1[r] = *(const ALAS float*)(uintptr_t)(bb + 4u * (unsigned)(27 - c)); }
    } else { p0 = f32x16{}; p1 = f32x16{}; }
    const lchar* kb[4];
#pragma unroll
    for (int dd = 0; dd < 4; ++dd) kb[dd] = K_lds + KB * SHM_K + KSWZ(r32, (dd * 16 + hi * 8) * 2) + koff;
#pragma unroll
    for (int d0 = 0; d0 < DQK / 16; ++d0) { const lchar* a = kb[d0 & 3] + (d0 >> 2) * 128;
        const bf16x8 b0 = *reinterpret_cast<const ALAS bf16x8*>(a);
        const bf16x8 b1 = *reinterpret_cast<const ALAS bf16x8*>(a + 32 * 256);
        p0 = __builtin_amdgcn_mfma_f32_32x32x16_bf16(b0, qr[d0], p0, 0, 0, 0);
        p1 = __builtin_amdgcn_mfma_f32_32x32x16_bf16(b1, qr[d0], p1, 0, 0, 0); }
}
template <int VB>
__device__ __forceinline__ void pv_tile(f32x16* o, unsigned vb0, bf16x8 pa0, bf16x8 pa1, bf16x8 pa2, bf16x8 pa3, bool act) {
    if (!act) return;
#define TRRD(dst, off) asm volatile("ds_read_b64_tr_b16 %0, %1 offset:%2" : "=&v"(dst) : "v"(vb0), "i"(off) : "memory")
#define PV_D0(d0) do { s16x4 l0, l1, l2, l3, h0, h1, h2, h3; constexpr int b_ = VB * SHM_V + v_rd_off(d0, 0, 0);   \
        TRRD(l0, b_); TRRD(h0, b_ + 2048); TRRD(l1, b_ + 4096); TRRD(h1, b_ + 6144); TRRD(l2, b_ + 8192); TRRD(h2, b_ + 10240); TRRD(l3, b_ + 12288); TRRD(h3, b_ + 14336); \
        asm volatile("s_waitcnt lgkmcnt(0)" ::: "memory"); SBAR();   \
        o[d0] = __builtin_amdgcn_mfma_f32_32x32x16_bf16(pa0, (bf16x8){l0[0], l0[1], l0[2], l0[3], h0[0], h0[1], h0[2], h0[3]}, o[d0], 0, 0, 0);   \
        o[d0] = __builtin_amdgcn_mfma_f32_32x32x16_bf16(pa1, (bf16x8){l1[0], l1[1], l1[2], l1[3], h1[0], h1[1], h1[2], h1[3]}, o[d0], 0, 0, 0);   \
        o[d0] = __builtin_amdgcn_mfma_f32_32x32x16_bf16(pa2, (bf16x8){l2[0], l2[1], l2[2], l2[3], h2[0], h2[1], h2[2], h2[3]}, o[d0], 0, 0, 0);   \
        o[d0] = __builtin_amdgcn_mfma_f32_32x32x16_bf16(pa3, (bf16x8){l3[0], l3[1], l3[2], l3[3], h3[0], h3[1], h3[2], h3[3]}, o[d0], 0, 0, 0); } while (0)
    PV_D0(0); PV_D0(1); PV_D0(2); PV_D0(3);
#undef PV_D0
#undef TRRD
}
__device__ __forceinline__ void partialSM_rel(f32x16& p0, f32x16& p1, float& m_reg, float& alpha, bool& started, f32x16& negm) {
    float pmax = fmaxf(p0[0], p1[0]);
#pragma unroll
    for (int r = 1; r < 16; ++r) pmax = fmaxf(pmax, fmaxf(p0[r], p1[r]));
    { auto rr = __builtin_amdgcn_permlane32_swap(__float_as_uint(pmax), __float_as_uint(pmax), false, false);
      pmax = fmaxf(__uint_as_float(rr[0]), __uint_as_float(rr[1])); }
    const bool fin = pmax > -__builtin_inff();
    alpha = 1.f;
    if (__builtin_expect(__any((started && pmax > THR) || (!started && fin)), 0)) {
        const float delta = started ? fmaxf(pmax, 0.f) : (fin ? pmax : 0.f);
        alpha = started ? __builtin_amdgcn_exp2f(-delta) : 1.f;
        started = started || fin;
        m_reg += delta;
#pragma unroll
        for (int r = 0; r < 16; ++r) { p0[r] -= delta; p1[r] -= delta; }
        const float nm = -m_reg;
#pragma unroll
        for (int r = 0; r < 16; ++r) negm[r] = nm;
    }
#pragma unroll
    for (int r = 0; r < 16; ++r) p0[r] = __builtin_amdgcn_exp2f(p0[r]);
}
typedef float f32x2 __attribute__((ext_vector_type(2)));
__device__ __forceinline__ void finishSM_pk(f32x16& p0, f32x16& p1, float alpha, float& l_reg, bf16x8& pa0, bf16x8& pa1, bf16x8& pa2, bf16x8& pa3) {
#pragma unroll
    for (int r = 0; r < 16; ++r) p1[r] = __builtin_amdgcn_exp2f(p1[r]);
    f32x2 s2 = (f32x2){p0[0], p0[1]} + (f32x2){p1[0], p1[1]};
#pragma unroll
    for (int r = 2; r < 16; r += 2) { s2 += (f32x2){p0[r], p0[r + 1]}; s2 += (f32x2){p1[r], p1[r + 1]}; }
    float ps = s2.x + s2.y;
    { auto rr = __builtin_amdgcn_permlane32_swap(__float_as_uint(ps), __float_as_uint(ps), false, false);
      ps = __uint_as_float(rr[0]) + __uint_as_float(rr[1]); }
    l_reg = l_reg * alpha + ps;
#define PK4(P, B_, OUT) do { unsigned a0 = cvtpk(P[B_+0], P[B_+1]), a1 = cvtpk(P[B_+2], P[B_+3]);                          \
        unsigned b0 = cvtpk(P[B_+4], P[B_+5]), b1 = cvtpk(P[B_+6], P[B_+7]);                                             \
        auto r0 = __builtin_amdgcn_permlane32_swap(a0, b0, false, false); auto r1 = __builtin_amdgcn_permlane32_swap(a1, b1, false, false); \
        u32x4 w = {r0[0], r1[0], r0[1], r1[1]}; OUT = __builtin_bit_cast(bf16x8, w); } while (0)
    PK4(p0, 0, pa0); PK4(p0, 8, pa1); PK4(p1, 0, pa2); PK4(p1, 8, pa3);
#undef PK4
}
template <int DQK>
__device__ __forceinline__ void qkt_neg(f32x16& p0, f32x16& p1, const lchar* Kb, int koff, int r32, int hi, const bf16x8* qr, bool act, bool nearb, unsigned bb, const f32x16& negm) {
    if (!act) { const float NEG = -__builtin_inff();
#pragma unroll
        for (int r = 0; r < 16; ++r) { p0[r] = NEG; p1[r] = NEG; } return; }
    const lchar* kb[4];
#pragma unroll
    for (int dd = 0; dd < 4; ++dd) kb[dd] = Kb + KSWZ(r32, (dd * 16 + hi * 8) * 2) + koff;
    if (nearb) {
#pragma unroll
        for (int r = 0; r < 16; ++r) { const int c = (r & 3) + 8 * (r >> 2);
            p0[r] = *(const ALAS float*)(uintptr_t)(bb + 4u * (unsigned)(59 - c)) + negm[r]; p1[r] = *(const ALAS float*)(uintptr_t)(bb + 4u * (unsigned)(27 - c)) + negm[r]; }
    }
    constexpr int NG = DQK / 32;
    bf16x8 kf[2][4];
#define KRD(g, sl) do { _Pragma("unroll") for (int j_ = 0; j_ < 2; ++j_) { const int d0_ = 2 * (g) + j_; const lchar* a_ = kb[d0_ & 3] + (d0_ >> 2) * 128; \
        kf[sl][2 * j_] = *reinterpret_cast<const ALAS bf16x8*>(a_); kf[sl][2 * j_ + 1] = *reinterpret_cast<const ALAS bf16x8*>(a_ + 32 * 256); } } while (0)
    KRD(0, 0); if (NG > 1) KRD(1, 1);
    SBAR();
#pragma unroll
    for (int g = 0; g < NG; ++g) {
#pragma unroll
        for (int j = 0; j < 2; ++j) {
            if (g == 0 && j == 0) {
                if (nearb) { p0 = __builtin_amdgcn_mfma_f32_32x32x16_bf16(kf[0][0], qr[0], p0, 0, 0, 0); p1 = __builtin_amdgcn_mfma_f32_32x32x16_bf16(kf[0][1], qr[0], p1, 0, 0, 0); }
                else { p0 = __builtin_amdgcn_mfma_f32_32x32x16_bf16(kf[0][0], qr[0], negm, 0, 0, 0); p1 = __builtin_amdgcn_mfma_f32_32x32x16_bf16(kf[0][1], qr[0], negm, 0, 0, 0); }
            } else { p0 = __builtin_amdgcn_mfma_f32_32x32x16_bf16(kf[g & 1][2 * j], qr[2 * g + j], p0, 0, 0, 0); p1 = __builtin_amdgcn_mfma_f32_32x32x16_bf16(kf[g & 1][2 * j + 1], qr[2 * g + j], p1, 0, 0, 0); }
        }
        if (g + 2 < NG) { SBAR(); KRD(g + 2, g & 1); SBAR(); }
    }
#undef KRD
}
template <int DQK>
__device__ __forceinline__ void qkt_rt(f32x16& p0, f32x16& p1, const lchar* Kb, int koff, int r32, int hi, const bf16x8* qr, bool act, bool nearb, unsigned bb) {
    if (!act) { const float NEG = -__builtin_inff();
#pragma unroll
        for (int r = 0; r < 16; ++r) { p0[r] = NEG; p1[r] = NEG; } return; }
    if (nearb) {
#pragma unroll
        for (int r = 0; r < 16; ++r) { const int c = (r & 3) + 8 * (r >> 2);
            p0[r] = *(const ALAS float*)(uintptr_t)(bb + 4u * (unsigned)(59 - c)); p1[r] = *(const ALAS float*)(uintptr_t)(bb + 4u * (unsigned)(27 - c)); }
    } else { p0 = f32x16{}; p1 = f32x16{}; }
    const lchar* kb[4];
#pragma unroll
    for (int dd = 0; dd < 4; ++dd) kb[dd] = Kb + KSWZ(r32, (dd * 16 + hi * 8) * 2) + koff;
    if constexpr (DQK == 64) {
    constexpr int NG = DQK / 32;
    bf16x8 kf[2][4];
#define KRD(g, sl) do { _Pragma("unroll") for (int j_ = 0; j_ < 2; ++j_) { const int d0_ = 2 * (g) + j_; const lchar* a_ = kb[d0_ & 3] + (d0_ >> 2) * 128; \
        kf[sl][2 * j_] = *reinterpret_cast<const ALAS bf16x8*>(a_); kf[sl][2 * j_ + 1] = *reinterpret_cast<const ALAS bf16x8*>(a_ + 32 * 256); } } while (0)
    KRD(0, 0); if (NG > 1) KRD(1, 1);
    SBAR();
#pragma unroll
    for (int g = 0; g < NG; ++g) {
#pragma unroll
        for (int j = 0; j < 2; ++j) { p0 = __builtin_amdgcn_mfma_f32_32x32x16_bf16(kf[g & 1][2 * j], qr[2 * g + j], p0, 0, 0, 0); p1 = __builtin_amdgcn_mfma_f32_32x32x16_bf16(kf[g & 1][2 * j + 1], qr[2 * g + j], p1, 0, 0, 0); }
        if (g + 2 < NG) { SBAR(); KRD(g + 2, g & 1); SBAR(); }
    }
#undef KRD
    } else {
#pragma unroll
        for (int g = 0; g < DQK / 32; ++g) {
            bf16x8 kg[4];
#pragma unroll
            for (int j = 0; j < 2; ++j) { const int d0 = 2 * g + j; const lchar* a = kb[d0 & 3] + (d0 >> 2) * 128;
                kg[2 * j] = *reinterpret_cast<const ALAS bf16x8*>(a); kg[2 * j + 1] = *reinterpret_cast<const ALAS bf16x8*>(a + 32 * 256); }
            SBAR();
#pragma unroll
            for (int j = 0; j < 2; ++j) { p0 = __builtin_amdgcn_mfma_f32_32x32x16_bf16(kg[2 * j], qr[2 * g + j], p0, 0, 0, 0); p1 = __builtin_amdgcn_mfma_f32_32x32x16_bf16(kg[2 * j + 1], qr[2 * g + j], p1, 0, 0, 0); }
            SBAR();
        }
    }
}
__device__ __forceinline__ void pv_rt(f32x16* o, unsigned vb, bf16x8 pa0, bf16x8 pa1, bf16x8 pa2, bf16x8 pa3, bool act) {
    if (!act) return;
#define TRRD(dst, off) asm volatile("ds_read_b64_tr_b16 %0, %1 offset:%2" : "=&v"(dst) : "v"(vb), "i"(off) : "memory")
#define PV_D0(d0) do { s16x4 l0, l1, l2, l3, h0, h1, h2, h3; constexpr int b_ = v_rd_off(d0, 0, 0);   \
        TRRD(l0, b_); TRRD(h0, b_ + 2048); TRRD(l1, b_ + 4096); TRRD(h1, b_ + 6144); TRRD(l2, b_ + 8192); TRRD(h2, b_ + 10240); TRRD(l3, b_ + 12288); TRRD(h3, b_ + 14336); \
        asm volatile("s_waitcnt lgkmcnt(0)" ::: "memory"); SBAR();   \
        o[d0] = __builtin_amdgcn_mfma_f32_32x32x16_bf16(pa0, (bf16x8){l0[0], l0[1], l0[2], l0[3], h0[0], h0[1], h0[2], h0[3]}, o[d0], 0, 0, 0);   \
        o[d0] = __builtin_amdgcn_mfma_f32_32x32x16_bf16(pa1, (bf16x8){l1[0], l1[1], l1[2], l1[3], h1[0], h1[1], h1[2], h1[3]}, o[d0], 0, 0, 0);   \
        o[d0] = __builtin_amdgcn_mfma_f32_32x32x16_bf16(pa2, (bf16x8){l2[0], l2[1], l2[2], l2[3], h2[0], h2[1], h2[2], h2[3]}, o[d0], 0, 0, 0);   \
        o[d0] = __builtin_amdgcn_mfma_f32_32x32x16_bf16(pa3, (bf16x8){l3[0], l3[1], l3[2], l3[3], h3[0], h3[1], h3[2], h3[3]}, o[d0], 0, 0, 0); } while (0)
    PV_D0(0); PV_D0(1); PV_D0(2); PV_D0(3);
#undef PV_D0
#undef TRRD
}
template <int MODE> __device__ __forceinline__ bool tile_act(int key0, int tj, const Lane L, unsigned sw0, unsigned sw1, unsigned sw2, unsigned sw3) {
    if constexpr (MODE == M_DIFF) return key0 <= L.qhi;
    else if constexpr (MODE == M_CMP) return 16 * key0 + 31 <= L.qhi;
    else if constexpr (MODE == M_WIN) return key0 <= L.qhi && key0 + 63 >= L.qlo - 511;
    else { const unsigned w = tj < 64 ? (tj < 32 ? sw0 : sw1) : (tj < 96 ? sw2 : sw3); return __any((int)((w >> (tj & 31)) & 1u)) != 0; }
}
template <int MODE> __device__ __forceinline__ bool tile_near(int key0, const Lane L) {
    if constexpr (MODE == M_CMP) return false; else return key0 + 63 > L.qlo - 113;
}
template <int MODE> __device__ __forceinline__ bool tile_needs_mask(int key0, const Lane L) {
    if constexpr (MODE == M_DIFF) return key0 + 63 > L.qlo;
    else if constexpr (MODE == M_CMP) return 16 * (key0 + 63) + 31 > L.qlo;
    else if constexpr (MODE == M_WIN) return key0 + 63 > L.qlo || key0 <= L.qhi - 512;
    else return true;
}
template <int MODE> __device__ __forceinline__ void tile_mask(f32x16& p0, f32x16& p1, int key0, int tj, const Lane L, int hi, bool act, unsigned sw0, unsigned sw1, unsigned sw2, unsigned sw3) {
    if (!act) return;
    if constexpr (MODE == M_DIFF) { if (key0 + 63 > L.qlo) mask_sel<MODE>(p0, p1, key0, tj, L, hi, true, sw0, sw1, sw2, sw3); }
    else if constexpr (MODE == M_CMP) { if (16 * (key0 + 63) + 31 > L.qlo) mask_sel<MODE>(p0, p1, key0, tj, L, hi, true, sw0, sw1, sw2, sw3); }
    else if constexpr (MODE == M_WIN) { if (key0 + 63 > L.qlo || key0 <= L.qhi - 512) mask_sel<MODE>(p0, p1, key0, tj, L, hi, true, sw0, sw1, sw2, sw3); }
    else { mask_sel<MODE>(p0, p1, key0, tj, L, hi, key0 + 63 > L.qlo, sw0, sw1, sw2, sw3); }
}
template <int MODE, int DQK>
__device__ __forceinline__ void attn_tiles1(lchar* lds, const bf16_t* __restrict__ Kg, const bf16_t* __restrict__ Vg, int ld, int j_lo, int NT, const ALAS int* list,
                                           const bf16x8* qr, int koff, const Lane L, unsigned sw0, unsigned sw1, unsigned sw2, unsigned sw3, f32x16* o, float& m_reg, float& l_reg) {
    int tid = threadIdx.x; asm volatile("" : "+v"(tid));
    const int wid = __builtin_amdgcn_readfirstlane(tid >> 6), lane = tid & 63, r32 = lane & 31, hi = lane >> 5;
    lchar* V_lds = lds + L_V; lchar* K_lds = lds + L_K;
    ALAS float* al_l = (ALAS float*)(lds + L_WS) + wid * 64 + 32;
    m_reg = -1e30f; l_reg = 0.f; o[0] = f32x16{}; o[1] = f32x16{}; o[2] = f32x16{}; o[3] = f32x16{};
    const int sr = tid >> 4, sc = (tid & 15) * 8, vst0 = v_st(sr, sc), vst1 = v_st(32 + sr, sc), kws = KSWZ(sr, sc * 2);
    const unsigned vb0 = lds_addr(V_lds) + (unsigned)v_rd_base(lane);
    bf16x8 st_v0, st_v1, st_k0, st_k1;
#define TIDX(t) ((MODE == M_SLC) ? __builtin_amdgcn_readfirstlane(list[(t)]) : (j_lo + (t)))
#define SLOAD(t) do { const size_t k0_ = (size_t)TIDX(t) * KVBLK; st_v0 = *(const bf16x8*)(Vg + (k0_ + sr) * ld + sc); st_v1 = *(const bf16x8*)(Vg + (k0_ + 32 + sr) * ld + sc); \
                      st_k0 = *(const bf16x8*)(Kg + (k0_ + sr) * ld + sc); st_k1 = *(const bf16x8*)(Kg + (k0_ + 32 + sr) * ld + sc); } while (0)
#define SWRITE(bf) do { *(ALAS bf16x8*)(V_lds + (bf) * SHM_V + vst0) = st_v0; *(ALAS bf16x8*)(V_lds + (bf) * SHM_V + vst1) = st_v1; \
                        *(ALAS bf16x8*)(K_lds + (bf) * SHM_K + kws) = st_k0; *(ALAS bf16x8*)(K_lds + (bf) * SHM_K + kws + 32 * 256) = st_k1; } while (0)
#define VMW() asm volatile("s_waitcnt vmcnt(0)" ::: "memory")
#define RESC(a) do { if (__any((a) < 1.f)) { if (hi == 0) al_l[r32] = (a); asm volatile("s_waitcnt lgkmcnt(0)" ::: "memory");              \
                     _Pragma("unroll") for (int d_ = 0; d_ < 4; ++d_) _Pragma("unroll") for (int r = 0; r < 16; ++r) o[d_][r] *= al_l[crow(r, hi)]; } } while (0)
#define ACT(t) tile_act<MODE>(TIDX(t) * KVBLK, TIDX(t), L, sw0, sw1, sw2, sw3)
#define NEARB(t) tile_near<MODE>(TIDX(t) * KVBLK, L)
#define BB(t) (L.lut + 4u * (unsigned)(L.qpos - TIDX(t) * KVBLK - 4 * hi + LUT0 - 59))
#define MASKT(P0_, P1_, t, a_) tile_mask<MODE>(P0_, P1_, TIDX(t) * KVBLK, TIDX(t), L, hi, a_, sw0, sw1, sw2, sw3)
    f32x16 p0, p1; float al = 1.f; bf16x8 pa0, pa1, pa2, pa3;
    SLOAD(0); VMW(); SWRITE(0); SBAR();
    if (NT > 1) SLOAD(1);
    __syncthreads();
#define STEP(t, BF) do {                                                                                                  \
        const bool a_ = ACT(t);                                                                                           \
        SBAR(); qkt<BF, DQK>(p0, p1, K_lds, koff, r32, hi, qr, a_, NEARB(t), BB(t));                                      \
        MASKT(p0, p1, (t), a_); partialSM(p0, p1, m_reg, al); RESC(al);                                                   \
        finishSM(p0, p1, al, l_reg, pa0, pa1, pa2, pa3); SBAR();                                                          \
        if ((t) + 1 < NT) { VMW(); SWRITE((BF) ^ 1); SBAR(); if ((t) + 2 < NT) { SLOAD((t) + 2); SBAR(); } }              \
        pv_tile<BF>(o, vb0, pa0, pa1, pa2, pa3, a_);                                                                      \
        __syncthreads(); } while (0)
    int t = 0;
    for (; t + 1 < NT; t += 2) { STEP(t, 0); STEP(t + 1, 1); }
    if (t < NT) STEP(t, 0);
#undef STEP
#undef TIDX
#undef SLOAD
#undef SWRITE
#undef VMW
#undef RESC
#undef ACT
#undef NEARB
#undef BB
#undef MASKT
}
template <int MODE, int DQK>
__device__ __forceinline__ void attn_tiles2(lchar* lds, const bf16_t* __restrict__ Kg, const bf16_t* __restrict__ Vg, int ld, int j_lo, int NT, const ALAS int* list,
                                           const bf16x8* qr, int koff, const Lane L, unsigned sw0, unsigned sw1, unsigned sw2, unsigned sw3, f32x16* o, float& m_reg, float& l_reg) {
    int tid = threadIdx.x; asm volatile("" : "+v"(tid));
    const int wid = __builtin_amdgcn_readfirstlane(tid >> 6), lane = tid & 63, r32 = lane & 31, hi = lane >> 5;
    lchar* V_lds = lds + L_V; lchar* K_lds = lds + L_K;
    ALAS float* al_l = (ALAS float*)(lds + L_WS) + wid * 64 + 32;
    m_reg = -1e30f; l_reg = 0.f; o[0] = f32x16{}; o[1] = f32x16{}; o[2] = f32x16{}; o[3] = f32x16{};
    const int sr = tid >> 4, sc = (tid & 15) * 8, vst0 = v_st(sr, sc), vst1 = v_st(32 + sr, sc), kws = KSWZ(sr, sc * 2);
    const unsigned vb0 = lds_addr(V_lds) + (unsigned)v_rd_base(lane);
    bf16x8 st_v0, st_v1, st_k0, st_k1;
#define TIDX(t) ((MODE == M_SLC) ? __builtin_amdgcn_readfirstlane(list[(t)]) : (j_lo + (t)))
#define SLOAD(t) do { const size_t k0_ = (size_t)TIDX(t) * KVBLK; st_v0 = *(const bf16x8*)(Vg + (k0_ + sr) * ld + sc); st_v1 = *(const bf16x8*)(Vg + (k0_ + 32 + sr) * ld + sc); \
                      st_k0 = *(const bf16x8*)(Kg + (k0_ + sr) * ld + sc); st_k1 = *(const bf16x8*)(Kg + (k0_ + 32 + sr) * ld + sc); } while (0)
#define SWRITE(bf) do { *(ALAS bf16x8*)(V_lds + (bf) * SHM_V + vst0) = st_v0; *(ALAS bf16x8*)(V_lds + (bf) * SHM_V + vst1) = st_v1; \
                        *(ALAS bf16x8*)(K_lds + (bf) * SHM_K + kws) = st_k0; *(ALAS bf16x8*)(K_lds + (bf) * SHM_K + kws + 32 * 256) = st_k1; } while (0)
#define VMW() asm volatile("s_waitcnt vmcnt(0)" ::: "memory")
#define RESC(a) do { if (__any((a) < 1.f)) { if (hi == 0) al_l[r32] = (a); asm volatile("s_waitcnt lgkmcnt(0)" ::: "memory");              \
                     _Pragma("unroll") for (int d_ = 0; d_ < 4; ++d_) _Pragma("unroll") for (int r = 0; r < 16; ++r) o[d_][r] *= al_l[crow(r, hi)]; } } while (0)
#define ACT(t) tile_act<MODE>(TIDX(t) * KVBLK, TIDX(t), L, sw0, sw1, sw2, sw3)
#define NEARB(t) tile_near<MODE>(TIDX(t) * KVBLK, L)
#define BB(t) (L.lut + 4u * (unsigned)(L.qpos - TIDX(t) * KVBLK - 4 * hi + LUT0 - 59))
#define MASKT(P0_, P1_, t, a_) tile_mask<MODE>(P0_, P1_, TIDX(t) * KVBLK, TIDX(t), L, hi, a_, sw0, sw1, sw2, sw3)
    f32x16 pA0, pA1, pB0, pB1; float alA = 1.f, alB = 1.f; bf16x8 pa0, pa1, pa2, pa3;
    SLOAD(0); VMW(); SWRITE(0); SBAR();
    if (NT > 1) SLOAD(1);
    __syncthreads();
    { const bool a0_ = ACT(0); SBAR(); qkt<0, DQK>(pA0, pA1, K_lds, koff, r32, hi, qr, a0_, NEARB(0), BB(0)); MASKT(pA0, pA1, 0, a0_); partialSM(pA0, pA1, m_reg, alA); }
    if (NT > 1) { VMW(); SWRITE(1); }
    __syncthreads();
#define HALF_STEP(PX0, PX1, alX, PY0, PY1, alY, t, KB, VB, SB) do {                                                      \
        const bool ax_ = ACT(t), ay_ = ACT((t) - 1);                                                                      \
        SBAR(); qkt<KB, DQK>(PX0, PX1, K_lds, koff, r32, hi, qr, ax_, NEARB(t), BB(t));                                   \
        finishSM(PY0, PY1, alY, l_reg, pa0, pa1, pa2, pa3); SBAR();                                                       \
        if ((t) + 1 < NT) { SLOAD((t) + 1); SBAR(); }                                                                     \
        pv_tile<VB>(o, vb0, pa0, pa1, pa2, pa3, ay_); MASKT(PX0, PX1, (t), ax_); partialSM(PX0, PX1, m_reg, alX);         \
        __syncthreads();                                                                                                  \
        if ((t) + 1 < NT) { VMW(); SWRITE(SB); }                                                                          \
        RESC(alX); __syncthreads(); } while (0)
    for (int t = 1; t + 1 < NT; t += 2) {
        HALF_STEP(pB0, pB1, alB, pA0, pA1, alA, t, 1, 0, 0);
        HALF_STEP(pA0, pA1, alA, pB0, pB1, alB, t + 1, 0, 1, 1);
    }
    const bool even = (NT & 1) == 0;
    const bool aL_ = ACT(NT - 1), aP_ = even ? ACT(NT - 2) : aL_;
    if (even) { SBAR(); qkt<1, DQK>(pB0, pB1, K_lds, koff, r32, hi, qr, aL_, NEARB(NT - 1), BB(NT - 1)); SBAR(); }
    finishSM(pA0, pA1, alA, l_reg, pa0, pa1, pa2, pa3); SBAR();
    pv_tile<0>(o, vb0, pa0, pa1, pa2, pa3, aP_);
    if (even) { MASKT(pB0, pB1, NT - 1, aL_); partialSM(pB0, pB1, m_reg, alB); __syncthreads(); RESC(alB);
        finishSM(pB0, pB1, alB, l_reg, pa0, pa1, pa2, pa3); SBAR(); pv_tile<1>(o, vb0, pa0, pa1, pa2, pa3, aL_); }
    __syncthreads();
#undef HALF_STEP
#undef TIDX
#undef SLOAD
#undef SWRITE
#undef VMW
#undef RESC
#undef ACT
#undef NEARB
#undef BB
#undef MASKT
}
#ifdef TPROBE_SEC
#define TP_ON (MODE == TPROBE_MODE && blockIdx.x == 0 && wid == TPROBE_WAVE)
#define TP_T(k) do { if (TP_ON) tp_[(k)] = __builtin_readcyclecounter(); } while (0)
#define TP_PIN(x) asm volatile("" :: "v"(x))
#define TP_ACC() do { if (TP_ON) { const unsigned long long sec_ = tp_[TPROBE_SEC + 1] - tp_[TPROBE_SEC]; tp_sec_ += sec_; tp_tot_ += tp_[5] - tp_[0]; } } while (0)
#define TP_ACC_Y() do { if (TP_ON) { const unsigned long long sec_ = (TPROBE_SEC == 0) ? tp_[1] - tp_[0] : (TPROBE_SEC == 1) ? tp_[7] - tp_[6] : (TPROBE_SEC == 2) ? tp_[6] - tp_[1] : (TPROBE_SEC == 3) ? tp_[4] - tp_[3] : tp_[5] - tp_[7]; tp_sec_ += sec_; tp_tot_ += tp_[5] - tp_[3]; } } while (0)
#else
#define TP_T(k) do {} while (0)
#define TP_PIN(x) do {} while (0)
#define TP_ACC() do {} while (0)
#define TP_ACC_Y() do {} while (0)
#endif
template <int MODE, int DQK, bool NEGM = false>
__device__ __forceinline__ void attn_tiles(lchar* lds, const bf16_t* __restrict__ Kg, const bf16_t* __restrict__ Vg, int ld, int j_lo, int NT, const ALAS int* list,
                                           const bf16x8* qr, int koff, const Lane L, unsigned sw0, unsigned sw1, unsigned sw2, unsigned sw3, f32x16* o, float& m_reg, float& l_reg) {
    int tid = threadIdx.x; asm volatile("" : "+v"(tid));
    const int wid = __builtin_amdgcn_readfirstlane(tid >> 6), lane = tid & 63, r32 = lane & 31, hi = lane >> 5;
    lchar* V_lds = lds + L_V; lchar* K_lds = lds + L_K;
    ALAS float* al_l = (ALAS float*)(lds + L_WS) + wid * 64 + 32;
    m_reg = -1e30f; l_reg = 0.f; o[0] = f32x16{}; o[1] = f32x16{}; o[2] = f32x16{}; o[3] = f32x16{};
    const int sr = tid >> 4, sc = (tid & 15) * 8, vst0 = v_st(sr, sc), vst1 = v_st(32 + sr, sc), kws = KSWZ(sr, sc * 2);
    const unsigned vb0 = lds_addr(V_lds) + (unsigned)v_rd_base(lane);
    bf16x8 st_v0, st_v1, st_k0, st_k1;
#define TIDX(t) ((MODE == M_SLC) ? __builtin_amdgcn_readfirstlane(list[(t)]) : (j_lo + (t)))
#define SLOAD(t) do { const size_t k0_ = (size_t)TIDX(t) * KVBLK; st_v0 = *(const bf16x8*)(Vg + (k0_ + sr) * ld + sc); st_v1 = *(const bf16x8*)(Vg + (k0_ + 32 + sr) * ld + sc); \
                      st_k0 = *(const bf16x8*)(Kg + (k0_ + sr) * ld + sc); st_k1 = *(const bf16x8*)(Kg + (k0_ + 32 + sr) * ld + sc); } while (0)
#define SWRITE(ko, vo) do { *(ALAS bf16x8*)(V_lds + (vo) + vst0) = st_v0; *(ALAS bf16x8*)(V_lds + (vo) + vst1) = st_v1; \
                            *(ALAS bf16x8*)(K_lds + (ko) + kws) = st_k0; *(ALAS bf16x8*)(K_lds + (ko) + kws + 32 * 256) = st_k1; } while (0)
#define VMW() asm volatile("s_waitcnt vmcnt(0)" ::: "memory")
#define RESC(a) do { if (__any((a) < 1.f)) { if (hi == 0) al_l[r32] = (a); asm volatile("s_waitcnt lgkmcnt(0)" ::: "memory");              \
                     _Pragma("unroll") for (int d_ = 0; d_ < 4; ++d_) _Pragma("unroll") for (int r = 0; r < 16; ++r) o[d_][r] *= al_l[crow(r, hi)]; } } while (0)
#define ACT(t) tile_act<MODE>(TIDX(t) * KVBLK, TIDX(t), L, sw0, sw1, sw2, sw3)
#define NEARB(t) tile_near<MODE>(TIDX(t) * KVBLK, L)
#define BB(t) (L.lut + 4u * (unsigned)(L.qpos - TIDX(t) * KVBLK - 4 * hi + LUT0 - 59))
#define MASKT(P0_, P1_, t, a_) tile_mask<MODE>(P0_, P1_, TIDX(t) * KVBLK, TIDX(t), L, hi, a_, sw0, sw1, sw2, sw3)
    f32x16 p0, p1; float al = 1.f; bf16x8 pa0, pa1, pa2, pa3;
    pa0 = pa1 = pa2 = pa3 = bf16x8{};
    f32x16 negm = f32x16{}; bool started = false; if (NEGM) { m_reg = 0.f; asm volatile("" : "+v"(negm)); }
#ifdef TPROBE_SEC
    unsigned long long tp_[8] = {0, 0, 0, 0, 0, 0, 0, 0}, tp_sec_ = 0, tp_tot_ = 0;
#endif
    SLOAD(0); VMW(); SWRITE(0, 0); SBAR();
    if (NT > 1) SLOAD(1);
    __syncthreads();
    int kbo = 0, vbo = 0, vbp = 0;
#define STAGE_NEXT(t) do { if ((t) + 1 < NT) { const int vbn_ = (vbo == (NVB - 1) * SHM_V) ? 0 : vbo + SHM_V; VMW(); SWRITE(kbo ^ SHM_K, vbn_); SBAR(); if ((t) + 2 < NT) { SLOAD((t) + 2); SBAR(); } } } while (0)
#define SOFTMAX(t, a_) do { MASKT(p0, p1, (t), a_); if constexpr (NEGM) { partialSM_rel(p0, p1, m_reg, al, started, negm); RESC(al); finishSM_pk(p0, p1, al, l_reg, pa0, pa1, pa2, pa3); } \
        else { partialSM(p0, p1, m_reg, al); RESC(al); finishSM(p0, p1, al, l_reg, pa0, pa1, pa2, pa3); } SBAR(); } while (0)
#define QKT(t, a_) do { if constexpr (NEGM) qkt_neg<DQK>(p0, p1, K_lds + kbo, koff, r32, hi, qr, a_, NEARB(t), BB(t), negm); else qkt_rt<DQK>(p0, p1, K_lds + kbo, koff, r32, hi, qr, a_, NEARB(t), BB(t)); } while (0)
#define ADVANCE() do { vbp = vbo; vbo = (vbo == 2 * SHM_V) ? 0 : vbo + SHM_V; kbo ^= SHM_K; } while (0)
    if (wid < 4) {
        for (int t = 0; t < NT; ++t) {
            const bool a_ = ACT(t);
            TP_T(0);
            SBAR(); QKT(t, a_);
            TP_PIN(p0); TP_T(1);
            SOFTMAX(t, a_);
            TP_T(2);
            STAGE_NEXT(t);
            TP_T(3);
            pv_rt(o, vb0 + (unsigned)vbo, pa0, pa1, pa2, pa3, a_);
            TP_PIN(o[3]); TP_T(4);
            __syncthreads();
            TP_T(5); TP_ACC();
            ADVANCE();
        }
        __syncthreads();
    } else {
        bool ap_ = false;
        for (int t = 0; t < NT; ++t) {
            TP_T(3);
            SBAR(); pv_rt(o, vb0 + (unsigned)vbp, pa0, pa1, pa2, pa3, ap_);
            TP_PIN(o[3]); TP_T(4);
            const bool a_ = ACT(t);
            TP_T(0);
            SBAR(); QKT(t, a_);
            TP_PIN(p0); TP_T(1);
            STAGE_NEXT(t);
            TP_T(6);
            SOFTMAX(t, a_);
            TP_T(7);
            ap_ = a_;
            __syncthreads();
            TP_T(5); TP_ACC_Y();
            ADVANCE();
        }
        SBAR(); pv_rt(o, vb0 + (unsigned)vbp, pa0, pa1, pa2, pa3, ap_);
        __syncthreads();
    }
#ifdef TPROBE_SEC
    if (TP_ON && lane == 0) { atomicAdd(L.tpw, tp_sec_); atomicAdd(L.tpw + 1, tp_tot_); }
#endif
#undef STAGE_NEXT
#undef SOFTMAX
#undef QKT
#undef ADVANCE
#undef TIDX
#undef SLOAD
#undef SWRITE
#undef VMW
#undef RESC
#undef ACT
#undef NEARB
#undef BB
#undef MASKT
}
typedef short v4i16_t __attribute__((ext_vector_type(4)));
__device__ __forceinline__ s16x4 vtr(unsigned a) { return __builtin_bit_cast(s16x4, __builtin_amdgcn_ds_read_tr16_b64_v4i16((ALAS v4i16_t*)(uintptr_t)a)); }
template <int GS, bool ASM = false>
__device__ __forceinline__ void k_first(bf16x8* kg, const lchar* Kb, int koff, int r32, int hi) {
    const lchar* rowp = Kb + r32 * 256; const int e = (hi * 16 + koff) ^ ((r32 & 15) << 4);
#pragma unroll
    for (int j = 0; j < GS; ++j) { const lchar* a = rowp + (e ^ (j * 32));
        if constexpr (ASM) { const unsigned aa_ = lds_addr(a);
            asm volatile("ds_read_b128 %0, %1" : "=v"(kg[2 * j]) : "v"(aa_) : "memory"); asm volatile("ds_read_b128 %0, %1 offset:8192" : "=v"(kg[2 * j + 1]) : "v"(aa_) : "memory"); }
        else { kg[2 * j] = *reinterpret_cast<const ALAS bf16x8*>(a); kg[2 * j + 1] = *reinterpret_cast<const ALAS bf16x8*>(a + 32 * 256); } }
}
template <int DQK, bool FIXM = false, int GS = 2, bool PRE = false, bool VPRE = false, bool KDB = false>
__device__ __forceinline__ void qkt_dma(f32x16& p0, f32x16& p1, const lchar* Kb, int koff, int r32, int hi, const bf16x8* qr, bool act, bool nearb, unsigned bb, const f32x16& negm = f32x16{}, const bf16x8* kpre = nullptr,
                                        s16x4* vpre = nullptr, unsigned vbaddr = 0u) {
    if (!act) { const float NEG = -__builtin_inff();
        if constexpr (PRE && KDB) { asm volatile("s_waitcnt lgkmcnt(0)" ::: "memory"); SBAR(); }
#pragma unroll
        for (int r = 0; r < 16; ++r) { p0[r] = NEG; p1[r] = NEG; } return; }
    const lchar* rowp = Kb + r32 * 256; const int e = (hi * 16 + koff) ^ ((r32 & 15) << 4);
    constexpr int NG = DQK / (16 * GS);
    bf16x8 kg[KDB ? 2 : 1][2 * GS];
#define KLD(g_, sl_) do { _Pragma("unroll") for (int j = 0; j < GS; ++j) { const int d0 = GS * (g_) + j; const lchar* a = rowp + (e ^ (d0 * 32));   \
            if constexpr (KDB) { const unsigned aa_ = lds_addr(a);                                                                                     \
                asm volatile("ds_read_b128 %0, %1" : "=v"(kg[sl_][2 * j]) : "v"(aa_) : "memory"); asm volatile("ds_read_b128 %0, %1 offset:8192" : "=v"(kg[sl_][2 * j + 1]) : "v"(aa_) : "memory"); }   \
            else { kg[sl_][2 * j] = *reinterpret_cast<const ALAS bf16x8*>(a); kg[sl_][2 * j + 1] = *reinterpret_cast<const ALAS bf16x8*>(a + 32 * 256); } } } while (0)
    if constexpr (PRE) {
#pragma unroll
        for (int j = 0; j < 2 * GS; ++j) kg[0][j] = kpre[j];
    } else KLD(0, 0);
#pragma unroll
    for (int g = 0; g < NG; ++g) {
        constexpr int dummy_ = 0; (void)dummy_;
        const int sl = KDB ? (g & 1) : 0;
        if (KDB) { if (g + 1 < NG) KLD(g + 1, (g + 1) & 1); }
        else if (g > 0) KLD(g, 0);
        if (VPRE && g == NG - 1) {
#pragma unroll
            for (int d_ = 0; d_ < 4; ++d_) { vpre[2 * d_] = vtr(vbaddr + v_rd_off(d_, 0, 0)); vpre[2 * d_ + 1] = vtr(vbaddr + v_rd_off(d_, 0, 1)); }
        }
        if constexpr (KDB) { static_assert(!VPRE, "counted waits assume only K reads in flight"); if (g + 1 < NG) asm volatile("s_waitcnt lgkmcnt(%0)" :: "n"(2 * GS) : "memory"); else asm volatile("s_waitcnt lgkmcnt(0)" ::: "memory"); }
        SBAR();
#pragma unroll
        for (int j = 0; j < GS; ++j) {
            if (g == 0 && j == 0) {
                if constexpr (FIXM) { p0 = __builtin_amdgcn_mfma_f32_32x32x16_bf16(kg[0][0], qr[0], negm, 0, 0, 0); p1 = __builtin_amdgcn_mfma_f32_32x32x16_bf16(kg[0][1], qr[0], negm, 0, 0, 0); }
                else { p0 = __builtin_amdgcn_mfma_f32_32x32x16_bf16(kg[0][0], qr[0], f32x16{}, 0, 0, 0); p1 = __builtin_amdgcn_mfma_f32_32x32x16_bf16(kg[0][1], qr[0], f32x16{}, 0, 0, 0); }
            } else { p0 = __builtin_amdgcn_mfma_f32_32x32x16_bf16(kg[sl][2 * j], qr[GS * g + j], p0, 0, 0, 0); p1 = __builtin_amdgcn_mfma_f32_32x32x16_bf16(kg[sl][2 * j + 1], qr[GS * g + j], p1, 0, 0, 0); }
        }
        SBAR();
    }
#undef KLD
    if (nearb) {
#pragma unroll
        for (int r = 0; r < 16; ++r) { const int c = (r & 3) + 8 * (r >> 2); p0[r] += *(const ALAS float*)(uintptr_t)(bb + 4u * (unsigned)(59 - c)); }
#pragma unroll
        for (int r = 0; r < 16; ++r) { const int c = (r & 3) + 8 * (r >> 2); p1[r] += *(const ALAS float*)(uintptr_t)(bb + 4u * (unsigned)(27 - c)); }
    }
}
template <int NF> __device__ __forceinline__ float qrow_norm2(const bf16x8* qr) {
    float n2 = 0.f;
#pragma unroll
    for (int d0 = 0; d0 < NF; ++d0)
#pragma unroll
        for (int j = 0; j < 8; ++j) { const float a = __uint_as_float(((unsigned)(unsigned short)qr[d0][j]) << 16); n2 += a * a; }
    auto rr = __builtin_amdgcn_permlane32_swap(__float_as_uint(n2), __float_as_uint(n2), false, false);
    return __uint_as_float(rr[0]) + __uint_as_float(rr[1]);
}
__device__ __forceinline__ void decideSM(const f32x16& p0, const f32x16& p1, float& m_reg, float& alpha) {
    float pmax = fmaxf(p0[0], p1[0]);
#pragma unroll
    for (int r = 1; r < 16; ++r) pmax = fmaxf(pmax, fmaxf(p0[r], p1[r]));
    { auto rr = __builtin_amdgcn_permlane32_swap(__float_as_uint(pmax), __float_as_uint(pmax), false, false);
      pmax = fmaxf(__uint_as_float(rr[0]), __uint_as_float(rr[1])); }
    if (__builtin_expect(__all(pmax - m_reg <= THR), 1)) { alpha = 1.f; }
    else { const float mn = fmaxf(m_reg, pmax); alpha = __builtin_amdgcn_exp2f(m_reg - mn); m_reg = mn; }
}
template <bool SUBM>
__device__ __forceinline__ void sm_pv(f32x16* o, unsigned vb, const f32x16& p0, const f32x16& p1, float msub, float& lpart, bool act) {
    if (!act) return;
    float ps = 0.f;
#define KS_STEP(P, B_, ks) do {                                                                                              \
        const s16x4 l0 = vtr(vb + v_rd_off(0, ks, 0)), h0 = vtr(vb + v_rd_off(0, ks, 1)), l1 = vtr(vb + v_rd_off(1, ks, 0)), h1 = vtr(vb + v_rd_off(1, ks, 1));   \
        const s16x4 l2 = vtr(vb + v_rd_off(2, ks, 0)), h2 = vtr(vb + v_rd_off(2, ks, 1)), l3 = vtr(vb + v_rd_off(3, ks, 0)), h3 = vtr(vb + v_rd_off(3, ks, 1));   \
        float e_[8];                                                                                                         \
        _Pragma("unroll") for (int j = 0; j < 8; ++j) { e_[j] = __builtin_amdgcn_exp2f(SUBM ? P[B_ + j] - msub : P[B_ + j]); ps += e_[j]; }                     \
        const u32x4 w_ = {cvtpk(e_[0], e_[1]), cvtpk(e_[2], e_[3]), cvtpk(e_[4], e_[5]), cvtpk(e_[6], e_[7])}; const bf16x8 pa_ = __builtin_bit_cast(bf16x8, w_);   \
        SBAR();                                                                                                              \
        o[0] = __builtin_amdgcn_mfma_f32_32x32x16_bf16(pa_, (bf16x8){l0[0], l0[1], l0[2], l0[3], h0[0], h0[1], h0[2], h0[3]}, o[0], 0, 0, 0);                     \
        o[1] = __builtin_amdgcn_mfma_f32_32x32x16_bf16(pa_, (bf16x8){l1[0], l1[1], l1[2], l1[3], h1[0], h1[1], h1[2], h1[3]}, o[1], 0, 0, 0);                     \
        o[2] = __builtin_amdgcn_mfma_f32_32x32x16_bf16(pa_, (bf16x8){l2[0], l2[1], l2[2], l2[3], h2[0], h2[1], h2[2], h2[3]}, o[2], 0, 0, 0);                     \
        o[3] = __builtin_amdgcn_mfma_f32_32x32x16_bf16(pa_, (bf16x8){l3[0], l3[1], l3[2], l3[3], h3[0], h3[1], h3[2], h3[3]}, o[3], 0, 0, 0);                     \
        SBAR(); } while (0)
    KS_STEP(p0, 0, 0); KS_STEP(p0, 8, 1); KS_STEP(p1, 0, 2); KS_STEP(p1, 8, 3);
#undef KS_STEP
    lpart += ps;
}
template <int DQK>
__device__ __forceinline__ void step_pipe(f32x16* o, const lchar* Kb, int koff, int r32, int hi, const bf16x8* qr, unsigned vb, bool nearb, unsigned bb, const f32x16& negm, float& lpart) {
    constexpr int NK = DQK / 16, EPG = 16 / NK;
    const lchar* rowp = Kb + r32 * 256; const int e = (hi * 16 + koff) ^ ((r32 & 15) << 4);
    f32x16 p0, p1;
    bf16x8 k0[NK], k1[NK];
#pragma unroll
    for (int d0 = 0; d0 < NK; ++d0) k0[d0] = *reinterpret_cast<const ALAS bf16x8*>(rowp + (e ^ (d0 * 32)));
#pragma unroll
    for (int d0 = 0; d0 < NK; ++d0) k1[d0] = *reinterpret_cast<const ALAS bf16x8*>(rowp + (e ^ (d0 * 32)) + 32 * 256);
    s16x4 va[8], vb_[8];
#define VRD(dst, ks) do { _Pragma("unroll") for (int d_ = 0; d_ < 4; ++d_) { dst[2 * d_] = vtr(vb + v_rd_off(d_, ks, 0)); dst[2 * d_ + 1] = vtr(vb + v_rd_off(d_, ks, 1)); } } while (0)
#define VFR(src, d_) ((bf16x8){src[2 * (d_)][0], src[2 * (d_)][1], src[2 * (d_)][2], src[2 * (d_)][3], src[2 * (d_) + 1][0], src[2 * (d_) + 1][1], src[2 * (d_) + 1][2], src[2 * (d_) + 1][3]})
    VRD(va, 0);
    if (nearb) {
#pragma unroll
        for (int r = 0; r < 16; ++r) { const int c = (r & 3) + 8 * (r >> 2);
            p0[r] = *(const ALAS float*)(uintptr_t)(bb + 4u * (unsigned)(59 - c)) + negm[r]; p1[r] = *(const ALAS float*)(uintptr_t)(bb + 4u * (unsigned)(27 - c)) + negm[r]; }
    } else { p0 = negm; p1 = negm; }
    SBAR();
#pragma unroll
    for (int d0 = 0; d0 < NK; ++d0) p0 = __builtin_amdgcn_mfma_f32_32x32x16_bf16(k0[d0], qr[d0], p0, 0, 0, 0);
    SBAR();
    float ps = 0.f;
#pragma unroll
    for (int d0 = 0; d0 < NK; ++d0) {
        p1 = __builtin_amdgcn_mfma_f32_32x32x16_bf16(k1[d0], qr[d0], p1, 0, 0, 0);
        SBAR();
#pragma unroll
        for (int j = 0; j < EPG; ++j) { p0[EPG * d0 + j] = __builtin_amdgcn_exp2f(p0[EPG * d0 + j]); ps += p0[EPG * d0 + j]; }
        SBAR();
    }
#define PK8(P, B_) __builtin_bit_cast(bf16x8, (u32x4){cvtpk(P[B_], P[B_ + 1]), cvtpk(P[B_ + 2], P[B_ + 3]), cvtpk(P[B_ + 4], P[B_ + 5]), cvtpk(P[B_ + 6], P[B_ + 7])})
    const bf16x8 pa0 = PK8(p0, 0), pa1 = PK8(p0, 8);
    VRD(vb_, 1);
    SBAR();
#pragma unroll
    for (int d_ = 0; d_ < 4; ++d_) {
        o[d_] = __builtin_amdgcn_mfma_f32_32x32x16_bf16(pa0, VFR(va, d_), o[d_], 0, 0, 0);
        SBAR();
        p1[2 * d_] = __builtin_amdgcn_exp2f(p1[2 * d_]); p1[2 * d_ + 1] = __builtin_amdgcn_exp2f(p1[2 * d_ + 1]); ps += p1[2 * d_]; ps += p1[2 * d_ + 1];
        SBAR();
    }
    const bf16x8 pa2 = PK8(p1, 0);
    VRD(va, 2);
    SBAR();
#pragma unroll
    for (int d_ = 0; d_ < 4; ++d_) {
        o[d_] = __builtin_amdgcn_mfma_f32_32x32x16_bf16(pa1, VFR(vb_, d_), o[d_], 0, 0, 0);
        SBAR();
        p1[8 + 2 * d_] = __builtin_amdgcn_exp2f(p1[8 + 2 * d_]); p1[9 + 2 * d_] = __builtin_amdgcn_exp2f(p1[9 + 2 * d_]); ps += p1[8 + 2 * d_]; ps += p1[9 + 2 * d_];
        SBAR();
    }
    const bf16x8 pa3 = PK8(p1, 8);
    VRD(vb_, 3);
    SBAR();
#pragma unroll
    for (int d_ = 0; d_ < 4; ++d_) o[d_] = __builtin_amdgcn_mfma_f32_32x32x16_bf16(pa2, VFR(va, d_), o[d_], 0, 0, 0);
    SBAR();
#pragma unroll
    for (int d_ = 0; d_ < 4; ++d_) o[d_] = __builtin_amdgcn_mfma_f32_32x32x16_bf16(pa3, VFR(vb_, d_), o[d_], 0, 0, 0);
    SBAR();
    lpart += ps;
#undef VRD
#undef VFR
#undef PK8
}
struct NoHook { __device__ __forceinline__ void operator()(int) const {} };
struct DmaHook {
    const bf16_t* Kg; const bf16_t* Vg; size_t k0; int ko0, ko1, vo0, vo1; lchar* kl; lchar* vl; bool on;
    __device__ __forceinline__ void operator()(int pi) const {
        if (!on) return;
        int o_ = (pi == 0) ? ko0 : (pi == 1) ? ko1 : (pi == 2) ? vo0 : vo1; asm volatile("" : "+v"(o_));
        const bf16_t* src_ = ((pi < 2) ? Kg : Vg) + k0 + o_;
        lchar* dst_ = ((pi < 2) ? kl : vl) + (pi & 1) * 1024;
        __builtin_amdgcn_global_load_lds((const unsigned*)src_, (ALAS unsigned*)dst_, 16, 0, 0);
    }
};
template <bool SUBM, bool VPRE = false, typename HOOK = NoHook, int DSP = 0>
__device__ __forceinline__ void sm_pv2(f32x16* o, unsigned vb, const f32x16& p0, const f32x16& p1, float msub, float& lpart, bool act, const s16x4* vpre = nullptr, const HOOK hook = HOOK{},
                                       bool d_on = false, const bf16_t* d_k = nullptr, const bf16_t* d_v = nullptr, int d_ko0 = 0, int d_ko1 = 0, int d_vo0 = 0, int d_vo1 = 0, lchar* d_kl = nullptr, lchar* d_vl = nullptr) {
#define DSPP(pi) do { if constexpr (DSP != 0) { if (d_on) { if ((pi) == 0) __builtin_amdgcn_global_load_lds((const unsigned*)(d_k + d_ko0), (ALAS unsigned*)(d_kl), 16, 0, 0); \
        else if ((pi) == 1) __builtin_amdgcn_global_load_lds((const unsigned*)(d_k + d_ko1), (ALAS unsigned*)(d_kl + 1024), 16, 0, 0); \
        else if ((pi) == 2) __builtin_amdgcn_global_load_lds((const unsigned*)(d_v + d_vo0), (ALAS unsigned*)(d_vl), 16, 0, 0); \
        else __builtin_amdgcn_global_load_lds((const unsigned*)(d_v + d_vo1), (ALAS unsigned*)(d_vl + 1024), 16, 0, 0); } } } while (0)
    if (!act) { hook(0); hook(1); hook(2); hook(3); DSPP(0); DSPP(1); DSPP(2); DSPP(3); return; }
#define DSPH(h) do { if constexpr (DSP == 1) DSPP(h); else if constexpr (DSP == 2) { if ((h) < 2) { DSPP(2 * (h)); DSPP(2 * (h) + 1); } } } while (0)
    float ps = 0.f;
    s16x4 va[8], vc[8];
#define VRD(dst, ks) do { _Pragma("unroll") for (int d_ = 0; d_ < 4; ++d_) { dst[2 * d_] = vtr(vb + v_rd_off(d_, ks, 0)); dst[2 * d_ + 1] = vtr(vb + v_rd_off(d_, ks, 1)); } } while (0)
#define VFR(src, d_) ((bf16x8){src[2 * (d_)][0], src[2 * (d_)][1], src[2 * (d_)][2], src[2 * (d_)][3], src[2 * (d_) + 1][0], src[2 * (d_) + 1][1], src[2 * (d_) + 1][2], src[2 * (d_) + 1][3]})
#define EX(P, i) __builtin_amdgcn_exp2f(SUBM ? P[i] - msub : P[i])
    if constexpr (VPRE) {
#pragma unroll
        for (int j = 0; j < 8; ++j) va[j] = vpre[j];
    } else VRD(va, 0);
    float e_[8]; u32x4 w_;
#pragma unroll
    for (int j = 0; j < 8; ++j) { e_[j] = EX(p0, j); ps += e_[j]; }
    w_ = (u32x4){cvtpk(e_[0], e_[1]), cvtpk(e_[2], e_[3]), cvtpk(e_[4], e_[5]), cvtpk(e_[6], e_[7])};
    bf16x8 pa_ = __builtin_bit_cast(bf16x8, w_);
    SBAR();
#define KS_PIPE(VCUR, VNXT, ksn, PN, BN) do {                                                                                  \
        VRD(VNXT, ksn);                                                                                                        \
        SBAR();                                                                                                                \
        o[0] = __builtin_amdgcn_mfma_f32_32x32x16_bf16(pa_, VFR(VCUR, 0), o[0], 0, 0, 0); SBAR();                               \
        e_[0] = EX(PN, BN + 0); e_[1] = EX(PN, BN + 1); ps += e_[0]; ps += e_[1]; SBAR();                                       \
        o[1] = __builtin_amdgcn_mfma_f32_32x32x16_bf16(pa_, VFR(VCUR, 1), o[1], 0, 0, 0); SBAR();                               \
        e_[2] = EX(PN, BN + 2); e_[3] = EX(PN, BN + 3); ps += e_[2]; ps += e_[3]; SBAR();                                       \
        o[2] = __builtin_amdgcn_mfma_f32_32x32x16_bf16(pa_, VFR(VCUR, 2), o[2], 0, 0, 0); SBAR();                               \
        e_[4] = EX(PN, BN + 4); e_[5] = EX(PN, BN + 5); ps += e_[4]; ps += e_[5]; w_[0] = cvtpk(e_[0], e_[1]); w_[1] = cvtpk(e_[2], e_[3]); SBAR();   \
        o[3] = __builtin_amdgcn_mfma_f32_32x32x16_bf16(pa_, VFR(VCUR, 3), o[3], 0, 0, 0); SBAR();                               \
        e_[6] = EX(PN, BN + 6); e_[7] = EX(PN, BN + 7); ps += e_[6]; ps += e_[7]; w_[2] = cvtpk(e_[4], e_[5]); w_[3] = cvtpk(e_[6], e_[7]);           \
        pa_ = __builtin_bit_cast(bf16x8, w_); SBAR(); } while (0)
    hook(0); DSPH(0); SBAR();
    KS_PIPE(va, vc, 1, p0, 8);
    hook(1); DSPH(1); SBAR();
    KS_PIPE(vc, va, 2, p1, 0);
    hook(2); DSPH(2); SBAR();
    KS_PIPE(va, vc, 3, p1, 8);
    hook(3); DSPH(3); SBAR();
#pragma unroll
    for (int d_ = 0; d_ < 4; ++d_) o[d_] = __builtin_amdgcn_mfma_f32_32x32x16_bf16(pa_, VFR(vc, d_), o[d_], 0, 0, 0);
    SBAR();
    lpart += ps;
#undef KS_PIPE
#undef EX
#undef VRD
#undef VFR
#undef DSPP
#undef DSPH
}
__device__ __forceinline__ void head_dma(lchar* lds, const bf16_t* __restrict__ Kg, const bf16_t* __restrict__ Vg, int ld, int j_lo, int NT) {
    int tid = threadIdx.x; asm volatile("" : "+v"(tid));
    const int wid = __builtin_amdgcn_readfirstlane(tid >> 6), lane = tid & 63;
    lchar* V_lds = lds + L_V; lchar* K_lds = lds + L_K; const int dpiece = wid * 2048;
#pragma unroll
    for (int t = 0; t < 2; ++t) {
        if (t < NT) { const size_t k0_ = (size_t)(j_lo + t) * KVBLK * (size_t)ld;
#pragma unroll
            for (int i = 0; i < 2; ++i) {
                const int row = (wid * 2 + i) * 4 + (lane >> 4), chunk = (lane & 15) ^ (row & 15);
                const int B_ = (wid * 2 + i) * 1024 + lane * 16, sub = B_ >> 9, kk = (sub >> 2) * 8 + ((B_ & 511) >> 6), cc = (sub & 3) * 32 + (((B_ & 511) >> 1) & 31);
                __builtin_amdgcn_global_load_lds((const unsigned*)(Kg + k0_ + row * ld + chunk * 8), (ALAS unsigned*)(K_lds + t * SHM_K + dpiece + i * 1024), 16, 0, 0);
                __builtin_amdgcn_global_load_lds((const unsigned*)(Vg + k0_ + kk * ld + cc), (ALAS unsigned*)(V_lds + t * SHM_V + dpiece + i * 1024), 16, 0, 0); } }
    }
}
template <int MODE, int DQK, bool NEGM = false, int FIXM = 0, bool FUSE = false, bool PIPE = false, int KGS = 2, bool SMP2 = false, bool KPRE = false, bool VPRE = false, bool KDB = false, int PRIO = 0, int DMAPOS = 0, bool HEADPRE = false>
__device__ __forceinline__ void attn_tiles_dma(lchar* lds, const bf16_t* __restrict__ Kg, const bf16_t* __restrict__ Vg, int ld, int j_lo, int NT, const ALAS int* list,
                                           const bf16x8* qr, int koff, const Lane L, unsigned sw0, unsigned sw1, unsigned sw2, unsigned sw3, f32x16* o, float& m_reg, float& l_reg) {
    int tid = threadIdx.x; asm volatile("" : "+v"(tid));
    const int wid = __builtin_amdgcn_readfirstlane(tid >> 6), lane = tid & 63, r32 = lane & 31, hi = lane >> 5;
    lchar* V_lds = lds + L_V; lchar* K_lds = lds + L_K;
    ALAS float* al_l = (ALAS float*)(lds + L_WS) + wid * 64 + 32;
    if (FIXM == 0) m_reg = -1e30f;
    l_reg = 0.f; o[0] = f32x16{}; o[1] = f32x16{}; o[2] = f32x16{}; o[3] = f32x16{};
    const unsigned vb0 = lds_addr(V_lds) + (unsigned)v_rd_base(lane);
    int koffs[2], voffs[2];
#pragma unroll
    for (int i = 0; i < 2; ++i) {
        const int row = (wid * 2 + i) * 4 + (lane >> 4), chunk = (lane & 15) ^ (row & 15);
        koffs[i] = row * ld + chunk * 8;
        const int B_ = (wid * 2 + i) * 1024 + lane * 16, sub = B_ >> 9, kk = (sub >> 2) * 8 + ((B_ & 511) >> 6), cc = (sub & 3) * 32 + (((B_ & 511) >> 1) & 31);
        const int k = kk;
        voffs[i] = k * ld + cc;
    }
    const int dpiece = wid * 2048;
#define TIDX(t) ((MODE == M_SLC) ? __builtin_amdgcn_readfirstlane(list[(t)]) : (j_lo + (t)))
#define DMA(t, ko, vo) do { const size_t k0_ = (size_t)TIDX(t) * KVBLK * (size_t)ld; _Pragma("unroll") for (int i_ = 0; i_ < 2; ++i_) { \
        __builtin_amdgcn_global_load_lds((const unsigned*)(Kg + k0_ + koffs[i_]), (ALAS unsigned*)(K_lds + (ko) + dpiece + i_ * 1024), 16, 0, 0); \
        __builtin_amdgcn_global_load_lds((const unsigned*)(Vg + k0_ + voffs[i_]), (ALAS unsigned*)(V_lds + (vo) + dpiece + i_ * 1024), 16, 0, 0); } } while (0)
#define DMAP(k0_, ko, vo, pi) do { const int i__ = (pi) & 1; if ((pi) < 2) __builtin_amdgcn_global_load_lds((const unsigned*)(Kg + (k0_) + koffs[i__]), (ALAS unsigned*)(K_lds + (ko) + dpiece + i__ * 1024), 16, 0, 0); \
        else __builtin_amdgcn_global_load_lds((const unsigned*)(Vg + (k0_) + voffs[i__]), (ALAS unsigned*)(V_lds + (vo) + dpiece + i__ * 1024), 16, 0, 0); } while (0)
#define VMW() asm volatile("s_waitcnt vmcnt(0)" ::: "memory")
#define RESC(a) do { if (__any((a) < 1.f)) { if (hi == 0) al_l[r32] = (a); asm volatile("s_waitcnt lgkmcnt(0)" ::: "memory");              \
                     _Pragma("unroll") for (int d_ = 0; d_ < 4; ++d_) _Pragma("unroll") for (int r = 0; r < 16; ++r) o[d_][r] *= al_l[crow(r, hi)]; } } while (0)
#define SELW(t) ((MODE == M_SLC) ? *(const ALAS unsigned*)(uintptr_t)(sw0 + 4u * (unsigned)(TIDX(t) >> 5)) : 0u)
#define ACT(t) tile_act<MODE>(TIDX(t) * KVBLK, TIDX(t) & 31, L, SELW(t), SELW(t), SELW(t), SELW(t))
#define NEARB(t) tile_near<MODE>(TIDX(t) * KVBLK, L)
#define BB(t) (L.lut + 4u * (unsigned)(L.qpos - TIDX(t) * KVBLK - 4 * hi + LUT0 - 59))
#define MASKT(P0_, P1_, t, a_) tile_mask<MODE>(P0_, P1_, TIDX(t) * KVBLK, TIDX(t) & 31, L, hi, a_, SELW(t), SELW(t), SELW(t), SELW(t))
    f32x16 p0, p1; float al = 1.f; bf16x8 pa0, pa1, pa2, pa3;
    pa0 = pa1 = pa2 = pa3 = bf16x8{};
    f32x16 negm = f32x16{}; bool started = false; if (NEGM) { m_reg = 0.f; asm volatile("" : "+v"(negm)); }
    if (FIXM == 1) { const float nm_ = -m_reg; _Pragma("unroll") for (int r = 0; r < 16; ++r) negm[r] = nm_; asm volatile("" : "+v"(negm)); }
#ifdef TPROBE_SEC
    unsigned long long tp_[8] = {0, 0, 0, 0, 0, 0, 0, 0}, tp_sec_ = 0, tp_tot_ = 0;
#endif
    int kbo = 0, vbo = 0, vbp = 0;
#define STAGE_NEXT(t) do { if ((t) + 1 < NT) { const int vbn_ = (vbo == 2 * SHM_V) ? 0 : vbo + SHM_V; DMA((t) + 1, kbo ^ SHM_K, vbn_); } } while (0)
#define SOFTMAX(t, a_) do { MASKT(p0, p1, (t), a_); if constexpr (FIXM == 1) { _Pragma("unroll") for (int r = 0; r < 16; ++r) p0[r] = __builtin_amdgcn_exp2f(p0[r]); al = 1.f; finishSM_direct(p0, p1, al, l_reg, pa0, pa1, pa2, pa3); } \
        else if constexpr (FIXM == 2) { partialSM_fix(p0, p1, m_reg); al = 1.f; finishSM_direct(p0, p1, al, l_reg, pa0, pa1, pa2, pa3); } else if constexpr (NEGM) { partialSM_rel(p0, p1, m_reg, al, started, negm); RESC(al); finishSM_pk(p0, p1, al, l_reg, pa0, pa1, pa2, pa3); } \
        else { partialSM(p0, p1, m_reg, al); RESC(al); finishSM_direct(p0, p1, al, l_reg, pa0, pa1, pa2, pa3); } SBAR(); } while (0)
#define QKT(t, a_) do { static_assert(!NEGM, "the LDS-DMA engine has no relative-score form"); qkt_dma<DQK, FIXM == 1, KGS>(p0, p1, K_lds + kbo, koff, r32, hi, qr, a_, NEARB(t), BB(t), negm); } while (0)
#define ADVANCE() do { vbp = vbo; vbo = (vbo == 2 * SHM_V) ? 0 : vbo + SHM_V; kbo ^= SHM_K; } while (0)
    if constexpr (FUSE) {
        float lpart = 0.f;
        const int NS = (NT + 1) >> 1;
        if constexpr (!HEADPRE) { DMA(0, 0, 0); if (NT > 1) DMA(1, SHM_K, SHM_V); }
        VMW(); __syncthreads();
        int so = 0;
        for (int s_ = 0; s_ < NS; ++s_) {
            const int t0_ = 2 * s_;
            int tjA_, tjB_, tjC_, tjD_; unsigned swA_ = 0u, swB_ = 0u;
            if constexpr (MODE == M_SLC) {
                const int lA_ = list[t0_], lB_ = list[t0_ + 1 < NT ? t0_ + 1 : NT - 1], lC_ = list[t0_ + 2 < NT ? t0_ + 2 : NT - 1], lD_ = list[t0_ + 3 < NT ? t0_ + 3 : NT - 1];
                tjA_ = __builtin_amdgcn_readfirstlane(lA_); tjB_ = __builtin_amdgcn_readfirstlane(lB_); tjC_ = __builtin_amdgcn_readfirstlane(lC_); tjD_ = __builtin_amdgcn_readfirstlane(lD_);
                swA_ = *(const ALAS unsigned*)(uintptr_t)(sw0 + 4u * (unsigned)(tjA_ >> 5)); swB_ = *(const ALAS unsigned*)(uintptr_t)(sw0 + 4u * (unsigned)(tjB_ >> 5));
            } else { tjA_ = j_lo + t0_; tjB_ = tjA_ + 1; tjC_ = tjA_ + 2; tjD_ = tjA_ + 3; }
#undef TIDX
#define TIDX(t) (((t) == t0_) ? tjA_ : ((t) == t0_ + 1) ? tjB_ : ((t) == t0_ + 2) ? tjC_ : tjD_)
#undef SELW
#define SELW(t) (((t) == t0_) ? swA_ : swB_)
            bf16x8 kq[2 * KGS];
            TP_T(0);
            if constexpr (KPRE) { k_first<KGS, KDB>(kq, K_lds + so, koff, r32, hi); SBAR(); }
#define DMA_NEXT_A() do { if (s_ + 1 < NS) { const int sn_ = so ^ SLOT; DMA(t0_ + 2, sn_, sn_); } } while (0)
#define DMA_NEXT_B() do { if (t0_ + 3 < NT) { const int sn_ = so ^ SLOT; DMA(t0_ + 3, sn_ + SHM_K, sn_ + SHM_V); } } while (0)
            const bool nA_ = s_ + 1 < NS, nB_ = t0_ + 3 < NT; const int snx_ = so ^ SLOT;
            size_t kA_ = 0, kB_ = 0;
            if constexpr (DMAPOS == 3) { if (nA_) kA_ = (size_t)TIDX(t0_ + 2) * KVBLK * (size_t)ld; if (nB_) kB_ = (size_t)TIDX(t0_ + 3) * KVBLK * (size_t)ld; }
            if constexpr (DMAPOS == 0) { DMA_NEXT_A(); DMA_NEXT_B(); }
#pragma unroll
            for (int u_ = 0; u_ < 2; ++u_) {
                const int t = t0_ + u_;
                if (u_ == 1 && t >= NT) { if constexpr (KPRE && KDB) { asm volatile("s_waitcnt lgkmcnt(0)" ::: "memory"); SBAR(); } break; }
                kbo = so + u_ * SHM_K; vbo = so + u_ * SHM_V;
                if constexpr (PRIO != 0) { const bool hp_ = (PRIO == 1) ? (((wid >> 2) ^ u_) & 1) == 0 : (PRIO == 2) ? (((wid >> 2) ^ u_) & 1) != 0 : (wid >= 4); if (hp_) __builtin_amdgcn_s_setprio(1); else __builtin_amdgcn_s_setprio(0); }
                const bool a_ = ACT(t);
                s16x4 vq[8];
                SBAR(); qkt_dma<DQK, FIXM == 1, KGS, KPRE, VPRE, KDB>(p0, p1, K_lds + kbo, koff, r32, hi, qr, a_, NEARB(t), BB(t), negm, kq, vq, vb0 + (unsigned)vbo);
                MASKT(p0, p1, (t), a_);
                if constexpr (FIXM == 0) { decideSM(p0, p1, m_reg, al); RESC(al); lpart *= al; }
                SBAR();
                TP_PIN(p0); if (u_ == 0) TP_T(1); else TP_T(3);
                if constexpr (DMAPOS == 1) { if (u_ == 0) { DMA_NEXT_A(); DMA_NEXT_B(); } }
                if constexpr (DMAPOS == 2) { if (u_ == 0) DMA_NEXT_A(); else DMA_NEXT_B(); }
                if constexpr (KPRE) { if (u_ == 0) { k_first<KGS, KDB>(kq, K_lds + so + SHM_K, koff, r32, hi); SBAR(); } }
                if constexpr (SMP2 && DMAPOS == 5) {
                    const bool on_ = u_ == 0 ? nA_ : nB_; size_t k0_ = 0; if (on_) k0_ = (size_t)TIDX(t0_ + 2 + u_) * KVBLK * (size_t)ld;
                    if (u_ == 0) {
                    sm_pv2<FIXM != 1, VPRE, NoHook, 1>(o, vb0 + (unsigned)vbo, p0, p1, m_reg, lpart, a_, vq, NoHook{}, on_, Kg + k0_, Vg + k0_, koffs[0], koffs[1], voffs[0], voffs[1],
                                                          K_lds + snx_ + u_ * SHM_K + dpiece, V_lds + snx_ + u_ * SHM_V + dpiece);
                    } else {
                    sm_pv2<FIXM != 1, VPRE, NoHook, 2>(o, vb0 + (unsigned)vbo, p0, p1, m_reg, lpart, a_, vq, NoHook{}, on_, Kg + k0_, Vg + k0_, koffs[0], koffs[1], voffs[0], voffs[1],
                                                          K_lds + snx_ + u_ * SHM_K + dpiece, V_lds + snx_ + u_ * SHM_V + dpiece);
                    }
                } else
                if constexpr (SMP2 && DMAPOS == 3) {
                    const DmaHook hk_{Kg, Vg, u_ == 0 ? kA_ : kB_, koffs[0], koffs[1], voffs[0], voffs[1], K_lds + snx_ + u_ * SHM_K + dpiece, V_lds + snx_ + u_ * SHM_V + dpiece, u_ == 0 ? nA_ : nB_};
                    sm_pv2<FIXM != 1, VPRE, DmaHook>(o, vb0 + (unsigned)vbo, p0, p1, m_reg, lpart, a_, vq, hk_);
                } else
                if constexpr (SMP2) sm_pv2<FIXM != 1, VPRE>(o, vb0 + (unsigned)vbo, p0, p1, m_reg, lpart, a_, vq); else sm_pv<FIXM != 1>(o, vb0 + (unsigned)vbo, p0, p1, m_reg, lpart, a_);
                TP_PIN(o[3]); if (u_ == 0) TP_T(2); else TP_T(4);
            }
            VMW(); __syncthreads();
            TP_T(5); TP_ACC();
#undef DMA_NEXT_A
#undef DMA_NEXT_B
            so ^= SLOT;
        }
        if constexpr (PRIO != 0) __builtin_amdgcn_s_setprio(0);
        { auto rr = __builtin_amdgcn_permlane32_swap(__float_as_uint(lpart), __float_as_uint(lpart), false, false); l_reg = __uint_as_float(rr[0]) + __uint_as_float(rr[1]); }
#undef TIDX
#define TIDX(t) ((MODE == M_SLC) ? __builtin_amdgcn_readfirstlane(list[(t)]) : (j_lo + (t)))
#undef SELW
#define SELW(t) ((MODE == M_SLC) ? *(const ALAS unsigned*)(uintptr_t)(sw0 + 4u * (unsigned)(TIDX(t) >> 5)) : 0u)
    } else {
    DMA(0, 0, 0); VMW();
    __syncthreads();
    if (wid < 4) {
        for (int t = 0; t < NT; ++t) {
            const bool a_ = ACT(t);
            STAGE_NEXT(t);
            TP_T(0);
            SBAR(); QKT(t, a_);
            TP_PIN(p0); TP_T(1);
            SOFTMAX(t, a_);
            TP_T(2);
            TP_T(3);
            pv_rt(o, vb0 + (unsigned)vbo, pa0, pa1, pa2, pa3, a_);
            TP_PIN(o[3]); TP_T(4);
            VMW(); __syncthreads();
            TP_T(5); TP_ACC();
            ADVANCE();
        }
        __syncthreads();
    } else {
        bool ap_ = false;
        for (int t = 0; t < NT; ++t) {
            STAGE_NEXT(t);
            TP_T(3);
            SBAR(); pv_rt(o, vb0 + (unsigned)vbp, pa0, pa1, pa2, pa3, ap_);
            TP_PIN(o[3]); TP_T(4);
            const bool a_ = ACT(t);
            TP_T(0);
            SBAR(); QKT(t, a_);
            TP_PIN(p0); TP_T(1);
            TP_T(6);
            SOFTMAX(t, a_);
            TP_T(7);
            ap_ = a_;
            VMW(); __syncthreads();
            TP_T(5); TP_ACC_Y();
            ADVANCE();
        }
        SBAR(); pv_rt(o, vb0 + (unsigned)vbp, pa0, pa1, pa2, pa3, ap_);
        __syncthreads();
    }
    }
#ifdef TPROBE_SEC
    if (TP_ON && lane == 0) { atomicAdd(L.tpw, tp_sec_); atomicAdd(L.tpw + 1, tp_tot_); }
#endif
#undef STAGE_NEXT
#undef SOFTMAX
#undef QKT
#undef ADVANCE
#undef TIDX
#undef DMA
#undef DMAP
#undef VMW
#undef RESC
#undef ACT
#undef SELW
#undef NEARB
#undef BB
#undef MASKT
}
}
constexpr int NWAVES = 8;
#ifndef MK_N_LAUNCHES
#define MK_N_LAUNCHES 1
#endif
constexpr int N_LAUNCHES = MK_N_LAUNCHES;
constexpr int PER_PHASE = 10;
static_assert(N_LAUNCHES == 1 || N_LAUNCHES == PER_PHASE, "MK_N_LAUNCHES is 1 or 10");
constexpr int BATCH = 2, SEQ = 8192, TOK = BATCH * SEQ, DM = 2048, NPROJ = 5656, LDP = 5888, DFF = 5632, NUP = 2 * DFF, NIN = 23;
constexpr float EPS = 1e-6f, LOG2E = 1.4426950408889634f;
constexpr float C2D = 0.125f * LOG2E, C2N = 0.08838834764831845f * LOG2E;
constexpr int C_DQ = 0, C_DK = 1024, C_DV = 2048, C_NQ = 3072, C_KC = 4096, C_VC = 4352, C_KS = 4608, C_VS = 4864, C_KW = 5120, C_VW = 5376;
constexpr size_t MiB = 1u << 20, KiB = 1u << 10;
constexpr size_t WS_CTL = 0, CTL_ZERO_BYTES = 1 * MiB;
constexpr size_t WS_WDN = 1 * MiB;
constexpr size_t WS_CW1K = 23 * MiB, WS_CW1V = 25 * MiB;
constexpr size_t WS_CW2K = 27 * MiB, WS_CW2V = 27 * MiB + 64 * KiB;
constexpr size_t WS_MISC = 27 * MiB + 128 * KiB;
constexpr size_t WS_KCMP = 28 * MiB, WS_VCMP = 28 * MiB + 512 * KiB;
constexpr size_t WS_WIN = 29 * MiB;
constexpr size_t WS_WOUT = 52 * MiB;
constexpr size_t WS_WUP = 60 * MiB;
constexpr size_t WS_H = 104 * MiB;
constexpr size_t WS_Y2 = 29 * MiB;
constexpr size_t WS_Y = 418 * MiB;
constexpr size_t WS_PROJ = 168 * MiB;
constexpr size_t WS_ACT = 168 * MiB;
constexpr size_t WS_MIX = 104 * MiB;
constexpr size_t WS_HALO = 29 * MiB;
constexpr size_t WS_GATES = 416 * MiB;
constexpr size_t WS_NSAACC = 418 * MiB;
constexpr size_t WS_END = 482 * MiB;
constexpr int MISC_LAM = 0, MISC_B1 = 64, MISC_LUT = 40960, MISC_B1F = 45056, MISC_LUTMAX = 45568;
constexpr int CTL_KMX = 36864, CTL_KCMX = 37120;
constexpr int CW_BAR = 4096;
constexpr int RING_OFF = 0, RING_BYTES = 131072;
constexpr int LDSCTL_OFF = 141312  , MISC_OFF = LDSCTL_OFF + 320;
constexpr int LDS_BYTES = 147456;
static_assert(att::L_END <= LDSCTL_OFF && RING_BYTES <= LDSCTL_OFF && MISC_OFF + 128 <= LDS_BYTES, "LDS map");

#define GAS __attribute__((address_space(1)))
#define LAS __attribute__((address_space(3)))
typedef unsigned short bf16;
typedef unsigned v4u __attribute__((ext_vector_type(4)));
typedef unsigned v2u __attribute__((ext_vector_type(2)));
typedef float f32x4 __attribute__((ext_vector_type(4)));
typedef short bf16x8 __attribute__((ext_vector_type(8)));
typedef GAS unsigned gu32;
#define RLX_AGENT __ATOMIC_RELAXED, __HIP_MEMORY_SCOPE_AGENT
#define LDS_WAIT() asm volatile("s_waitcnt lgkmcnt(0)" ::: "memory")
#define VM_WAIT() asm volatile("s_waitcnt vmcnt(0)" ::: "memory")
__device__ __forceinline__ unsigned f2bf(float f) { unsigned u = __builtin_bit_cast(unsigned, f); return (u + 0x7fffu + ((u >> 16) & 1u)) >> 16; }
__device__ __forceinline__ unsigned pk2(float lo, float hi) { return f2bf(lo) | (f2bf(hi) << 16); }
__device__ __forceinline__ float gelu_tanh_f(float v) { const float z2 = 1.5957691216f * (v + 0.044715f * v * v * v); return v * __builtin_amdgcn_rcpf(1.0f + __builtin_amdgcn_exp2f(-1.4426950408889634f * z2)); }
#define XB_TMO      128
#define XB_XCNT(j)  (256  + 64 * (j))
#define XB_XSUB(j)  (1280 + 64 * (j))
#define XB_XGEN(j)  (2304 + 64 * (j))
#define XB_TOP      3328
#define XB_TOPGEN   3392
#define XCD_BAR_WORDS 3456
#define XB_SPIN_CAP (1u << 18)

__device__ __forceinline__ unsigned xb_ld(unsigned* p)              { return __hip_atomic_load(p, __ATOMIC_RELAXED, __HIP_MEMORY_SCOPE_AGENT); }
__device__ __forceinline__ unsigned xb_add(unsigned* p, unsigned v) { return __hip_atomic_fetch_add(p, v, __ATOMIC_RELAXED, __HIP_MEMORY_SCOPE_AGENT); }
__device__ __forceinline__ unsigned xb_xcc_id() { return (unsigned)__builtin_amdgcn_s_getreg((3 << 11) | 20) & 0xFu; }
#define XB_SPIN(cond, bar) do { unsigned _sp = 0; while (cond) { __builtin_amdgcn_s_sleep(1); \
    if ((++_sp & 255u) == 0u) { if (xb_ld(&(bar)[XB_TMO])) break; if (_sp > XB_SPIN_CAP) { atomicAdd(&(bar)[XB_TMO], 1u); break; } } } } while (0)

struct XcdBarrier {
    unsigned* bar; unsigned x;
    volatile LAS unsigned* st;
};

__device__ __forceinline__ XcdBarrier xcd_barrier_post(unsigned* bar, volatile LAS unsigned* st) {
    XcdBarrier b; b.bar = bar; b.x = xb_xcc_id(); b.st = st;
    if (threadIdx.x == 0) (void)xb_add(&bar[XB_XCNT(b.x)], 1u);
    return b;
}
__device__ __forceinline__ void xcd_barrier_complete(unsigned* bar, unsigned x, unsigned& nloc, unsigned& nx) {
    const unsigned G = gridDim.x * gridDim.y * gridDim.z;
    unsigned sum, cnt, mine, sp = 0u;
    for (;;) {
        sum = 0u; cnt = 0u; mine = 0u;
#pragma unroll
        for (unsigned j = 0; j < 16; ++j) { const unsigned c = xb_ld(&bar[XB_XCNT(j)]); sum += c; cnt += (c > 0u) ? 1u : 0u; mine = (j == x) ? c : mine; }
        if (sum == G) break;
        __builtin_amdgcn_s_sleep(1);
        if ((++sp & 255u) == 0u) { if (xb_ld(&bar[XB_TMO])) break; if (sp > XB_SPIN_CAP) { atomicAdd(&bar[XB_TMO], 1u); break; } }
    }
    nloc = mine > 0u ? mine : 1u; nx = cnt > 0u ? cnt : 1u;
}

__device__ __forceinline__ void xcd_barrier(const XcdBarrier& b) {
    asm volatile("s_waitcnt vmcnt(0)" ::: "memory");
    __syncthreads();
    if (threadIdx.x == 0) {
        unsigned* bar = b.bar;
        __builtin_amdgcn_s_waitcnt(0);
        unsigned nloc = b.st[0], nx = b.st[1];
        if (nloc == 0u) { xcd_barrier_complete(bar, b.x, nloc, nx); b.st[0] = nloc; b.st[1] = nx; }
        const unsigned old = xb_add(&bar[XB_XSUB(b.x)], 1u);
        const unsigned gen = old / nloc;
        if (old + 1u == (gen + 1u) * nloc) {
            __builtin_amdgcn_fence(__ATOMIC_RELEASE, "agent");
            asm volatile("s_waitcnt vmcnt(0)" ::: "memory");
            const unsigned og = xb_add(&bar[XB_TOP], 1u);
            const unsigned tg = og / nx;
            if (og + 1u == (tg + 1u) * nx) xb_add(&bar[XB_TOPGEN], 1u);
            else XB_SPIN(xb_ld(&bar[XB_TOPGEN]) == tg, bar);
            __builtin_amdgcn_fence(__ATOMIC_ACQUIRE, "agent");
            xb_add(&bar[XB_XGEN(b.x)], 1u);
            asm volatile("s_waitcnt vmcnt(0)" ::: "memory");
        } else {
            XB_SPIN(xb_ld(&bar[XB_XGEN(b.x)]) == gen, bar);
            __builtin_amdgcn_fence(__ATOMIC_ACQUIRE, "agent");
            asm volatile("s_waitcnt vmcnt(0)" ::: "memory");
        }
    }
    __syncthreads();
}
__device__ __forceinline__ float wave_sum(float v) {
#pragma unroll
    for (int o = 1; o < 64; o <<= 1) v += __shfl_xor(v, o);
    return v;
}
__device__ __forceinline__ unsigned cvtpk2(float lo, float hi) { unsigned r; asm volatile("v_cvt_pk_bf16_f32 %0, %1, %2" : "=v"(r) : "v"(lo), "v"(hi)); return r; }
__device__ __forceinline__ void transpose_item(const float* __restrict__ W, int K, int N, int npad, int nblk, bf16* WT, int mode, int item, int lane) {
    const int kb = item / nblk, nb = item - kb * nblk, k0 = 32 * kb, n = 256 * nb + 4 * lane;
    if (n >= npad) return;
    const bool inb = n < N;
    int orow = n;
    if (mode == 1) { const int bj = n / DFF, rem = n - bj * DFF; orow = (rem >> 7) * 256 + bj * 128 + (rem & 127); }
    const float* src = W + (size_t)k0 * N + n; bf16* dst = (mode == 2) ? WT + ((size_t)kb * N + n) * 32 : WT + (size_t)orow * K + k0;
    const size_t estride = (mode == 2) ? 32 : (size_t)K;
    f32x4 v[32];
#pragma unroll
    for (int j = 0; j < 32; ++j) v[j] = inb ? __builtin_nontemporal_load((const f32x4*)(src + (size_t)j * N)) : (f32x4){0.f, 0.f, 0.f, 0.f};
#pragma unroll
    for (int kk = 0; kk < 32; kk += 8) {
#pragma unroll
        for (int e = 0; e < 4; ++e) { v4u o; o.x = cvtpk2(v[kk + 0][e], v[kk + 1][e]); o.y = cvtpk2(v[kk + 2][e], v[kk + 3][e]); o.z = cvtpk2(v[kk + 4][e], v[kk + 5][e]); o.w = cvtpk2(v[kk + 6][e], v[kk + 7][e]);
            *(v4u*)(dst + (size_t)e * estride + kk) = o; }
    }
}
__device__ __forceinline__ int t5_bucket(int d) {
    if (d < 16) return d;
    return 16 + (d >= 19) + (d >= 21) + (d >= 24) + (d >= 27) + (d >= 31) + (d >= 35) + (d >= 40) + (d >= 46) + (d >= 52) + (d >= 59) + (d >= 67) + (d >= 77) + (d >= 87) + (d >= 99) + (d >= 113);
}
__device__ __forceinline__ void rms_rows2_bf16(const float* xrow0, const float* xrow1, const f32x4 (&gvr)[8], bf16* orow0, bf16* orow1, int lane) {
    f32x4 v0[8], v1[8]; float s0 = 0.f, s1 = 0.f;
#pragma unroll
    for (int j = 0; j < 4; ++j) { const int c = 8 * lane + 512 * j;
        v0[2 * j] = __builtin_nontemporal_load((const f32x4*)(xrow0 + c)); v0[2 * j + 1] = __builtin_nontemporal_load((const f32x4*)(xrow0 + c + 4));
        v1[2 * j] = __builtin_nontemporal_load((const f32x4*)(xrow1 + c)); v1[2 * j + 1] = __builtin_nontemporal_load((const f32x4*)(xrow1 + c + 4)); }
#pragma unroll
    for (int j = 0; j < 8; ++j) { s0 += (v0[j].x * v0[j].x + v0[j].y * v0[j].y) + (v0[j].z * v0[j].z + v0[j].w * v0[j].w); s1 += (v1[j].x * v1[j].x + v1[j].y * v1[j].y) + (v1[j].z * v1[j].z + v1[j].w * v1[j].w); }
    const float r0 = 1.0f / sqrtf(wave_sum(s0) * (1.0f / DM) + EPS), r1 = 1.0f / sqrtf(wave_sum(s1) * (1.0f / DM) + EPS);
#pragma unroll
    for (int j = 0; j < 4; ++j) { const int c = 8 * lane + 512 * j; const f32x4 ga = gvr[2 * j], gb = gvr[2 * j + 1];
        v4u w; w.x = pk2(v0[2 * j].x * r0 * ga.x, v0[2 * j].y * r0 * ga.y); w.y = pk2(v0[2 * j].z * r0 * ga.z, v0[2 * j].w * r0 * ga.w);
        w.z = pk2(v0[2 * j + 1].x * r0 * gb.x, v0[2 * j + 1].y * r0 * gb.y); w.w = pk2(v0[2 * j + 1].z * r0 * gb.z, v0[2 * j + 1].w * r0 * gb.w); *(v4u*)(orow0 + c) = w;
        v4u u; u.x = pk2(v1[2 * j].x * r1 * ga.x, v1[2 * j].y * r1 * ga.y); u.y = pk2(v1[2 * j].z * r1 * ga.z, v1[2 * j].w * r1 * ga.w);
        u.z = pk2(v1[2 * j + 1].x * r1 * gb.x, v1[2 * j + 1].y * r1 * gb.y); u.w = pk2(v1[2 * j + 1].z * r1 * gb.z, v1[2 * j + 1].w * r1 * gb.w); *(v4u*)(orow1 + c) = u; }
}

struct Ptrs {
    const float* in[NIN]; float* out; unsigned char* ws; int ph_lo, ph_hi;
};

__device__ __forceinline__ void p0_prologue(const Ptrs& P, LAS unsigned char* lds, int vcu, int G, int tid, int lane, int wave) {
    const int gw = vcu * NWAVES + wave, NGW = G * NWAVES;
    constexpr int I_IN = 64 * 23, I_C1 = 128, I_C2 = 8;
    constexpr int NITEMS = I_IN + 2 * I_C1 + 2 * I_C2;
    unsigned char* ws = P.ws;
    for (int it = gw; it < NITEMS; it += NGW) {
        int r = it;
        if (r < I_IN) { transpose_item(P.in[2], DM, NPROJ, LDP, 23, (bf16*)(ws + WS_WIN), 0, r, lane); continue; } r -= I_IN;
        if (r < I_C1) { transpose_item(P.in[10], 4096, 256, 256, 1, (bf16*)(ws + WS_CW1K), 2, r, lane); continue; } r -= I_C1;
        if (r < I_C1) { transpose_item(P.in[12], 4096, 256, 256, 1, (bf16*)(ws + WS_CW1V), 2, r, lane); continue; } r -= I_C1;
        if (r < I_C2) { transpose_item(P.in[11], 256, 128, 128, 1, (bf16*)(ws + WS_CW2K), 0, r, lane); continue; } r -= I_C2;
        transpose_item(P.in[13], 256, 128, 128, 1, (bf16*)(ws + WS_CW2V), 0, r, lane);
    }
    f32x4 gvr0[8];
#pragma unroll
    for (int j = 0; j < 4; ++j) { gvr0[2 * j] = *(const f32x4*)(P.in[1] + 8 * lane + 512 * j); gvr0[2 * j + 1] = *(const f32x4*)(P.in[1] + 8 * lane + 512 * j + 4); }
    for (int m = gw; m < TOK; m += 2 * NGW) { const int m1 = (m + NGW < TOK) ? m + NGW : m;
        rms_rows2_bf16(P.in[0] + (size_t)m * DM, P.in[0] + (size_t)m1 * DM, gvr0, (bf16*)(ws + WS_H) + (size_t)m * DM, (bf16*)(ws + WS_H) + (size_t)m1 * DM, lane); }
    float* misc = (float*)(ws + WS_MISC);
    const int gt = vcu * (NWAVES * 64) + tid;
    if (gt < 2048) {
        const int h = gt >> 7, d = gt & 127; const float* rb = P.in[14];
        misc[MISC_LUT + gt] = (d < 113) ? (rb[t5_bucket(d) * 16 + h] - rb[31 * 16 + h]) * LOG2E : 0.f;
    }
    if (gt >= 2112 && gt < 2176) {
        const int ln = gt - 2112, h = ln >> 2, q = ln & 3; const float* rb = P.in[14]; float mx = 0.f;
        const float far_ = rb[31 * 16 + h];
#pragma unroll
        for (int k = 0; k < 29; ++k) { const int d = q + 4 * k; const float v = (d < 113) ? (rb[t5_bucket(d < 113 ? d : 112) * 16 + h] - far_) * LOG2E : 0.f; mx = fmaxf(mx, v); }
        mx = fmaxf(mx, __shfl_xor(mx, 1)); mx = fmaxf(mx, __shfl_xor(mx, 2));
        if (q == 0) misc[MISC_LUTMAX + h] = mx;
    }
    if (gt >= 2176 && gt < 2240) {
        const int i = gt - 2176;
        const float s1 = wave_sum(P.in[3][i] * P.in[4][i]), s2 = wave_sum(P.in[5][i] * P.in[6][i]);
        if (i == 0) misc[MISC_LAM] = expf(s1) - expf(s2) + 0.2f;
    }
    if (gt >= 8192 && gt < 8192 + 32768) {
        const int q = gt - 8192, which = q >> 14, kc = (q >> 8) & 63, n = q & 255;
        const float* pos = which ? P.in[9] : P.in[8]; const float* w1 = which ? P.in[12] : P.in[10];
        float s0 = 0.f, s1 = 0.f;
#pragma unroll 8
        for (int k = 64 * kc; k < 64 * kc + 64; k += 2) { s0 += pos[k] * w1[(size_t)k * 256 + n]; s1 += pos[k + 1] * w1[(size_t)(k + 1) * 256 + n]; }
        misc[MISC_B1 + (which * 64 + kc) * 256 + n] = s0 + s1;
    }
}

__device__ __forceinline__ bool p0b_weights(const Ptrs& P, int lane, int budget = 1 << 30) {
    constexpr int I_OUT = 64 * 8, I_UP = 64 * 44, I_DN = 176 * 8;
    unsigned char* ws = P.ws;
    unsigned* ctr = (unsigned*)(ws + WS_CTL + 32768);
    for (int n_ = 0; n_ < budget; ++n_) {
        unsigned it0 = 0;
        if (lane == 0) it0 = __hip_atomic_fetch_add(ctr, 1u, __ATOMIC_RELAXED, __HIP_MEMORY_SCOPE_AGENT);
        const int it = __builtin_amdgcn_readfirstlane(it0);
        if (it >= I_OUT + I_UP + I_DN) return true;
        int r = it;
        if (r < I_OUT) { transpose_item(P.in[15], DM, DM, DM, 8, (bf16*)(ws + WS_WOUT), 0, r, lane); continue; } r -= I_OUT;
        if (r < I_UP) { transpose_item(P.in[18], DM, NUP, NUP, 44, (bf16*)(ws + WS_WUP), 1, r, lane); continue; } r -= I_UP;
        transpose_item(P.in[21], DFF, DM, DM, 8, (bf16*)(ws + WS_WDN), 0, r, lane);
    }
    return false;
}
template <int K> __device__ __forceinline__ float swzx(float v) { return __builtin_bit_cast(float, __builtin_amdgcn_ds_swizzle(__builtin_bit_cast(int, v), (K << 10) | 0x1F)); }
__device__ __forceinline__ float sq8(const v4u w) { float s = 0.f; const unsigned a[4] = {w.x, w.y, w.z, w.w};
#pragma unroll
    for (int i = 0; i < 4; ++i) { const float lo = __uint_as_float(a[i] << 16), hi_ = __uint_as_float(a[i] & 0xffff0000u); s += lo * lo + hi_ * hi_; } return s; }
__device__ __forceinline__ void knorm_prep(const Ptrs& P, LAS unsigned char* lds, int vcu, int G, int tid, int lane, int wave) {
    unsigned char* ws = P.ws; const bf16* proj = (const bf16*)(ws + WS_PROJ); unsigned* kmx = (unsigned*)(ws + WS_CTL + CTL_KMX);
    LAS float* red = (LAS float*)(lds + RING_OFF);
    for (int u = vcu; u < 256; u += G) {
        const int b = u >> 7, tile = u & 127, cl = lane & 7;
        const bf16* row = proj + ((size_t)b * SEQ + 64 * tile + 8 * wave + (lane >> 3)) * LDP + cl * 8;
        float n2[20];
#pragma unroll
        for (int gi = 0; gi < 16; ++gi) n2[gi] = sq8(*(const v4u*)(row + C_DK + (gi >> 1) * 128 + (gi & 1) * 64));
#pragma unroll
        for (int g2 = 0; g2 < 2; ++g2) { n2[16 + g2] = sq8(*(const v4u*)(row + C_KS + g2 * 128)) + sq8(*(const v4u*)(row + C_KS + g2 * 128 + 64));
                                         n2[18 + g2] = sq8(*(const v4u*)(row + C_KW + g2 * 128)) + sq8(*(const v4u*)(row + C_KW + g2 * 128 + 64)); }
#pragma unroll
        for (int gi = 0; gi < 20; ++gi) { float v = n2[gi];
            v += __builtin_bit_cast(float, __builtin_amdgcn_update_dpp(0, __builtin_bit_cast(int, v), 0xB1, 0xF, 0xF, false));
            v += __builtin_bit_cast(float, __builtin_amdgcn_update_dpp(0, __builtin_bit_cast(int, v), 0x4E, 0xF, 0xF, false));
            v += __builtin_bit_cast(float, __builtin_amdgcn_update_dpp(0, __builtin_bit_cast(int, v), 0x141, 0xF, 0xF, false));
            v = fmaxf(v, swzx<8>(v)); v = fmaxf(v, swzx<16>(v)); v = fmaxf(v, __shfl_xor(v, 32));
            n2[gi] = v; }
        __syncthreads();
        if (lane == 0) {
#pragma unroll
            for (int gi = 0; gi < 20; ++gi) red[wave * 20 + gi] = n2[gi]; }
        __syncthreads();
        if (tid < 20) { float m = red[tid];
#pragma unroll
            for (int w8 = 1; w8 < 8; ++w8) m = fmaxf(m, red[w8 * 20 + tid]);
            atomicMax(kmx + b * 20 + tid, __float_as_uint(m)); }
    }
}
__device__ __forceinline__ void cmp_unit(const Ptrs& P, LAS unsigned char* lds, int u, int tid, int lane, int wave) {
    typedef float f32x4_ __attribute__((ext_vector_type(4)));
    unsigned char* ws = P.ws;
    const int which = u >> 7, bg = (u >> 5) & 3, blk = u & 31, b = bg >> 1, g = bg & 1;
    const bf16* proj = (const bf16*)(ws + WS_PROJ);
    const bf16* w1T = (const bf16*)(ws + (which ? WS_CW1V : WS_CW1K));
    const bf16* w2T = (const bf16*)(ws + (which ? WS_CW2V : WS_CW2K));
    bf16* outp = (bf16*)(ws + (which ? WS_VCMP : WS_KCMP));
    const int i = lane & 15, kq = lane >> 4;
    const int c = blk * 16 + i;
    const int srccol = (which ? C_VC : C_KC) + g * 128;
    const bf16* arow = proj + (size_t)b * SEQ * LDP + srccol + 8 * kq;
    const bf16* brow = w1T + (size_t)i * 32 + 8 * kq;
    f32x4_ acc[16];
#pragma unroll
    for (int nb = 0; nb < 16; ++nb) acc[nb] = (f32x4_){0.f, 0.f, 0.f, 0.f};
    bf16x8 wA[16], wB[16], aA, aB;
#define CLOAD(kk_, a_, w_) do { const int ks_ = 16 * wave + (((kk_) + blk) & 15);        \
        int tok_ = 16 * c + (ks_ >> 2); tok_ = tok_ > SEQ - 1 ? SEQ - 1 : tok_;                                                          \
        a_ = *(const bf16x8*)(arow + (size_t)tok_ * LDP + 32 * (ks_ & 3));                                                              \
        _Pragma("unroll") for (int nb = 0; nb < 16; ++nb) w_[nb] = *(const bf16x8*)(brow + ((size_t)ks_ * 256 + nb * 16) * 32); } while (0)
#define CMMA(a_, w_) do { _Pragma("unroll") for (int nb = 0; nb < 16; ++nb) acc[nb] = __builtin_amdgcn_mfma_f32_16x16x32_bf16(a_, w_[nb], acc[nb], 0, 0, 0); } while (0)
    CLOAD(0, aA, wA);
#pragma unroll 1
    for (int kk = 0; kk < 16; kk += 2) {
        CLOAD(kk + 1, aB, wB);
        __builtin_amdgcn_sched_barrier(0);
        CMMA(aA, wA);
        __builtin_amdgcn_sched_barrier(0);
        if (kk + 2 < 16) CLOAD(kk + 2, aA, wA);
        __builtin_amdgcn_sched_barrier(0);
        CMMA(aB, wB);
        __builtin_amdgcn_sched_barrier(0);
    }
#undef CLOAD
#undef CMMA
    LAS float* red = (LAS float*)(lds + RING_OFF);
    __syncthreads();
#pragma unroll
    for (int nb = 0; nb < 16; ++nb)
#pragma unroll
        for (int r = 0; r < 4; ++r) red[(wave * 16 + 4 * kq + r) * 256 + ((16 * nb + i) ^ (16 * kq))] = acc[nb][r];
    __syncthreads();
    const int hr = tid >> 5, hc = 8 * (tid & 31);
    f32x4_ s0 = {0.f, 0.f, 0.f, 0.f}, s1 = {0.f, 0.f, 0.f, 0.f};
#pragma unroll
    for (int w8 = 0; w8 < 8; ++w8) { const LAS float* rp = red + (w8 * 16 + hr) * 256 + (hc ^ (16 * (hr >> 2))); s0 += *(const LAS f32x4_*)rp; s1 += *(const LAS f32x4_*)(rp + 4); }
    float bs[8];
    { const float* bf_ = (const float*)(ws + WS_MISC) + MISC_B1F + which * 256 + hc; const f32x4_ b0 = *(const f32x4_*)bf_, b1 = *(const f32x4_*)(bf_ + 4);
      bs[0] = b0[0]; bs[1] = b0[1]; bs[2] = b0[2]; bs[3] = b0[3]; bs[4] = b1[0]; bs[5] = b1[1]; bs[6] = b1[2]; bs[7] = b1[3]; }
    __syncthreads();
    LAS bf16* hid = (LAS bf16*)(lds + RING_OFF);
    { v4u o; o.x = cvtpk2(gelu_tanh_f(s0[0] + bs[0]), gelu_tanh_f(s0[1] + bs[1])); o.y = cvtpk2(gelu_tanh_f(s0[2] + bs[2]), gelu_tanh_f(s0[3] + bs[3]));
      o.z = cvtpk2(gelu_tanh_f(s1[0] + bs[4]), gelu_tanh_f(s1[1] + bs[5])); o.w = cvtpk2(gelu_tanh_f(s1[2] + bs[6]), gelu_tanh_f(s1[3] + bs[7]));
      *(LAS v4u*)(hid + hr * 264 + hc) = o; }
    __syncthreads();
    f32x4_ acc2 = {0.f, 0.f, 0.f, 0.f};
    const bf16* b2row = w2T + (size_t)(16 * wave + i) * 256 + 8 * kq;
#pragma unroll
    for (int ks = 0; ks < 8; ++ks) {
        const bf16x8 a = *(const LAS bf16x8*)(hid + i * 264 + 32 * ks + 8 * kq);
        const bf16x8 w = *(const bf16x8*)(b2row + 32 * ks);
        acc2 = __builtin_amdgcn_mfma_f32_16x16x32_bf16(a, w, acc2, 0, 0, 0);
    }
    float rs[4];
#pragma unroll
    for (int r = 0; r < 4; ++r) { const int cc = blk * 16 + 4 * kq + r; const unsigned ob = (cc >= 511) ? 0u : f2bf(acc2[r]); outp[((size_t)bg * 512 + cc) * 128 + 16 * wave + i] = (bf16)ob;
        const float vr = __uint_as_float(ob << 16); rs[r] = vr * vr; }
    if (which == 0) {
#pragma unroll
        for (int r = 0; r < 4; ++r) { float v = rs[r];
            v += __builtin_bit_cast(float, __builtin_amdgcn_update_dpp(0, __builtin_bit_cast(int, v), 0xB1, 0xF, 0xF, false));
            v += __builtin_bit_cast(float, __builtin_amdgcn_update_dpp(0, __builtin_bit_cast(int, v), 0x4E, 0xF, 0xF, false));
            v += __builtin_bit_cast(float, __builtin_amdgcn_update_dpp(0, __builtin_bit_cast(int, v), 0x141, 0xF, 0xF, false));
            v += __builtin_bit_cast(float, __builtin_amdgcn_update_dpp(0, __builtin_bit_cast(int, v), 0x140, 0xF, 0xF, false));
            rs[r] = v; }
        LAS float* part = (LAS float*)(lds + RING_OFF + 16384);
        if (i == 0) {
#pragma unroll
            for (int r = 0; r < 4; ++r) part[wave * 16 + 4 * kq + r] = rs[r]; }
        __syncthreads();
        if (tid < 16) { float s = 0.f;
#pragma unroll
            for (int w8 = 0; w8 < 8; ++w8) s += part[w8 * 16 + tid];
            s = fmaxf(s, swzx<1>(s)); s = fmaxf(s, swzx<2>(s)); s = fmaxf(s, swzx<4>(s)); s = fmaxf(s, swzx<8>(s));
            if (tid == 0) atomicMax((unsigned*)(ws + WS_CTL + CTL_KCMX) + bg, __float_as_uint(s)); }
    }
    __syncthreads();
}

template <int K> __device__ __forceinline__ float swz_xor(float v) { return __builtin_bit_cast(float, __builtin_amdgcn_ds_swizzle(__builtin_bit_cast(int, v), (K << 10) | 0x1F)); }
__device__ __forceinline__ void diff_unit(const Ptrs& P, LAS unsigned char* ldsb, int b, int h, int qb) {
    using namespace att;
    lchar* lds = (lchar*)ldsb;
    unsigned char* ws = P.ws;
    const bf16_t* proj = (const bf16_t*)(ws + WS_PROJ); bf16_t* mix = (bf16_t*)(ws + WS_MIX);
    const float* misc = (const float*)(ws + WS_MISC);
    int tid = threadIdx.x; asm volatile("" : "+v"(tid));
    const int wid = __builtin_amdgcn_readfirstlane(tid >> 6), lane = tid & 63, r32 = lane & 31, hi = lane >> 5;
    const int map = wid >> 2, wq = wid & 3, q0 = 128 * qb + 32 * wq;
    const size_t tokb = (size_t)b * SEQ;
    __syncthreads();
#ifndef ATT_HEADPRE
#define ATT_HEADPRE true
#endif
    if (ATT_HEADPRE) head_dma(lds, proj + tokb * LDP + C_DK + h * 128, proj + tokb * LDP + C_DV + h * 128, LDP, 0, 2 * (qb + 1));
    if (tid < LUTX) { const int d = tid - LUT0; ((ALAS float*)(lds + L_LUT))[tid] = (d >= 0 && d < 113) ? misc[MISC_LUT + h * 128 + d] : 0.f; }
    const bf16_t* qp = proj + (tokb + q0 + r32) * LDP + C_DQ + h * 128 + map * 64 + hi * 8;
    bf16x8 qr[4];
#pragma unroll
    for (int d0 = 0; d0 < 4; ++d0) qr[d0] = *(const bf16x8*)(qp + d0 * 16);
    Lane L; L.qpos = q0 + r32; L.qlo = q0; L.qhi = q0 + 31; L.lut = lds_addr(lds + L_LUT);
#ifdef TPROBE_SEC
    L.tpw = (unsigned long long*)(ws + WS_CTL + 40960);
#endif
    f32x16 o[4]; float m_reg = 0.f, l_reg;
#ifndef DIFF_ENGINE
#define DIFF_ENGINE attn_tiles_dma
#endif
#ifndef DIFF_NEGM
#define DIFF_NEGM false
#endif
#ifdef EPROBE
    unsigned long long ep_t0 = __builtin_amdgcn_s_memrealtime();
#endif
#ifndef DIFF_FIXM
#define DIFF_FIXM 1
#endif
#ifndef NSA_FIXM_CMP
#define NSA_FIXM_CMP 1
#endif
#ifndef NSA_FIXM_SLC
#define NSA_FIXM_SLC 1
#endif
#ifndef NSA_FIXM_WIN
#define NSA_FIXM_WIN 1
#endif
    if (DIFF_FIXM) { const float k2 = __uint_as_float(((const unsigned*)(ws + WS_CTL + CTL_KMX))[b * 20 + h * 2 + map]);
        m_reg = sqrtf(qrow_norm2<4>(qr) * k2) * 1.002f + misc[MISC_LUTMAX + h]; }
#ifndef ATT_FUSE
#define ATT_FUSE true
#endif
#ifndef DIFF_DMAPOS
#define DIFF_DMAPOS 2
#endif
#ifndef ATT_DMAPOS
#define ATT_DMAPOS 2
#endif
#ifndef ATT_PRIO
#define ATT_PRIO 1
#endif
#ifndef DIFF_KDB
#define DIFF_KDB false
#endif
#ifndef DIFF_VPRE
#define DIFF_VPRE true
#endif
#ifndef DIFF_KPRE
#define DIFF_KPRE true
#endif
#ifndef DIFF_SMP2
#define DIFF_SMP2 true
#endif
#ifndef DIFF_KGS
#define DIFF_KGS 2
#endif
#ifndef DIFF_PIPE
#define DIFF_PIPE false
#endif
    DIFF_ENGINE<M_DIFF, 64, DIFF_NEGM, DIFF_FIXM, ATT_FUSE, DIFF_PIPE, DIFF_KGS, DIFF_SMP2, DIFF_KPRE, DIFF_VPRE, DIFF_KDB, ATT_PRIO, DIFF_DMAPOS, ATT_HEADPRE>(lds, proj + tokb * LDP + C_DK + h * 128, proj + tokb * LDP + C_DV + h * 128, LDP, 0, 2 * (qb + 1), nullptr, qr, map * 128, L, 0u, 0u, 0u, 0u, o, m_reg, l_reg);
#ifdef EPROBE
    if (blockIdx.x == 0 && tid == 0) { unsigned long long* w_ = (unsigned long long*)(ws + WS_CTL + 40960); w_[0] += __builtin_amdgcn_s_memrealtime() - ep_t0; }
#endif
    ALAS float* li_l = (ALAS float*)(lds + L_WS) + wid * 64;
    if (hi == 0) li_l[r32] = l_reg;
    asm volatile("s_waitcnt lgkmcnt(0)" ::: "memory");
    float rli[16];
#pragma unroll
    for (int r = 0; r < 16; ++r) { const float l_ = li_l[crow(r, hi)]; rli[r] = l_ > 0.f ? 1.0f / l_ : 0.f; }
    ALAS float* X = (ALAS float*)(lds + L_V);
    float gsub4[4] = {0.f, 0.f, 0.f, 0.f}, lam = 0.f;
    if (map == 0) { lam = misc[MISC_LAM]; const float* subln = P.in[7];
#pragma unroll
        for (int d0 = 0; d0 < 4; ++d0) gsub4[d0] = subln[32 * d0 + r32]; }
    if (map == 1) {
#pragma unroll
        for (int d0 = 0; d0 < 4; ++d0)
#pragma unroll
            for (int r = 0; r < 16; ++r) X[(wq * 64 + d0 * 16 + r) * 64 + lane] = o[d0][r] * rli[r];
    }
    __syncthreads();
    if (map == 0) {
        float ss[16];
#pragma unroll
        for (int r = 0; r < 16; ++r) ss[r] = 0.f;
#pragma unroll
        for (int d0 = 0; d0 < 4; ++d0)
#pragma unroll
            for (int r = 0; r < 16; ++r) { const float o2 = X[(wq * 64 + d0 * 16 + r) * 64 + lane]; const float d = o[d0][r] * rli[r] - lam * o2; o[d0][r] = d; ss[r] += d * d; }
#pragma unroll
        for (int r = 0; r < 16; ++r) { float s = ss[r]; s += swz_xor<1>(s); s += swz_xor<2>(s); s += swz_xor<4>(s); s += swz_xor<8>(s); s += swz_xor<16>(s);
            ss[r] = 0.8f / sqrtf(s * (1.0f / 128.0f) + EPS); }
#pragma unroll
        for (int d0 = 0; d0 < 4; ++d0) { const float gsub = gsub4[d0];
#pragma unroll
            for (int r = 0; r < 16; ++r) { const float v = o[d0][r] * ss[r] * gsub; const float vn = swz_xor<1>(v);
                if ((r32 & 1) == 0) *(unsigned*)(mix + (tokb + q0 + crow(r, hi)) * DM + h * 128 + 32 * d0 + r32) = cvtpk(v, vn); } }
    }
}

#ifndef NSA_PARTS
#define NSA_PARTS 31
#endif
#define NSA_PARTS_DEF NSA_PARTS
__device__ __forceinline__ void nsa_unit(const Ptrs& P, LAS unsigned char* ldsb, int bg, int qb) {
    using namespace att;
#ifdef TSEL_A
#define NSTAMP(k) do { if (blockIdx.x == 0 && threadIdx.x == 0 && qb == 127) { unsigned long long* t_ = (unsigned long long*)(P.ws + WS_CTL + 8192); t_[(k)] = __builtin_amdgcn_s_memrealtime(); } } while (0)
#else
#define NSTAMP(k) do {} while (0)
#endif
    NSTAMP(21);
    lchar* lds = (lchar*)ldsb;
    unsigned char* ws = P.ws;
    const bf16_t* proj = (const bf16_t*)(ws + WS_PROJ); bf16_t* mix = (bf16_t*)(ws + WS_MIX);
    const bf16_t* kcmp = (const bf16_t*)(ws + WS_KCMP) + (size_t)bg * 512 * 128; const bf16_t* vcmp = (const bf16_t*)(ws + WS_VCMP) + (size_t)bg * 512 * 128;
    const float* misc = (const float*)(ws + WS_MISC); const float* gates = (const float*)(ws + WS_GATES);
    int tid = threadIdx.x; asm volatile("" : "+v"(tid));
    const int wid = __builtin_amdgcn_readfirstlane(tid >> 6), lane = tid & 63, r32 = lane & 31, hi = lane >> 5;
    const int b = bg >> 1, g = bg & 1, t0 = 64 * qb; const size_t tokb = (size_t)b * SEQ;
    const int ql = 8 * wid + (r32 >> 2), hg = r32 & 3;
    ALAS unsigned* imp = (ALAS unsigned*)(lds + L_IMP); ALAS unsigned* selm = (ALAS unsigned*)(lds + L_SEL); ALAS unsigned* un = (ALAS unsigned*)(lds + L_UN); ALAS int* list = (ALAS int*)(lds + L_LIST);
    ALAS float* li_l = (ALAS float*)(lds + L_WS) + wid * 64;
    __syncthreads();
    if (ATT_HEADPRE && (NSA_PARTS_DEF & 1)) head_dma(lds, kcmp, vcmp, 128, 0, (((t0 + 63 - 31) >> 4) >> 6) + 1);
    if (tid < 4) un[tid] = 0u;
    for (int i = tid; i < 4 * LUTX; i += NWAVES * 64) { const int hh = i / LUTX, d = i - hh * LUTX - LUT0; ((ALAS float*)(lds + L_LUT))[i] = (d >= 0 && d < 113) ? misc[MISC_LUT + (8 + g * 4 + hh) * 128 + d] : 0.f; }
    const bf16_t* qp = proj + (tokb + t0 + ql) * LDP + C_NQ + g * 512 + hg * 128 + hi * 8;
    bf16x8 qr[8];
#pragma unroll
    for (int d0 = 0; d0 < 8; ++d0) qr[d0] = *(const bf16x8*)(qp + d0 * 16);
    Lane L; L.qpos = t0 + ql; L.qlo = t0 + 8 * wid; L.qhi = L.qlo + 7; L.lut = lds_addr(lds + L_LUT) + (unsigned)hg * (LUTX * 4u);
#ifdef TPROBE_SEC
    L.tpw = (unsigned long long*)(ws + WS_CTL + 40960);
#endif
#define NSA_GATE(k) ({ int l_ = lane; asm volatile("" : "+v"(l_)); gates[(tokb + t0 + 8 * wid + ((l_ & 31) >> 2)) * 32 + g * 12 + (l_ & 3) * 3 + (k)]; })
#define NSA_ACCP ({ int l_ = lane; asm volatile("" : "+v"(l_)); (float*)(ws + WS_NSAACC) + ((size_t)blockIdx.x * NWAVES + wid) * 4096 + l_; })
    f32x16 o[4]; float m_c = 0.f, l_c, m_x = 0.f, l_x;
    if (NSA_FIXM_CMP) m_c = sqrtf(qrow_norm2<8>(qr) * __uint_as_float(((const unsigned*)(ws + WS_CTL + CTL_KCMX))[bg])) * 1.01f;
    const int NTc = (((t0 + 63 - 31) >> 4) >> 6) + 1;
#ifndef NSA_PARTS
#define NSA_PARTS 31
#endif
#ifndef NSA_ENGINE
#define NSA_ENGINE attn_tiles_dma
#ifndef NSA_KDB_CMP
#define NSA_KDB_CMP false
#endif
#ifndef NSA_KDB_SLC
#define NSA_KDB_SLC false
#endif
#ifndef NSA_KDB_WIN
#define NSA_KDB_WIN false
#endif
#ifndef NSA_VPRE_CMP
#define NSA_VPRE_CMP true
#endif
#ifndef NSA_VPRE_SLC
#define NSA_VPRE_SLC true
#endif
#ifndef NSA_VPRE_WIN
#define NSA_VPRE_WIN true
#endif
#ifndef NSA_KPRE_CMP
#define NSA_KPRE_CMP true
#endif
#ifndef NSA_KPRE_SLC
#define NSA_KPRE_SLC true
#endif
#ifndef NSA_KPRE_WIN
#define NSA_KPRE_WIN true
#endif
#ifndef NSA_SMP2_CMP
#define NSA_SMP2_CMP true
#endif
#ifndef NSA_SMP2_SLC
#define NSA_SMP2_SLC true
#endif
#ifndef NSA_SMP2_WIN
#define NSA_SMP2_WIN true
#endif
#ifndef NSA_KGS_CMP
#define NSA_KGS_CMP 2
#endif
#ifndef NSA_KGS_SLC
#define NSA_KGS_SLC 2
#endif
#ifndef NSA_KGS_WIN
#define NSA_KGS_WIN 2
#endif
#endif
    if (NSA_PARTS & 1) NSA_ENGINE<M_CMP, 128, false, NSA_FIXM_CMP, ATT_FUSE, false, NSA_KGS_CMP, NSA_SMP2_CMP, NSA_KPRE_CMP, NSA_VPRE_CMP, NSA_KDB_CMP, ATT_PRIO, ATT_DMAPOS, ATT_HEADPRE>(lds, kcmp, vcmp, 128, 0, NTc, nullptr, qr, 0, L, 0u, 0u, 0u, 0u, o, m_c, l_c); else { m_c = 0.f; l_c = 1.f; o[0] = o[1] = o[2] = o[3] = f32x16{}; }
    { const float sc = l_c > 0.f ? NSA_GATE(0) / l_c : 0.f; if (hi == 0) li_l[r32] = sc; asm volatile("s_waitcnt lgkmcnt(0)" ::: "memory");
      float* ap = NSA_ACCP; float lv[16];
#pragma unroll
      for (int r = 0; r < 16; ++r) lv[r] = li_l[crow(r, hi)];
#pragma unroll
      for (int d0 = 0; d0 < 4; ++d0) {
#pragma unroll
          for (int r = 0; r < 16; ++r) ap[64 * r] = o[d0][r] * lv[r];
          ap += 1024; asm volatile("" : "+v"(ap)); } }
    NSTAMP(22);
    { int t_ = threadIdx.x; asm volatile("" : "+v"(t_)); for (int i = t_; i < 64 * IMP_LD; i += NWAVES * 64) imp[i] = 0u; }
    if (NSA_PARTS & 2) { const float fx = (l_c > 0.f ? 1.0f / l_c : 0.f) * 268435456.0f;
      const int sr = tid >> 4, sc = (tid & 15) * 8, kws = KSWZ(sr, sc * 2);
      lchar* K_lds = lds + L_K;
      bf16x8 k0 = *(const bf16x8*)(kcmp + (size_t)sr * 128 + sc), k1 = *(const bf16x8*)(kcmp + (size_t)(32 + sr) * 128 + sc);
      for (int t = 0; t < NTc; ++t) {
          *(ALAS bf16x8*)(K_lds + kws) = k0; *(ALAS bf16x8*)(K_lds + kws + 32 * 256) = k1;
          __syncthreads();
          if (t + 1 < NTc) { k0 = *(const bf16x8*)(kcmp + (size_t)(64 * (t + 1) + sr) * 128 + sc); k1 = *(const bf16x8*)(kcmp + (size_t)(64 * (t + 1) + 32 + sr) * 128 + sc); }
          const bool act = 16 * (64 * t) + 31 <= L.qhi;
          if (act) {
              f32x16 p0, p1;
              qkt<0, 128>(p0, p1, K_lds, 0, r32, hi, qr, true, false, 0u);
              tile_mask<M_CMP>(p0, p1, 64 * t, t, L, hi, true, 0u, 0u, 0u, 0u);
#pragma unroll
              for (int r = 0; r < 16; ++r) { p0[r] = __builtin_amdgcn_exp2f(p0[r] - m_c) * fx; p1[r] = __builtin_amdgcn_exp2f(p1[r] - m_c) * fx; }
              ALAS unsigned* ir = imp + ql * IMP_LD + 16 * t + hi;
#define QSUM(x) do { x += __builtin_bit_cast(float, __builtin_amdgcn_update_dpp(0, __builtin_bit_cast(int, x), 0xB1, 0xF, 0xF, false)); \
                     x += __builtin_bit_cast(float, __builtin_amdgcn_update_dpp(0, __builtin_bit_cast(int, x), 0x4E, 0xF, 0xF, false)); } while (0)
              float va[8], vb[8];
#pragma unroll
              for (int gi = 0; gi < 4; ++gi) {
                  va[gi] = p0[4 * gi]; vb[gi] = va[gi] + 2.0f * (p0[4 * gi + 1] + p0[4 * gi + 2] + p0[4 * gi + 3]);
                  va[4 + gi] = p1[4 * gi]; vb[4 + gi] = va[4 + gi] + 2.0f * (p1[4 * gi + 1] + p1[4 * gi + 2] + p1[4 * gi + 3]);
              }
#pragma unroll
              for (int k = 0; k < 8; ++k) { QSUM(va[k]); QSUM(vb[k]); }
#undef QSUM
              if (hg == 0) {
#pragma unroll
                  for (int k = 0; k < 8; ++k) {
                      __hip_atomic_fetch_add(ir + 2 * k, (unsigned)va[k], __ATOMIC_RELAXED, __HIP_MEMORY_SCOPE_WORKGROUP);
                      __hip_atomic_fetch_add(ir + 2 * k + 1, (unsigned)vb[k], __ATOMIC_RELAXED, __HIP_MEMORY_SCOPE_WORKGROUP);
                  }
              }
          }
          __syncthreads();
      }
    }
    NSTAMP(23);
    if (NSA_PARTS & 4) { const int cur = qb;
      for (int qi = 0; qi < 8; ++qi) {
          const int qq = 8 * wid + qi; const int j0 = lane, j1 = lane + 64;
          unsigned k0, k1;
          { const unsigned v = imp[qq * IMP_LD + j0]; k0 = (j0 > cur) ? 0u : ((j0 == 0 || j0 == cur || j0 + 1 == cur) ? (0xFFFFFF80u | (unsigned)(127 - j0)) : ((v & ~127u) | (unsigned)(127 - j0))); }
          { const unsigned v = imp[qq * IMP_LD + j1]; k1 = (j1 > cur) ? 0u : ((j1 == cur || j1 + 1 == cur) ? (0xFFFFFF80u | (unsigned)(127 - j1)) : ((v & ~127u) | (unsigned)(127 - j1))); }
          unsigned thr = 0u;
          for (int bit = 31; bit >= 0; --bit) { const unsigned cand = thr | (1u << bit);
              const int cnt = __popcll(__ballot(k0 >= cand)) + __popcll(__ballot(k1 >= cand)); if (cnt >= 16) thr = cand; }
          const unsigned long long m0 = __ballot(k0 >= thr && k0 != 0u), m1 = __ballot(k1 >= thr && k1 != 0u);
          if (lane == 0) { selm[qq * 4 + 0] = (unsigned)m0; selm[qq * 4 + 1] = (unsigned)(m0 >> 32); selm[qq * 4 + 2] = (unsigned)m1; selm[qq * 4 + 3] = (unsigned)(m1 >> 32);
              __hip_atomic_fetch_or(un + 0, (unsigned)m0, __ATOMIC_RELAXED, __HIP_MEMORY_SCOPE_WORKGROUP); __hip_atomic_fetch_or(un + 1, (unsigned)(m0 >> 32), __ATOMIC_RELAXED, __HIP_MEMORY_SCOPE_WORKGROUP);
              __hip_atomic_fetch_or(un + 2, (unsigned)m1, __ATOMIC_RELAXED, __HIP_MEMORY_SCOPE_WORKGROUP); __hip_atomic_fetch_or(un + 3, (unsigned)(m1 >> 32), __ATOMIC_RELAXED, __HIP_MEMORY_SCOPE_WORKGROUP); }
      }
    }
    __syncthreads();
    int NTs; unsigned sw0, sw1, sw2, sw3;
    { const unsigned u0 = un[0], u1 = un[1], u2 = un[2], u3 = un[3];
      NTs = __popc(u0) + __popc(u1) + __popc(u2) + __popc(u3);
      if (tid < 128) { const int wsel = tid >> 5, bpos = tid & 31; const unsigned w = wsel == 0 ? u0 : (wsel == 1 ? u1 : (wsel == 2 ? u2 : u3));
          if ((w >> bpos) & 1u) { const int below = (wsel > 0 ? __popc(u0) : 0) + (wsel > 1 ? __popc(u1) : 0) + (wsel > 2 ? __popc(u2) : 0) + __popc(w & ((1u << bpos) - 1u)); list[below] = tid; } }
      sw0 = selm[ql * 4 + 0]; sw1 = selm[ql * 4 + 1]; sw2 = selm[ql * 4 + 2]; sw3 = selm[ql * 4 + 3]; }
    __syncthreads();
    NSTAMP(24);
    m_x = 0.f; l_x = 1.f;
    if (NSA_FIXM_SLC) { int t_ = threadIdx.x; asm volatile("" : "+v"(t_)); m_x = sqrtf(qrow_norm2<8>(qr) * __uint_as_float(((const unsigned*)(ws + WS_CTL + CTL_KMX))[b * 20 + 16 + g])) * 1.002f + misc[MISC_LUTMAX + 8 + g * 4 + (t_ & 3)]; }
    if (NSA_PARTS & 8) NSA_ENGINE<M_SLC, 128, false, NSA_FIXM_SLC, ATT_FUSE, false, NSA_KGS_SLC, NSA_SMP2_SLC, NSA_KPRE_SLC, NSA_VPRE_SLC, NSA_KDB_SLC, ATT_PRIO, ATT_DMAPOS>(lds, proj + tokb * LDP + C_KS + g * 128, proj + tokb * LDP + C_VS + g * 128, LDP, 0, NTs, list, qr, 0, L, lds_addr(lds + L_SEL) + (unsigned)ql * 16u, 0u, 0u, 0u, o, m_x, l_x);
    if (ATT_HEADPRE && (NSA_PARTS & 16)) { const int jlo = qb > 8 ? qb - 8 : 0; head_dma(lds, proj + tokb * LDP + C_KW + g * 128, proj + tokb * LDP + C_VW + g * 128, LDP, jlo, qb - jlo + 1); }
    { int t_ = threadIdx.x; asm volatile("" : "+v"(t_)); const int r32_ = t_ & 31, hi_ = (t_ >> 5) & 1;
      ALAS float* li2 = (ALAS float*)(lds + L_WS) + wid * 64;
      const float sc = l_x > 0.f ? NSA_GATE(1) / l_x : 0.f; if (hi_ == 0) li2[r32_] = sc; asm volatile("s_waitcnt lgkmcnt(0)" ::: "memory");
      float* ap = NSA_ACCP; float lv[16];
#pragma unroll
      for (int r = 0; r < 16; ++r) lv[r] = li2[crow(r, hi_)];
#pragma unroll
      for (int d0 = 0; d0 < 4; ++d0) { float t[16];
#pragma unroll
          for (int r = 0; r < 16; ++r) t[r] = ap[64 * r];
#pragma unroll
          for (int r = 0; r < 16; ++r) ap[64 * r] = t[r] + o[d0][r] * lv[r];
          ap += 1024; asm volatile("" : "+v"(ap)); } }
    NSTAMP(25);
    if (NSA_FIXM_WIN) { int t_ = threadIdx.x; asm volatile("" : "+v"(t_)); m_x = sqrtf(qrow_norm2<8>(qr) * __uint_as_float(((const unsigned*)(ws + WS_CTL + CTL_KMX))[b * 20 + 18 + g])) * 1.002f + misc[MISC_LUTMAX + 8 + g * 4 + (t_ & 3)]; }
    if (NSA_PARTS & 16) { const int jlo = qb > 8 ? qb - 8 : 0;
      NSA_ENGINE<M_WIN, 128, false, NSA_FIXM_WIN, ATT_FUSE, false, NSA_KGS_WIN, NSA_SMP2_WIN, NSA_KPRE_WIN, NSA_VPRE_WIN, NSA_KDB_WIN, ATT_PRIO, ATT_DMAPOS, ATT_HEADPRE>(lds, proj + tokb * LDP + C_KW + g * 128, proj + tokb * LDP + C_VW + g * 128, LDP, jlo, qb - jlo + 1, nullptr, qr, 0, L, 0u, 0u, 0u, 0u, o, m_x, l_x); }
    { int t_ = threadIdx.x; asm volatile("" : "+v"(t_)); const int r32_ = t_ & 31, hi_ = (t_ >> 5) & 1;
      ALAS float* li2 = (ALAS float*)(lds + L_WS) + wid * 64;
      const float sc = l_x > 0.f ? NSA_GATE(2) / l_x : 0.f; if (hi_ == 0) li2[r32_] = sc; asm volatile("s_waitcnt lgkmcnt(0)" ::: "memory");
      float* ap = NSA_ACCP; float lv[16];
#pragma unroll
      for (int r = 0; r < 16; ++r) lv[r] = li2[crow(r, hi_)];
#pragma unroll
      for (int d0 = 0; d0 < 4; ++d0) { float t[16];
#pragma unroll
          for (int r = 0; r < 16; ++r) t[r] = ap[64 * r];
          ap += 1024; asm volatile("" : "+v"(ap));
#pragma unroll
          for (int r = 0; r < 16; ++r) { const int rho = crow(r, hi_); const float v = t[r] + o[d0][r] * lv[r]; const float vn = swz_xor<1>(v);
              if ((r32_ & 1) == 0) *(unsigned*)(mix + (tokb + t0 + 8 * wid + (rho >> 2)) * DM + 1024 + g * 512 + (rho & 3) * 128 + 32 * d0 + r32_) = cvtpk(v, vn); } } }
    NSTAMP(26);
#undef NSA_GATE
#undef NSA_ACCP
}

__device__ __forceinline__ void unpack8(const v4u w, float* f) {
    f[0] = __uint_as_float(w.x << 16); f[1] = __uint_as_float(w.x & 0xffff0000u); f[2] = __uint_as_float(w.y << 16); f[3] = __uint_as_float(w.y & 0xffff0000u);
    f[4] = __uint_as_float(w.z << 16); f[5] = __uint_as_float(w.z & 0xffff0000u); f[6] = __uint_as_float(w.w << 16); f[7] = __uint_as_float(w.w & 0xffff0000u);
}
__device__ __forceinline__ void p5_row(const float* xrow, bf16* yrow, const float* g1, const float* g2, bf16* hrow, int lane) {
    float y[4][8]; float s = 0.f;
#pragma unroll
    for (int j = 0; j < 4; ++j) { unpack8(*(const v4u*)(yrow + 8 * lane + 512 * j), y[j]);
#pragma unroll
        for (int e = 0; e < 8; ++e) s += y[j][e] * y[j][e]; }
    const float r1 = 1.0f / sqrtf(wave_sum(s) * (1.0f / DM) + EPS);
    float s2 = 0.f;
#pragma unroll
    for (int j = 0; j < 4; ++j) { const int c = 8 * lane + 512 * j;
        const f32x4 xa = *(const f32x4*)(xrow + c), xb = *(const f32x4*)(xrow + c + 4), ga = *(const f32x4*)(g1 + c), gb = *(const f32x4*)(g1 + c + 4);
        f32x4 va, vb;
#pragma unroll
        for (int e = 0; e < 4; ++e) { va[e] = xa[e] + y[j][e] * r1 * ga[e]; vb[e] = xb[e] + y[j][4 + e] * r1 * gb[e]; y[j][e] = va[e]; y[j][4 + e] = vb[e]; s2 += va[e] * va[e] + vb[e] * vb[e]; }
        { v4u w; w.x = cvtpk2(va[0], va[1]); w.y = cvtpk2(va[2], va[3]); w.z = cvtpk2(vb[0], vb[1]); w.w = cvtpk2(vb[2], vb[3]); *(v4u*)(yrow + c) = w; } }
    const float r2 = 1.0f / sqrtf(wave_sum(s2) * (1.0f / DM) + EPS);
#pragma unroll
    for (int j = 0; j < 4; ++j) { const int c = 8 * lane + 512 * j; const f32x4 ga = *(const f32x4*)(g2 + c), gb = *(const f32x4*)(g2 + c + 4);
        v4u w; w.x = cvtpk2(y[j][0] * r2 * ga[0], y[j][1] * r2 * ga[1]); w.y = cvtpk2(y[j][2] * r2 * ga[2], y[j][3] * r2 * ga[3]);
        w.z = cvtpk2(y[j][4] * r2 * gb[0], y[j][5] * r2 * gb[1]); w.w = cvtpk2(y[j][6] * r2 * gb[2], y[j][7] * r2 * gb[3]);
        *(v4u*)(hrow + c) = w; }
}
__device__ __forceinline__ void p9_row(float* orow, const bf16* x1row, const bf16* yrow, const float* g, int lane) {
    float y[4][8]; float s = 0.f;
#pragma unroll
    for (int j = 0; j < 4; ++j) { unpack8(*(const v4u*)(yrow + 8 * lane + 512 * j), y[j]);
#pragma unroll
        for (int e = 0; e < 8; ++e) s += y[j][e] * y[j][e]; }
    const float r1 = 1.0f / sqrtf(wave_sum(s) * (1.0f / DM) + EPS);
#pragma unroll
    for (int j = 0; j < 4; ++j) { const int c = 8 * lane + 512 * j; float x1[8]; unpack8(*(const v4u*)(x1row + c), x1);
        const f32x4 ga = *(const f32x4*)(g + c), gb = *(const f32x4*)(g + c + 4);
        f32x4 va, vb;
#pragma unroll
        for (int e = 0; e < 4; ++e) { va[e] = x1[e] + y[j][e] * r1 * ga[e]; vb[e] = x1[4 + e] + y[j][4 + e] * r1 * gb[e]; }
        *(f32x4*)(orow + c) = va; *(f32x4*)(orow + c + 4) = vb; }
}
__device__ __forceinline__ void p5_rows(const float* x, bf16* ybase, const float* g1, const float* g2, bf16* hbase, int gw, int NGW, int lane) {
    int m = gw; if (m >= TOK) return;
    v4u yn[4]; f32x4 xn[8];
#define P5_LOAD(m_) do { _Pragma("unroll") for (int j = 0; j < 4; ++j) { const size_t o_ = (size_t)(m_) * DM + 8 * lane + 512 * j; yn[j] = __builtin_nontemporal_load((const v4u*)(ybase + o_)); xn[2 * j] = __builtin_nontemporal_load((const f32x4*)(x + o_)); xn[2 * j + 1] = __builtin_nontemporal_load((const f32x4*)(x + o_ + 4)); } } while (0)
    P5_LOAD(m);
    f32x4 g1v[8], g2v[8];
#pragma unroll
    for (int j = 0; j < 4; ++j) { const int c = 8 * lane + 512 * j; g1v[2 * j] = *(const f32x4*)(g1 + c); g1v[2 * j + 1] = *(const f32x4*)(g1 + c + 4); g2v[2 * j] = *(const f32x4*)(g2 + c); g2v[2 * j + 1] = *(const f32x4*)(g2 + c + 4); }
#pragma unroll 1
    for (; m < TOK; m += NGW) {
        float y[4][8]; f32x4 xc[8]; float s = 0.f;
#pragma unroll
        for (int j = 0; j < 4; ++j) { unpack8(yn[j], y[j]); xc[2 * j] = xn[2 * j]; xc[2 * j + 1] = xn[2 * j + 1];
#pragma unroll
            for (int e = 0; e < 8; ++e) s += y[j][e] * y[j][e]; }
        if (m + NGW < TOK) P5_LOAD(m + NGW);
        bf16* yrow = ybase + (size_t)m * DM; bf16* hrow = hbase + (size_t)m * DM;
        const float r1 = 1.0f / sqrtf(wave_sum(s) * (1.0f / DM) + EPS);
        float s2 = 0.f;
#pragma unroll
        for (int j = 0; j < 4; ++j) { const int c = 8 * lane + 512 * j;
            const f32x4 xa = xc[2 * j], xb = xc[2 * j + 1], ga = g1v[2 * j], gb = g1v[2 * j + 1];
            f32x4 va, vb;
#pragma unroll
            for (int e = 0; e < 4; ++e) { va[e] = xa[e] + y[j][e] * r1 * ga[e]; vb[e] = xb[e] + y[j][4 + e] * r1 * gb[e]; y[j][e] = va[e]; y[j][4 + e] = vb[e]; s2 += va[e] * va[e] + vb[e] * vb[e]; }
            { v4u w; w.x = cvtpk2(va[0], va[1]); w.y = cvtpk2(va[2], va[3]); w.z = cvtpk2(vb[0], vb[1]); w.w = cvtpk2(vb[2], vb[3]); *(v4u*)(yrow + c) = w; } }
        const float r2 = 1.0f / sqrtf(wave_sum(s2) * (1.0f / DM) + EPS);
#pragma unroll
        for (int j = 0; j < 4; ++j) { const int c = 8 * lane + 512 * j; const f32x4 ga = g2v[2 * j], gb = g2v[2 * j + 1];
            v4u w; w.x = cvtpk2(y[j][0] * r2 * ga[0], y[j][1] * r2 * ga[1]); w.y = cvtpk2(y[j][2] * r2 * ga[2], y[j][3] * r2 * ga[3]);
            w.z = cvtpk2(y[j][4] * r2 * gb[0], y[j][5] * r2 * gb[1]); w.w = cvtpk2(y[j][6] * r2 * gb[2], y[j][7] * r2 * gb[3]);
            *(v4u*)(hrow + c) = w; }
    }
#undef P5_LOAD
}
__device__ __forceinline__ void p9_rows(float* obase, const bf16* x1base, const bf16* ybase, const float* g, int gw, int NGW, int lane) {
    int m = gw; if (m >= TOK) return;
    v4u yn[4], xn[4];
#define P9_LOAD(m_) do { _Pragma("unroll") for (int j = 0; j < 4; ++j) { const size_t o_ = (size_t)(m_) * DM + 8 * lane + 512 * j; yn[j] = __builtin_nontemporal_load((const v4u*)(ybase + o_)); xn[j] = __builtin_nontemporal_load((const v4u*)(x1base + o_)); } } while (0)
    P9_LOAD(m);
    f32x4 gv9[8];
#pragma unroll
    for (int j = 0; j < 4; ++j) { const int c = 8 * lane + 512 * j; gv9[2 * j] = *(const f32x4*)(g + c); gv9[2 * j + 1] = *(const f32x4*)(g + c + 4); }
#pragma unroll 1
    for (; m < TOK; m += NGW) {
        float y[4][8]; v4u xc[4]; float s = 0.f;
#pragma unroll
        for (int j = 0; j < 4; ++j) { unpack8(yn[j], y[j]); xc[j] = xn[j];
#pragma unroll
            for (int e = 0; e < 8; ++e) s += y[j][e] * y[j][e]; }
        if (m + NGW < TOK) P9_LOAD(m + NGW);
        float* orow = obase + (size_t)m * DM;
        const float r1 = 1.0f / sqrtf(wave_sum(s) * (1.0f / DM) + EPS);
#pragma unroll
        for (int j = 0; j < 4; ++j) { const int c = 8 * lane + 512 * j; float x1[8]; unpack8(xc[j], x1);
            const f32x4 ga = gv9[2 * j], gb = gv9[2 * j + 1];
            f32x4 va, vb;
#pragma unroll
            for (int e = 0; e < 4; ++e) { va[e] = x1[e] + y[j][e] * r1 * ga[e]; vb[e] = x1[4 + e] + y[j][4 + e] * r1 * gb[e]; }
            __builtin_nontemporal_store(va, (f32x4*)(orow + c)); __builtin_nontemporal_store(vb, (f32x4*)(orow + c + 4)); }
    }
#undef P9_LOAD
}
__device__ __forceinline__ f32x4 ld4bf(const bf16* p) { const v2u w = *(const v2u*)p; f32x4 r; r[0] = __uint_as_float(w.x << 16); r[1] = __uint_as_float(w.x & 0xffff0000u); r[2] = __uint_as_float(w.y << 16); r[3] = __uint_as_float(w.y & 0xffff0000u); return r; }
__device__ __forceinline__ void p7_halo(const Ptrs& P, int gt, int NGT) {
    unsigned char* ws = P.ws; const bf16* halo = (const bf16*)(ws + WS_HALO); bf16* act = (bf16*)(ws + WS_ACT);
    const float* cw = P.in[19]; const float* cb = P.in[20];
    constexpr int C4 = DFF / 4;
    for (int it = gt; it < 256 * 2 * C4; it += NGT) {
        const int c4 = it % C4, i = (it / C4) & 1, s = it / (2 * C4), c = 4 * c4;
        const bool first = (s & 127) == 0;
        const f32x4 z = {0.f, 0.f, 0.f, 0.f};
        const bf16* hc = halo + ((size_t)s * 4 + i) * NUP + c;
        const int sp = first ? s : s - 1;
        const bf16* hp3 = halo + ((size_t)sp * 4 + 3) * NUP + c; const bf16* hp2 = halo + ((size_t)sp * 4 + 2) * NUP + c; const bf16* h0 = halo + ((size_t)s * 4 + 0) * NUP + c;
        const f32x4 cg = ld4bf(hc), cu = ld4bf(hc + DFF);
        f32x4 g1, g2, u1, u2;
        if (i == 1) { g1 = ld4bf(h0); u1 = ld4bf(h0 + DFF); if (first) { g2 = z; u2 = z; } else { g2 = ld4bf(hp3); u2 = ld4bf(hp3 + DFF); } }
        else { if (first) { g1 = z; u1 = z; g2 = z; u2 = z; } else { g1 = ld4bf(hp3); u1 = ld4bf(hp3 + DFF); g2 = ld4bf(hp2); u2 = ld4bf(hp2 + DFF); } }
        const f32x4 wg0 = *(const f32x4*)(cw + c), wg1 = *(const f32x4*)(cw + NUP + c), wg2 = *(const f32x4*)(cw + 2 * NUP + c), bg = *(const f32x4*)(cb + c);
        const f32x4 wu0 = *(const f32x4*)(cw + DFF + c), wu1 = *(const f32x4*)(cw + NUP + DFF + c), wu2 = *(const f32x4*)(cw + 2 * NUP + DFF + c), bu = *(const f32x4*)(cb + DFF + c);
        const f32x4 yg = bg + wg0 * g2 + wg1 * g1 + wg2 * cg, yu = bu + wu0 * u2 + wu1 * u1 + wu2 * cu;
        v2u w; w.x = pk2(gelu_tanh_f(yg.x) * yu.x, gelu_tanh_f(yg.y) * yu.y); w.y = pk2(gelu_tanh_f(yg.z) * yu.z, gelu_tanh_f(yg.w) * yu.w);
        *(v2u*)(act + (size_t)(64 * s + i) * DFF + c) = w;
    }
}
typedef Ptrs Args;
__global__ void __launch_bounds__(NWAVES * 64, 2) hybrid_fwd(Args args) {
    extern __shared__ __attribute__((aligned(16))) unsigned char lds_raw[];
    LAS unsigned char* lds = (LAS unsigned char*)lds_raw;
    volatile LAS unsigned* MISCW = (volatile LAS unsigned*)(lds + MISC_OFF);
    const int tid = threadIdx.x, lane = tid & 63, wave = __builtin_amdgcn_readfirstlane(tid >> 6);
    const int G = gridDim.x; const int bx = blockIdx.x; const int vcu = (G % 8 == 0) ? (bx % 8) * (G / 8) + bx / 8 : bx;
    const Args& P = args;
    unsigned char* ws = args.ws;
    gu32* ctl = (gu32*)(ws + WS_CTL);
    for (int u = tid; u < (LDS_BYTES - LDSCTL_OFF) / 4; u += NWAVES * 64) ((LAS unsigned*)(lds + LDSCTL_OFF))[u] = 0u;
    __syncthreads();
    XcdBarrier bar; bar.bar = (unsigned*)(ctl + CW_BAR); bar.x = 0; bar.st = nullptr;
    if (N_LAUNCHES == 1) bar = xcd_barrier_post((unsigned*)(ctl + CW_BAR), MISCW + 8);
#define GRID_BAR() do { if (N_LAUNCHES == 1) xcd_barrier(bar); } while (0)
    const int lo = args.ph_lo, hi = args.ph_hi;
#ifndef PH_MASK
#define PH_MASK 0x3ff
#endif
#define IN(k) (((PH_MASK >> (k)) & 1) && lo <= (k) && (k) < hi)
#define BOTH(k) (IN(k) && IN((k) + 1))
    const int gw = vcu * NWAVES + wave, NGW = G * NWAVES;
#ifdef TSEL_A
    unsigned long long* tsw = (unsigned long long*)(ws + WS_CTL + 8192);
#define STAMP(k) do { if (vcu == 0 && tid == 0) tsw[(k)] = __builtin_amdgcn_s_memrealtime(); } while (0)
#else
#define STAMP(k) do {} while (0)
#endif
    STAMP(0);
#ifndef REP_PHASE
#define REP_PHASE -1
#endif
#define REPS(k) _Pragma("unroll 1") for (int rep_ = 0; rep_ < ((REP_PHASE == (k)) ? 2 : 1); ++rep_)
#define REPBAR(k) do { if ((REP_PHASE == (k)) && rep_ == 0) GRID_BAR(); } while (0)

    if (IN(0)) { REPS(0) { p0_prologue(P, lds, vcu, G, tid, lane, wave); REPBAR(0); } if (BOTH(0)) GRID_BAR(); STAMP(1); }

    if (IN(1)) { REPS(1) {
        { const int gt = (vcu == G - 1) ? tid : 512;
          if (gt < 512) { float* misc = (float*)(ws + WS_MISC); float s = 0.f; for (int kc = 0; kc < 64; ++kc) s += misc[MISC_B1 + ((gt >> 8) * 64 + kc) * 256 + (gt & 255)]; misc[MISC_B1F + gt] = s; } }
        pg8::Gemm g{(const pg8::bf16_t*)(ws + WS_H), (const pg8::bf16_t*)(ws + WS_WIN), TOK, LDP, DM}; pg8::StaticOrder S; S.init(TOK, LDP, G, bx);
        pg8::EpiProj E{(pg8::bf16_t*)(ws + WS_PROJ), LDP, (float*)(ws + WS_GATES), C2D, C2N};
        pg8::gemm_phase<pg8::EpiProj, pg8::StaticOrder, true, true>(lds + RING_OFF, g, S, E); REPBAR(1); }
        if (BOTH(1)) GRID_BAR(); STAMP(2);
    }

    if (IN(2)) { REPS(2) {
        for (int u = vcu; u < 256; u += G) cmp_unit(P, lds, u, tid, lane, wave);
        knorm_prep(P, lds, vcu, G, tid, lane, wave);
 REPBAR(2); }
        if (BOTH(2)) GRID_BAR(); STAMP(3);
    }

    if (IN(3)) { REPS(3) {
        STAMP(20);
#ifdef CLKPROBE
        unsigned long long ck0_ = 0, ck1_ = 0, rt0_ = 0, rt1_ = 0; if (vcu == 0 && tid == 0) { ck0_ = __builtin_amdgcn_s_memtime(); rt0_ = __builtin_amdgcn_s_memrealtime(); }
#endif
        bool qdone_ = false;
        for (int L = vcu; L < 256; L += G) {
            const int bh = L >> 4, s = L & 15;
#pragma unroll 1
            for (int i = 0; i < 4; ++i) { const int qb = (i == 0) ? 63 - s : (i == 1) ? 32 + s : (i == 2) ? 31 - s : s; diff_unit(P, lds, bh >> 3, bh & 7, qb);
#ifndef P3_QUEUE_ITEMS
#define P3_QUEUE_ITEMS 1
#endif
                if (P3_QUEUE_ITEMS > 0 && !qdone_) qdone_ = p0b_weights(P, lane, P3_QUEUE_ITEMS); }
        }
#ifdef CLKPROBE
        if (CLKPROBE == 0 && vcu == 0 && tid == 0) { ck1_ = __builtin_amdgcn_s_memtime(); rt1_ = __builtin_amdgcn_s_memrealtime(); ((unsigned long long*)(ws + WS_CTL + 40960))[0] = ck1_ - ck0_; ((unsigned long long*)(ws + WS_CTL + 40960))[1] = rt1_ - rt0_; }
        if (CLKPROBE == 1 && vcu == 0 && tid == 0) { ck0_ = __builtin_amdgcn_s_memtime(); rt0_ = __builtin_amdgcn_s_memrealtime(); }
#endif
        for (int L = vcu; L < 256; L += G) { const int bg = L >> 6, s = L & 63;
#pragma unroll 1
            for (int i = 0; i < 2; ++i) nsa_unit(P, lds, bg, i ? s : 127 - s); }
#ifdef CLKPROBE
        if (CLKPROBE == 1 && vcu == 0 && tid == 0) { ck1_ = __builtin_amdgcn_s_memtime(); rt1_ = __builtin_amdgcn_s_memrealtime(); ((unsigned long long*)(ws + WS_CTL + 40960))[0] = ck1_ - ck0_; ((unsigned long long*)(ws + WS_CTL + 40960))[1] = rt1_ - rt0_; }
#endif
        p0b_weights(P, lane); REPBAR(3); }
        if (BOTH(3)) GRID_BAR(); STAMP(4);
    }

    if (IN(4)) { REPS(4) {
        __syncthreads();
        pg8::Gemm g{(const pg8::bf16_t*)(ws + WS_MIX), (const pg8::bf16_t*)(ws + WS_WOUT), TOK, DM, DM}; pg8::StaticOrder S; S.init(TOK, DM, G, bx);
        pg8::EpiBf16Plain E{(pg8::bf16_t*)(ws + WS_Y), DM};
        pg8::gemm_phase<pg8::EpiBf16Plain, pg8::StaticOrder, true, true>(lds + RING_OFF, g, S, E); REPBAR(4); }
        if (BOTH(4)) GRID_BAR(); STAMP(5);
    }

    if (IN(5)) {
        p5_rows(P.in[0], (bf16*)(ws + WS_Y), P.in[16], P.in[17], (bf16*)(ws + WS_H), gw, NGW, lane);
        if (BOTH(5)) GRID_BAR(); STAMP(6);
    }

    if (IN(6)) { REPS(6) {
        pg8::Gemm g{(const pg8::bf16_t*)(ws + WS_H), (const pg8::bf16_t*)(ws + WS_WUP), TOK, NUP, DM}; pg8::StaticOrder S; S.init(TOK, NUP, G, bx);
        pg8::EpiUpGlu E{(pg8::bf16_t*)(ws + WS_ACT), (pg8::bf16_t*)(ws + WS_HALO), P.in[19], P.in[20], DFF};
        pg8::gemm_phase<pg8::EpiUpGlu, pg8::StaticOrder, true, true>(lds + RING_OFF, g, S, E); REPBAR(6); }
        if (BOTH(6)) GRID_BAR(); STAMP(7);
    }

    if (IN(7)) { p7_halo(P, vcu * (NWAVES * 64) + tid, G * NWAVES * 64); if (BOTH(7)) GRID_BAR(); STAMP(8); }

    if (IN(8)) { REPS(8) {
        pg8::Gemm g{(const pg8::bf16_t*)(ws + WS_ACT), (const pg8::bf16_t*)(ws + WS_WDN), TOK, DM, DFF}; pg8::StaticOrder S; S.init(TOK, DM, G, bx);
        pg8::EpiBf16Plain E{(pg8::bf16_t*)(ws + WS_Y2), DM};
        pg8::gemm_phase<pg8::EpiBf16Plain, pg8::StaticOrder, true, true>(lds + RING_OFF, g, S, E); REPBAR(8); }
        if (BOTH(8)) GRID_BAR(); STAMP(9);
    }

    if (IN(9)) {
        p9_rows(P.out, (const bf16*)(ws + WS_Y), (const bf16*)(ws + WS_Y2), P.in[22], gw, NGW, lane);
#ifdef CLKPROBE
        if (vcu == 0) { asm volatile("s_waitcnt vmcnt(0) lgkmcnt(0)" ::: "memory"); __syncthreads(); if (tid == 0) { const unsigned long long* w = (const unsigned long long*)(ws + WS_CTL + 40960);
            const float ratio = (float)w[0] / (float)(w[1] ? w[1] : 1ull); P.out[0] += 20.0f + floorf(ratio + 0.5f); } }
#endif
#ifdef EPROBE
        if (vcu == 0) { asm volatile("s_waitcnt vmcnt(0) lgkmcnt(0)" ::: "memory"); __syncthreads(); if (tid == 0) { const unsigned long long* w = (const unsigned long long*)(ws + WS_CTL + 40960);
            const unsigned long long* tsw2 = (const unsigned long long*)(ws + WS_CTL + 8192);
            const float ratio = (float)w[0] / (float)(tsw2[3] - tsw2[20]); P.out[0] += 20.0f + floorf(ratio * 40.0f + 0.5f); } }
#endif
#ifdef TPROBE_SEC
        if (vcu == 0) { asm volatile("s_waitcnt vmcnt(0) lgkmcnt(0)" ::: "memory"); __syncthreads(); if (tid == 0) { const unsigned long long* w = (const unsigned long long*)(ws + WS_CTL + 40960);
            const float ratio = (float)w[0] / (float)(w[1] ? w[1] : 1ull); P.out[0] += 20.0f + floorf(ratio * 40.0f + 0.5f); } }
#endif
#ifdef TSEL_A
        STAMP(10);
        if (vcu == 0) { asm volatile("s_waitcnt vmcnt(0) lgkmcnt(0)" ::: "memory"); __syncthreads(); if (tid == 0) { const float us = (float)(tsw[TSEL_B] - tsw[TSEL_A]) * 0.01f; P.out[0] += us; } }
#endif
    }
#undef IN
#undef BOTH
#undef GRID_BAR
}

extern "C" void kernel_launch(void* const* d_in, const int* in_sizes, int n_in, void* d_out, int out_size, void* d_ws, size_t ws_size, hipStream_t stream) {
    static int grid = 0;
    if (grid == 0) {
        if (n_in != NIN || in_sizes[0] != TOK * DM || out_size != TOK * DM || ws_size < WS_END) {
            fprintf(stderr, "kernel_launch: shape mismatch (n_in %d, in0 %d, out %d, ws %zu; need %zu bytes of workspace); nothing launched\n", n_in, n_in > 0 ? in_sizes[0] : -1, out_size, ws_size, (size_t)WS_END); grid = -1; return; }
        int dev = 0, cus = 0, per_cu = 0;
        if (hipGetDevice(&dev) != hipSuccess || hipDeviceGetAttribute(&cus, hipDeviceAttributeMultiprocessorCount, dev) != hipSuccess) { fprintf(stderr, "kernel_launch: device query failed\n"); grid = -1; return; }
        if (hipFuncSetAttribute((const void*)hybrid_fwd, hipFuncAttributeMaxDynamicSharedMemorySize, LDS_BYTES) != hipSuccess) { fprintf(stderr, "kernel_launch: hipFuncSetAttribute failed\n"); grid = -1; return; }
        if (hipOccupancyMaxActiveBlocksPerMultiprocessor(&per_cu, (const void*)hybrid_fwd, NWAVES * 64, LDS_BYTES) != hipSuccess || per_cu < 1)
            fprintf(stderr, "kernel_launch: note: occupancy query reports %d workgroups per CU\n", per_cu);
        (void)hipGetLastError();
        grid = cus;
    }
    if (grid < 0) return;
    if (hipMemsetAsync((char*)d_ws + WS_CTL, 0, CTL_ZERO_BYTES, stream) != hipSuccess) { fprintf(stderr, "kernel_launch: hipMemsetAsync failed\n"); return; }
    Args a{};
    for (int i = 0; i < NIN; ++i) a.in[i] = (const float*)d_in[i];
    a.out = (float*)d_out; a.ws = (unsigned char*)d_ws;
    for (int li = 0; li < N_LAUNCHES; ++li) {
        a.ph_lo = (N_LAUNCHES == PER_PHASE) ? li : 0; a.ph_hi = (N_LAUNCHES == PER_PHASE) ? li + 1 : PER_PHASE;
        hipLaunchKernelGGL(hybrid_fwd, dim3(grid), dim3(NWAVES * 64), LDS_BYTES, stream, a);
        const hipError_t le = hipPeekAtLastError();
        if (le != hipSuccess) { fprintf(stderr, "kernel_launch: launch %d failed: %s\n", li, hipGetErrorName(le)); break; }
    }
}
```

```cpp
#include <hip/hip_runtime.h>
#include <hip/hip_bf16.h>
#include <cstdio>
#include <cstdint>
namespace pg8 {
#define PG8_LAS __attribute__((address_space(3)))
typedef unsigned short bf16_t;
typedef short bf16x8 __attribute__((ext_vector_type(8)));
typedef float f32x4 __attribute__((ext_vector_type(4)));
typedef unsigned u32x4 __attribute__((ext_vector_type(4)));
constexpr int BM = 256, BK = 64, HALF = 128, HTB = HALF * BK * 2  , STAGE_BYTES = 8 * HTB, NXCD = 8, WGM = 8;

__host__ __device__ __forceinline__ int lds_byte(int r, int c) { const int st = (r >> 4) * 2 + (c >> 5), rr = r & 15, cc = c & 31, ob = rr * 64 + cc * 2; return st * 1024 + (ob ^ (((ob >> 9) & 1) << 5)); }
__host__ __device__ __forceinline__ void stage_rc(int b, int& R, int& C) { const int st = b / 1024, sb = b % 1024, swz = sb ^ (((sb >> 9) & 1) << 5); R = (st >> 1) * 16 + swz / 64; C = (st & 1) * 32 + (swz % 64) / 2; }
__host__ __device__ __forceinline__ int perm32(int rho) { const int n = rho >> 4, i = rho & 15; return 8 * (i >> 2) + 4 * n + (i & 3); }

struct Unit { int pm, pn; };
struct Gemm { const bf16_t* A; const bf16_t* Bt; int M, N, K; };

struct StaticOrder {
    int nM, nN, nwg, G, c;
    __host__ __device__ void init(int M, int N, int G_, int c_) { nM = M / BM; nN = N / BM; nwg = nM * nN; G = G_; c = c_; }
    __host__ __device__ bool next(int i, Unit& u) const {
        const long L = (long)i * G + c; if (L >= nwg) return false;
        int wgid = (int)L; { const int q = nwg / NXCD, r = nwg % NXCD, xcd = wgid % NXCD, off = wgid / NXCD; wgid = (xcd < r ? xcd * (q + 1) : r * (q + 1) + (xcd - r) * q) + off; }
        const int nig = WGM * nN, gid = wgid / nig, fm = gid * WGM, gsz = (nM - fm) < WGM ? (nM - fm) : WGM;
        u.pm = fm + ((wgid % nig) % gsz); u.pn = (wgid % nig) / gsz; return true;
    }
    __device__ __forceinline__ void a_ready(const Unit&) const {}
    __device__ __forceinline__ void done(const Unit&) const {}
};


__device__ __forceinline__ unsigned cvt_pk_bf16(float lo, float hi) { unsigned r; asm volatile("v_cvt_pk_bf16_f32 %0, %1, %2" : "=v"(r) : "v"(lo), "v"(hi)); return r; }
__device__ __forceinline__ float fast_sigmoid(float v) { return __builtin_amdgcn_rcpf(1.0f + __builtin_amdgcn_exp2f(-1.4426950408889634f * v)); }
__device__ __forceinline__ float gelu_tanh(float v) { const float z2 = 1.5957691216f * (v + 0.044715f * v * v * v); return v * __builtin_amdgcn_rcpf(1.0f + __builtin_amdgcn_exp2f(-1.4426950408889634f * z2)); }

struct EpiF32 {
    static constexpr bool PERM = false, AFTER_DRAIN = false;
    float* C; int ldc;
    __device__ __forceinline__ void operator()(const f32x4 (&acc)[2][2][4][2], const Unit& u, int wr, int wc, int fr, int fq) const {
        const int row0 = u.pm * BM + wr * 64 + fr, col0 = u.pn * BM + wc * 32 + 4 * fq;
#pragma unroll
        for (int ai = 0; ai < 2; ++ai)
#pragma unroll
            for (int m = 0; m < 4; ++m) { float* rowp = C + (size_t)(row0 + ai * HALF + m * 16) * ldc + col0;
#pragma unroll
                for (int bj = 0; bj < 2; ++bj)
#pragma unroll
                    for (int n = 0; n < 2; ++n) *(f32x4*)(rowp + bj * HALF + n * 16) = acc[ai][bj][m][n]; }
    }
};
struct EpiBf16Plain {
    static constexpr bool PERM = true, AFTER_DRAIN = false;
    bf16_t* O; int ldc;
    __device__ __forceinline__ void operator()(const f32x4 (&acc)[2][2][4][2], const Unit& u, int wr, int wc, int fr, int fq) const {
        const int row0 = u.pm * BM + wr * 64 + fr, col0 = u.pn * BM + wc * 32 + 8 * fq;
#pragma unroll
        for (int ai = 0; ai < 2; ++ai)
#pragma unroll
            for (int m = 0; m < 4; ++m) { bf16_t* rowp = O + (size_t)(row0 + ai * HALF + m * 16) * ldc + col0;
#pragma unroll
                for (int bj = 0; bj < 2; ++bj) { const f32x4 v0 = acc[ai][bj][m][0], v1 = acc[ai][bj][m][1];
                    u32x4 w; w.x = cvt_pk_bf16(v0[0], v0[1]); w.y = cvt_pk_bf16(v0[2], v0[3]); w.z = cvt_pk_bf16(v1[0], v1[1]); w.w = cvt_pk_bf16(v1[2], v1[3]);
                    *(u32x4*)(rowp + bj * HALF) = w; } }
    }
};
struct EpiProj {
    static constexpr bool PERM = true, AFTER_DRAIN = false;
    bf16_t* O; int ldc; float* gates; float c2d, c2n;
    __device__ __forceinline__ void operator()(const f32x4 (&acc)[2][2][4][2], const Unit& u, int wr, int wc, int fr, int fq) const {
        const int pn = u.pn; const int row0 = u.pm * BM + wr * 64 + fr;
        if (pn == 22) {
            if (wc == 0) {
#pragma unroll
                for (int ai = 0; ai < 2; ++ai)
#pragma unroll
                    for (int m = 0; m < 4; ++m) { float* gp = gates + (size_t)(row0 + ai * HALF + m * 16) * 32 + 8 * fq;
#pragma unroll
                        for (int n = 0; n < 2; ++n) { const f32x4 v = acc[ai][0][m][n]; f32x4 s; s[0] = fast_sigmoid(v[0]); s[1] = fast_sigmoid(v[1]); s[2] = fast_sigmoid(v[2]); s[3] = fast_sigmoid(v[3]); *(f32x4*)(gp + 4 * n) = s; } }
            }
            return;
        }
        const float sc = (pn < 4) ? c2d : ((pn >= 12 && pn < 16) ? c2n : 1.0f);
        const int col0 = pn * BM + wc * 32 + 8 * fq;
#pragma unroll
        for (int ai = 0; ai < 2; ++ai)
#pragma unroll
            for (int m = 0; m < 4; ++m) { bf16_t* rowp = O + (size_t)(row0 + ai * HALF + m * 16) * ldc + col0;
#pragma unroll
                for (int bj = 0; bj < 2; ++bj) { const f32x4 v0 = acc[ai][bj][m][0] * sc, v1 = acc[ai][bj][m][1] * sc;
                    u32x4 w; w.x = cvt_pk_bf16(v0[0], v0[1]); w.y = cvt_pk_bf16(v0[2], v0[3]); w.z = cvt_pk_bf16(v1[0], v1[1]); w.w = cvt_pk_bf16(v1[2], v1[3]);
                    *(u32x4*)(rowp + bj * HALF) = w; } }
    }
};
typedef float f32x2p __attribute__((ext_vector_type(2)));
__device__ __forceinline__ f32x2p glu_pk(f32x2p g, f32x2p u) {
    const f32x2p g2 = g * g;
    const f32x2p t = (g2 * 0.044715f + 1.0f) * g;
    const f32x2p a = t * (-1.4426950408889634f * 1.5957691216f);
    f32x2p e; e.x = __builtin_amdgcn_exp2f(a.x); e.y = __builtin_amdgcn_exp2f(a.y);
    const f32x2p d = e + 1.0f;
    f32x2p r; r.x = __builtin_amdgcn_rcpf(d.x); r.y = __builtin_amdgcn_rcpf(d.y);
    return (g * u) * r;
}
__device__ __forceinline__ float dpp_shr1(float v) { return __builtin_bit_cast(float, __builtin_amdgcn_update_dpp(0, __builtin_bit_cast(int, v), 0x111, 0xF, 0xF, true)); }
__device__ __forceinline__ float dpp_shr2(float v) { return __builtin_bit_cast(float, __builtin_amdgcn_update_dpp(0, __builtin_bit_cast(int, v), 0x112, 0xF, 0xF, true)); }
__device__ __forceinline__ float dpp_shl15(float v) { return __builtin_bit_cast(float, __builtin_amdgcn_update_dpp(0, __builtin_bit_cast(int, v), 0x10F, 0xF, 0xF, true)); }
__device__ __forceinline__ float dpp_shl14(float v) { return __builtin_bit_cast(float, __builtin_amdgcn_update_dpp(0, __builtin_bit_cast(int, v), 0x10E, 0xF, 0xF, true)); }
struct EpiUpGlu {
    static constexpr bool PERM = true, AFTER_DRAIN = false;
    bf16_t* act; bf16_t* halo; const float* cw; const float* cb; int dff;
    __device__ __forceinline__ void operator()(const f32x4 (&acc)[2][2][4][2], const Unit& u, int wr, int wc, int fr, int fq) const {
        typedef unsigned u32x2 __attribute__((ext_vector_type(2)));
        const int nu = 2 * dff;
#pragma unroll
        for (int n = 0; n < 2; ++n) {
            const int cc = u.pn * HALF + wc * 32 + 8 * fq + 4 * n;
            const f32x4 wg0 = *(const f32x4*)(cw + cc), wg1 = *(const f32x4*)(cw + (size_t)nu + cc), wg2 = *(const f32x4*)(cw + (size_t)2 * nu + cc), bg = *(const f32x4*)(cb + cc);
            const f32x4 wu0 = *(const f32x4*)(cw + dff + cc), wu1 = *(const f32x4*)(cw + (size_t)nu + dff + cc), wu2 = *(const f32x4*)(cw + (size_t)2 * nu + dff + cc), bu = *(const f32x4*)(cb + dff + cc);
#pragma unroll
            for (int ai = 0; ai < 2; ++ai) {
                const int strip = 4 * u.pm + 2 * ai + wr; const int rowb = u.pm * BM + ai * HALF + wr * 64 + fr;
#pragma unroll
                for (int m = 0; m < 4; ++m) {
                    const f32x4 g = acc[ai][0][m][n], up = acc[ai][1][m][n]; f32x4 g1, g2, u1, u2;
#pragma unroll
                    for (int e = 0; e < 4; ++e) { g1[e] = dpp_shr1(g[e]); g2[e] = dpp_shr2(g[e]); u1[e] = dpp_shr1(up[e]); u2[e] = dpp_shr2(up[e]); }
                    if (m > 0) { const f32x4 gp = acc[ai][0][m > 0 ? m - 1 : 0][n], upp = acc[ai][1][m > 0 ? m - 1 : 0][n];
#pragma unroll
                        for (int e = 0; e < 4; ++e) { g1[e] += dpp_shl15(gp[e]); g2[e] += dpp_shl14(gp[e]); u1[e] += dpp_shl15(upp[e]); u2[e] += dpp_shl14(upp[e]); } }
                    const f32x4 yg = bg + wg0 * g2 + wg1 * g1 + wg2 * g;
                    const f32x4 yu = bu + wu0 * u2 + wu1 * u1 + wu2 * up;
                    if ((m == 0 && fr < 2) || (m == 3 && fr >= 14)) { bf16_t* hp = halo + ((size_t)strip * 4 + (m == 0 ? fr : fr - 12)) * nu + cc;
                        u32x2 wg_; wg_.x = cvt_pk_bf16(g[0], g[1]); wg_.y = cvt_pk_bf16(g[2], g[3]); *(u32x2*)hp = wg_; u32x2 wu_; wu_.x = cvt_pk_bf16(up[0], up[1]); wu_.y = cvt_pk_bf16(up[2], up[3]); *(u32x2*)(hp + dff) = wu_; }
                    if (m > 0 || fr >= 2) { const f32x2p o01 = glu_pk((f32x2p){yg[0], yg[1]}, (f32x2p){yu[0], yu[1]}), o23 = glu_pk((f32x2p){yg[2], yg[3]}, (f32x2p){yu[2], yu[3]});
                        u32x2 w; w.x = cvt_pk_bf16(o01.x, o01.y); w.y = cvt_pk_bf16(o23.x, o23.y);
                        *(u32x2*)(act + (size_t)(rowb + m * 16) * dff + cc) = w; }
                }
            }
        }
    }
};
template <class Epi, class Sched, bool ALIGN_EPI = false, bool SP2 = false>
__device__ __forceinline__ void gemm_phase(PG8_LAS unsigned char* lds, const Gemm g, const Sched& S, const Epi& E) {
    int tid = threadIdx.x; asm volatile("" : "+v"(tid));
    const int wid = __builtin_amdgcn_readfirstlane(tid >> 6), lane = tid & 63, wr = wid >> 2, wc = wid & 3, fr = lane & 15, fq = lane >> 4;
    const int K = g.K, nt = K / BK;
    unsigned voffA[2], voffB[2];
#pragma unroll
    for (int i = 0; i < 2; ++i) { int R, C; stage_rc(tid * 16 + i * 8192, R, C); const int Rb = Epi::PERM ? ((R & ~31) + perm32(R & 31)) : R;
        voffA[i] = (unsigned)(R * K + C) * 2u; voffB[i] = (unsigned)(Rb * K + C) * 2u; }
    const size_t kstep = (size_t)(BK * 2);
    const size_t hstep = (size_t)HALF * K * 2;
    const size_t tstep = 2 * hstep;
    const unsigned ldsw = (unsigned)wid * 1024u;
    const int aoff = lds_byte(wr * 64 + fr, fq * 8), boff = lds_byte(wc * 32 + fr, fq * 8);
#define PG8_SA(b, h) (((b) * 2 + (h)) * HTB)
#define PG8_SB(b, h) ((4 + (b) * 2 + (h)) * HTB)
#define PG8_STAGE(bufoff, gbase, voff) do { _Pragma("unroll") for (int _i = 0; _i < 2; ++_i) \
        __builtin_amdgcn_global_load_lds((const unsigned*)((const char*)(gbase) + (voff)[_i]), (PG8_LAS unsigned*)(lds + (bufoff) + ldsw + _i * 8192), 16, 0, 0); } while (0)
#define PG8_LDA(dst, b, h) do { _Pragma("unroll") for (int m = 0; m < 4; ++m) _Pragma("unroll") for (int k = 0; k < 2; ++k) dst[m][k] = *(const PG8_LAS bf16x8*)(lds + PG8_SA(b, h) + aoff + m * 2048 + k * 1024); } while (0)
#define PG8_LDB(dst, b, h) do { _Pragma("unroll") for (int n = 0; n < 2; ++n) _Pragma("unroll") for (int k = 0; k < 2; ++k) dst[n][k] = *(const PG8_LAS bf16x8*)(lds + PG8_SB(b, h) + boff + n * 2048 + k * 1024); } while (0)
#define PG8_MMA(ai, bj, At, Bt) do { __builtin_amdgcn_s_setprio(1); _Pragma("unroll") for (int m = 0; m < 4; ++m) _Pragma("unroll") for (int n = 0; n < 2; ++n) _Pragma("unroll") for (int k = 0; k < 2; ++k) \
        acc[ai][bj][m][n] = __builtin_amdgcn_mfma_f32_16x16x32_bf16(Bt[n][k], At[m][k], acc[ai][bj][m][n], 0, 0, 0); __builtin_amdgcn_s_setprio(0); } while (0)
#define PG8_WAIT_V(n) asm volatile("s_waitcnt vmcnt(" #n ")" ::: "memory")
#define PG8_WAIT_L(n) asm volatile("s_waitcnt lgkmcnt(" #n ")" ::: "memory")
#define PG8_BAR __builtin_amdgcn_s_barrier()
#define PG8_SCHED __builtin_amdgcn_sched_barrier(0)
    Unit cur, nxt; int ui = 0;
    if (!S.next(0, cur)) return;
    f32x4 acc[2][2][4][2];
#pragma unroll
    for (int a = 0; a < 2; ++a)
#pragma unroll
        for (int b = 0; b < 2; ++b)
#pragma unroll
            for (int m = 0; m < 4; ++m)
#pragma unroll
                for (int n = 0; n < 2; ++n) acc[a][b][m][n] = (f32x4){0.f, 0.f, 0.f, 0.f};
    bf16x8 At[4][2], B0[2][2], B1[2][2];
    const char* cA = (const char*)g.A + (size_t)cur.pm * tstep; const char* cB = (const char*)g.Bt + (size_t)cur.pn * tstep;
    S.a_ready(cur);
    if constexpr (SP2) {
        PG8_STAGE(PG8_SB(0, 0), cB, voffB); PG8_STAGE(PG8_SB(0, 1), cB + hstep, voffB); PG8_STAGE(PG8_SA(0, 0), cA, voffA); PG8_STAGE(PG8_SA(0, 1), cA + hstep, voffA);
        if (wr == 1) PG8_BAR;
        PG8_WAIT_V(2); PG8_BAR;
        PG8_STAGE(PG8_SB(1, 0), cB + kstep, voffB); PG8_STAGE(PG8_SA(1, 0), cA + kstep, voffA); PG8_STAGE(PG8_SB(1, 1), cB + hstep + kstep, voffB);
        PG8_WAIT_V(6); PG8_BAR;
    } else {
        PG8_STAGE(PG8_SB(0, 0), cB, voffB); PG8_STAGE(PG8_SA(0, 0), cA, voffA); PG8_STAGE(PG8_SB(0, 1), cB + hstep, voffB); PG8_STAGE(PG8_SA(0, 1), cA + hstep, voffA);
        if (wr == 1) PG8_BAR;
        PG8_WAIT_V(4); PG8_BAR;
        PG8_STAGE(PG8_SB(1, 0), cB + kstep, voffB); PG8_STAGE(PG8_SA(1, 0), cA + kstep, voffA); PG8_STAGE(PG8_SB(1, 1), cB + hstep + kstep, voffB);
        PG8_WAIT_V(6); PG8_BAR;
    }
    for (;;) {
        const bool has_next = S.next(ui + 1, nxt);
        const char* nA = has_next ? (const char*)g.A + (size_t)nxt.pm * tstep : cA; const char* nB = has_next ? (const char*)g.Bt + (size_t)nxt.pn * tstep : cB;
        for (int t = 0; t < nt; t += 2) {
            const bool last = (t == nt - 2);
            const char* a1 = cA + (size_t)(t + 1) * kstep;
            const char* a2 = last ? nA : cA + (size_t)(t + 2) * kstep; const char* b2 = last ? nB : cB + (size_t)(t + 2) * kstep;
            const char* a3 = a2 + kstep; const char* b3 = b2 + kstep;
            if (last && has_next) S.a_ready(nxt);
            if constexpr (SP2) {
            PG8_LDB(B0, 0, 0); PG8_LDB(B1, 0, 1); PG8_SCHED; PG8_LDA(At, 0, 0); PG8_STAGE(PG8_SA(1, 1), a1 + hstep, voffA);
            PG8_WAIT_V(8); PG8_WAIT_L(0); PG8_BAR; PG8_MMA(0, 0, At, B0); PG8_MMA(0, 1, At, B1); PG8_BAR; PG8_SCHED;
            PG8_LDA(At, 0, 1); PG8_STAGE(PG8_SB(0, 0), b2, voffB); PG8_STAGE(PG8_SB(0, 1), b2 + hstep, voffB); PG8_STAGE(PG8_SA(0, 0), a2, voffA);
            PG8_WAIT_V(8); PG8_WAIT_L(0); PG8_BAR; PG8_MMA(1, 0, At, B0); PG8_MMA(1, 1, At, B1); PG8_BAR; PG8_SCHED;
            PG8_LDB(B0, 1, 0); PG8_LDB(B1, 1, 1); PG8_SCHED; PG8_LDA(At, 1, 0); PG8_STAGE(PG8_SA(0, 1), a2 + hstep, voffA);
            PG8_WAIT_V(8); PG8_WAIT_L(0); PG8_BAR; PG8_MMA(0, 0, At, B0); PG8_MMA(0, 1, At, B1); PG8_BAR; PG8_SCHED;
            PG8_LDA(At, 1, 1); PG8_STAGE(PG8_SB(1, 0), b3, voffB); PG8_STAGE(PG8_SB(1, 1), b3 + hstep, voffB); PG8_STAGE(PG8_SA(1, 0), a3, voffA);
            PG8_WAIT_V(8); PG8_WAIT_L(0); PG8_BAR; PG8_MMA(1, 0, At, B0); PG8_MMA(1, 1, At, B1); PG8_BAR; PG8_SCHED;
            } else {
            PG8_LDB(B0, 0, 0); PG8_SCHED; PG8_LDA(At, 0, 0); PG8_STAGE(PG8_SA(1, 1), a1 + hstep, voffA);
            PG8_WAIT_L(8); PG8_BAR; PG8_WAIT_L(0); PG8_MMA(0, 0, At, B0); PG8_BAR; PG8_SCHED;
            PG8_LDB(B1, 0, 1); PG8_STAGE(PG8_SB(0, 0), b2, voffB);
            PG8_BAR; PG8_WAIT_L(0); PG8_MMA(0, 1, At, B1); PG8_BAR;
            PG8_LDA(At, 0, 1); PG8_STAGE(PG8_SA(0, 0), a2, voffA);
            PG8_BAR; PG8_WAIT_L(0); PG8_MMA(1, 0, At, B0); PG8_BAR; PG8_SCHED;
            PG8_STAGE(PG8_SB(0, 1), b2 + hstep, voffB);
            PG8_WAIT_V(6); PG8_BAR; PG8_MMA(1, 1, At, B1); PG8_BAR;
            PG8_LDB(B0, 1, 0); PG8_SCHED; PG8_LDA(At, 1, 0); PG8_STAGE(PG8_SA(0, 1), a2 + hstep, voffA);
            PG8_WAIT_L(8); PG8_BAR; PG8_WAIT_L(0); PG8_MMA(0, 0, At, B0); PG8_BAR; PG8_SCHED;
            PG8_LDB(B1, 1, 1); PG8_STAGE(PG8_SB(1, 0), b3, voffB);
            PG8_BAR; PG8_WAIT_L(0); PG8_MMA(0, 1, At, B1); PG8_BAR;
            PG8_LDA(At, 1, 1); PG8_STAGE(PG8_SA(1, 0), a3, voffA);
            PG8_BAR; PG8_WAIT_L(0); PG8_MMA(1, 0, At, B0); PG8_BAR; PG8_SCHED;
            PG8_STAGE(PG8_SB(1, 1), b3 + hstep, voffB);
            PG8_WAIT_V(6); PG8_BAR; PG8_MMA(1, 1, At, B1); PG8_BAR;
            }
        }
        if constexpr (ALIGN_EPI) { if (wr == 0) PG8_BAR; }
        if constexpr (!Epi::AFTER_DRAIN) { E(acc, cur, wr, wc, fr, fq); S.done(cur); }
        if (!has_next) break;
#pragma unroll
        for (int a = 0; a < 2; ++a)
#pragma unroll
            for (int b = 0; b < 2; ++b)
#pragma unroll
                for (int m = 0; m < 4; ++m)
#pragma unroll
                    for (int n = 0; n < 2; ++n) acc[a][b][m][n] = (f32x4){0.f, 0.f, 0.f, 0.f};
        cur = nxt; cA = nA; cB = nB; ++ui;
        if constexpr (ALIGN_EPI) { if (wr == 1) PG8_BAR; }
    }
    PG8_WAIT_V(0);
    if constexpr (!ALIGN_EPI) { if (wr == 0) PG8_BAR; }
    PG8_BAR;
    if constexpr (Epi::AFTER_DRAIN) { E.fused(acc, cur, wr, wc, fr, fq, lds, wid, lane); S.done(cur); }
#undef PG8_SA
#undef PG8_SB
#undef PG8_STAGE
#undef PG8_LDA
#undef PG8_LDB
#undef PG8_MMA
#undef PG8_WAIT_V
#undef PG8_WAIT_L
#undef PG8_BAR
#undef PG8_SCHED
}
}
namespace att {
#define ALAS __attribute__((address_space(3)))
typedef unsigned short bf16_t;
typedef short bf16x8 __attribute__((ext_vector_type(8)));
typedef short s16x4 __attribute__((ext_vector_type(4)));
typedef float f32x16 __attribute__((ext_vector_type(16)));
typedef float f32x4 __attribute__((ext_vector_type(4)));
typedef unsigned u32x4 __attribute__((ext_vector_type(4)));
typedef ALAS char lchar;
constexpr int KVBLK = 64, SHM_K = 16384, SHM_V = 16384;
constexpr int LUTX = 328, LUT0 = 96;
constexpr int NVB = 4;
constexpr int SLOT = 2 * SHM_K;
constexpr int L_LUT = 0, L_V = 5632, L_K = L_V + NVB * SHM_V, L_WS = L_K + NVB * SHM_K, IMP_LD = 132, L_IMP = L_V, L_SEL = L_WS + 2048, L_UN = L_SEL + 1024, L_LIST = L_UN + 64, L_END = L_LIST + 512;
static_assert(64 * IMP_LD * 4 <= NVB * SHM_V, "importance table overlays the V ring");
constexpr float THR = 8.0f;
enum { M_DIFF = 0, M_CMP = 1, M_SLC = 2, M_WIN = 3 };
#define KSWZ(row, colB) ((row) * 256 + ((colB) ^ (((row) & 7) << 4)))
#define SBAR() __builtin_amdgcn_sched_barrier(0)
__device__ __forceinline__ int v_st(int k, int c) { const int kk = (k & ~0xC) | ((k & 4) << 1) | ((k & 8) >> 1); return ((kk >> 3) * 4 + (c >> 5)) * 512 + ((kk & 7) * 32 + (c & 31)) * 2; }
__device__ __forceinline__ int v_rd_base(int lane) { return ((lane & 3) << 3) | (((lane >> 2) & 3) << 6) | (((lane >> 4) & 1) << 5) | (((lane >> 5) & 1) << 8); }
constexpr int v_rd_off(int d0, int ks, int half) { return d0 * 512 + ks * 4096 + half * 2048; }
__device__ __forceinline__ int crow(int r, int hi) { return (r & 3) + 8 * (r >> 2) + 4 * hi; }
__device__ __forceinline__ unsigned cvtpk(float lo, float hi) { unsigned r; asm volatile("v_cvt_pk_bf16_f32 %0, %1, %2" : "=v"(r) : "v"(lo), "v"(hi)); return r; }
__device__ __forceinline__ unsigned lds_addr(const lchar* p) { return (unsigned)(uintptr_t)p; }

struct Lane {
    int qpos;
    int qlo, qhi;
    unsigned lut;
#ifdef TPROBE_SEC
    unsigned long long* tpw;
#endif
};
template <int MODE>
__device__ __forceinline__ void mask_sel(f32x16& p0, f32x16& p1, int key0, int tj, const Lane L, int hi, bool cross, unsigned sw0, unsigned sw1, unsigned sw2, unsigned sw3) {
    const float NEG = -__builtin_inff();
    if constexpr (MODE == M_CMP) {
        const int lim = ((L.qpos - 31) >> 4) - key0 - 4 * hi;
#pragma unroll
        for (int r = 0; r < 16; ++r) { const int c = (r & 3) + 8 * (r >> 2); if (c > lim) p0[r] = NEG; if (c + 32 > lim) p1[r] = NEG; }
    } else {
        if constexpr (MODE == M_SLC) {
            const unsigned w = tj < 64 ? (tj < 32 ? sw0 : sw1) : (tj < 96 ? sw2 : sw3);
            if (((w >> (tj & 31)) & 1u) == 0u) {
#pragma unroll
                for (int r = 0; r < 16; ++r) { p0[r] = NEG; p1[r] = NEG; } }
        }
        if (cross) {
            const int dq = L.qpos - key0 - 4 * hi;
#pragma unroll
            for (int r = 0; r < 16; ++r) {
                const int c = (r & 3) + 8 * (r >> 2);
                if constexpr (MODE == M_WIN) { if ((unsigned)(dq - c) >= 512u) p0[r] = NEG; if ((unsigned)(dq - c - 32) >= 512u) p1[r] = NEG; }
                else { if (dq - c < 0) p0[r] = NEG; if (dq - c - 32 < 0) p1[r] = NEG; }
            }
        }
    }
}
__device__ __forceinline__ void partialSM(f32x16& p0, f32x16& p1, float& m_reg, float& alpha) {
    float pmax = p0[0];
#pragma unroll
    for (int r = 1; r < 16; ++r) pmax = fmaxf(pmax, p0[r]);
#pragma unroll
    for (int r = 0; r < 16; ++r) pmax = fmaxf(pmax, p1[r]);
    { auto rr = __builtin_amdgcn_permlane32_swap(__float_as_uint(pmax), __float_as_uint(pmax), false, false);
      pmax = fmaxf(__uint_as_float(rr[0]), __uint_as_float(rr[1])); }
    if (__builtin_expect(__all(pmax - m_reg <= THR), 1)) { alpha = 1.f; }
    else { const float mn = fmaxf(m_reg, pmax); alpha = __builtin_amdgcn_exp2f(m_reg - mn); m_reg = mn; }
    const float mm = m_reg;
#pragma unroll
    for (int r = 0; r < 16; ++r) { p0[r] = p0[r] - mm; p1[r] = p1[r] - mm; }
#pragma unroll
    for (int r = 0; r < 16; ++r) p0[r] = __builtin_amdgcn_exp2f(p0[r]);
}
__device__ __forceinline__ void finishSM_direct(f32x16& p0, f32x16& p1, float alpha, float& l_reg, bf16x8& pa0, bf16x8& pa1, bf16x8& pa2, bf16x8& pa3) {
#pragma unroll
    for (int r = 0; r < 16; ++r) p1[r] = __builtin_amdgcn_exp2f(p1[r]);
    float ps = 0;
#pragma unroll
    for (int r = 0; r < 16; ++r) ps += p0[r];
#pragma unroll
    for (int r = 0; r < 16; ++r) ps += p1[r];
    { auto rr = __builtin_amdgcn_permlane32_swap(__float_as_uint(ps), __float_as_uint(ps), false, false);
      ps = __uint_as_float(rr[0]) + __uint_as_float(rr[1]); }
    l_reg = l_reg * alpha + ps;
#define PKD(P, B_, OUT) do { u32x4 w = {cvtpk(P[B_+0], P[B_+1]), cvtpk(P[B_+2], P[B_+3]), cvtpk(P[B_+4], P[B_+5]), cvtpk(P[B_+6], P[B_+7])}; OUT = __builtin_bit_cast(bf16x8, w); } while (0)
    PKD(p0, 0, pa0); PKD(p0, 8, pa1); PKD(p1, 0, pa2); PKD(p1, 8, pa3);
#undef PKD
}
__device__ __forceinline__ void partialSM_fix(f32x16& p0, f32x16& p1, float mref) {
#pragma unroll
    for (int r = 0; r < 16; ++r) { p0[r] = p0[r] - mref; p1[r] = p1[r] - mref; }
#pragma unroll
    for (int r = 0; r < 16; ++r) p0[r] = __builtin_amdgcn_exp2f(p0[r]);
}
__device__ __forceinline__ void finishSM(f32x16& p0, f32x16& p1, float alpha, float& l_reg, bf16x8& pa0, bf16x8& pa1, bf16x8& pa2, bf16x8& pa3) {
#pragma unroll
    for (int r = 0; r < 16; ++r) p1[r] = __builtin_amdgcn_exp2f(p1[r]);
    float ps = 0;
#pragma unroll
    for (int r = 0; r < 16; ++r) ps += p0[r];
#pragma unroll
    for (int r = 0; r < 16; ++r) ps += p1[r];
    { auto rr = __builtin_amdgcn_permlane32_swap(__float_as_uint(ps), __float_as_uint(ps), false, false);
      ps = __uint_as_float(rr[0]) + __uint_as_float(rr[1]); }
    l_reg = l_reg * alpha + ps;
#define PK4(P, B_, OUT) do { unsigned a0 = cvtpk(P[B_+0], P[B_+1]), a1 = cvtpk(P[B_+2], P[B_+3]);                          \
        unsigned b0 = cvtpk(P[B_+4], P[B_+5]), b1 = cvtpk(P[B_+6], P[B_+7]);                                             \
        auto r0 = __builtin_amdgcn_permlane32_swap(a0, b0, false, false); auto r1 = __builtin_amdgcn_permlane32_swap(a1, b1, false, false); \
        u32x4 w = {r0[0], r1[0], r0[1], r1[1]}; OUT = __builtin_bit_cast(bf16x8, w); } while (0)
    PK4(p0, 0, pa0); PK4(p0, 8, pa1); PK4(p1, 0, pa2); PK4(p1, 8, pa3);
#undef PK4
}
template <int KB, int DQK>
__device__ __forceinline__ void qkt(f32x16& p0, f32x16& p1, const lchar* K_lds, int koff, int r32, int hi, const bf16x8* qr, bool act, bool nearb, unsigned bb) {
    if (!act) { const float NEG = -__builtin_inff();
#pragma unroll
        for (int r = 0; r < 16; ++r) { p0[r] = NEG; p1[r] = NEG; } return; }
    if (nearb) {
#pragma unroll
        for (int r = 0; r < 16; ++r) { const int c = (r & 3) + 8 * (r >> 2);
            p0[r] = *(const ALAS float*)(uintptr_t)(bb + 4u * (unsigned)(59 - c)); p1[r] = *(const ALAS float*)(uintptr_t)(bb + 4u * (unsigned)(27 - c)); }
    } else { p0 = f32x16{}; p1 = f32x16{}; }
    const lchar* kb[4];
#pragma unroll
    for (int dd = 0; dd < 4; ++dd) kb[dd] = K_lds + KB * SHM_K + KSWZ(r32, (dd * 16 + hi * 8) * 2) + koff;
#pragma unroll
    for (int d0 = 0; d0 < DQK / 16; ++d0) { const lchar* a = kb[d0 & 3] + (d0 >> 2) * 128;
        const bf16x8 b0 = *reinterpret_cast<const ALAS bf16x8*>(a);
        const bf16x8 b1 = *reinterpret_cast<const ALAS bf16x8*>(a + 32 * 256);
        p0 = __builtin_amdgcn_mfma_f32_32x32x16_bf16(b0, qr[d0], p0, 0, 0, 0);
        p1 = __builtin_amdgcn_mfma_f32_32x32x16_bf16(b1, qr[d0], p1, 0, 0, 0); }
}
template <int VB>
__device__ __forceinline__ void pv_tile(f32x16* o, unsigned vb0, bf16x8 pa0, bf16x8 pa1, bf16x8 pa2, bf16x8 pa3, bool act) {
    if (!act) return;
#define TRRD(dst, off) asm volatile("ds_read_b64_tr_b16 %0, %1 offset:%2" : "=&v"(dst) : "v"(vb0), "i"(off) : "memory")
#define PV_D0(d0) do { s16x4 l0, l1, l2, l3, h0, h1, h2, h3; constexpr int b_ = VB * SHM_V + v_rd_off(d0, 0, 0);   \
        TRRD(l0, b_); TRRD(h0, b_ + 2048); TRRD(l1, b_ + 4096); TRRD(h1, b_ + 6144); TRRD(l2, b_ + 8192); TRRD(h2, b_ + 10240); TRRD(l3, b_ + 12288); TRRD(h3, b_ + 14336); \
        asm volatile("s_waitcnt lgkmcnt(0)" ::: "memory"); SBAR();   \
        o[d0] = __builtin_amdgcn_mfma_f32_32x32x16_bf16(pa0, (bf16x8){l0[0], l0[1], l0[2], l0[3], h0[0], h0[1], h0[2], h0[3]}, o[d0], 0, 0, 0);   \
        o[d0] = __builtin_amdgcn_mfma_f32_32x32x16_bf16(pa1, (bf16x8){l1[0], l1[1], l1[2], l1[3], h1[0], h1[1], h1[2], h1[3]}, o[d0], 0, 0, 0);   \
        o[d0] = __builtin_amdgcn_mfma_f32_32x32x16_bf16(pa2, (bf16x8){l2[0], l2[1], l2[2], l2[3], h2[0], h2[1], h2[2], h2[3]}, o[d0], 0, 0, 0);   \
        o[d0] = __builtin_amdgcn_mfma_f32_32x32x16_bf16(pa3, (bf16x8){l3[0], l3[1], l3[2], l3[3], h3[0], h3[1], h3[2], h3[3]}, o[d0], 0, 0, 0); } while (0)
    PV_D0(0); PV_D0(1); PV_D0(2); PV_D0(3);
#undef PV_D0
#undef TRRD
}
__device__ __forceinline__ void partialSM_rel(f32x16& p0, f32x16& p1, float& m_reg, float& alpha, bool& started, f32x16& negm) {
    float pmax = fmaxf(p0[0], p1[0]);
#pragma unroll
    for (int r = 1; r < 16; ++r) pmax = fmaxf(pmax, fmaxf(p0[r], p1[r]));
    { auto rr = __builtin_amdgcn_permlane32_swap(__float_as_uint(pmax), __float_as_uint(pmax), false, false);
      pmax = fmaxf(__uint_as_float(rr[0]), __uint_as_float(rr[1])); }
    const bool fin = pmax > -__builtin_inff();
    alpha = 1.f;
    if (__builtin_expect(__any((started && pmax > THR) || (!started && fin)), 0)) {
        const float delta = started ? fmaxf(pmax, 0.f) : (fin ? pmax : 0.f);
        alpha = started ? __builtin_amdgcn_exp2f(-delta) : 1.f;
        started = started || fin;
        m_reg += delta;
#pragma unroll
        for (int r = 0; r < 16; ++r) { p0[r] -= delta; p1[r] -= delta; }
        const float nm = -m_reg;
#pragma unroll
        for (int r = 0; r < 16; ++r) negm[r] = nm;
    }
#pragma unroll
    for (int r = 0; r < 16; ++r) p0[r] = __builtin_amdgcn_exp2f(p0[r]);
}
typedef float f32x2 __attribute__((ext_vector_type(2)));
__device__ __forceinline__ void finishSM_pk(f32x16& p0, f32x16& p1, float alpha, float& l_reg, bf16x8& pa0, bf16x8& pa1, bf16x8& pa2, bf16x8& pa3) {
#pragma unroll
    for (int r = 0; r < 16; ++r) p1[r] = __builtin_amdgcn_exp2f(p1[r]);
    f32x2 s2 = (f32x2){p0[0], p0[1]} + (f32x2){p1[0], p1[1]};
#pragma unroll
    for (int r = 2; r < 16; r += 2) { s2 += (f32x2){p0[r], p0[r + 1]}; s2 += (f32x2){p1[r], p1[r + 1]}; }
    float ps = s2.x + s2.y;
    { auto rr = __builtin_amdgcn_permlane32_swap(__float_as_uint(ps), __float_as_uint(ps), false, false);
      ps = __uint_as_float(rr[0]) + __uint_as_float(rr[1]); }
    l_reg = l_reg * alpha + ps;
#define PK4(P, B_, OUT) do { unsigned a0 = cvtpk(P[B_+0], P[B_+1]), a1 = cvtpk(P[B_+2], P[B_+3]);                          \
        unsigned b0 = cvtpk(P[B_+4], P[B_+5]), b1 = cvtpk(P[B_+6], P[B_+7]);                                             \
        auto r0 = __builtin_amdgcn_permlane32_swap(a0, b0, false, false); auto r1 = __builtin_amdgcn_permlane32_swap(a1, b1, false, false); \
        u32x4 w = {r0[0], r1[0], r0[1], r1[1]}; OUT = __builtin_bit_cast(bf16x8, w); } while (0)
    PK4(p0, 0, pa0); PK4(p0, 8, pa1); PK4(p1, 0, pa2); PK4(p1, 8, pa3);
#undef PK4
}
template <int DQK>
__device__ __forceinline__ void qkt_neg(f32x16& p0, f32x16& p1, const lchar* Kb, int koff, int r32, int hi, const bf16x8* qr, bool act, bool nearb, unsigned bb, const f32x16& negm) {
    if (!act) { const float NEG = -__builtin_inff();
#pragma unroll
        for (int r = 0; r < 16; ++r) { p0[r] = NEG; p1[r] = NEG; } return; }
    const lchar* kb[4];
#pragma unroll
    for (int dd = 0; dd < 4; ++dd) kb[dd] = Kb + KSWZ(r32, (dd * 16 + hi * 8) * 2) + koff;
    if (nearb) {
#pragma unroll
        for (int r = 0; r < 16; ++r) { const int c = (r & 3) + 8 * (r >> 2);
            p0[r] = *(const ALAS float*)(uintptr_t)(bb + 4u * (unsigned)(59 - c)) + negm[r]; p1[r] = *(const ALAS float*)(uintptr_t)(bb + 4u * (unsigned)(27 - c)) + negm[r]; }
    }
    constexpr int NG = DQK / 32;
    bf16x8 kf[2][4];
#define KRD(g, sl) do { _Pragma("unroll") for (int j_ = 0; j_ < 2; ++j_) { const int d0_ = 2 * (g) + j_; const lchar* a_ = kb[d0_ & 3] + (d0_ >> 2) * 128; \
        kf[sl][2 * j_] = *reinterpret_cast<const ALAS bf16x8*>(a_); kf[sl][2 * j_ + 1] = *reinterpret_cast<const ALAS bf16x8*>(a_ + 32 * 256); } } while (0)
    KRD(0, 0); if (NG > 1) KRD(1, 1);
    SBAR();
#pragma unroll
    for (int g = 0; g < NG; ++g) {
#pragma unroll
        for (int j = 0; j < 2; ++j) {
            if (g == 0 && j == 0) {
                if (nearb) { p0 = __builtin_amdgcn_mfma_f32_32x32x16_bf16(kf[0][0], qr[0], p0, 0, 0, 0); p1 = __builtin_amdgcn_mfma_f32_32x32x16_bf16(kf[0][1], qr[0], p1, 0, 0, 0); }
                else { p0 = __builtin_amdgcn_mfma_f32_32x32x16_bf16(kf[0][0], qr[0], negm, 0, 0, 0); p1 = __builtin_amdgcn_mfma_f32_32x32x16_bf16(kf[0][1], qr[0], negm, 0, 0, 0); }
            } else { p0 = __builtin_amdgcn_mfma_f32_32x32x16_bf16(kf[g & 1][2 * j], qr[2 * g + j], p0, 0, 0, 0); p1 = __builtin_amdgcn_mfma_f32_32x32x16_bf16(kf[g & 1][2 * j + 1], qr[2 * g + j], p1, 0, 0, 0); }
        }
        if (g + 2 < NG) { SBAR(); KRD(g + 2, g & 1); SBAR(); }
    }
#undef KRD
}
template <int DQK>
__device__ __forceinline__ void qkt_rt(f32x16& p0, f32x16& p1, const lchar* Kb, int koff, int r32, int hi, const bf16x8* qr, bool act, bool nearb, unsigned bb) {
    if (!act) { const float NEG = -__builtin_inff();
#pragma unroll
        for (int r = 0; r < 16; ++r) { p0[r] = NEG; p1[r] = NEG; } return; }
    if (nearb) {
#pragma unroll
        for (int r = 0; r < 16; ++r) { const int c = (r & 3) + 8 * (r >> 2);
            p0[r] = *(const ALAS float*)(uintptr_t)(bb + 4u * (unsigned)(59 - c)); p1[r] = *(const ALAS float*)(uintptr_t)(bb + 4u * (unsigned)(27 - c)); }
    } else { p0 = f32x16{}; p1 = f32x16{}; }
    const lchar* kb[4];
#pragma unroll
    for (int dd = 0; dd < 4; ++dd) kb[dd] = Kb + KSWZ(r32, (dd * 16 + hi * 8) * 2) + koff;
    if constexpr (DQK == 64) {
    constexpr int NG = DQK / 32;
    bf16x8 kf[2][4];
#define KRD(g, sl) do { _Pragma("unroll") for (int j_ = 0; j_ < 2; ++j_) { const int d0_ = 2 * (g) + j_; const lchar* a_ = kb[d0_ & 3] + (d0_ >> 2) * 128; \
        kf[sl][2 * j_] = *reinterpret_cast<const ALAS bf16x8*>(a_); kf[sl][2 * j_ + 1] = *reinterpret_cast<const ALAS bf16x8*>(a_ + 32 * 256); } } while (0)
    KRD(0, 0); if (NG > 1) KRD(1, 1);
    SBAR();
#pragma unroll
    for (int g = 0; g < NG; ++g) {
#pragma unroll
        for (int j = 0; j < 2; ++j) { p0 = __builtin_amdgcn_mfma_f32_32x32x16_bf16(kf[g & 1][2 * j], qr[2 * g + j], p0, 0, 0, 0); p1 = __builtin_amdgcn_mfma_f32_32x32x16_bf16(kf[g & 1][2 * j + 1], qr[2 * g + j], p1, 0, 0, 0); }
        if (g + 2 < NG) { SBAR(); KRD(g + 2, g & 1); SBAR(); }
    }
#undef KRD
    } else {
#pragma unroll
        for (int g = 0; g < DQK / 32; ++g) {
            bf16x8 kg[4];
#pragma unroll
            for (int j = 0; j < 2; ++j) { const int d0 = 2 * g + j; const lchar* a = kb[d0 & 3] + (d0 >> 2) * 128;
                kg[2 * j] = *reinterpret_cast<const ALAS bf16x8*>(a); kg[2 * j + 1] = *reinterpret_cast<const ALAS bf16x8*>(a + 32 * 256); }
            SBAR();
#pragma unroll
            for (int j = 0; j < 2; ++j) { p0 = __builtin_amdgcn_mfma_f32_32x32x16_bf16(kg[2 * j], qr[2 * g + j], p0, 0, 0, 0); p1 = __builtin_amdgcn_mfma_f32_32x32x16_bf16(kg[2 * j + 1], qr[2 * g + j], p1, 0, 0, 0); }
            SBAR();
        }
    }
}
__device__ __forceinline__ void pv_rt(f32x16* o, unsigned vb, bf16x8 pa0, bf16x8 pa1, bf16x8 pa2, bf16x8 pa3, bool act) {
    if (!act) return;
#define TRRD(dst, off) asm volatile("ds_read_b64_tr_b16 %0, %1 offset:%2" : "=&v"(dst) : "v"(vb), "i"(off) : "memory")
#define PV_D0(d0) do { s16x4 l0, l1, l2, l3, h0, h1, h2, h3; constexpr int b_ = v_rd_off(d0, 0, 0);   \
        TRRD(l0, b_); TRRD(h0, b_ + 2048); TRRD(l1, b_ + 4096); TRRD(h1, b_ + 6144); TRRD(l2, b_ + 8192); TRRD(h2, b_ + 10240); TRRD(l3, b_ + 12288); TRRD(h3, b_ + 14336); \
        asm volatile("s_waitcnt lgkmcnt(0)" ::: "memory"); SBAR();   \
        o[d0] = __builtin_amdgcn_mfma_f32_32x32x16_bf16(pa0, (bf16x8){l0[0], l0[1], l0[2], l0[3], h0[0], h0[1], h0[2], h0[3]}, o[d0], 0, 0, 0);   \
        o[d0] = __builtin_amdgcn_mfma_f32_32x32x16_bf16(pa1, (bf16x8){l1[0], l1[1], l1[2], l1[3], h1[0], h1[1], h1[2], h1[3]}, o[d0], 0, 0, 0);   \
        o[d0] = __builtin_amdgcn_mfma_f32_32x32x16_bf16(pa2, (bf16x8){l2[0], l2[1], l2[2], l2[3], h2[0], h2[1], h2[2], h2[3]}, o[d0], 0, 0, 0);   \
        o[d0] = __builtin_amdgcn_mfma_f32_32x32x16_bf16(pa3, (bf16x8){l3[0], l3[1], l3[2], l3[3], h3[0], h3[1], h3[2], h3[3]}, o[d0], 0, 0, 0); } while (0)
    PV_D0(0); PV_D0(1); PV_D0(2); PV_D0(3);
#undef PV_D0
#undef TRRD
}
template <int MODE> __device__ __forceinline__ bool tile_act(int key0, int tj, const Lane L, unsigned sw0, unsigned sw1, unsigned sw2, unsigned sw3) {
    if constexpr (MODE == M_DIFF) return key0 <= L.qhi;
    else if constexpr (MODE == M_CMP) return 16 * key0 + 31 <= L.qhi;
    else if constexpr (MODE == M_WIN) return key0 <= L.qhi && key0 + 63 >= L.qlo - 511;
    else { const unsigned w = tj < 64 ? (tj < 32 ? sw0 : sw1) : (tj < 96 ? sw2 : sw3); return __any((int)((w >> (tj & 31)) & 1u)) != 0; }
}
template <int MODE> __device__ __forceinline__ bool tile_near(int key0, const Lane L) {
    if constexpr (MODE == M_CMP) return false; else return key0 + 63 > L.qlo - 113;
}
template <int MODE> __device__ __forceinline__ bool tile_needs_mask(int key0, const Lane L) {
    if constexpr (MODE == M_DIFF) return key0 + 63 > L.qlo;
    else if constexpr (MODE == M_CMP) return 16 * (key0 + 63) + 31 > L.qlo;
    else if constexpr (MODE == M_WIN) return key0 + 63 > L.qlo || key0 <= L.qhi - 512;
    else return true;
}
template <int MODE> __device__ __forceinline__ void tile_mask(f32x16& p0, f32x16& p1, int key0, int tj, const Lane L, int hi, bool act, unsigned sw0, unsigned sw1, unsigned sw2, unsigned sw3) {
    if (!act) return;
    if constexpr (MODE == M_DIFF) { if (key0 + 63 > L.qlo) mask_sel<MODE>(p0, p1, key0, tj, L, hi, true, sw0, sw1, sw2, sw3); }
    else if constexpr (MODE == M_CMP) { if (16 * (key0 + 63) + 31 > L.qlo) mask_sel<MODE>(p0, p1, key0, tj, L, hi, true, sw0, sw1, sw2, sw3); }
    else if constexpr (MODE == M_WIN) { if (key0 + 63 > L.qlo || key0 <= L.qhi - 512) mask_sel<MODE>(p0, p1, key0, tj, L, hi, true, sw0, sw1, sw2, sw3); }
    else { mask_sel<MODE>(p0, p1, key0, tj, L, hi, key0 + 63 > L.qlo, sw0, sw1, sw2, sw3); }
}
template <int MODE, int DQK>
__device__ __forceinline__ void attn_tiles1(lchar* lds, const bf16_t* __restrict__ Kg, const bf16_t* __restrict__ Vg, int ld, int j_lo, int NT, const ALAS int* list,
                                           const bf16x8* qr, int koff, const Lane L, unsigned sw0, unsigned sw1, unsigned sw2, unsigned sw3, f32x16* o, float& m_reg, float& l_reg) {
    int tid = threadIdx.x; asm volatile("" : "+v"(tid));
    const int wid = __builtin_amdgcn_readfirstlane(tid >> 6), lane = tid & 63, r32 = lane & 31, hi = lane >> 5;
    lchar* V_lds = lds + L_V; lchar* K_lds = lds + L_K;
    ALAS float* al_l = (ALAS float*)(lds + L_WS) + wid * 64 + 32;
    m_reg = -1e30f; l_reg = 0.f; o[0] = f32x16{}; o[1] = f32x16{}; o[2] = f32x16{}; o[3] = f32x16{};
    const int sr = tid >> 4, sc = (tid & 15) * 8, vst0 = v_st(sr, sc), vst1 = v_st(32 + sr, sc), kws = KSWZ(sr, sc * 2);
    const unsigned vb0 = lds_addr(V_lds) + (unsigned)v_rd_base(lane);
    bf16x8 st_v0, st_v1, st_k0, st_k1;
#define TIDX(t) ((MODE == M_SLC) ? __builtin_amdgcn_readfirstlane(list[(t)]) : (j_lo + (t)))
#define SLOAD(t) do { const size_t k0_ = (size_t)TIDX(t) * KVBLK; st_v0 = *(const bf16x8*)(Vg + (k0_ + sr) * ld + sc); st_v1 = *(const bf16x8*)(Vg + (k0_ + 32 + sr) * ld + sc); \
                      st_k0 = *(const bf16x8*)(Kg + (k0_ + sr) * ld + sc); st_k1 = *(const bf16x8*)(Kg + (k0_ + 32 + sr) * ld + sc); } while (0)
#define SWRITE(bf) do { *(ALAS bf16x8*)(V_lds + (bf) * SHM_V + vst0) = st_v0; *(ALAS bf16x8*)(V_lds + (bf) * SHM_V + vst1) = st_v1; \
                        *(ALAS bf16x8*)(K_lds + (bf) * SHM_K + kws) = st_k0; *(ALAS bf16x8*)(K_lds + (bf) * SHM_K + kws + 32 * 256) = st_k1; } while (0)
#define VMW() asm volatile("s_waitcnt vmcnt(0)" ::: "memory")
#define RESC(a) do { if (__any((a) < 1.f)) { if (hi == 0) al_l[r32] = (a); asm volatile("s_waitcnt lgkmcnt(0)" ::: "memory");              \
                     _Pragma("unroll") for (int d_ = 0; d_ < 4; ++d_) _Pragma("unroll") for (int r = 0; r < 16; ++r) o[d_][r] *= al_l[crow(r, hi)]; } } while (0)
#define ACT(t) tile_act<MODE>(TIDX(t) * KVBLK, TIDX(t), L, sw0, sw1, sw2, sw3)
#define NEARB(t) tile_near<MODE>(TIDX(t) * KVBLK, L)
#define BB(t) (L.lut + 4u * (unsigned)(L.qpos - TIDX(t) * KVBLK - 4 * hi + LUT0 - 59))
#define MASKT(P0_, P1_, t, a_) tile_mask<MODE>(P0_, P1_, TIDX(t) * KVBLK, TIDX(t), L, hi, a_, sw0, sw1, sw2, sw3)
    f32x16 p0, p1; float al = 1.f; bf16x8 pa0, pa1, pa2, pa3;
    SLOAD(0); VMW(); SWRITE(0); SBAR();
    if (NT > 1) SLOAD(1);
    __syncthreads();
#define STEP(t, BF) do {                                                                                                  \
        const bool a_ = ACT(t);                                                                                           \
        SBAR(); qkt<BF, DQK>(p0, p1, K_lds, koff, r32, hi, qr, a_, NEARB(t), BB(t));                                      \
        MASKT(p0, p1, (t), a_); partialSM(p0, p1, m_reg, al); RESC(al);                                                   \
        finishSM(p0, p1, al, l_reg, pa0, pa1, pa2, pa3); SBAR();                                                          \
        if ((t) + 1 < NT) { VMW(); SWRITE((BF) ^ 1); SBAR(); if ((t) + 2 < NT) { SLOAD((t) + 2); SBAR(); } }              \
        pv_tile<BF>(o, vb0, pa0, pa1, pa2, pa3, a_);                                                                      \
        __syncthreads(); } while (0)
    int t = 0;
    for (; t + 1 < NT; t += 2) { STEP(t, 0); STEP(t + 1, 1); }
    if (t < NT) STEP(t, 0);
#undef STEP
#undef TIDX
#undef SLOAD
#undef SWRITE
#undef VMW
#undef RESC
#undef ACT
#undef NEARB
#undef BB
#undef MASKT
}
template <int MODE, int DQK>
__device__ __forceinline__ void attn_tiles2(lchar* lds, const bf16_t* __restrict__ Kg, const bf16_t* __restrict__ Vg, int ld, int j_lo, int NT, const ALAS int* list,
                                           const bf16x8* qr, int koff, const Lane L, unsigned sw0, unsigned sw1, unsigned sw2, unsigned sw3, f32x16* o, float& m_reg, float& l_reg) {
    int tid = threadIdx.x; asm volatile("" : "+v"(tid));
    const int wid = __builtin_amdgcn_readfirstlane(tid >> 6), lane = tid & 63, r32 = lane & 31, hi = lane >> 5;
    lchar* V_lds = lds + L_V; lchar* K_lds = lds + L_K;
    ALAS float* al_l = (ALAS float*)(lds + L_WS) + wid * 64 + 32;
    m_reg = -1e30f; l_reg = 0.f; o[0] = f32x16{}; o[1] = f32x16{}; o[2] = f32x16{}; o[3] = f32x16{};
    const int sr = tid >> 4, sc = (tid & 15) * 8, vst0 = v_st(sr, sc), vst1 = v_st(32 + sr, sc), kws = KSWZ(sr, sc * 2);
    const unsigned vb0 = lds_addr(V_lds) + (unsigned)v_rd_base(lane);
    bf16x8 st_v0, st_v1, st_k0, st_k1;
#define TIDX(t) ((MODE == M_SLC) ? __builtin_amdgcn_readfirstlane(list[(t)]) : (j_lo + (t)))
#define SLOAD(t) do { const size_t k0_ = (size_t)TIDX(t) * KVBLK; st_v0 = *(const bf16x8*)(Vg + (k0_ + sr) * ld + sc); st_v1 = *(const bf16x8*)(Vg + (k0_ + 32 + sr) * ld + sc); \
                      st_k0 = *(const bf16x8*)(Kg + (k0_ + sr) * ld + sc); st_k1 = *(const bf16x8*)(Kg + (k0_ + 32 + sr) * ld + sc); } while (0)
#define SWRITE(bf) do { *(ALAS bf16x8*)(V_lds + (bf) * SHM_V + vst0) = st_v0; *(ALAS bf16x8*)(V_lds + (bf) * SHM_V + vst1) = st_v1; \
                        *(ALAS bf16x8*)(K_lds + (bf) * SHM_K + kws) = st_k0; *(ALAS bf16x8*)(K_lds + (bf) * SHM_K + kws + 32 * 256) = st_k1; } while (0)
#define VMW() asm volatile("s_waitcnt vmcnt(0)" ::: "memory")
#define RESC(a) do { if (__any((a) < 1.f)) { if (hi == 0) al_l[r32] = (a); asm volatile("s_waitcnt lgkmcnt(0)" ::: "memory");              \
                     _Pragma("unroll") for (int d_ = 0; d_ < 4; ++d_) _Pragma("unroll") for (int r = 0; r < 16; ++r) o[d_][r] *= al_l[crow(r, hi)]; } } while (0)
#define ACT(t) tile_act<MODE>(TIDX(t) * KVBLK, TIDX(t), L, sw0, sw1, sw2, sw3)
#define NEARB(t) tile_near<MODE>(TIDX(t) * KVBLK, L)
#define BB(t) (L.lut + 4u * (unsigned)(L.qpos - TIDX(t) * KVBLK - 4 * hi + LUT0 - 59))
#define MASKT(P0_, P1_, t, a_) tile_mask<MODE>(P0_, P1_, TIDX(t) * KVBLK, TIDX(t), L, hi, a_, sw0, sw1, sw2, sw3)
    f32x16 pA0, pA1, pB0, pB1; float alA = 1.f, alB = 1.f; bf16x8 pa0, pa1, pa2, pa3;
    SLOAD(0); VMW(); SWRITE(0); SBAR();
    if (NT > 1) SLOAD(1);
    __syncthreads();
    { const bool a0_ = ACT(0); SBAR(); qkt<0, DQK>(pA0, pA1, K_lds, koff, r32, hi, qr, a0_, NEARB(0), BB(0)); MASKT(pA0, pA1, 0, a0_); partialSM(pA0, pA1, m_reg, alA); }
    if (NT > 1) { VMW(); SWRITE(1); }
    __syncthreads();
#define HALF_STEP(PX0, PX1, alX, PY0, PY1, alY, t, KB, VB, SB) do {                                                      \
        const bool ax_ = ACT(t), ay_ = ACT((t) - 1);                                                                      \
        SBAR(); qkt<KB, DQK>(PX0, PX1, K_lds, koff, r32, hi, qr, ax_, NEARB(t), BB(t));                                   \
        finishSM(PY0, PY1, alY, l_reg, pa0, pa1, pa2, pa3); SBAR();                                                       \
        if ((t) + 1 < NT) { SLOAD((t) + 1); SBAR(); }                                                                     \
        pv_tile<VB>(o, vb0, pa0, pa1, pa2, pa3, ay_); MASKT(PX0, PX1, (t), ax_); partialSM(PX0, PX1, m_reg, alX);         \
        __syncthreads();                                                                                                  \
        if ((t) + 1 < NT) { VMW(); SWRITE(SB); }                                                                          \
        RESC(alX); __syncthreads(); } while (0)
    for (int t = 1; t + 1 < NT; t += 2) {
        HALF_STEP(pB0, pB1, alB, pA0, pA1, alA, t, 1, 0, 0);
        HALF_STEP(pA0, pA1, alA, pB0, pB1, alB, t + 1, 0, 1, 1);
    }
    const bool even = (NT & 1) == 0;
    const bool aL_ = ACT(NT - 1), aP_ = even ? ACT(NT - 2) : aL_;
    if (even) { SBAR(); qkt<1, DQK>(pB0, pB1, K_lds, koff, r32, hi, qr, aL_, NEARB(NT - 1), BB(NT - 1)); SBAR(); }
    finishSM(pA0, pA1, alA, l_reg, pa0, pa1, pa2, pa3); SBAR();
    pv_tile<0>(o, vb0, pa0, pa1, pa2, pa3, aP_);
    if (even) { MASKT(pB0, pB1, NT - 1, aL_); partialSM(pB0, pB1, m_reg, alB); __syncthreads(); RESC(alB);
        finishSM(pB0, pB1, alB, l_reg, pa0, pa1, pa2, pa3); SBAR(); pv_tile<1>(o, vb0, pa0, pa1, pa2, pa3, aL_); }
    __syncthreads();
#undef HALF_STEP
#undef TIDX
#undef SLOAD
#undef SWRITE
#undef VMW
#undef RESC
#undef ACT
#undef NEARB
#undef BB
#undef MASKT
}
#ifdef TPROBE_SEC
#define TP_ON (MODE == TPROBE_MODE && blockIdx.x == 0 && wid == TPROBE_WAVE)
#define TP_T(k) do { if (TP_ON) tp_[(k)] = __builtin_readcyclecounter(); } while (0)
#define TP_PIN(x) asm volatile("" :: "v"(x))
#define TP_ACC() do { if (TP_ON) { const unsigned long long sec_ = tp_[TPROBE_SEC + 1] - tp_[TPROBE_SEC]; tp_sec_ += sec_; tp_tot_ += tp_[5] - tp_[0]; } } while (0)
#define TP_ACC_Y() do { if (TP_ON) { const unsigned long long sec_ = (TPROBE_SEC == 0) ? tp_[1] - tp_[0] : (TPROBE_SEC == 1) ? tp_[7] - tp_[6] : (TPROBE_SEC == 2) ? tp_[6] - tp_[1] : (TPROBE_SEC == 3) ? tp_[4] - tp_[3] : tp_[5] - tp_[7]; tp_sec_ += sec_; tp_tot_ += tp_[5] - tp_[3]; } } while (0)
#else
#define TP_T(k) do {} while (0)
#define TP_PIN(x) do {} while (0)
#define TP_ACC() do {} while (0)
#define TP_ACC_Y() do {} while (0)
#endif
template <int MODE, int DQK, bool NEGM = false>
__device__ __forceinline__ void attn_tiles(lchar* lds, const bf16_t* __restrict__ Kg, const bf16_t* __restrict__ Vg, int ld, int j_lo, int NT, const ALAS int* list,
                                           const bf16x8* qr, int koff, const Lane L, unsigned sw0, unsigned sw1, unsigned sw2, unsigned sw3, f32x16* o, float& m_reg, float& l_reg) {
    int tid = threadIdx.x; asm volatile("" : "+v"(tid));
    const int wid = __builtin_amdgcn_readfirstlane(tid >> 6), lane = tid & 63, r32 = lane & 31, hi = lane >> 5;
    lchar* V_lds = lds + L_V; lchar* K_lds = lds + L_K;
    ALAS float* al_l = (ALAS float*)(lds + L_WS) + wid * 64 + 32;
    m_reg = -1e30f; l_reg = 0.f; o[0] = f32x16{}; o[1] = f32x16{}; o[2] = f32x16{}; o[3] = f32x16{};
    const int sr = tid >> 4, sc = (tid & 15) * 8, vst0 = v_st(sr, sc), vst1 = v_st(32 + sr, sc), kws = KSWZ(sr, sc * 2);
    const unsigned vb0 = lds_addr(V_lds) + (unsigned)v_rd_base(lane);
    bf16x8 st_v0, st_v1, st_k0, st_k1;
#define TIDX(t) ((MODE == M_SLC) ? __builtin_amdgcn_readfirstlane(list[(t)]) : (j_lo + (t)))
#define SLOAD(t) do { const size_t k0_ = (size_t)TIDX(t) * KVBLK; st_v0 = *(const bf16x8*)(Vg + (k0_ + sr) * ld + sc); st_v1 = *(const bf16x8*)(Vg + (k0_ + 32 + sr) * ld + sc); \
                      st_k0 = *(const bf16x8*)(Kg + (k0_ + sr) * ld + sc); st_k1 = *(const bf16x8*)(Kg + (k0_ + 32 + sr) * ld + sc); } while (0)
#define SWRITE(ko, vo) do { *(ALAS bf16x8*)(V_lds + (vo) + vst0) = st_v0; *(ALAS bf16x8*)(V_lds + (vo) + vst1) = st_v1; \
                            *(ALAS bf16x8*)(K_lds + (ko) + kws) = st_k0; *(ALAS bf16x8*)(K_lds + (ko) + kws + 32 * 256) = st_k1; } while (0)
#define VMW() asm volatile("s_waitcnt vmcnt(0)" ::: "memory")
#define RESC(a) do { if (__any((a) < 1.f)) { if (hi == 0) al_l[r32] = (a); asm volatile("s_waitcnt lgkmcnt(0)" ::: "memory");              \
                     _Pragma("unroll") for (int d_ = 0; d_ < 4; ++d_) _Pragma("unroll") for (int r = 0; r < 16; ++r) o[d_][r] *= al_l[crow(r, hi)]; } } while (0)
#define ACT(t) tile_act<MODE>(TIDX(t) * KVBLK, TIDX(t), L, sw0, sw1, sw2, sw3)
#define NEARB(t) tile_near<MODE>(TIDX(t) * KVBLK, L)
#define BB(t) (L.lut + 4u * (unsigned)(L.qpos - TIDX(t) * KVBLK - 4 * hi + LUT0 - 59))
#define MASKT(P0_, P1_, t, a_) tile_mask<MODE>(P0_, P1_, TIDX(t) * KVBLK, TIDX(t), L, hi, a_, sw0, sw1, sw2, sw3)
    f32x16 p0, p1; float al = 1.f; bf16x8 pa0, pa1, pa2, pa3;
    pa0 = pa1 = pa2 = pa3 = bf16x8{};
    f32x16 negm = f32x16{}; bool started = false; if (NEGM) { m_reg = 0.f; asm volatile("" : "+v"(negm)); }
#ifdef TPROBE_SEC
    unsigned long long tp_[8] = {0, 0, 0, 0, 0, 0, 0, 0}, tp_sec_ = 0, tp_tot_ = 0;
#endif
    SLOAD(0); VMW(); SWRITE(0, 0); SBAR();
    if (NT > 1) SLOAD(1);
    __syncthreads();
    int kbo = 0, vbo = 0, vbp = 0;
#define STAGE_NEXT(t) do { if ((t) + 1 < NT) { const int vbn_ = (vbo == (NVB - 1) * SHM_V) ? 0 : vbo + SHM_V; VMW(); SWRITE(kbo ^ SHM_K, vbn_); SBAR(); if ((t) + 2 < NT) { SLOAD((t) + 2); SBAR(); } } } while (0)
#define SOFTMAX(t, a_) do { MASKT(p0, p1, (t), a_); if constexpr (NEGM) { partialSM_rel(p0, p1, m_reg, al, started, negm); RESC(al); finishSM_pk(p0, p1, al, l_reg, pa0, pa1, pa2, pa3); } \
        else { partialSM(p0, p1, m_reg, al); RESC(al); finishSM(p0, p1, al, l_reg, pa0, pa1, pa2, pa3); } SBAR(); } while (0)
#define QKT(t, a_) do { if constexpr (NEGM) qkt_neg<DQK>(p0, p1, K_lds + kbo, koff, r32, hi, qr, a_, NEARB(t), BB(t), negm); else qkt_rt<DQK>(p0, p1, K_lds + kbo, koff, r32, hi, qr, a_, NEARB(t), BB(t)); } while (0)
#define ADVANCE() do { vbp = vbo; vbo = (vbo == 2 * SHM_V) ? 0 : vbo + SHM_V; kbo ^= SHM_K; } while (0)
    if (wid < 4) {
        for (int t = 0; t < NT; ++t) {
            const bool a_ = ACT(t);
            TP_T(0);
            SBAR(); QKT(t, a_);
            TP_PIN(p0); TP_T(1);
            SOFTMAX(t, a_);
            TP_T(2);
            STAGE_NEXT(t);
            TP_T(3);
            pv_rt(o, vb0 + (unsigned)vbo, pa0, pa1, pa2, pa3, a_);
            TP_PIN(o[3]); TP_T(4);
            __syncthreads();
            TP_T(5); TP_ACC();
            ADVANCE();
        }
        __syncthreads();
    } else {
        bool ap_ = false;
        for (int t = 0; t < NT; ++t) {
            TP_T(3);
            SBAR(); pv_rt(o, vb0 + (unsigned)vbp, pa0, pa1, pa2, pa3, ap_);
            TP_PIN(o[3]); TP_T(4);
            const bool a_ = ACT(t);
            TP_T(0);
            SBAR(); QKT(t, a_);
            TP_PIN(p0); TP_T(1);
            STAGE_NEXT(t);
            TP_T(6);
            SOFTMAX(t, a_);
            TP_T(7);
            ap_ = a_;
            __syncthreads();
            TP_T(5); TP_ACC_Y();
            ADVANCE();
        }
        SBAR(); pv_rt(o, vb0 + (unsigned)vbp, pa0, pa1, pa2, pa3, ap_);
        __syncthreads();
    }
#ifdef TPROBE_SEC
    if (TP_ON && lane == 0) { atomicAdd(L.tpw, tp_sec_); atomicAdd(L.tpw + 1, tp_tot_); }
#endif
#undef STAGE_NEXT
#undef SOFTMAX
#undef QKT
#undef ADVANCE
#undef TIDX
#undef SLOAD
#undef SWRITE
#undef VMW
#undef RESC
#undef ACT
#undef NEARB
#undef BB
#undef MASKT
}
typedef short v4i16_t __attribute__((ext_vector_type(4)));
__device__ __forceinline__ s16x4 vtr(unsigned a) { return __builtin_bit_cast(s16x4, __builtin_amdgcn_ds_read_tr16_b64_v4i16((ALAS v4i16_t*)(uintptr_t)a)); }
template <int GS, bool ASM = false>
__device__ __forceinline__ void k_first(bf16x8* kg, const lchar* Kb, int koff, int r32, int hi) {
    const lchar* rowp = Kb + r32 * 256; const int e = (hi * 16 + koff) ^ ((r32 & 15) << 4);
#pragma unroll
    for (int j = 0; j < GS; ++j) { const lchar* a = rowp + (e ^ (j * 32));
        if constexpr (ASM) { const unsigned aa_ = lds_addr(a);
            asm volatile("ds_read_b128 %0, %1" : "=v"(kg[2 * j]) : "v"(aa_) : "memory"); asm volatile("ds_read_b128 %0, %1 offset:8192" : "=v"(kg[2 * j + 1]) : "v"(aa_) : "memory"); }
        else { kg[2 * j] = *reinterpret_cast<const ALAS bf16x8*>(a); kg[2 * j + 1] = *reinterpret_cast<const ALAS bf16x8*>(a + 32 * 256); } }
}
template <int DQK, bool FIXM = false, int GS = 2, bool PRE = false, bool VPRE = false, bool KDB = false>
__device__ __forceinline__ void qkt_dma(f32x16& p0, f32x16& p1, const lchar* Kb, int koff, int r32, int hi, const bf16x8* qr, bool act, bool nearb, unsigned bb, const f32x16& negm = f32x16{}, const bf16x8* kpre = nullptr,
                                        s16x4* vpre = nullptr, unsigned vbaddr = 0u) {
    if (!act) { const float NEG = -__builtin_inff();
        if constexpr (PRE && KDB) { asm volatile("s_waitcnt lgkmcnt(0)" ::: "memory"); SBAR(); }
#pragma unroll
        for (int r = 0; r < 16; ++r) { p0[r] = NEG; p1[r] = NEG; } return; }
    const lchar* rowp = Kb + r32 * 256; const int e = (hi * 16 + koff) ^ ((r32 & 15) << 4);
    constexpr int NG = DQK / (16 * GS);
    bf16x8 kg[KDB ? 2 : 1][2 * GS];
#define KLD(g_, sl_) do { _Pragma("unroll") for (int j = 0; j < GS; ++j) { const int d0 = GS * (g_) + j; const lchar* a = rowp + (e ^ (d0 * 32));   \
            if constexpr (KDB) { const unsigned aa_ = lds_addr(a);                                                                                     \
                asm volatile("ds_read_b128 %0, %1" : "=v"(kg[sl_][2 * j]) : "v"(aa_) : "memory"); asm volatile("ds_read_b128 %0, %1 offset:8192" : "=v"(kg[sl_][2 * j + 1]) : "v"(aa_) : "memory"); }   \
            else { kg[sl_][2 * j] = *reinterpret_cast<const ALAS bf16x8*>(a); kg[sl_][2 * j + 1] = *reinterpret_cast<const ALAS bf16x8*>(a + 32 * 256); } } } while (0)
    if constexpr (PRE) {
#pragma unroll
        for (int j = 0; j < 2 * GS; ++j) kg[0][j] = kpre[j];
    } else KLD(0, 0);
#pragma unroll
    for (int g = 0; g < NG; ++g) {
        constexpr int dummy_ = 0; (void)dummy_;
        const int sl = KDB ? (g & 1) : 0;
        if (KDB) { if (g + 1 < NG) KLD(g + 1, (g + 1) & 1); }
        else if (g > 0) KLD(g, 0);
        if (VPRE && g == NG - 1) {
#pragma unroll
            for (int d_ = 0; d_ < 4; ++d_) { vpre[2 * d_] = vtr(vbaddr + v_rd_off(d_, 0, 0)); vpre[2 * d_ + 1] = vtr(vbaddr + v_rd_off(d_, 0, 1)); }
        }
        if constexpr (KDB) { static_assert(!VPRE, "counted waits assume only K reads in flight"); if (g + 1 < NG) asm volatile("s_waitcnt lgkmcnt(%0)" :: "n"(2 * GS) : "memory"); else asm volatile("s_waitcnt lgkmcnt(0)" ::: "memory"); }
        SBAR();
#pragma unroll
        for (int j = 0; j < GS; ++j) {
            if (g == 0 && j == 0) {
                if constexpr (FIXM) { p0 = __builtin_amdgcn_mfma_f32_32x32x16_bf16(kg[0][0], qr[0], negm, 0, 0, 0); p1 = __builtin_amdgcn_mfma_f32_32x32x16_bf16(kg[0][1], qr[0], negm, 0, 0, 0); }
                else { p0 = __builtin_amdgcn_mfma_f32_32x32x16_bf16(kg[0][0], qr[0], f32x16{}, 0, 0, 0); p1 = __builtin_amdgcn_mfma_f32_32x32x16_bf16(kg[0][1], qr[0], f32x16{}, 0, 0, 0); }
            } else { p0 = __builtin_amdgcn_mfma_f32_32x32x16_bf16(kg[sl][2 * j], qr[GS * g + j], p0, 0, 0, 0); p1 = __builtin_amdgcn_mfma_f32_32x32x16_bf16(kg[sl][2 * j + 1], qr[GS * g + j], p1, 0, 0, 0); }
        }
        SBAR();
    }
#undef KLD
    if (nearb) {
#pragma unroll
        for (int r = 0; r < 16; ++r) { const int c = (r & 3) + 8 * (r >> 2); p0[r] += *(const ALAS float*)(uintptr_t)(bb + 4u * (unsigned)(59 - c)); }
#pragma unroll
        for (int r = 0; r < 16; ++r) { const int c = (r & 3) + 8 * (r >> 2); p1[r] += *(const ALAS float*)(uintptr_t)(bb + 4u * (unsigned)(27 - c)); }
    }
}
template <int NF> __device__ __forceinline__ float qrow_norm2(const bf16x8* qr) {
    float n2 = 0.f;
#pragma unroll
    for (int d0 = 0; d0 < NF; ++d0)
#pragma unroll
        for (int j = 0; j < 8; ++j) { const float a = __uint_as_float(((unsigned)(unsigned short)qr[d0][j]) << 16); n2 += a * a; }
    auto rr = __builtin_amdgcn_permlane32_swap(__float_as_uint(n2), __float_as_uint(n2), false, false);
    return __uint_as_float(rr[0]) + __uint_as_float(rr[1]);
}
__device__ __forceinline__ void decideSM(const f32x16& p0, const f32x16& p1, float& m_reg, float& alpha) {
    float pmax = fmaxf(p0[0], p1[0]);
#pragma unroll
    for (int r = 1; r < 16; ++r) pmax = fmaxf(pmax, fmaxf(p0[r], p1[r]));
    { auto rr = __builtin_amdgcn_permlane32_swap(__float_as_uint(pmax), __float_as_uint(pmax), false, false);
      pmax = fmaxf(__uint_as_float(rr[0]), __uint_as_float(rr[1])); }
    if (__builtin_expect(__all(pmax - m_reg <= THR), 1)) { alpha = 1.f; }
    else { const float mn = fmaxf(m_reg, pmax); alpha = __builtin_amdgcn_exp2f(m_reg - mn); m_reg = mn; }
}
template <bool SUBM>
__device__ __forceinline__ void sm_pv(f32x16* o, unsigned vb, const f32x16& p0, const f32x16& p1, float msub, float& lpart, bool act) {
    if (!act) return;
    float ps = 0.f;
#define KS_STEP(P, B_, ks) do {                                                                                              \
        const s16x4 l0 = vtr(vb + v_rd_off(0, ks, 0)), h0 = vtr(vb + v_rd_off(0, ks, 1)), l1 = vtr(vb + v_rd_off(1, ks, 0)), h1 = vtr(vb + v_rd_off(1, ks, 1));   \
        const s16x4 l2 = vtr(vb + v_rd_off(2, ks, 0)), h2 = vtr(vb + v_rd_off(2, ks, 1)), l3 = vtr(vb + v_rd_off(3, ks, 0)), h3 = vtr(vb + v_rd_off(3, ks, 1));   \
        float e_[8];                                                                                                         \
        _Pragma("unroll") for (int j = 0; j < 8; ++j) { e_[j] = __builtin_amdgcn_exp2f(SUBM ? P[B_ + j] - msub : P[B_ + j]); ps += e_[j]; }                     \
        const u32x4 w_ = {cvtpk(e_[0], e_[1]), cvtpk(e_[2], e_[3]), cvtpk(e_[4], e_[5]), cvtpk(e_[6], e_[7])}; const bf16x8 pa_ = __builtin_bit_cast(bf16x8, w_);   \
        SBAR();                                                                                                              \
        o[0] = __builtin_amdgcn_mfma_f32_32x32x16_bf16(pa_, (bf16x8){l0[0], l0[1], l0[2], l0[3], h0[0], h0[1], h0[2], h0[3]}, o[0], 0, 0, 0);                     \
        o[1] = __builtin_amdgcn_mfma_f32_32x32x16_bf16(pa_, (bf16x8){l1[0], l1[1], l1[2], l1[3], h1[0], h1[1], h1[2], h1[3]}, o[1], 0, 0, 0);                     \
        o[2] = __builtin_amdgcn_mfma_f32_32x32x16_bf16(pa_, (bf16x8){l2[0], l2[1], l2[2], l2[3], h2[0], h2[1], h2[2], h2[3]}, o[2], 0, 0, 0);                     \
        o[3] = __builtin_amdgcn_mfma_f32_32x32x16_bf16(pa_, (bf16x8){l3[0], l3[1], l3[2], l3[3], h3[0], h3[1], h3[2], h3[3]}, o[3], 0, 0, 0);                     \
        SBAR(); } while (0)
    KS_STEP(p0, 0, 0); KS_STEP(p0, 8, 1); KS_STEP(p1, 0, 2); KS_STEP(p1, 8, 3);
#undef KS_STEP
    lpart += ps;
}
template <int DQK>
__device__ __forceinline__ void step_pipe(f32x16* o, const lchar* Kb, int koff, int r32, int hi, const bf16x8* qr, unsigned vb, bool nearb, unsigned bb, const f32x16& negm, float& lpart) {
    constexpr int NK = DQK / 16, EPG = 16 / NK;
    const lchar* rowp = Kb + r32 * 256; const int e = (hi * 16 + koff) ^ ((r32 & 15) << 4);
    f32x16 p0, p1;
    bf16x8 k0[NK], k1[NK];
#pragma unroll
    for (int d0 = 0; d0 < NK; ++d0) k0[d0] = *reinterpret_cast<const ALAS bf16x8*>(rowp + (e ^ (d0 * 32)));
#pragma unroll
    for (int d0 = 0; d0 < NK; ++d0) k1[d0] = *reinterpret_cast<const ALAS bf16x8*>(rowp + (e ^ (d0 * 32)) + 32 * 256);
    s16x4 va[8], vb_[8];
#define VRD(dst, ks) do { _Pragma("unroll") for (int d_ = 0; d_ < 4; ++d_) { dst[2 * d_] = vtr(vb + v_rd_off(d_, ks, 0)); dst[2 * d_ + 1] = vtr(vb + v_rd_off(d_, ks, 1)); } } while (0)
#define VFR(src, d_) ((bf16x8){src[2 * (d_)][0], src[2 * (d_)][1], src[2 * (d_)][2], src[2 * (d_)][3], src[2 * (d_) + 1][0], src[2 * (d_) + 1][1], src[2 * (d_) + 1][2], src[2 * (d_) + 1][3]})
    VRD(va, 0);
    if (nearb) {
#pragma unroll
        for (int r = 0; r < 16; ++r) { const int c = (r & 3) + 8 * (r >> 2);
            p0[r] = *(const ALAS float*)(uintptr_t)(bb + 4u * (unsigned)(59 - c)) + negm[r]; p1[r] = *(const ALAS float*)(uintptr_t)(bb + 4u * (unsigned)(27 - c)) + negm[r]; }
    } else { p0 = negm; p1 = negm; }
    SBAR();
#pragma unroll
    for (int d0 = 0; d0 < NK; ++d0) p0 = __builtin_amdgcn_mfma_f32_32x32x16_bf16(k0[d0], qr[d0], p0, 0, 0, 0);
    SBAR();
    float ps = 0.f;
#pragma unroll
    for (int d0 = 0; d0 < NK; ++d0) {
        p1 = __builtin_amdgcn_mfma_f32_32x32x16_bf16(k1[d0], qr[d0], p1, 0, 0, 0);
        SBAR();
#pragma unroll
        for (int j = 0; j < EPG; ++j) { p0[EPG * d0 + j] = __builtin_amdgcn_exp2f(p0[EPG * d0 + j]); ps += p0[EPG * d0 + j]; }
        SBAR();
    }
#define PK8(P, B_) __builtin_bit_cast(bf16x8, (u32x4){cvtpk(P[B_], P[B_ + 1]), cvtpk(P[B_ + 2], P[B_ + 3]), cvtpk(P[B_ + 4], P[B_ + 5]), cvtpk(P[B_ + 6], P[B_ + 7])})
    const bf16x8 pa0 = PK8(p0, 0), pa1 = PK8(p0, 8);
    VRD(vb_, 1);
    SBAR();
#pragma unroll
    for (int d_ = 0; d_ < 4; ++d_) {
        o[d_] = __builtin_amdgcn_mfma_f32_32x32x16_bf16(pa0, VFR(va, d_), o[d_], 0, 0, 0);
        SBAR();
        p1[2 * d_] = __builtin_amdgcn_exp2f(p1[2 * d_]); p1[2 * d_ + 1] = __builtin_amdgcn_exp2f(p1[2 * d_ + 1]); ps += p1[2 * d_]; ps += p1[2 * d_ + 1];
        SBAR();
    }
    const bf16x8 pa2 = PK8(p1, 0);
    VRD(va, 2);
    SBAR();
#pragma unroll
    for (int d_ = 0; d_ < 4; ++d_) {
        o[d_] = __builtin_amdgcn_mfma_f32_32x32x16_bf16(pa1, VFR(vb_, d_), o[d_], 0, 0, 0);
        SBAR();
        p1[8 + 2 * d_] = __builtin_amdgcn_exp2f(p1[8 + 2 * d_]); p1[9 + 2 * d_] = __builtin_amdgcn_exp2f(p1[9 + 2 * d_]); ps += p1[8 + 2 * d_]; ps += p1[9 + 2 * d_];
        SBAR();
    }
    const bf16x8 pa3 = PK8(p1, 8);
    VRD(vb_, 3);
    SBAR();
#pragma unroll
    for (int d_ = 0; d_ < 4; ++d_) o[d_] = __builtin_amdgcn_mfma_f32_32x32x16_bf16(pa2, VFR(va, d_), o[d_], 0, 0, 0);
    SBAR();
#pragma unroll
    for (int d_ = 0; d_ < 4; ++d_) o[d_] = __builtin_amdgcn_mfma_f32_32x32x16_bf16(pa3, VFR(vb_, d_), o[d_], 0, 0, 0);
    SBAR();
    lpart += ps;
#undef VRD
#undef VFR
#undef PK8
}
struct NoHook { __device__ __forceinline__ void operator()(int) const {} };
struct DmaHook {
    const bf16_t* Kg; const bf16_t* Vg; size_t k0; int ko0, ko1, vo0, vo1; lchar* kl; lchar* vl; bool on;
    __device__ __forceinline__ void operator()(int pi) const {
        if (!on) return;
        int o_ = (pi == 0) ? ko0 : (pi == 1) ? ko1 : (pi == 2) ? vo0 : vo1; asm volatile("" : "+v"(o_));
        const bf16_t* src_ = ((pi < 2) ? Kg : Vg) + k0 + o_;
        lchar* dst_ = ((pi < 2) ? kl : vl) + (pi & 1) * 1024;
        __builtin_amdgcn_global_load_lds((const unsigned*)src_, (ALAS unsigned*)dst_, 16, 0, 0);
    }
};
template <bool SUBM, bool VPRE = false, typename HOOK = NoHook, int DSP = 0>
__device__ __forceinline__ void sm_pv2(f32x16* o, unsigned vb, const f32x16& p0, const f32x16& p1, float msub, float& lpart, bool act, const s16x4* vpre = nullptr, const HOOK hook = HOOK{},
                                       bool d_on = false, const bf16_t* d_k = nullptr, const bf16_t* d_v = nullptr, int d_ko0 = 0, int d_ko1 = 0, int d_vo0 = 0, int d_vo1 = 0, lchar* d_kl = nullptr, lchar* d_vl = nullptr) {
#define DSPP(pi) do { if constexpr (DSP != 0) { if (d_on) { if ((pi) == 0) __builtin_amdgcn_global_load_lds((const unsigned*)(d_k + d_ko0), (ALAS unsigned*)(d_kl), 16, 0, 0); \
        else if ((pi) == 1) __builtin_amdgcn_global_load_lds((const unsigned*)(d_k + d_ko1), (ALAS unsigned*)(d_kl + 1024), 16, 0, 0); \
        else if ((pi) == 2) __builtin_amdgcn_global_load_lds((const unsigned*)(d_v + d_vo0), (ALAS unsigned*)(d_vl), 16, 0, 0); \
        else __builtin_amdgcn_global_load_lds((const unsigned*)(d_v + d_vo1), (ALAS unsigned*)(d_vl + 1024), 16, 0, 0); } } } while (0)
    if (!act) { hook(0); hook(1); hook(2); hook(3); DSPP(0); DSPP(1); DSPP(2); DSPP(3); return; }
#define DSPH(h) do { if constexpr (DSP == 1) DSPP(h); else if constexpr (DSP == 2) { if ((h) < 2) { DSPP(2 * (h)); DSPP(2 * (h) + 1); } } } while (0)
    float ps = 0.f;
    s16x4 va[8], vc[8];
#define VRD(dst, ks) do { _Pragma("unroll") for (int d_ = 0; d_ < 4; ++d_) { dst[2 * d_] = vtr(vb + v_rd_off(d_, ks, 0)); dst[2 * d_ + 1] = vtr(vb + v_rd_off(d_, ks, 1)); } } while (0)
#define VFR(src, d_) ((bf16x8){src[2 * (d_)][0], src[2 * (d_)][1], src[2 * (d_)][2], src[2 * (d_)][3], src[2 * (d_) + 1][0], src[2 * (d_) + 1][1], src[2 * (d_) + 1][2], src[2 * (d_) + 1][3]})
#define EX(P, i) __builtin_amdgcn_exp2f(SUBM ? P[i] - msub : P[i])
    if constexpr (VPRE) {
#pragma unroll
        for (int j = 0; j < 8; ++j) va[j] = vpre[j];
    } else VRD(va, 0);
    float e_[8]; u32x4 w_;
#pragma unroll
    for (int j = 0; j < 8; ++j) { e_[j] = EX(p0, j); ps += e_[j]; }
    w_ = (u32x4){cvtpk(e_[0], e_[1]), cvtpk(e_[2], e_[3]), cvtpk(e_[4], e_[5]), cvtpk(e_[6], e_[7])};
    bf16x8 pa_ = __builtin_bit_cast(bf16x8, w_);
    SBAR();
#define KS_PIPE(VCUR, VNXT, ksn, PN, BN) do {                                                                                  \
        VRD(VNXT, ksn);                                                                                                        \
        SBAR();                                                                                                                \
        o[0] = __builtin_amdgcn_mfma_f32_32x32x16_bf16(pa_, VFR(VCUR, 0), o[0], 0, 0, 0); SBAR();                               \
        e_[0] = EX(PN, BN + 0); e_[1] = EX(PN, BN + 1); ps += e_[0]; ps += e_[1]; SBAR();                                       \
        o[1] = __builtin_amdgcn_mfma_f32_32x32x16_bf16(pa_, VFR(VCUR, 1), o[1], 0, 0, 0); SBAR();                               \
        e_[2] = EX(PN, BN + 2); e_[3] = EX(PN, BN + 3); ps += e_[2]; ps += e_[3]; SBAR();                                       \
        o[2] = __builtin_amdgcn_mfma_f32_32x32x16_bf16(pa_, VFR(VCUR, 2), o[2], 0, 0, 0); SBAR();                               \
        e_[4] = EX(PN, BN + 4); e_[5] = EX(PN, BN + 5); ps += e_[4]; ps += e_[5]; w_[0] = cvtpk(e_[0], e_[1]); w_[1] = cvtpk(e_[2], e_[3]); SBAR();   \
        o[3] = __builtin_amdgcn_mfma_f32_32x32x16_bf16(pa_, VFR(VCUR, 3), o[3], 0, 0, 0); SBAR();                               \
        e_[6] = EX(PN, BN + 6); e_[7] = EX(PN, BN + 7); ps += e_[6]; ps += e_[7]; w_[2] = cvtpk(e_[4], e_[5]); w_[3] = cvtpk(e_[6], e_[7]);           \
        pa_ = __builtin_bit_cast(bf16x8, w_); SBAR(); } while (0)
    hook(0); DSPH(0); SBAR();
    KS_PIPE(va, vc, 1, p0, 8);
    hook(1); DSPH(1); SBAR();
    KS_PIPE(vc, va, 2, p1, 0);
    hook(2); DSPH(2); SBAR();
    KS_PIPE(va, vc, 3, p1, 8);
    hook(3); DSPH(3); SBAR();
#pragma unroll
    for (int d_ = 0; d_ < 4; ++d_) o[d_] = __builtin_amdgcn_mfma_f32_32x32x16_bf16(pa_, VFR(vc, d_), o[d_], 0, 0, 0);
    SBAR();
    lpart += ps;
#undef KS_PIPE
#undef EX
#undef VRD
#undef VFR
#undef DSPP
#undef DSPH
}
__device__ __forceinline__ void head_dma(lchar* lds, const bf16_t* __restrict__ Kg, const bf16_t* __restrict__ Vg, int ld, int j_lo, int NT) {
    int tid = threadIdx.x; asm volatile("" : "+v"(tid));
    const int wid = __builtin_amdgcn_readfirstlane(tid >> 6), lane = tid & 63;
    lchar* V_lds = lds + L_V; lchar* K_lds = lds + L_K; const int dpiece = wid * 2048;
#pragma unroll
    for (int t = 0; t < 2; ++t) {
        if (t < NT) { const size_t k0_ = (size_t)(j_lo + t) * KVBLK * (size_t)ld;
#pragma unroll
            for (int i = 0; i < 2; ++i) {
                const int row = (wid * 2 + i) * 4 + (lane >> 4), chunk = (lane & 15) ^ (row & 15);
                const int B_ = (wid * 2 + i) * 1024 + lane * 16, sub = B_ >> 9, kk = (sub >> 2) * 8 + ((B_ & 511) >> 6), cc = (sub & 3) * 32 + (((B_ & 511) >> 1) & 31);
                __builtin_amdgcn_global_load_lds((const unsigned*)(Kg + k0_ + row * ld + chunk * 8), (ALAS unsigned*)(K_lds + t * SHM_K + dpiece + i * 1024), 16, 0, 0);
                __builtin_amdgcn_global_load_lds((const unsigned*)(Vg + k0_ + kk * ld + cc), (ALAS unsigned*)(V_lds + t * SHM_V + dpiece + i * 1024), 16, 0, 0); } }
    }
}
template <int MODE, int DQK, bool NEGM = false, int FIXM = 0, bool FUSE = false, bool PIPE = false, int KGS = 2, bool SMP2 = false, bool KPRE = false, bool VPRE = false, bool KDB = false, int PRIO = 0, int DMAPOS = 0, bool HEADPRE = false>
__device__ __forceinline__ void attn_tiles_dma(lchar* lds, const bf16_t* __restrict__ Kg, const bf16_t* __restrict__ Vg, int ld, int j_lo, int NT, const ALAS int* list,
                                           const bf16x8* qr, int koff, const Lane L, unsigned sw0, unsigned sw1, unsigned sw2, unsigned sw3, f32x16* o, float& m_reg, float& l_reg) {
    int tid = threadIdx.x; asm volatile("" : "+v"(tid));
    const int wid = __builtin_amdgcn_readfirstlane(tid >> 6), lane = tid & 63, r32 = lane & 31, hi = lane >> 5;
    lchar* V_lds = lds + L_V; lchar* K_lds = lds + L_K;
    ALAS float* al_l = (ALAS float*)(lds + L_WS) + wid * 64 + 32;
    if (FIXM == 0) m_reg = -1e30f;
    l_reg = 0.f; o[0] = f32x16{}; o[1] = f32x16{}; o[2] = f32x16{}; o[3] = f32x16{};
    const unsigned vb0 = lds_addr(V_lds) + (unsigned)v_rd_base(lane);
    int koffs[2], voffs[2];
#pragma unroll
    for (int i = 0; i < 2; ++i) {
        const int row = (wid * 2 + i) * 4 + (lane >> 4), chunk = (lane & 15) ^ (row & 15);
        koffs[i] = row * ld + chunk * 8;
        const int B_ = (wid * 2 + i) * 1024 + lane * 16, sub = B_ >> 9, kk = (sub >> 2) * 8 + ((B_ & 511) >> 6), cc = (sub & 3) * 32 + (((B_ & 511) >> 1) & 31);
        const int k = kk;
        voffs[i] = k * ld + cc;
    }
    const int dpiece = wid * 2048;
#define TIDX(t) ((MODE == M_SLC) ? __builtin_amdgcn_readfirstlane(list[(t)]) : (j_lo + (t)))
#define DMA(t, ko, vo) do { const size_t k0_ = (size_t)TIDX(t) * KVBLK * (size_t)ld; _Pragma("unroll") for (int i_ = 0; i_ < 2; ++i_) { \
        __builtin_amdgcn_global_load_lds((const unsigned*)(Kg + k0_ + koffs[i_]), (ALAS unsigned*)(K_lds + (ko) + dpiece + i_ * 1024), 16, 0, 0); \
        __builtin_amdgcn_global_load_lds((const unsigned*)(Vg + k0_ + voffs[i_]), (ALAS unsigned*)(V_lds + (vo) + dpiece + i_ * 1024), 16, 0, 0); } } while (0)
#define DMAP(k0_, ko, vo, pi) do { const int i__ = (pi) & 1; if ((pi) < 2) __builtin_amdgcn_global_load_lds((const unsigned*)(Kg + (k0_) + koffs[i__]), (ALAS unsigned*)(K_lds + (ko) + dpiece + i__ * 1024), 16, 0, 0); \
        else __builtin_amdgcn_global_load_lds((const unsigned*)(Vg + (k0_) + voffs[i__]), (ALAS unsigned*)(V_lds + (vo) + dpiece + i__ * 1024), 16, 0, 0); } while (0)
#define VMW() asm volatile("s_waitcnt vmcnt(0)" ::: "memory")
#define RESC(a) do { if (__any((a) < 1.f)) { if (hi == 0) al_l[r32] = (a); asm volatile("s_waitcnt lgkmcnt(0)" ::: "memory");              \
                     _Pragma("unroll") for (int d_ = 0; d_ < 4; ++d_) _Pragma("unroll") for (int r = 0; r < 16; ++r) o[d_][r] *= al_l[crow(r, hi)]; } } while (0)
#define SELW(t) ((MODE == M_SLC) ? *(const ALAS unsigned*)(uintptr_t)(sw0 + 4u * (unsigned)(TIDX(t) >> 5)) : 0u)
#define ACT(t) tile_act<MODE>(TIDX(t) * KVBLK, TIDX(t) & 31, L, SELW(t), SELW(t), SELW(t), SELW(t))
#define NEARB(t) tile_near<MODE>(TIDX(t) * KVBLK, L)
#define BB(t) (L.lut + 4u * (unsigned)(L.qpos - TIDX(t) * KVBLK - 4 * hi + LUT0 - 59))
#define MASKT(P0_, P1_, t, a_) tile_mask<MODE>(P0_, P1_, TIDX(t) * KVBLK, TIDX(t) & 31, L, hi, a_, SELW(t), SELW(t), SELW(t), SELW(t))
    f32x16 p0, p1; float al = 1.f; bf16x8 pa0, pa1, pa2, pa3;
    pa0 = pa1 = pa2 = pa3 = bf16x8{};
    f32x16 negm = f32x16{}; bool started = false; if (NEGM) { m_reg = 0.f; asm volatile("" : "+v"(negm)); }
    if (FIXM == 1) { const float nm_ = -m_reg; _Pragma("unroll") for (int r = 0; r < 16; ++r) negm[r] = nm_; asm volatile("" : "+v"(negm)); }
#ifdef TPROBE_SEC
    unsigned long long tp_[8] = {0, 0, 0, 0, 0, 0, 0, 0}, tp_sec_ = 0, tp_tot_ = 0;
#endif
    int kbo = 0, vbo = 0, vbp = 0;
#define STAGE_NEXT(t) do { if ((t) + 1 < NT) { const int vbn_ = (vbo == 2 * SHM_V) ? 0 : vbo + SHM_V; DMA((t) + 1, kbo ^ SHM_K, vbn_); } } while (0)
#define SOFTMAX(t, a_) do { MASKT(p0, p1, (t), a_); if constexpr (FIXM == 1) { _Pragma("unroll") for (int r = 0; r < 16; ++r) p0[r] = __builtin_amdgcn_exp2f(p0[r]); al = 1.f; finishSM_direct(p0, p1, al, l_reg, pa0, pa1, pa2, pa3); } \
        else if constexpr (FIXM == 2) { partialSM_fix(p0, p1, m_reg); al = 1.f; finishSM_direct(p0, p1, al, l_reg, pa0, pa1, pa2, pa3); } else if constexpr (NEGM) { partialSM_rel(p0, p1, m_reg, al, started, negm); RESC(al); finishSM_pk(p0, p1, al, l_reg, pa0, pa1, pa2, pa3); } \
        else { partialSM(p0, p1, m_reg, al); RESC(al); finishSM_direct(p0, p1, al, l_reg, pa0, pa1, pa2, pa3); } SBAR(); } while (0)
#define QKT(t, a_) do { static_assert(!NEGM, "the LDS-DMA engine has no relative-score form"); qkt_dma<DQK, FIXM == 1, KGS>(p0, p1, K_lds + kbo, koff, r32, hi, qr, a_, NEARB(t), BB(t), negm); } while (0)
#define ADVANCE() do { vbp = vbo; vbo = (vbo == 2 * SHM_V) ? 0 : vbo + SHM_V; kbo ^= SHM_K; } while (0)
    if constexpr (FUSE) {
        float lpart = 0.f;
        const int NS = (NT + 1) >> 1;
        if constexpr (!HEADPRE) { DMA(0, 0, 0); if (NT > 1) DMA(1, SHM_K, SHM_V); }
        VMW(); __syncthreads();
        int so = 0;
        for (int s_ = 0; s_ < NS; ++s_) {
            const int t0_ = 2 * s_;
            int tjA_, tjB_, tjC_, tjD_; unsigned swA_ = 0u, swB_ = 0u;
            if constexpr (MODE == M_SLC) {
                const int lA_ = list[t0_], lB_ = list[t0_ + 1 < NT ? t0_ + 1 : NT - 1], lC_ = list[t0_ + 2 < NT ? t0_ + 2 : NT - 1], lD_ = list[t0_ + 3 < NT ? t0_ + 3 : NT - 1];
                tjA_ = __builtin_amdgcn_readfirstlane(lA_); tjB_ = __builtin_amdgcn_readfirstlane(lB_); tjC_ = __builtin_amdgcn_readfirstlane(lC_); tjD_ = __builtin_amdgcn_readfirstlane(lD_);
                swA_ = *(const ALAS unsigned*)(uintptr_t)(sw0 + 4u * (unsigned)(tjA_ >> 5)); swB_ = *(const ALAS unsigned*)(uintptr_t)(sw0 + 4u * (unsigned)(tjB_ >> 5));
            } else { tjA_ = j_lo + t0_; tjB_ = tjA_ + 1; tjC_ = tjA_ + 2; tjD_ = tjA_ + 3; }
#undef TIDX
#define TIDX(t) (((t) == t0_) ? tjA_ : ((t) == t0_ + 1) ? tjB_ : ((t) == t0_ + 2) ? tjC_ : tjD_)
#undef SELW
#define SELW(t) (((t) == t0_) ? swA_ : swB_)
            bf16x8 kq[2 * KGS];
            TP_T(0);
            if constexpr (KPRE) { k_first<KGS, KDB>(kq, K_lds + so, koff, r32, hi); SBAR(); }
#define DMA_NEXT_A() do { if (s_ + 1 < NS) { const int sn_ = so ^ SLOT; DMA(t0_ + 2, sn_, sn_); } } while (0)
#define DMA_NEXT_B() do { if (t0_ + 3 < NT) { const int sn_ = so ^ SLOT; DMA(t0_ + 3, sn_ + SHM_K, sn_ + SHM_V); } } while (0)
            const bool nA_ = s_ + 1 < NS, nB_ = t0_ + 3 < NT; const int snx_ = so ^ SLOT;
            size_t kA_ = 0, kB_ = 0;
            if constexpr (DMAPOS == 3) { if (nA_) kA_ = (size_t)TIDX(t0_ + 2) * KVBLK * (size_t)ld; if (nB_) kB_ = (size_t)TIDX(t0_ + 3) * KVBLK * (size_t)ld; }
            if constexpr (DMAPOS == 0) { DMA_NEXT_A(); DMA_NEXT_B(); }
#pragma unroll
            for (int u_ = 0; u_ < 2; ++u_) {
                const int t = t0_ + u_;
                if (u_ == 1 && t >= NT) { if constexpr (KPRE && KDB) { asm volatile("s_waitcnt lgkmcnt(0)" ::: "memory"); SBAR(); } break; }
                kbo = so + u_ * SHM_K; vbo = so + u_ * SHM_V;
                if constexpr (PRIO != 0) { const bool hp_ = (PRIO == 1) ? (((wid >> 2) ^ u_) & 1) == 0 : (PRIO == 2) ? (((wid >> 2) ^ u_) & 1) != 0 : (wid >= 4); if (hp_) __builtin_amdgcn_s_setprio(1); else __builtin_amdgcn_s_setprio(0); }
                const bool a_ = ACT(t);
                s16x4 vq[8];
                SBAR(); qkt_dma<DQK, FIXM == 1, KGS, KPRE, VPRE, KDB>(p0, p1, K_lds + kbo, koff, r32, hi, qr, a_, NEARB(t), BB(t), negm, kq, vq, vb0 + (unsigned)vbo);
                MASKT(p0, p1, (t), a_);
                if constexpr (FIXM == 0) { decideSM(p0, p1, m_reg, al); RESC(al); lpart *= al; }
                SBAR();
                TP_PIN(p0); if (u_ == 0) TP_T(1); else TP_T(3);
                if constexpr (DMAPOS == 1) { if (u_ == 0) { DMA_NEXT_A(); DMA_NEXT_B(); } }
                if constexpr (DMAPOS == 2) { if (u_ == 0) DMA_NEXT_A(); else DMA_NEXT_B(); }
                if constexpr (KPRE) { if (u_ == 0) { k_first<KGS, KDB>(kq, K_lds + so + SHM_K, koff, r32, hi); SBAR(); } }
                if constexpr (SMP2 && DMAPOS == 5) {
                    const bool on_ = u_ == 0 ? nA_ : nB_; size_t k0_ = 0; if (on_) k0_ = (size_t)TIDX(t0_ + 2 + u_) * KVBLK * (size_t)ld;
                    if (u_ == 0) {
                    sm_pv2<FIXM != 1, VPRE, NoHook, 1>(o, vb0 + (unsigned)vbo, p0, p1, m_reg, lpart, a_, vq, NoHook{}, on_, Kg + k0_, Vg + k0_, koffs[0], koffs[1], voffs[0], voffs[1],
                                                          K_lds + snx_ + u_ * SHM_K + dpiece, V_lds + snx_ + u_ * SHM_V + dpiece);
                    } else {
                    sm_pv2<FIXM != 1, VPRE, NoHook, 2>(o, vb0 + (unsigned)vbo, p0, p1, m_reg, lpart, a_, vq, NoHook{}, on_, Kg + k0_, Vg + k0_, koffs[0], koffs[1], voffs[0], voffs[1],
                                                          K_lds + snx_ + u_ * SHM_K + dpiece, V_lds + snx_ + u_ * SHM_V + dpiece);
                    }
                } else
                if constexpr (SMP2 && DMAPOS == 3) {
                    const DmaHook hk_{Kg, Vg, u_ == 0 ? kA_ : kB_, koffs[0], koffs[1], voffs[0], voffs[1], K_lds + snx_ + u_ * SHM_K + dpiece, V_lds + snx_ + u_ * SHM_V + dpiece, u_ == 0 ? nA_ : nB_};
                    sm_pv2<FIXM != 1, VPRE, DmaHook>(o, vb0 + (unsigned)vbo, p0, p1, m_reg, lpart, a_, vq, hk_);
                } else
                if constexpr (SMP2) sm_pv2<FIXM != 1, VPRE>(o, vb0 + (unsigned)vbo, p0, p1, m_reg, lpart, a_, vq); else sm_pv<FIXM != 1>(o, vb0 + (unsigned)vbo, p0, p1, m_reg, lpart, a_);
                TP_PIN(o[3]); if (u_ == 0) TP_T(2); else TP_T(4);
            }
            VMW(); __syncthreads();
            TP_T(5); TP_ACC();
#undef DMA_NEXT_A
#undef DMA_NEXT_B
            so ^= SLOT;
        }
        if constexpr (PRIO != 0) __builtin_amdgcn_s_setprio(0);
        { auto rr = __builtin_amdgcn_permlane32_swap(__float_as_uint(lpart), __float_as_uint(lpart), false, false); l_reg = __uint_as_float(rr[0]) + __uint_as_float(rr[1]); }
#undef TIDX
#define TIDX(t) ((MODE == M_SLC) ? __builtin_amdgcn_readfirstlane(list[(t)]) : (j_lo + (t)))
#undef SELW
#define SELW(t) ((MODE == M_SLC) ? *(const ALAS unsigned*)(uintptr_t)(sw0 + 4u * (unsigned)(TIDX(t) >> 5)) : 0u)
    } else {
    DMA(0, 0, 0); VMW();
    __syncthreads();
    if (wid < 4) {
        for (int t = 0; t < NT; ++t) {
            const bool a_ = ACT(t);
            STAGE_NEXT(t);
            TP_T(0);
            SBAR(); QKT(t, a_);
            TP_PIN(p0); TP_T(1);
            SOFTMAX(t, a_);
            TP_T(2);
            TP_T(3);
            pv_rt(o, vb0 + (unsigned)vbo, pa0, pa1, pa2, pa3, a_);
            TP_PIN(o[3]); TP_T(4);
            VMW(); __syncthreads();
            TP_T(5); TP_ACC();
            ADVANCE();
        }
        __syncthreads();
    } else {
        bool ap_ = false;
        for (int t = 0; t < NT; ++t) {
            STAGE_NEXT(t);
            TP_T(3);
            SBAR(); pv_rt(o, vb0 + (unsigned)vbp, pa0, pa1, pa2, pa3, ap_);
            TP_PIN(o[3]); TP_T(4);
            const bool a_ = ACT(t);
            TP_T(0);
            SBAR(); QKT(t, a_);
            TP_PIN(p0); TP_T(1);
            TP_T(6);
            SOFTMAX(t, a_);
            TP_T(7);
            ap_ = a_;
            VMW(); __syncthreads();
            TP_T(5); TP_ACC_Y();
            ADVANCE();
        }
        SBAR(); pv_rt(o, vb0 + (unsigned)vbp, pa0, pa1, pa2, pa3, ap_);
        __syncthreads();
    }
    }
#ifdef TPROBE_SEC
    if (TP_ON && lane == 0) { atomicAdd(L.tpw, tp_sec_); atomicAdd(L.tpw + 1, tp_tot_); }
#endif
#undef STAGE_NEXT
#undef SOFTMAX
#undef QKT
#undef ADVANCE
#undef TIDX
#undef DMA
#undef DMAP
#undef VMW
#undef RESC
#undef ACT
#undef SELW
#undef NEARB
#undef BB
#undef MASKT
}
}
constexpr int NWAVES = 8;
#ifndef MK_N_LAUNCHES
#define MK_N_LAUNCHES 1
#endif
constexpr int N_LAUNCHES = MK_N_LAUNCHES;
constexpr int PER_PHASE = 10;
static_assert(N_LAUNCHES == 1 || N_LAUNCHES == PER_PHASE, "MK_N_LAUNCHES is 1 or 10");
constexpr int BATCH = 2, SEQ = 8192, TOK = BATCH * SEQ, DM = 2048, NPROJ = 5656, LDP = 5888, DFF = 5632, NUP = 2 * DFF, NIN = 23;
constexpr float EPS = 1e-6f, LOG2E = 1.4426950408889634f;
constexpr float C2D = 0.125f * LOG2E, C2N = 0.08838834764831845f * LOG2E;
constexpr int C_DQ = 0, C_DK = 1024, C_DV = 2048, C_NQ = 3072, C_KC = 4096, C_VC = 4352, C_KS = 4608, C_VS = 4864, C_KW = 5120, C_VW = 5376;
constexpr size_t MiB = 1u << 20, KiB = 1u << 10;
constexpr size_t WS_CTL = 0, CTL_ZERO_BYTES = 1 * MiB;
constexpr size_t WS_WDN = 1 * MiB;
constexpr size_t WS_CW1K = 23 * MiB, WS_CW1V = 25 * MiB;
constexpr size_t WS_CW2K = 27 * MiB, WS_CW2V = 27 * MiB + 64 * KiB;
constexpr size_t WS_MISC = 27 * MiB + 128 * KiB;
constexpr size_t WS_KCMP = 28 * MiB, WS_VCMP = 28 * MiB + 512 * KiB;
constexpr size_t WS_WIN = 29 * MiB;
constexpr size_t WS_WOUT = 52 * MiB;
constexpr size_t WS_WUP = 60 * MiB;
constexpr size_t WS_H = 104 * MiB;
constexpr size_t WS_Y2 = 29 * MiB;
constexpr size_t WS_Y = 418 * MiB;
constexpr size_t WS_PROJ = 168 * MiB;
constexpr size_t WS_ACT = 168 * MiB;
constexpr size_t WS_MIX = 104 * MiB;
constexpr size_t WS_HALO = 29 * MiB;
constexpr size_t WS_GATES = 416 * MiB;
constexpr size_t WS_NSAACC = 418 * MiB;
constexpr size_t WS_END = 482 * MiB;
constexpr int MISC_LAM = 0, MISC_B1 = 64, MISC_LUT = 40960, MISC_B1F = 45056, MISC_LUTMAX = 45568;
constexpr int CTL_KMX = 36864, CTL_KCMX = 37120;
constexpr int CW_BAR = 4096;
constexpr int RING_OFF = 0, RING_BYTES = 131072;
constexpr int LDSCTL_OFF = 141312  , MISC_OFF = LDSCTL_OFF + 320;
constexpr int LDS_BYTES = 147456;
static_assert(att::L_END <= LDSCTL_OFF && RING_BYTES <= LDSCTL_OFF && MISC_OFF + 128 <= LDS_BYTES, "LDS map");

#define GAS __attribute__((address_space(1)))
#define LAS __attribute__((address_space(3)))
typedef unsigned short bf16;
typedef unsigned v4u __attribute__((ext_vector_type(4)));
typedef unsigned v2u __attribute__((ext_vector_type(2)));
typedef float f32x4 __attribute__((ext_vector_type(4)));
typedef short bf16x8 __attribute__((ext_vector_type(8)));
typedef GAS unsigned gu32;
#define RLX_AGENT __ATOMIC_RELAXED, __HIP_MEMORY_SCOPE_AGENT
#define LDS_WAIT() asm volatile("s_waitcnt lgkmcnt(0)" ::: "memory")
#define VM_WAIT() asm volatile("s_waitcnt vmcnt(0)" ::: "memory")
__device__ __forceinline__ unsigned f2bf(float f) { unsigned u = __builtin_bit_cast(unsigned, f); return (u + 0x7fffu + ((u >> 16) & 1u)) >> 16; }
__device__ __forceinline__ unsigned pk2(float lo, float hi) { return f2bf(lo) | (f2bf(hi) << 16); }
__device__ __forceinline__ float gelu_tanh_f(float v) { const float z2 = 1.5957691216f * (v + 0.044715f * v * v * v); return v * __builtin_amdgcn_rcpf(1.0f + __builtin_amdgcn_exp2f(-1.4426950408889634f * z2)); }
#define XB_TMO      128
#define XB_XCNT(j)  (256  + 64 * (j))
#define XB_XSUB(j)  (1280 + 64 * (j))
#define XB_XGEN(j)  (2304 + 64 * (j))
#define XB_TOP      3328
#define XB_TOPGEN   3392
#define XCD_BAR_WORDS 3456
#define XB_SPIN_CAP (1u << 18)

__device__ __forceinline__ unsigned xb_ld(unsigned* p)              { return __hip_atomic_load(p, __ATOMIC_RELAXED, __HIP_MEMORY_SCOPE_AGENT); }
__device__ __forceinline__ unsigned xb_add(unsigned* p, unsigned v) { return __hip_atomic_fetch_add(p, v, __ATOMIC_RELAXED, __HIP_MEMORY_SCOPE_AGENT); }
__device__ __forceinline__ unsigned xb_xcc_id() { return (unsigned)__builtin_amdgcn_s_getreg((3 << 11) | 20) & 0xFu; }
#define XB_SPIN(cond, bar) do { unsigned _sp = 0; while (cond) { __builtin_amdgcn_s_sleep(1); \
    if ((++_sp & 255u) == 0u) { if (xb_ld(&(bar)[XB_TMO])) break; if (_sp > XB_SPIN_CAP) { atomicAdd(&(bar)[XB_TMO], 1u); break; } } } } while (0)

struct XcdBarrier {
    unsigned* bar; unsigned x;
    volatile LAS unsigned* st;
};

__device__ __forceinline__ XcdBarrier xcd_barrier_post(unsigned* bar, volatile LAS unsigned* st) {
    XcdBarrier b; b.bar = bar; b.x = xb_xcc_id(); b.st = st;
    if (threadIdx.x == 0) (void)xb_add(&bar[XB_XCNT(b.x)], 1u);
    return b;
}
__device__ __forceinline__ void xcd_barrier_complete(unsigned* bar, unsigned x, unsigned& nloc, unsigned& nx) {
    const unsigned G = gridDim.x * gridDim.y * gridDim.z;
    unsigned sum, cnt, mine, sp = 0u;
    for (;;) {
        sum = 0u; cnt = 0u; mine = 0u;
#pragma unroll
        for (unsigned j = 0; j < 16; ++j) { const unsigned c = xb_ld(&bar[XB_XCNT(j)]); sum += c; cnt += (c > 0u) ? 1u : 0u; mine = (j == x) ? c : mine; }
        if (sum == G) break;
        __builtin_amdgcn_s_sleep(1);
        if ((++sp & 255u) == 0u) { if (xb_ld(&bar[XB_TMO])) break; if (sp > XB_SPIN_CAP) { atomicAdd(&bar[XB_TMO], 1u); break; } }
    }
    nloc = mine > 0u ? mine : 1u; nx = cnt > 0u ? cnt : 1u;
}

__device__ __forceinline__ void xcd_barrier(const XcdBarrier& b) {
    asm volatile("s_waitcnt vmcnt(0)" ::: "memory");
    __syncthreads();
    if (threadIdx.x == 0) {
        unsigned* bar = b.bar;
        __builtin_amdgcn_s_waitcnt(0);
        unsigned nloc = b.st[0], nx = b.st[1];
        if (nloc == 0u) { xcd_barrier_complete(bar, b.x, nloc, nx); b.st[0] = nloc; b.st[1] = nx; }
        const unsigned old = xb_add(&bar[XB_XSUB(b.x)], 1u);
        const unsigned gen = old / nloc;
        if (old + 1u == (gen + 1u) * nloc) {
            __builtin_amdgcn_fence(__ATOMIC_RELEASE, "agent");
            asm volatile("s_waitcnt vmcnt(0)" ::: "memory");
            const unsigned og = xb_add(&bar[XB_TOP], 1u);
            const unsigned tg = og / nx;
            if (og + 1u == (tg + 1u) * nx) xb_add(&bar[XB_TOPGEN], 1u);
            else XB_SPIN(xb_ld(&bar[XB_TOPGEN]) == tg, bar);
            __builtin_amdgcn_fence(__ATOMIC_ACQUIRE, "agent");
            xb_add(&bar[XB_XGEN(b.x)], 1u);
            asm volatile("s_waitcnt vmcnt(0)" ::: "memory");
        } else {
            XB_SPIN(xb_ld(&bar[XB_XGEN(b.x)]) == gen, bar);
            __builtin_amdgcn_fence(__ATOMIC_ACQUIRE, "agent");
            asm volatile("s_waitcnt vmcnt(0)" ::: "memory");
        }
    }
    __syncthreads();
}
__device__ __forceinline__ float wave_sum(float v) {
#pragma unroll
    for (int o = 1; o < 64; o <<= 1) v += __shfl_xor(v, o);
    return v;
}
__device__ __forceinline__ unsigned cvtpk2(float lo, float hi) { unsigned r; asm volatile("v_cvt_pk_bf16_f32 %0, %1, %2" : "=v"(r) : "v"(lo), "v"(hi)); return r; }
__device__ __forceinline__ void transpose_item(const float* __restrict__ W, int K, int N, int npad, int nblk, bf16* WT, int mode, int item, int lane) {
    const int kb = item / nblk, nb = item - kb * nblk, k0 = 32 * kb, n = 256 * nb + 4 * lane;
    if (n >= npad) return;
    const bool inb = n < N;
    int orow = n;
    if (mode == 1) { const int bj = n / DFF, rem = n - bj * DFF; orow = (rem >> 7) * 256 + bj * 128 + (rem & 127); }
    const float* src = W + (size_t)k0 * N + n; bf16* dst = (mode == 2) ? WT + ((size_t)kb * N + n) * 32 : WT + (size_t)orow * K + k0;
    const size_t estride = (mode == 2) ? 32 : (size_t)K;
    f32x4 v[32];
#pragma unroll
    for (int j = 0; j < 32; ++j) v[j] = inb ? __builtin_nontemporal_load((const f32x4*)(src + (size_t)j * N)) : (f32x4){0.f, 0.f, 0.f, 0.f};
#pragma unroll
    for (int kk = 0; kk < 32; kk += 8) {
#pragma unroll
        for (int e = 0; e < 4; ++e) { v4u o; o.x = cvtpk2(v[kk + 0][e], v[kk + 1][e]); o.y = cvtpk2(v[kk + 2][e], v[kk + 3][e]); o.z = cvtpk2(v[kk + 4][e], v[kk + 5][e]); o.w = cvtpk2(v[kk + 6][e], v[kk + 7][e]);
            *(v4u*)(dst + (size_t)e * estride + kk) = o; }
    }
}
__device__ __forceinline__ int t5_bucket(int d) {
    if (d < 16) return d;
    return 16 + (d >= 19) + (d >= 21) + (d >= 24) + (d >= 27) + (d >= 31) + (d >= 35) + (d >= 40) + (d >= 46) + (d >= 52) + (d >= 59) + (d >= 67) + (d >= 77) + (d >= 87) + (d >= 99) + (d >= 113);
}
__device__ __forceinline__ void rms_rows2_bf16(const float* xrow0, const float* xrow1, const f32x4 (&gvr)[8], bf16* orow0, bf16* orow1, int lane) {
    const f32x4* xr0 = (const f32x4*)xrow0 + lane; const f32x4* xr1 = (const f32x4*)xrow1 + lane;
    f32x4 v0[8], v1[8]; float s0 = 0.f, s1 = 0.f;
#pragma unroll
    for (int j = 0; j < 8; ++j) { v0[j] = __builtin_nontemporal_load(xr0 + 64 * j); v1[j] = __builtin_nontemporal_load(xr1 + 64 * j); }
#pragma unroll
    for (int j = 0; j < 8; ++j) { s0 += (v0[j].x * v0[j].x + v0[j].y * v0[j].y) + (v0[j].z * v0[j].z + v0[j].w * v0[j].w); s1 += (v1[j].x * v1[j].x + v1[j].y * v1[j].y) + (v1[j].z * v1[j].z + v1[j].w * v1[j].w); }
    const float r0 = 1.0f / sqrtf(wave_sum(s0) * (1.0f / DM) + EPS), r1 = 1.0f / sqrtf(wave_sum(s1) * (1.0f / DM) + EPS);
    v2u* o0 = (v2u*)orow0 + lane; v2u* o1 = (v2u*)orow1 + lane;
#pragma unroll
    for (int j = 0; j < 8; ++j) { const f32x4 gv = gvr[j];
        v2u w; w.x = pk2(v0[j].x * r0 * gv.x, v0[j].y * r0 * gv.y); w.y = pk2(v0[j].z * r0 * gv.z, v0[j].w * r0 * gv.w); o0[64 * j] = w;
        v2u u; u.x = pk2(v1[j].x * r1 * gv.x, v1[j].y * r1 * gv.y); u.y = pk2(v1[j].z * r1 * gv.z, v1[j].w * r1 * gv.w); o1[64 * j] = u; }
}

struct Ptrs {
    const float* in[NIN]; float* out; unsigned char* ws; int ph_lo, ph_hi;
};

__device__ __forceinline__ void p0_prologue(const Ptrs& P, LAS unsigned char* lds, int vcu, int G, int tid, int lane, int wave) {
    const int gw = vcu * NWAVES + wave, NGW = G * NWAVES;
    constexpr int I_IN = 64 * 23, I_C1 = 128, I_C2 = 8;
    constexpr int NITEMS = I_IN + 2 * I_C1 + 2 * I_C2;
    unsigned char* ws = P.ws;
    for (int it = gw; it < NITEMS; it += NGW) {
        int r = it;
        if (r < I_IN) { transpose_item(P.in[2], DM, NPROJ, LDP, 23, (bf16*)(ws + WS_WIN), 0, r, lane); continue; } r -= I_IN;
        if (r < I_C1) { transpose_item(P.in[10], 4096, 256, 256, 1, (bf16*)(ws + WS_CW1K), 2, r, lane); continue; } r -= I_C1;
        if (r < I_C1) { transpose_item(P.in[12], 4096, 256, 256, 1, (bf16*)(ws + WS_CW1V), 2, r, lane); continue; } r -= I_C1;
        if (r < I_C2) { transpose_item(P.in[11], 256, 128, 128, 1, (bf16*)(ws + WS_CW2K), 0, r, lane); continue; } r -= I_C2;
        transpose_item(P.in[13], 256, 128, 128, 1, (bf16*)(ws + WS_CW2V), 0, r, lane);
    }
    f32x4 gvr0[8];
#pragma unroll
    for (int j = 0; j < 8; ++j) gvr0[j] = ((const f32x4*)P.in[1] + lane)[64 * j];
    for (int m = gw; m < TOK; m += 2 * NGW) { const int m1 = (m + NGW < TOK) ? m + NGW : m;
        rms_rows2_bf16(P.in[0] + (size_t)m * DM, P.in[0] + (size_t)m1 * DM, gvr0, (bf16*)(ws + WS_H) + (size_t)m * DM, (bf16*)(ws + WS_H) + (size_t)m1 * DM, lane); }
    float* misc = (float*)(ws + WS_MISC);
    const int gt = vcu * (NWAVES * 64) + tid;
    if (gt < 2048) {
        const int h = gt >> 7, d = gt & 127; const float* rb = P.in[14];
        misc[MISC_LUT + gt] = (d < 113) ? (rb[t5_bucket(d) * 16 + h] - rb[31 * 16 + h]) * LOG2E : 0.f;
    }
    if (gt >= 2112 && gt < 2176) {
        const int ln = gt - 2112, h = ln >> 2, q = ln & 3; const float* rb = P.in[14]; float mx = 0.f;
        const float far_ = rb[31 * 16 + h];
#pragma unroll
        for (int k = 0; k < 29; ++k) { const int d = q + 4 * k; const float v = (d < 113) ? (rb[t5_bucket(d < 113 ? d : 112) * 16 + h] - far_) * LOG2E : 0.f; mx = fmaxf(mx, v); }
        mx = fmaxf(mx, __shfl_xor(mx, 1)); mx = fmaxf(mx, __shfl_xor(mx, 2));
        if (q == 0) misc[MISC_LUTMAX + h] = mx;
    }
    if (gt >= 2176 && gt < 2240) {
        const int i = gt - 2176;
        const float s1 = wave_sum(P.in[3][i] * P.in[4][i]), s2 = wave_sum(P.in[5][i] * P.in[6][i]);
        if (i == 0) misc[MISC_LAM] = expf(s1) - expf(s2) + 0.2f;
    }
    if (gt >= 8192 && gt < 8192 + 32768) {
        const int q = gt - 8192, which = q >> 14, kc = (q >> 8) & 63, n = q & 255;
        const float* pos = which ? P.in[9] : P.in[8]; const float* w1 = which ? P.in[12] : P.in[10];
        float s0 = 0.f, s1 = 0.f;
#pragma unroll 8
        for (int k = 64 * kc; k < 64 * kc + 64; k += 2) { s0 += pos[k] * w1[(size_t)k * 256 + n]; s1 += pos[k + 1] * w1[(size_t)(k + 1) * 256 + n]; }
        misc[MISC_B1 + (which * 64 + kc) * 256 + n] = s0 + s1;
    }
}

__device__ __forceinline__ bool p0b_weights(const Ptrs& P, int lane, int budget = 1 << 30) {
    constexpr int I_OUT = 64 * 8, I_UP = 64 * 44, I_DN = 176 * 8;
    unsigned char* ws = P.ws;
    unsigned* ctr = (unsigned*)(ws + WS_CTL + 32768);
    for (int n_ = 0; n_ < budget; ++n_) {
        unsigned it0 = 0;
        if (lane == 0) it0 = __hip_atomic_fetch_add(ctr, 1u, __ATOMIC_RELAXED, __HIP_MEMORY_SCOPE_AGENT);
        const int it = __builtin_amdgcn_readfirstlane(it0);
        if (it >= I_OUT + I_UP + I_DN) return true;
        int r = it;
        if (r < I_OUT) { transpose_item(P.in[15], DM, DM, DM, 8, (bf16*)(ws + WS_WOUT), 0, r, lane); continue; } r -= I_OUT;
        if (r < I_UP) { transpose_item(P.in[18], DM, NUP, NUP, 44, (bf16*)(ws + WS_WUP), 1, r, lane); continue; } r -= I_UP;
        transpose_item(P.in[21], DFF, DM, DM, 8, (bf16*)(ws + WS_WDN), 0, r, lane);
    }
    return false;
}
template <int K> __device__ __forceinline__ float swzx(float v) { return __builtin_bit_cast(float, __builtin_amdgcn_ds_swizzle(__builtin_bit_cast(int, v), (K << 10) | 0x1F)); }
__device__ __forceinline__ float sq8(const v4u w) { float s = 0.f; const unsigned a[4] = {w.x, w.y, w.z, w.w};
#pragma unroll
    for (int i = 0; i < 4; ++i) { const float lo = __uint_as_float(a[i] << 16), hi_ = __uint_as_float(a[i] & 0xffff0000u); s += lo * lo + hi_ * hi_; } return s; }
__device__ __forceinline__ void knorm_prep(const Ptrs& P, LAS unsigned char* lds, int vcu, int G, int tid, int lane, int wave) {
    unsigned char* ws = P.ws; const bf16* proj = (const bf16*)(ws + WS_PROJ); unsigned* kmx = (unsigned*)(ws + WS_CTL + CTL_KMX);
    LAS float* red = (LAS float*)(lds + RING_OFF);
    for (int u = vcu; u < 256; u += G) {
        const int b = u >> 7, tile = u & 127, cl = lane & 7;
        const bf16* row = proj + ((size_t)b * SEQ + 64 * tile + 8 * wave + (lane >> 3)) * LDP + cl * 8;
        float n2[20];
#pragma unroll
        for (int gi = 0; gi < 16; ++gi) n2[gi] = sq8(*(const v4u*)(row + C_DK + (gi >> 1) * 128 + (gi & 1) * 64));
#pragma unroll
        for (int g2 = 0; g2 < 2; ++g2) { n2[16 + g2] = sq8(*(const v4u*)(row + C_KS + g2 * 128)) + sq8(*(const v4u*)(row + C_KS + g2 * 128 + 64));
                                         n2[18 + g2] = sq8(*(const v4u*)(row + C_KW + g2 * 128)) + sq8(*(const v4u*)(row + C_KW + g2 * 128 + 64)); }
#pragma unroll
        for (int gi = 0; gi < 20; ++gi) { float v = n2[gi];
            v += __builtin_bit_cast(float, __builtin_amdgcn_update_dpp(0, __builtin_bit_cast(int, v), 0xB1, 0xF, 0xF, false));
            v += __builtin_bit_cast(float, __builtin_amdgcn_update_dpp(0, __builtin_bit_cast(int, v), 0x4E, 0xF, 0xF, false));
            v += __builtin_bit_cast(float, __builtin_amdgcn_update_dpp(0, __builtin_bit_cast(int, v), 0x141, 0xF, 0xF, false));
            v = fmaxf(v, swzx<8>(v)); v = fmaxf(v, swzx<16>(v)); v = fmaxf(v, __shfl_xor(v, 32));
            n2[gi] = v; }
        __syncthreads();
        if (lane == 0) {
#pragma unroll
            for (int gi = 0; gi < 20; ++gi) red[wave * 20 + gi] = n2[gi]; }
        __syncthreads();
        if (tid < 20) { float m = red[tid];
#pragma unroll
            for (int w8 = 1; w8 < 8; ++w8) m = fmaxf(m, red[w8 * 20 + tid]);
            atomicMax(kmx + b * 20 + tid, __float_as_uint(m)); }
    }
}
__device__ __forceinline__ void cmp_unit(const Ptrs& P, LAS unsigned char* lds, int u, int tid, int lane, int wave) {
    typedef float f32x4_ __attribute__((ext_vector_type(4)));
    unsigned char* ws = P.ws;
    const int which = u >> 7, bg = (u >> 5) & 3, blk = u & 31, b = bg >> 1, g = bg & 1;
    const bf16* proj = (const bf16*)(ws + WS_PROJ);
    const bf16* w1T = (const bf16*)(ws + (which ? WS_CW1V : WS_CW1K));
    const bf16* w2T = (const bf16*)(ws + (which ? WS_CW2V : WS_CW2K));
    bf16* outp = (bf16*)(ws + (which ? WS_VCMP : WS_KCMP));
    const int i = lane & 15, kq = lane >> 4;
    const int c = blk * 16 + i;
    const int srccol = (which ? C_VC : C_KC) + g * 128;
    const bf16* arow = proj + (size_t)b * SEQ * LDP + srccol + 8 * kq;
    const bf16* brow = w1T + (size_t)i * 32 + 8 * kq;
    f32x4_ acc[16];
#pragma unroll
    for (int nb = 0; nb < 16; ++nb) acc[nb] = (f32x4_){0.f, 0.f, 0.f, 0.f};
    bf16x8 wA[16], wB[16], aA, aB;
#define CLOAD(kk_, a_, w_) do { const int ks_ = 16 * wave + (((kk_) + blk) & 15);        \
        int tok_ = 16 * c + (ks_ >> 2); tok_ = tok_ > SEQ - 1 ? SEQ - 1 : tok_;                                                          \
        a_ = *(const bf16x8*)(arow + (size_t)tok_ * LDP + 32 * (ks_ & 3));                                                              \
        _Pragma("unroll") for (int nb = 0; nb < 16; ++nb) w_[nb] = *(const bf16x8*)(brow + ((size_t)ks_ * 256 + nb * 16) * 32); } while (0)
#define CMMA(a_, w_) do { _Pragma("unroll") for (int nb = 0; nb < 16; ++nb) acc[nb] = __builtin_amdgcn_mfma_f32_16x16x32_bf16(a_, w_[nb], acc[nb], 0, 0, 0); } while (0)
    CLOAD(0, aA, wA);
#pragma unroll 1
    for (int kk = 0; kk < 16; kk += 2) {
        CLOAD(kk + 1, aB, wB);
        __builtin_amdgcn_sched_barrier(0);
        CMMA(aA, wA);
        __builtin_amdgcn_sched_barrier(0);
        if (kk + 2 < 16) CLOAD(kk + 2, aA, wA);
        __builtin_amdgcn_sched_barrier(0);
        CMMA(aB, wB);
        __builtin_amdgcn_sched_barrier(0);
    }
#undef CLOAD
#undef CMMA
    LAS float* red = (LAS float*)(lds + RING_OFF);
    __syncthreads();
#pragma unroll
    for (int nb = 0; nb < 16; ++nb)
#pragma unroll
        for (int r = 0; r < 4; ++r) red[(wave * 16 + 4 * kq + r) * 256 + ((16 * nb + i) ^ (16 * kq))] = acc[nb][r];
    __syncthreads();
    const int hr = tid >> 5, hc = 8 * (tid & 31);
    f32x4_ s0 = {0.f, 0.f, 0.f, 0.f}, s1 = {0.f, 0.f, 0.f, 0.f};
#pragma unroll
    for (int w8 = 0; w8 < 8; ++w8) { const LAS float* rp = red + (w8 * 16 + hr) * 256 + (hc ^ (16 * (hr >> 2))); s0 += *(const LAS f32x4_*)rp; s1 += *(const LAS f32x4_*)(rp + 4); }
    float bs[8];
    { const float* bf_ = (const float*)(ws + WS_MISC) + MISC_B1F + which * 256 + hc; const f32x4_ b0 = *(const f32x4_*)bf_, b1 = *(const f32x4_*)(bf_ + 4);
      bs[0] = b0[0]; bs[1] = b0[1]; bs[2] = b0[2]; bs[3] = b0[3]; bs[4] = b1[0]; bs[5] = b1[1]; bs[6] = b1[2]; bs[7] = b1[3]; }
    __syncthreads();
    LAS bf16* hid = (LAS bf16*)(lds + RING_OFF);
    { v4u o; o.x = cvtpk2(gelu_tanh_f(s0[0] + bs[0]), gelu_tanh_f(s0[1] + bs[1])); o.y = cvtpk2(gelu_tanh_f(s0[2] + bs[2]), gelu_tanh_f(s0[3] + bs[3]));
      o.z = cvtpk2(gelu_tanh_f(s1[0] + bs[4]), gelu_tanh_f(s1[1] + bs[5])); o.w = cvtpk2(gelu_tanh_f(s1[2] + bs[6]), gelu_tanh_f(s1[3] + bs[7]));
      *(LAS v4u*)(hid + hr * 264 + hc) = o; }
    __syncthreads();
    f32x4_ acc2 = {0.f, 0.f, 0.f, 0.f};
    const bf16* b2row = w2T + (size_t)(16 * wave + i) * 256 + 8 * kq;
#pragma unroll
    for (int ks = 0; ks < 8; ++ks) {
        const bf16x8 a = *(const LAS bf16x8*)(hid + i * 264 + 32 * ks + 8 * kq);
        const bf16x8 w = *(const bf16x8*)(b2row + 32 * ks);
        acc2 = __builtin_amdgcn_mfma_f32_16x16x32_bf16(a, w, acc2, 0, 0, 0);
    }
    float rs[4];
#pragma unroll
    for (int r = 0; r < 4; ++r) { const int cc = blk * 16 + 4 * kq + r; const unsigned ob = (cc >= 511) ? 0u : f2bf(acc2[r]); outp[((size_t)bg * 512 + cc) * 128 + 16 * wave + i] = (bf16)ob;
        const float vr = __uint_as_float(ob << 16); rs[r] = vr * vr; }
    if (which == 0) {
#pragma unroll
        for (int r = 0; r < 4; ++r) { float v = rs[r];
            v += __builtin_bit_cast(float, __builtin_amdgcn_update_dpp(0, __builtin_bit_cast(int, v), 0xB1, 0xF, 0xF, false));
            v += __builtin_bit_cast(float, __builtin_amdgcn_update_dpp(0, __builtin_bit_cast(int, v), 0x4E, 0xF, 0xF, false));
            v += __builtin_bit_cast(float, __builtin_amdgcn_update_dpp(0, __builtin_bit_cast(int, v), 0x141, 0xF, 0xF, false));
            v += __builtin_bit_cast(float, __builtin_amdgcn_update_dpp(0, __builtin_bit_cast(int, v), 0x140, 0xF, 0xF, false));
            rs[r] = v; }
        LAS float* part = (LAS float*)(lds + RING_OFF + 16384);
        if (i == 0) {
#pragma unroll
            for (int r = 0; r < 4; ++r) part[wave * 16 + 4 * kq + r] = rs[r]; }
        __syncthreads();
        if (tid < 16) { float s = 0.f;
#pragma unroll
            for (int w8 = 0; w8 < 8; ++w8) s += part[w8 * 16 + tid];
            s = fmaxf(s, swzx<1>(s)); s = fmaxf(s, swzx<2>(s)); s = fmaxf(s, swzx<4>(s)); s = fmaxf(s, swzx<8>(s));
            if (tid == 0) atomicMax((unsigned*)(ws + WS_CTL + CTL_KCMX) + bg, __float_as_uint(s)); }
    }
    __syncthreads();
}

template <int K> __device__ __forceinline__ float swz_xor(float v) { return __builtin_bit_cast(float, __builtin_amdgcn_ds_swizzle(__builtin_bit_cast(int, v), (K << 10) | 0x1F)); }
__device__ __forceinline__ void diff_unit(const Ptrs& P, LAS unsigned char* ldsb, int b, int h, int qb) {
    using namespace att;
    lchar* lds = (lchar*)ldsb;
    unsigned char* ws = P.ws;
    const bf16_t* proj = (const bf16_t*)(ws + WS_PROJ); bf16_t* mix = (bf16_t*)(ws + WS_MIX);
    const float* misc = (const float*)(ws + WS_MISC);
    int tid = threadIdx.x; asm volatile("" : "+v"(tid));
    const int wid = __builtin_amdgcn_readfirstlane(tid >> 6), lane = tid & 63, r32 = lane & 31, hi = lane >> 5;
    const int map = wid >> 2, wq = wid & 3, q0 = 128 * qb + 32 * wq;
    const size_t tokb = (size_t)b * SEQ;
    __syncthreads();
#ifndef ATT_HEADPRE
#define ATT_HEADPRE true
#endif
    if (ATT_HEADPRE) head_dma(lds, proj + tokb * LDP + C_DK + h * 128, proj + tokb * LDP + C_DV + h * 128, LDP, 0, 2 * (qb + 1));
    if (tid < LUTX) { const int d = tid - LUT0; ((ALAS float*)(lds + L_LUT))[tid] = (d >= 0 && d < 113) ? misc[MISC_LUT + h * 128 + d] : 0.f; }
    const bf16_t* qp = proj + (tokb + q0 + r32) * LDP + C_DQ + h * 128 + map * 64 + hi * 8;
    bf16x8 qr[4];
#pragma unroll
    for (int d0 = 0; d0 < 4; ++d0) qr[d0] = *(const bf16x8*)(qp + d0 * 16);
    Lane L; L.qpos = q0 + r32; L.qlo = q0; L.qhi = q0 + 31; L.lut = lds_addr(lds + L_LUT);
#ifdef TPROBE_SEC
    L.tpw = (unsigned long long*)(ws + WS_CTL + 40960);
#endif
    f32x16 o[4]; float m_reg = 0.f, l_reg;
#ifndef DIFF_ENGINE
#define DIFF_ENGINE attn_tiles_dma
#endif
#ifndef DIFF_NEGM
#define DIFF_NEGM false
#endif
#ifdef EPROBE
    unsigned long long ep_t0 = __builtin_amdgcn_s_memrealtime();
#endif
#ifndef DIFF_FIXM
#define DIFF_FIXM 1
#endif
#ifndef NSA_FIXM_CMP
#define NSA_FIXM_CMP 1
#endif
#ifndef NSA_FIXM_SLC
#define NSA_FIXM_SLC 1
#endif
#ifndef NSA_FIXM_WIN
#define NSA_FIXM_WIN 1
#endif
    if (DIFF_FIXM) { const float k2 = __uint_as_float(((const unsigned*)(ws + WS_CTL + CTL_KMX))[b * 20 + h * 2 + map]);
        m_reg = sqrtf(qrow_norm2<4>(qr) * k2) * 1.002f + misc[MISC_LUTMAX + h]; }
#ifndef ATT_FUSE
#define ATT_FUSE true
#endif
#ifndef DIFF_DMAPOS
#define DIFF_DMAPOS 2
#endif
#ifndef ATT_DMAPOS
#define ATT_DMAPOS 2
#endif
#ifndef ATT_PRIO
#define ATT_PRIO 1
#endif
#ifndef DIFF_KDB
#define DIFF_KDB false
#endif
#ifndef DIFF_VPRE
#define DIFF_VPRE true
#endif
#ifndef DIFF_KPRE
#define DIFF_KPRE true
#endif
#ifndef DIFF_SMP2
#define DIFF_SMP2 true
#endif
#ifndef DIFF_KGS
#define DIFF_KGS 2
#endif
#ifndef DIFF_PIPE
#define DIFF_PIPE false
#endif
    DIFF_ENGINE<M_DIFF, 64, DIFF_NEGM, DIFF_FIXM, ATT_FUSE, DIFF_PIPE, DIFF_KGS, DIFF_SMP2, DIFF_KPRE, DIFF_VPRE, DIFF_KDB, ATT_PRIO, DIFF_DMAPOS, ATT_HEADPRE>(lds, proj + tokb * LDP + C_DK + h * 128, proj + tokb * LDP + C_DV + h * 128, LDP, 0, 2 * (qb + 1), nullptr, qr, map * 128, L, 0u, 0u, 0u, 0u, o, m_reg, l_reg);
#ifdef EPROBE
    if (blockIdx.x == 0 && tid == 0) { unsigned long long* w_ = (unsigned long long*)(ws + WS_CTL + 40960); w_[0] += __builtin_amdgcn_s_memrealtime() - ep_t0; }
#endif
    ALAS float* li_l = (ALAS float*)(lds + L_WS) + wid * 64;
    if (hi == 0) li_l[r32] = l_reg;
    asm volatile("s_waitcnt lgkmcnt(0)" ::: "memory");
    float rli[16];
#pragma unroll
    for (int r = 0; r < 16; ++r) { const float l_ = li_l[crow(r, hi)]; rli[r] = l_ > 0.f ? 1.0f / l_ : 0.f; }
    ALAS float* X = (ALAS float*)(lds + L_V);
    float gsub4[4] = {0.f, 0.f, 0.f, 0.f}, lam = 0.f;
    if (map == 0) { lam = misc[MISC_LAM]; const float* subln = P.in[7];
#pragma unroll
        for (int d0 = 0; d0 < 4; ++d0) gsub4[d0] = subln[32 * d0 + r32]; }
    if (map == 1) {
#pragma unroll
        for (int d0 = 0; d0 < 4; ++d0)
#pragma unroll
            for (int r = 0; r < 16; ++r) X[(wq * 64 + d0 * 16 + r) * 64 + lane] = o[d0][r] * rli[r];
    }
    __syncthreads();
    if (map == 0) {
        float ss[16];
#pragma unroll
        for (int r = 0; r < 16; ++r) ss[r] = 0.f;
#pragma unroll
        for (int d0 = 0; d0 < 4; ++d0)
#pragma unroll
            for (int r = 0; r < 16; ++r) { const float o2 = X[(wq * 64 + d0 * 16 + r) * 64 + lane]; const float d = o[d0][r] * rli[r] - lam * o2; o[d0][r] = d; ss[r] += d * d; }
#pragma unroll
        for (int r = 0; r < 16; ++r) { float s = ss[r]; s += swz_xor<1>(s); s += swz_xor<2>(s); s += swz_xor<4>(s); s += swz_xor<8>(s); s += swz_xor<16>(s);
            ss[r] = 0.8f / sqrtf(s * (1.0f / 128.0f) + EPS); }
#pragma unroll
        for (int d0 = 0; d0 < 4; ++d0) { const float gsub = gsub4[d0];
#pragma unroll
            for (int r = 0; r < 16; ++r) { const float v = o[d0][r] * ss[r] * gsub; const float vn = swz_xor<1>(v);
                if ((r32 & 1) == 0) *(unsigned*)(mix + (tokb + q0 + crow(r, hi)) * DM + h * 128 + 32 * d0 + r32) = cvtpk(v, vn); } }
    }
}

#ifndef NSA_PARTS
#define NSA_PARTS 31
#endif
#define NSA_PARTS_DEF NSA_PARTS
__device__ __forceinline__ void nsa_unit(const Ptrs& P, LAS unsigned char* ldsb, int bg, int qb) {
    using namespace att;
#ifdef TSEL_A
#define NSTAMP(k) do { if (blockIdx.x == 0 && threadIdx.x == 0 && qb == 127) { unsigned long long* t_ = (unsigned long long*)(P.ws + WS_CTL + 8192); t_[(k)] = __builtin_amdgcn_s_memrealtime(); } } while (0)
#else
#define NSTAMP(k) do {} while (0)
#endif
    NSTAMP(21);
    lchar* lds = (lchar*)ldsb;
    unsigned char* ws = P.ws;
    const bf16_t* proj = (const bf16_t*)(ws + WS_PROJ); bf16_t* mix = (bf16_t*)(ws + WS_MIX);
    const bf16_t* kcmp = (const bf16_t*)(ws + WS_KCMP) + (size_t)bg * 512 * 128; const bf16_t* vcmp = (const bf16_t*)(ws + WS_VCMP) + (size_t)bg * 512 * 128;
    const float* misc = (const float*)(ws + WS_MISC); const float* gates = (const float*)(ws + WS_GATES);
    int tid = threadIdx.x; asm volatile("" : "+v"(tid));
    const int wid = __builtin_amdgcn_readfirstlane(tid >> 6), lane = tid & 63, r32 = lane & 31, hi = lane >> 5;
    const int b = bg >> 1, g = bg & 1, t0 = 64 * qb; const size_t tokb = (size_t)b * SEQ;
    const int ql = 8 * wid + (r32 >> 2), hg = r32 & 3;
    ALAS unsigned* imp = (ALAS unsigned*)(lds + L_IMP); ALAS unsigned* selm = (ALAS unsigned*)(lds + L_SEL); ALAS unsigned* un = (ALAS unsigned*)(lds + L_UN); ALAS int* list = (ALAS int*)(lds + L_LIST);
    ALAS float* li_l = (ALAS float*)(lds + L_WS) + wid * 64;
    __syncthreads();
    if (ATT_HEADPRE && (NSA_PARTS_DEF & 1)) head_dma(lds, kcmp, vcmp, 128, 0, (((t0 + 63 - 31) >> 4) >> 6) + 1);
    if (tid < 4) un[tid] = 0u;
    for (int i = tid; i < 4 * LUTX; i += NWAVES * 64) { const int hh = i / LUTX, d = i - hh * LUTX - LUT0; ((ALAS float*)(lds + L_LUT))[i] = (d >= 0 && d < 113) ? misc[MISC_LUT + (8 + g * 4 + hh) * 128 + d] : 0.f; }
    const bf16_t* qp = proj + (tokb + t0 + ql) * LDP + C_NQ + g * 512 + hg * 128 + hi * 8;
    bf16x8 qr[8];
#pragma unroll
    for (int d0 = 0; d0 < 8; ++d0) qr[d0] = *(const bf16x8*)(qp + d0 * 16);
    Lane L; L.qpos = t0 + ql; L.qlo = t0 + 8 * wid; L.qhi = L.qlo + 7; L.lut = lds_addr(lds + L_LUT) + (unsigned)hg * (LUTX * 4u);
#ifdef TPROBE_SEC
    L.tpw = (unsigned long long*)(ws + WS_CTL + 40960);
#endif
#define NSA_GATE(k) ({ int l_ = lane; asm volatile("" : "+v"(l_)); gates[(tokb + t0 + 8 * wid + ((l_ & 31) >> 2)) * 32 + g * 12 + (l_ & 3) * 3 + (k)]; })
#define NSA_ACCP ({ int l_ = lane; asm volatile("" : "+v"(l_)); (float*)(ws + WS_NSAACC) + ((size_t)blockIdx.x * NWAVES + wid) * 4096 + l_; })
    f32x16 o[4]; float m_c = 0.f, l_c, m_x = 0.f, l_x;
    if (NSA_FIXM_CMP) m_c = sqrtf(qrow_norm2<8>(qr) * __uint_as_float(((const unsigned*)(ws + WS_CTL + CTL_KCMX))[bg])) * 1.01f;
    const int NTc = (((t0 + 63 - 31) >> 4) >> 6) + 1;
#ifndef NSA_PARTS
#define NSA_PARTS 31
#endif
#ifndef NSA_ENGINE
#define NSA_ENGINE attn_tiles_dma
#ifndef NSA_KDB_CMP
#define NSA_KDB_CMP false
#endif
#ifndef NSA_KDB_SLC
#define NSA_KDB_SLC false
#endif
#ifndef NSA_KDB_WIN
#define NSA_KDB_WIN false
#endif
#ifndef NSA_VPRE_CMP
#define NSA_VPRE_CMP true
#endif
#ifndef NSA_VPRE_SLC
#define NSA_VPRE_SLC true
#endif
#ifndef NSA_VPRE_WIN
#define NSA_VPRE_WIN true
#endif
#ifndef NSA_KPRE_CMP
#define NSA_KPRE_CMP true
#endif
#ifndef NSA_KPRE_SLC
#define NSA_KPRE_SLC true
#endif
#ifndef NSA_KPRE_WIN
#define NSA_KPRE_WIN true
#endif
#ifndef NSA_SMP2_CMP
#define NSA_SMP2_CMP true
#endif
#ifndef NSA_SMP2_SLC
#define NSA_SMP2_SLC true
#endif
#ifndef NSA_SMP2_WIN
#define NSA_SMP2_WIN true
#endif
#ifndef NSA_KGS_CMP
#define NSA_KGS_CMP 2
#endif
#ifndef NSA_KGS_SLC
#define NSA_KGS_SLC 2
#endif
#ifndef NSA_KGS_WIN
#define NSA_KGS_WIN 2
#endif
#endif
    if (NSA_PARTS & 1) NSA_ENGINE<M_CMP, 128, false, NSA_FIXM_CMP, ATT_FUSE, false, NSA_KGS_CMP, NSA_SMP2_CMP, NSA_KPRE_CMP, NSA_VPRE_CMP, NSA_KDB_CMP, ATT_PRIO, ATT_DMAPOS, ATT_HEADPRE>(lds, kcmp, vcmp, 128, 0, NTc, nullptr, qr, 0, L, 0u, 0u, 0u, 0u, o, m_c, l_c); else { m_c = 0.f; l_c = 1.f; o[0] = o[1] = o[2] = o[3] = f32x16{}; }
    { const float sc = l_c > 0.f ? NSA_GATE(0) / l_c : 0.f; if (hi == 0) li_l[r32] = sc; asm volatile("s_waitcnt lgkmcnt(0)" ::: "memory");
      float* ap = NSA_ACCP; float lv[16];
#pragma unroll
      for (int r = 0; r < 16; ++r) lv[r] = li_l[crow(r, hi)];
#pragma unroll
      for (int d0 = 0; d0 < 4; ++d0) {
#pragma unroll
          for (int r = 0; r < 16; ++r) ap[64 * r] = o[d0][r] * lv[r];
          ap += 1024; asm volatile("" : "+v"(ap)); } }
    NSTAMP(22);
    { int t_ = threadIdx.x; asm volatile("" : "+v"(t_)); for (int i = t_; i < 64 * IMP_LD; i += NWAVES * 64) imp[i] = 0u; }
    if (NSA_PARTS & 2) { const float fx = (l_c > 0.f ? 1.0f / l_c : 0.f) * 268435456.0f;
      const int sr = tid >> 4, sc = (tid & 15) * 8, kws = KSWZ(sr, sc * 2);
      lchar* K_lds = lds + L_K;
      bf16x8 k0 = *(const bf16x8*)(kcmp + (size_t)sr * 128 + sc), k1 = *(const bf16x8*)(kcmp + (size_t)(32 + sr) * 128 + sc);
      for (int t = 0; t < NTc; ++t) {
          *(ALAS bf16x8*)(K_lds + kws) = k0; *(ALAS bf16x8*)(K_lds + kws + 32 * 256) = k1;
          __syncthreads();
          if (t + 1 < NTc) { k0 = *(const bf16x8*)(kcmp + (size_t)(64 * (t + 1) + sr) * 128 + sc); k1 = *(const bf16x8*)(kcmp + (size_t)(64 * (t + 1) + 32 + sr) * 128 + sc); }
          const bool act = 16 * (64 * t) + 31 <= L.qhi;
          if (act) {
              f32x16 p0, p1;
              qkt<0, 128>(p0, p1, K_lds, 0, r32, hi, qr, true, false, 0u);
              tile_mask<M_CMP>(p0, p1, 64 * t, t, L, hi, true, 0u, 0u, 0u, 0u);
#pragma unroll
              for (int r = 0; r < 16; ++r) { p0[r] = __builtin_amdgcn_exp2f(p0[r] - m_c) * fx; p1[r] = __builtin_amdgcn_exp2f(p1[r] - m_c) * fx; }
              ALAS unsigned* ir = imp + ql * IMP_LD + 16 * t + hi;
#define QSUM(x) do { x += __builtin_bit_cast(float, __builtin_amdgcn_update_dpp(0, __builtin_bit_cast(int, x), 0xB1, 0xF, 0xF, false)); \
                     x += __builtin_bit_cast(float, __builtin_amdgcn_update_dpp(0, __builtin_bit_cast(int, x), 0x4E, 0xF, 0xF, false)); } while (0)
              float va[8], vb[8];
#pragma unroll
              for (int gi = 0; gi < 4; ++gi) {
                  va[gi] = p0[4 * gi]; vb[gi] = va[gi] + 2.0f * (p0[4 * gi + 1] + p0[4 * gi + 2] + p0[4 * gi + 3]);
                  va[4 + gi] = p1[4 * gi]; vb[4 + gi] = va[4 + gi] + 2.0f * (p1[4 * gi + 1] + p1[4 * gi + 2] + p1[4 * gi + 3]);
              }
#pragma unroll
              for (int k = 0; k < 8; ++k) { QSUM(va[k]); QSUM(vb[k]); }
#undef QSUM
              if (hg == 0) {
#pragma unroll
                  for (int k = 0; k < 8; ++k) {
                      __hip_atomic_fetch_add(ir + 2 * k, (unsigned)va[k], __ATOMIC_RELAXED, __HIP_MEMORY_SCOPE_WORKGROUP);
                      __hip_atomic_fetch_add(ir + 2 * k + 1, (unsigned)vb[k], __ATOMIC_RELAXED, __HIP_MEMORY_SCOPE_WORKGROUP);
                  }
              }
          }
          __syncthreads();
      }
    }
    NSTAMP(23);
    if (NSA_PARTS & 4) { const int cur = qb;
      for (int qi = 0; qi < 8; ++qi) {
          const int qq = 8 * wid + qi; const int j0 = lane, j1 = lane + 64;
          unsigned k0, k1;
          { const unsigned v = imp[qq * IMP_LD + j0]; k0 = (j0 > cur) ? 0u : ((j0 == 0 || j0 == cur || j0 + 1 == cur) ? (0xFFFFFF80u | (unsigned)(127 - j0)) : ((v & ~127u) | (unsigned)(127 - j0))); }
          { const unsigned v = imp[qq * IMP_LD + j1]; k1 = (j1 > cur) ? 0u : ((j1 == cur || j1 + 1 == cur) ? (0xFFFFFF80u | (unsigned)(127 - j1)) : ((v & ~127u) | (unsigned)(127 - j1))); }
          unsigned thr = 0u;
          for (int bit = 31; bit >= 0; --bit) { const unsigned cand = thr | (1u << bit);
              const int cnt = __popcll(__ballot(k0 >= cand)) + __popcll(__ballot(k1 >= cand)); if (cnt >= 16) thr = cand; }
          const unsigned long long m0 = __ballot(k0 >= thr && k0 != 0u), m1 = __ballot(k1 >= thr && k1 != 0u);
          if (lane == 0) { selm[qq * 4 + 0] = (unsigned)m0; selm[qq * 4 + 1] = (unsigned)(m0 >> 32); selm[qq * 4 + 2] = (unsigned)m1; selm[qq * 4 + 3] = (unsigned)(m1 >> 32);
              __hip_atomic_fetch_or(un + 0, (unsigned)m0, __ATOMIC_RELAXED, __HIP_MEMORY_SCOPE_WORKGROUP); __hip_atomic_fetch_or(un + 1, (unsigned)(m0 >> 32), __ATOMIC_RELAXED, __HIP_MEMORY_SCOPE_WORKGROUP);
              __hip_atomic_fetch_or(un + 2, (unsigned)m1, __ATOMIC_RELAXED, __HIP_MEMORY_SCOPE_WORKGROUP); __hip_atomic_fetch_or(un + 3, (unsigned)(m1 >> 32), __ATOMIC_RELAXED, __HIP_MEMORY_SCOPE_WORKGROUP); }
      }
    }
    __syncthreads();
    int NTs; unsigned sw0, sw1, sw2, sw3;
    { const unsigned u0 = un[0], u1 = un[1], u2 = un[2], u3 = un[3];
      NTs = __popc(u0) + __popc(u1) + __popc(u2) + __popc(u3);
      if (tid < 128) { const int wsel = tid >> 5, bpos = tid & 31; const unsigned w = wsel == 0 ? u0 : (wsel == 1 ? u1 : (wsel == 2 ? u2 : u3));
          if ((w >> bpos) & 1u) { const int below = (wsel > 0 ? __popc(u0) : 0) + (wsel > 1 ? __popc(u1) : 0) + (wsel > 2 ? __popc(u2) : 0) + __popc(w & ((1u << bpos) - 1u)); list[below] = tid; } }
      sw0 = selm[ql * 4 + 0]; sw1 = selm[ql * 4 + 1]; sw2 = selm[ql * 4 + 2]; sw3 = selm[ql * 4 + 3]; }
    __syncthreads();
    NSTAMP(24);
    m_x = 0.f; l_x = 1.f;
    if (NSA_FIXM_SLC) { int t_ = threadIdx.x; asm volatile("" : "+v"(t_)); m_x = sqrtf(qrow_norm2<8>(qr) * __uint_as_float(((const unsigned*)(ws + WS_CTL + CTL_KMX))[b * 20 + 16 + g])) * 1.002f + misc[MISC_LUTMAX + 8 + g * 4 + (t_ & 3)]; }
    if (NSA_PARTS & 8) NSA_ENGINE<M_SLC, 128, false, NSA_FIXM_SLC, ATT_FUSE, false, NSA_KGS_SLC, NSA_SMP2_SLC, NSA_KPRE_SLC, NSA_VPRE_SLC, NSA_KDB_SLC, ATT_PRIO, ATT_DMAPOS>(lds, proj + tokb * LDP + C_KS + g * 128, proj + tokb * LDP + C_VS + g * 128, LDP, 0, NTs, list, qr, 0, L, lds_addr(lds + L_SEL) + (unsigned)ql * 16u, 0u, 0u, 0u, o, m_x, l_x);
    if (ATT_HEADPRE && (NSA_PARTS & 16)) { const int jlo = qb > 8 ? qb - 8 : 0; head_dma(lds, proj + tokb * LDP + C_KW + g * 128, proj + tokb * LDP + C_VW + g * 128, LDP, jlo, qb - jlo + 1); }
    { int t_ = threadIdx.x; asm volatile("" : "+v"(t_)); const int r32_ = t_ & 31, hi_ = (t_ >> 5) & 1;
      ALAS float* li2 = (ALAS float*)(lds + L_WS) + wid * 64;
      const float sc = l_x > 0.f ? NSA_GATE(1) / l_x : 0.f; if (hi_ == 0) li2[r32_] = sc; asm volatile("s_waitcnt lgkmcnt(0)" ::: "memory");
      float* ap = NSA_ACCP; float lv[16];
#pragma unroll
      for (int r = 0; r < 16; ++r) lv[r] = li2[crow(r, hi_)];
#pragma unroll
      for (int d0 = 0; d0 < 4; ++d0) { float t[16];
#pragma unroll
          for (int r = 0; r < 16; ++r) t[r] = ap[64 * r];
#pragma unroll
          for (int r = 0; r < 16; ++r) ap[64 * r] = t[r] + o[d0][r] * lv[r];
          ap += 1024; asm volatile("" : "+v"(ap)); } }
    NSTAMP(25);
    if (NSA_FIXM_WIN) { int t_ = threadIdx.x; asm volatile("" : "+v"(t_)); m_x = sqrtf(qrow_norm2<8>(qr) * __uint_as_float(((const unsigned*)(ws + WS_CTL + CTL_KMX))[b * 20 + 18 + g])) * 1.002f + misc[MISC_LUTMAX + 8 + g * 4 + (t_ & 3)]; }
    if (NSA_PARTS & 16) { const int jlo = qb > 8 ? qb - 8 : 0;
      NSA_ENGINE<M_WIN, 128, false, NSA_FIXM_WIN, ATT_FUSE, false, NSA_KGS_WIN, NSA_SMP2_WIN, NSA_KPRE_WIN, NSA_VPRE_WIN, NSA_KDB_WIN, ATT_PRIO, ATT_DMAPOS, ATT_HEADPRE>(lds, proj + tokb * LDP + C_KW + g * 128, proj + tokb * LDP + C_VW + g * 128, LDP, jlo, qb - jlo + 1, nullptr, qr, 0, L, 0u, 0u, 0u, 0u, o, m_x, l_x); }
    { int t_ = threadIdx.x; asm volatile("" : "+v"(t_)); const int r32_ = t_ & 31, hi_ = (t_ >> 5) & 1;
      ALAS float* li2 = (ALAS float*)(lds + L_WS) + wid * 64;
      const float sc = l_x > 0.f ? NSA_GATE(2) / l_x : 0.f; if (hi_ == 0) li2[r32_] = sc; asm volatile("s_waitcnt lgkmcnt(0)" ::: "memory");
      float* ap = NSA_ACCP; float lv[16];
#pragma unroll
      for (int r = 0; r < 16; ++r) lv[r] = li2[crow(r, hi_)];
#pragma unroll
      for (int d0 = 0; d0 < 4; ++d0) { float t[16];
#pragma unroll
          for (int r = 0; r < 16; ++r) t[r] = ap[64 * r];
          ap += 1024; asm volatile("" : "+v"(ap));
#pragma unroll
          for (int r = 0; r < 16; ++r) { const int rho = crow(r, hi_); const float v = t[r] + o[d0][r] * lv[r]; const float vn = swz_xor<1>(v);
              if ((r32_ & 1) == 0) *(unsigned*)(mix + (tokb + t0 + 8 * wid + (rho >> 2)) * DM + 1024 + g * 512 + (rho & 3) * 128 + 32 * d0 + r32_) = cvtpk(v, vn); } } }
    NSTAMP(26);
#undef NSA_GATE
#undef NSA_ACCP
}

__device__ __forceinline__ void unpack8(const v4u w, float* f) {
    f[0] = __uint_as_float(w.x << 16); f[1] = __uint_as_float(w.x & 0xffff0000u); f[2] = __uint_as_float(w.y << 16); f[3] = __uint_as_float(w.y & 0xffff0000u);
    f[4] = __uint_as_float(w.z << 16); f[5] = __uint_as_float(w.z & 0xffff0000u); f[6] = __uint_as_float(w.w << 16); f[7] = __uint_as_float(w.w & 0xffff0000u);
}
__device__ __forceinline__ void p5_row(const float* xrow, bf16* yrow, const float* g1, const float* g2, bf16* hrow, int lane) {
    float y[4][8]; float s = 0.f;
#pragma unroll
    for (int j = 0; j < 4; ++j) { unpack8(*(const v4u*)(yrow + 8 * lane + 512 * j), y[j]);
#pragma unroll
        for (int e = 0; e < 8; ++e) s += y[j][e] * y[j][e]; }
    const float r1 = 1.0f / sqrtf(wave_sum(s) * (1.0f / DM) + EPS);
    float s2 = 0.f;
#pragma unroll
    for (int j = 0; j < 4; ++j) { const int c = 8 * lane + 512 * j;
        const f32x4 xa = *(const f32x4*)(xrow + c), xb = *(const f32x4*)(xrow + c + 4), ga = *(const f32x4*)(g1 + c), gb = *(const f32x4*)(g1 + c + 4);
        f32x4 va, vb;
#pragma unroll
        for (int e = 0; e < 4; ++e) { va[e] = xa[e] + y[j][e] * r1 * ga[e]; vb[e] = xb[e] + y[j][4 + e] * r1 * gb[e]; y[j][e] = va[e]; y[j][4 + e] = vb[e]; s2 += va[e] * va[e] + vb[e] * vb[e]; }
        { v4u w; w.x = cvtpk2(va[0], va[1]); w.y = cvtpk2(va[2], va[3]); w.z = cvtpk2(vb[0], vb[1]); w.w = cvtpk2(vb[2], vb[3]); *(v4u*)(yrow + c) = w; } }
    const float r2 = 1.0f / sqrtf(wave_sum(s2) * (1.0f / DM) + EPS);
#pragma unroll
    for (int j = 0; j < 4; ++j) { const int c = 8 * lane + 512 * j; const f32x4 ga = *(const f32x4*)(g2 + c), gb = *(const f32x4*)(g2 + c + 4);
        v4u w; w.x = cvtpk2(y[j][0] * r2 * ga[0], y[j][1] * r2 * ga[1]); w.y = cvtpk2(y[j][2] * r2 * ga[2], y[j][3] * r2 * ga[3]);
        w.z = cvtpk2(y[j][4] * r2 * gb[0], y[j][5] * r2 * gb[1]); w.w = cvtpk2(y[j][6] * r2 * gb[2], y[j][7] * r2 * gb[3]);
        *(v4u*)(hrow + c) = w; }
}
__device__ __forceinline__ void p9_row(float* orow, const bf16* x1row, const bf16* yrow, const float* g, int lane) {
    float y[4][8]; float s = 0.f;
#pragma unroll
    for (int j = 0; j < 4; ++j) { unpack8(*(const v4u*)(yrow + 8 * lane + 512 * j), y[j]);
#pragma unroll
        for (int e = 0; e < 8; ++e) s += y[j][e] * y[j][e]; }
    const float r1 = 1.0f / sqrtf(wave_sum(s) * (1.0f / DM) + EPS);
#pragma unroll
    for (int j = 0; j < 4; ++j) { const int c = 8 * lane + 512 * j; float x1[8]; unpack8(*(const v4u*)(x1row + c), x1);
        const f32x4 ga = *(const f32x4*)(g + c), gb = *(const f32x4*)(g + c + 4);
        f32x4 va, vb;
#pragma unroll
        for (int e = 0; e < 4; ++e) { va[e] = x1[e] + y[j][e] * r1 * ga[e]; vb[e] = x1[4 + e] + y[j][4 + e] * r1 * gb[e]; }
        *(f32x4*)(orow + c) = va; *(f32x4*)(orow + c + 4) = vb; }
}
__device__ __forceinline__ void p5_rows(const float* x, bf16* ybase, const float* g1, const float* g2, bf16* hbase, int gw, int NGW, int lane) {
    int m = gw; if (m >= TOK) return;
    v4u yn[4]; f32x4 xn[8];
#define P5_LOAD(m_) do { _Pragma("unroll") for (int j = 0; j < 4; ++j) { const size_t o_ = (size_t)(m_) * DM + 8 * lane + 512 * j; yn[j] = __builtin_nontemporal_load((const v4u*)(ybase + o_)); xn[2 * j] = __builtin_nontemporal_load((const f32x4*)(x + o_)); xn[2 * j + 1] = __builtin_nontemporal_load((const f32x4*)(x + o_ + 4)); } } while (0)
    P5_LOAD(m);
    f32x4 g1v[8], g2v[8];
#pragma unroll
    for (int j = 0; j < 4; ++j) { const int c = 8 * lane + 512 * j; g1v[2 * j] = *(const f32x4*)(g1 + c); g1v[2 * j + 1] = *(const f32x4*)(g1 + c + 4); g2v[2 * j] = *(const f32x4*)(g2 + c); g2v[2 * j + 1] = *(const f32x4*)(g2 + c + 4); }
#pragma unroll 1
    for (; m < TOK; m += NGW) {
        float y[4][8]; f32x4 xc[8]; float s = 0.f;
#pragma unroll
        for (int j = 0; j < 4; ++j) { unpack8(yn[j], y[j]); xc[2 * j] = xn[2 * j]; xc[2 * j + 1] = xn[2 * j + 1];
#pragma unroll
            for (int e = 0; e < 8; ++e) s += y[j][e] * y[j][e]; }
        if (m + NGW < TOK) P5_LOAD(m + NGW);
        bf16* yrow = ybase + (size_t)m * DM; bf16* hrow = hbase + (size_t)m * DM;
        const float r1 = 1.0f / sqrtf(wave_sum(s) * (1.0f / DM) + EPS);
        float s2 = 0.f;
#pragma unroll
        for (int j = 0; j < 4; ++j) { const int c = 8 * lane + 512 * j;
            const f32x4 xa = xc[2 * j], xb = xc[2 * j + 1], ga = g1v[2 * j], gb = g1v[2 * j + 1];
            f32x4 va, vb;
#pragma unroll
            for (int e = 0; e < 4; ++e) { va[e] = xa[e] + y[j][e] * r1 * ga[e]; vb[e] = xb[e] + y[j][4 + e] * r1 * gb[e]; y[j][e] = va[e]; y[j][4 + e] = vb[e]; s2 += va[e] * va[e] + vb[e] * vb[e]; }
            { v4u w; w.x = cvtpk2(va[0], va[1]); w.y = cvtpk2(va[2], va[3]); w.z = cvtpk2(vb[0], vb[1]); w.w = cvtpk2(vb[2], vb[3]); *(v4u*)(yrow + c) = w; } }
        const float r2 = 1.0f / sqrtf(wave_sum(s2) * (1.0f / DM) + EPS);
#pragma unroll
        for (int j = 0; j < 4; ++j) { const int c = 8 * lane + 512 * j; const f32x4 ga = g2v[2 * j], gb = g2v[2 * j + 1];
            v4u w; w.x = cvtpk2(y[j][0] * r2 * ga[0], y[j][1] * r2 * ga[1]); w.y = cvtpk2(y[j][2] * r2 * ga[2], y[j][3] * r2 * ga[3]);
            w.z = cvtpk2(y[j][4] * r2 * gb[0], y[j][5] * r2 * gb[1]); w.w = cvtpk2(y[j][6] * r2 * gb[2], y[j][7] * r2 * gb[3]);
            *(v4u*)(hrow + c) = w; }
    }
#undef P5_LOAD
}
__device__ __forceinline__ void p9_rows(float* obase, const bf16* x1base, const bf16* ybase, const float* g, int gw, int NGW, int lane) {
    int m = gw; if (m >= TOK) return;
    v2u yn[8], xn[8];
#define P9_LOAD(m_) do { _Pragma("unroll") for (int j = 0; j < 8; ++j) { const size_t o_ = (size_t)(m_) * DM + 4 * lane + 256 * j; yn[j] = __builtin_nontemporal_load((const v2u*)(ybase + o_)); xn[j] = __builtin_nontemporal_load((const v2u*)(x1base + o_)); } } while (0)
    P9_LOAD(m);
    f32x4 gv9[8];
#pragma unroll
    for (int j = 0; j < 8; ++j) gv9[j] = *(const f32x4*)(g + 4 * lane + 256 * j);
#pragma unroll 1
    for (; m < TOK; m += NGW) {
        f32x4 y[8], x1[8]; float s = 0.f;
#pragma unroll
        for (int j = 0; j < 8; ++j) {
            y[j][0] = __uint_as_float(yn[j].x << 16); y[j][1] = __uint_as_float(yn[j].x & 0xffff0000u); y[j][2] = __uint_as_float(yn[j].y << 16); y[j][3] = __uint_as_float(yn[j].y & 0xffff0000u);
            x1[j][0] = __uint_as_float(xn[j].x << 16); x1[j][1] = __uint_as_float(xn[j].x & 0xffff0000u); x1[j][2] = __uint_as_float(xn[j].y << 16); x1[j][3] = __uint_as_float(xn[j].y & 0xffff0000u);
            s += (y[j][0] * y[j][0] + y[j][1] * y[j][1]) + (y[j][2] * y[j][2] + y[j][3] * y[j][3]); }
        if (m + NGW < TOK) P9_LOAD(m + NGW);
        float* orow = obase + (size_t)m * DM;
        const float r1 = 1.0f / sqrtf(wave_sum(s) * (1.0f / DM) + EPS);
#pragma unroll
        for (int j = 0; j < 8; ++j) { f32x4 va;
#pragma unroll
            for (int e = 0; e < 4; ++e) va[e] = x1[j][e] + y[j][e] * r1 * gv9[j][e];
            __builtin_nontemporal_store(va, (f32x4*)(orow + 4 * lane + 256 * j)); }
    }
#undef P9_LOAD
}
__device__ __forceinline__ f32x4 ld4bf(const bf16* p) { const v2u w = *(const v2u*)p; f32x4 r; r[0] = __uint_as_float(w.x << 16); r[1] = __uint_as_float(w.x & 0xffff0000u); r[2] = __uint_as_float(w.y << 16); r[3] = __uint_as_float(w.y & 0xffff0000u); return r; }
__device__ __forceinline__ void p7_halo(const Ptrs& P, int gt, int NGT) {
    unsigned char* ws = P.ws; const bf16* halo = (const bf16*)(ws + WS_HALO); bf16* act = (bf16*)(ws + WS_ACT);
    const float* cw = P.in[19]; const float* cb = P.in[20];
    constexpr int C4 = DFF / 4;
    for (int it = gt; it < 256 * 2 * C4; it += NGT) {
        const int c4 = it % C4, i = (it / C4) & 1, s = it / (2 * C4), c = 4 * c4;
        const bool first = (s & 127) == 0;
        const f32x4 z = {0.f, 0.f, 0.f, 0.f};
        const bf16* hc = halo + ((size_t)s * 4 + i) * NUP + c;
        const int sp = first ? s : s - 1;
        const bf16* hp3 = halo + ((size_t)sp * 4 + 3) * NUP + c; const bf16* hp2 = halo + ((size_t)sp * 4 + 2) * NUP + c; const bf16* h0 = halo + ((size_t)s * 4 + 0) * NUP + c;
        const f32x4 cg = ld4bf(hc), cu = ld4bf(hc + DFF);
        f32x4 g1, g2, u1, u2;
        if (i == 1) { g1 = ld4bf(h0); u1 = ld4bf(h0 + DFF); if (first) { g2 = z; u2 = z; } else { g2 = ld4bf(hp3); u2 = ld4bf(hp3 + DFF); } }
        else { if (first) { g1 = z; u1 = z; g2 = z; u2 = z; } else { g1 = ld4bf(hp3); u1 = ld4bf(hp3 + DFF); g2 = ld4bf(hp2); u2 = ld4bf(hp2 + DFF); } }
        const f32x4 wg0 = *(const f32x4*)(cw + c), wg1 = *(const f32x4*)(cw + NUP + c), wg2 = *(const f32x4*)(cw + 2 * NUP + c), bg = *(const f32x4*)(cb + c);
        const f32x4 wu0 = *(const f32x4*)(cw + DFF + c), wu1 = *(const f32x4*)(cw + NUP + DFF + c), wu2 = *(const f32x4*)(cw + 2 * NUP + DFF + c), bu = *(const f32x4*)(cb + DFF + c);
        const f32x4 yg = bg + wg0 * g2 + wg1 * g1 + wg2 * cg, yu = bu + wu0 * u2 + wu1 * u1 + wu2 * cu;
        v2u w; w.x = pk2(gelu_tanh_f(yg.x) * yu.x, gelu_tanh_f(yg.y) * yu.y); w.y = pk2(gelu_tanh_f(yg.z) * yu.z, gelu_tanh_f(yg.w) * yu.w);
        *(v2u*)(act + (size_t)(64 * s + i) * DFF + c) = w;
    }
}
typedef Ptrs Args;
__global__ void __launch_bounds__(NWAVES * 64, 2) hybrid_fwd(Args args) {
    extern __shared__ __attribute__((aligned(16))) unsigned char lds_raw[];
    LAS unsigned char* lds = (LAS unsigned char*)lds_raw;
    volatile LAS unsigned* MISCW = (volatile LAS unsigned*)(lds + MISC_OFF);
    const int tid = threadIdx.x, lane = tid & 63, wave = __builtin_amdgcn_readfirstlane(tid >> 6);
    const int G = gridDim.x; const int bx = blockIdx.x; const int vcu = (G % 8 == 0) ? (bx % 8) * (G / 8) + bx / 8 : bx;
    const Args& P = args;
    unsigned char* ws = args.ws;
    gu32* ctl = (gu32*)(ws + WS_CTL);
    for (int u = tid; u < (LDS_BYTES - LDSCTL_OFF) / 4; u += NWAVES * 64) ((LAS unsigned*)(lds + LDSCTL_OFF))[u] = 0u;
    __syncthreads();
    XcdBarrier bar; bar.bar = (unsigned*)(ctl + CW_BAR); bar.x = 0; bar.st = nullptr;
    if (N_LAUNCHES == 1) bar = xcd_barrier_post((unsigned*)(ctl + CW_BAR), MISCW + 8);
#define GRID_BAR() do { if (N_LAUNCHES == 1) xcd_barrier(bar); } while (0)
    const int lo = args.ph_lo, hi = args.ph_hi;
#ifndef PH_MASK
#define PH_MASK 0x3ff
#endif
#define IN(k) (((PH_MASK >> (k)) & 1) && lo <= (k) && (k) < hi)
#define BOTH(k) (IN(k) && IN((k) + 1))
    const int gw = vcu * NWAVES + wave, NGW = G * NWAVES;
#ifdef TSEL_A
    unsigned long long* tsw = (unsigned long long*)(ws + WS_CTL + 8192);
#define STAMP(k) do { if (vcu == 0 && tid == 0) tsw[(k)] = __builtin_amdgcn_s_memrealtime(); } while (0)
#else
#define STAMP(k) do {} while (0)
#endif
    STAMP(0);
#ifndef REP_PHASE
#define REP_PHASE -1
#endif
#define REPS(k) _Pragma("unroll 1") for (int rep_ = 0; rep_ < ((REP_PHASE == (k)) ? 2 : 1); ++rep_)
#define REPBAR(k) do { if ((REP_PHASE == (k)) && rep_ == 0) GRID_BAR(); } while (0)

    if (IN(0)) { REPS(0) { p0_prologue(P, lds, vcu, G, tid, lane, wave); REPBAR(0); } if (BOTH(0)) GRID_BAR(); STAMP(1); }

    if (IN(1)) { REPS(1) {
        { const int gt = (vcu == G - 1) ? tid : 512;
          if (gt < 512) { float* misc = (float*)(ws + WS_MISC); float s = 0.f; for (int kc = 0; kc < 64; ++kc) s += misc[MISC_B1 + ((gt >> 8) * 64 + kc) * 256 + (gt & 255)]; misc[MISC_B1F + gt] = s; } }
        pg8::Gemm g{(const pg8::bf16_t*)(ws + WS_H), (const pg8::bf16_t*)(ws + WS_WIN), TOK, LDP, DM}; pg8::StaticOrder S; S.init(TOK, LDP, G, bx);
        pg8::EpiProj E{(pg8::bf16_t*)(ws + WS_PROJ), LDP, (float*)(ws + WS_GATES), C2D, C2N};
        pg8::gemm_phase<pg8::EpiProj, pg8::StaticOrder, true, true>(lds + RING_OFF, g, S, E); REPBAR(1); }
        if (BOTH(1)) GRID_BAR(); STAMP(2);
    }

    if (IN(2)) { REPS(2) {
        for (int u = vcu; u < 256; u += G) cmp_unit(P, lds, u, tid, lane, wave);
        knorm_prep(P, lds, vcu, G, tid, lane, wave);
 REPBAR(2); }
        if (BOTH(2)) GRID_BAR(); STAMP(3);
    }

    if (IN(3)) { REPS(3) {
        STAMP(20);
#ifdef CLKPROBE
        unsigned long long ck0_ = 0, ck1_ = 0, rt0_ = 0, rt1_ = 0; if (vcu == 0 && tid == 0) { ck0_ = __builtin_amdgcn_s_memtime(); rt0_ = __builtin_amdgcn_s_memrealtime(); }
#endif
        bool qdone_ = false;
        for (int L = vcu; L < 256; L += G) {
            const int bh = L >> 4, s = L & 15;
#pragma unroll 1
            for (int i = 0; i < 4; ++i) { const int qb = (i == 0) ? 63 - s : (i == 1) ? 32 + s : (i == 2) ? 31 - s : s; diff_unit(P, lds, bh >> 3, bh & 7, qb);
#ifndef P3_QUEUE_ITEMS
#define P3_QUEUE_ITEMS 1
#endif
                if (P3_QUEUE_ITEMS > 0 && !qdone_) qdone_ = p0b_weights(P, lane, P3_QUEUE_ITEMS); }
        }
#ifdef CLKPROBE
        if (CLKPROBE == 0 && vcu == 0 && tid == 0) { ck1_ = __builtin_amdgcn_s_memtime(); rt1_ = __builtin_amdgcn_s_memrealtime(); ((unsigned long long*)(ws + WS_CTL + 40960))[0] = ck1_ - ck0_; ((unsigned long long*)(ws + WS_CTL + 40960))[1] = rt1_ - rt0_; }
        if (CLKPROBE == 1 && vcu == 0 && tid == 0) { ck0_ = __builtin_amdgcn_s_memtime(); rt0_ = __builtin_amdgcn_s_memrealtime(); }
#endif
        for (int L = vcu; L < 256; L += G) { const int bg = L >> 6, s = L & 63;
#pragma unroll 1
            for (int i = 0; i < 2; ++i) nsa_unit(P, lds, bg, i ? s : 127 - s); }
#ifdef CLKPROBE
        if (CLKPROBE == 1 && vcu == 0 && tid == 0) { ck1_ = __builtin_amdgcn_s_memtime(); rt1_ = __builtin_amdgcn_s_memrealtime(); ((unsigned long long*)(ws + WS_CTL + 40960))[0] = ck1_ - ck0_; ((unsigned long long*)(ws + WS_CTL + 40960))[1] = rt1_ - rt0_; }
#endif
        p0b_weights(P, lane); REPBAR(3); }
        if (BOTH(3)) GRID_BAR(); STAMP(4);
    }

    if (IN(4)) { REPS(4) {
        __syncthreads();
        pg8::Gemm g{(const pg8::bf16_t*)(ws + WS_MIX), (const pg8::bf16_t*)(ws + WS_WOUT), TOK, DM, DM}; pg8::StaticOrder S; S.init(TOK, DM, G, bx);
        pg8::EpiBf16Plain E{(pg8::bf16_t*)(ws + WS_Y), DM};
        pg8::gemm_phase<pg8::EpiBf16Plain, pg8::StaticOrder, true, true>(lds + RING_OFF, g, S, E); REPBAR(4); }
        if (BOTH(4)) GRID_BAR(); STAMP(5);
    }

    if (IN(5)) {
        p5_rows(P.in[0], (bf16*)(ws + WS_Y), P.in[16], P.in[17], (bf16*)(ws + WS_H), gw, NGW, lane);
        if (BOTH(5)) GRID_BAR(); STAMP(6);
    }

    if (IN(6)) { REPS(6) {
        pg8::Gemm g{(const pg8::bf16_t*)(ws + WS_H), (const pg8::bf16_t*)(ws + WS_WUP), TOK, NUP, DM}; pg8::StaticOrder S; S.init(TOK, NUP, G, bx);
        pg8::EpiUpGlu E{(pg8::bf16_t*)(ws + WS_ACT), (pg8::bf16_t*)(ws + WS_HALO), P.in[19], P.in[20], DFF};
        pg8::gemm_phase<pg8::EpiUpGlu, pg8::StaticOrder, true, true>(lds + RING_OFF, g, S, E); REPBAR(6); }
        if (BOTH(6)) GRID_BAR(); STAMP(7);
    }

    if (IN(7)) { p7_halo(P, vcu * (NWAVES * 64) + tid, G * NWAVES * 64); if (BOTH(7)) GRID_BAR(); STAMP(8); }

    if (IN(8)) { REPS(8) {
        pg8::Gemm g{(const pg8::bf16_t*)(ws + WS_ACT), (const pg8::bf16_t*)(ws + WS_WDN), TOK, DM, DFF}; pg8::StaticOrder S; S.init(TOK, DM, G, bx);
        pg8::EpiBf16Plain E{(pg8::bf16_t*)(ws + WS_Y2), DM};
        pg8::gemm_phase<pg8::EpiBf16Plain, pg8::StaticOrder, true, true>(lds + RING_OFF, g, S, E); REPBAR(8); }
        if (BOTH(8)) GRID_BAR(); STAMP(9);
    }

    if (IN(9)) {
        p9_rows(P.out, (const bf16*)(ws + WS_Y), (const bf16*)(ws + WS_Y2), P.in[22], gw, NGW, lane);
#ifdef CLKPROBE
        if (vcu == 0) { asm volatile("s_waitcnt vmcnt(0) lgkmcnt(0)" ::: "memory"); __syncthreads(); if (tid == 0) { const unsigned long long* w = (const unsigned long long*)(ws + WS_CTL + 40960);
            const float ratio = (float)w[0] / (float)(w[1] ? w[1] : 1ull); P.out[0] += 20.0f + floorf(ratio + 0.5f); } }
#endif
#ifdef EPROBE
        if (vcu == 0) { asm volatile("s_waitcnt vmcnt(0) lgkmcnt(0)" ::: "memory"); __syncthreads(); if (tid == 0) { const unsigned long long* w = (const unsigned long long*)(ws + WS_CTL + 40960);
            const unsigned long long* tsw2 = (const unsigned long long*)(ws + WS_CTL + 8192);
            const float ratio = (float)w[0] / (float)(tsw2[3] - tsw2[20]); P.out[0] += 20.0f + floorf(ratio * 40.0f + 0.5f); } }
#endif
#ifdef TPROBE_SEC
        if (vcu == 0) { asm volatile("s_waitcnt vmcnt(0) lgkmcnt(0)" ::: "memory"); __syncthreads(); if (tid == 0) { const unsigned long long* w = (const unsigned long long*)(ws + WS_CTL + 40960);
            const float ratio = (float)w[0] / (float)(w[1] ? w[1] : 1ull); P.out[0] += 20.0f + floorf(ratio * 40.0f + 0.5f); } }
#endif
#ifdef TSEL_A
        STAMP(10);
        if (vcu == 0) { asm volatile("s_waitcnt vmcnt(0) lgkmcnt(0)" ::: "memory"); __syncthreads(); if (tid == 0) { const float us = (float)(tsw[TSEL_B] - tsw[TSEL_A]) * 0.01f; P.out[0] += us; } }
#endif
    }
#undef IN
#undef BOTH
#undef GRID_BAR
}

extern "C" void kernel_launch(void* const* d_in, const int* in_sizes, int n_in, void* d_out, int out_size, void* d_ws, size_t ws_size, hipStream_t stream) {
    static int grid = 0;
    if (grid == 0) {
        if (n_in != NIN || in_sizes[0] != TOK * DM || out_size != TOK * DM || ws_size < WS_END) {
            fprintf(stderr, "kernel_launch: shape mismatch (n_in %d, in0 %d, out %d, ws %zu; need %zu bytes of workspace); nothing launched\n", n_in, n_in > 0 ? in_sizes[0] : -1, out_size, ws_size, (size_t)WS_END); grid = -1; return; }
        int dev = 0, cus = 0, per_cu = 0;
        if (hipGetDevice(&dev) != hipSuccess || hipDeviceGetAttribute(&cus, hipDeviceAttributeMultiprocessorCount, dev) != hipSuccess) { fprintf(stderr, "kernel_launch: device query failed\n"); grid = -1; return; }
        if (hipFuncSetAttribute((const void*)hybrid_fwd, hipFuncAttributeMaxDynamicSharedMemorySize, LDS_BYTES) != hipSuccess) { fprintf(stderr, "kernel_launch: hipFuncSetAttribute failed\n"); grid = -1; return; }
        if (hipOccupancyMaxActiveBlocksPerMultiprocessor(&per_cu, (const void*)hybrid_fwd, NWAVES * 64, LDS_BYTES) != hipSuccess || per_cu < 1)
            fprintf(stderr, "kernel_launch: note: occupancy query reports %d workgroups per CU\n", per_cu);
        (void)hipGetLastError();
        grid = cus;
    }
    if (grid < 0) return;
    if (hipMemsetAsync((char*)d_ws + WS_CTL, 0, CTL_ZERO_BYTES, stream) != hipSuccess) { fprintf(stderr, "kernel_launch: hipMemsetAsync failed\n"); return; }
    Args a{};
    for (int i = 0; i < NIN; ++i) a.in[i] = (const float*)d_in[i];
    a.out = (float*)d_out; a.ws = (unsigned char*)d_ws;
    for (int li = 0; li < N_LAUNCHES; ++li) {
        a.ph_lo = (N_LAUNCHES == PER_PHASE) ? li : 0; a.ph_hi = (N_LAUNCHES == PER_PHASE) ? li + 1 : PER_PHASE;
        hipLaunchKernelGGL(hybrid_fwd, dim3(grid), dim3(NWAVES * 64), LDS_BYTES, stream, a);
        const hipError_t le = hipPeekAtLastError();
        if (le != hipSuccess) { fprintf(stderr, "kernel_launch: launch %d failed: %s\n", li, hipGetErrorName(le)); break; }
    }
}
```

```cpp
#include <hip/hip_runtime.h>
#include <hip/hip_bf16.h>
#include <cstdio>
#include <cstdint>
namespace pg8 {
#define PG8_LAS __attribute__((address_space(3)))
typedef unsigned short bf16_t;
typedef short bf16x8 __attribute__((ext_vector_type(8)));
typedef float f32x4 __attribute__((ext_vector_type(4)));
typedef unsigned u32x4 __attribute__((ext_vector_type(4)));
constexpr int BM = 256, BK = 64, HALF = 128, HTB = HALF * BK * 2  , STAGE_BYTES = 8 * HTB, NXCD = 8, WGM = 8;

__host__ __device__ __forceinline__ int lds_byte(int r, int c) { const int st = (r >> 4) * 2 + (c >> 5), rr = r & 15, cc = c & 31, ob = rr * 64 + cc * 2; return st * 1024 + (ob ^ (((ob >> 9) & 1) << 5)); }
__host__ __device__ __forceinline__ void stage_rc(int b, int& R, int& C) { const int st = b / 1024, sb = b % 1024, swz = sb ^ (((sb >> 9) & 1) << 5); R = (st >> 1) * 16 + swz / 64; C = (st & 1) * 32 + (swz % 64) / 2; }
__host__ __device__ __forceinline__ int perm32(int rho) { const int n = rho >> 4, i = rho & 15; return 8 * (i >> 2) + 4 * n + (i & 3); }

struct Unit { int pm, pn; };
struct Gemm { const bf16_t* A; const bf16_t* Bt; int M, N, K; };

struct StaticOrder {
    int nM, nN, nwg, G, c;
    __host__ __device__ void init(int M, int N, int G_, int c_) { nM = M / BM; nN = N / BM; nwg = nM * nN; G = G_; c = c_; }
    __host__ __device__ bool next(int i, Unit& u) const {
        const long L = (long)i * G + c; if (L >= nwg) return false;
        int wgid = (int)L; { const int q = nwg / NXCD, r = nwg % NXCD, xcd = wgid % NXCD, off = wgid / NXCD; wgid = (xcd < r ? xcd * (q + 1) : r * (q + 1) + (xcd - r) * q) + off; }
        const int nig = WGM * nN, gid = wgid / nig, fm = gid * WGM, gsz = (nM - fm) < WGM ? (nM - fm) : WGM;
        u.pm = fm + ((wgid % nig) % gsz); u.pn = (wgid % nig) / gsz; return true;
    }
    __device__ __forceinline__ void a_ready(const Unit&) const {}
    __device__ __forceinline__ void done(const Unit&) const {}
};


__device__ __forceinline__ unsigned cvt_pk_bf16(float lo, float hi) { unsigned r; asm volatile("v_cvt_pk_bf16_f32 %0, %1, %2" : "=v"(r) : "v"(lo), "v"(hi)); return r; }
__device__ __forceinline__ float fast_sigmoid(float v) { return __builtin_amdgcn_rcpf(1.0f + __builtin_amdgcn_exp2f(-1.4426950408889634f * v)); }
__device__ __forceinline__ float gelu_tanh(float v) { const float z2 = 1.5957691216f * (v + 0.044715f * v * v * v); return v * __builtin_amdgcn_rcpf(1.0f + __builtin_amdgcn_exp2f(-1.4426950408889634f * z2)); }

struct EpiF32 {
    static constexpr bool PERM = false, AFTER_DRAIN = false;
    float* C; int ldc;
    __device__ __forceinline__ void operator()(const f32x4 (&acc)[2][2][4][2], const Unit& u, int wr, int wc, int fr, int fq) const {
        const int row0 = u.pm * BM + wr * 64 + fr, col0 = u.pn * BM + wc * 32 + 4 * fq;
#pragma unroll
        for (int ai = 0; ai < 2; ++ai)
#pragma unroll
            for (int m = 0; m < 4; ++m) { float* rowp = C + (size_t)(row0 + ai * HALF + m * 16) * ldc + col0;
#pragma unroll
                for (int bj = 0; bj < 2; ++bj)
#pragma unroll
                    for (int n = 0; n < 2; ++n) *(f32x4*)(rowp + bj * HALF + n * 16) = acc[ai][bj][m][n]; }
    }
};
struct EpiBf16Plain {
    static constexpr bool PERM = true, AFTER_DRAIN = false;
    bf16_t* O; int ldc;
    __device__ __forceinline__ void operator()(const f32x4 (&acc)[2][2][4][2], const Unit& u, int wr, int wc, int fr, int fq) const {
        const int row0 = u.pm * BM + wr * 64 + fr, col0 = u.pn * BM + wc * 32 + 8 * fq;
#pragma unroll
        for (int ai = 0; ai < 2; ++ai)
#pragma unroll
            for (int m = 0; m < 4; ++m) { bf16_t* rowp = O + (size_t)(row0 + ai * HALF + m * 16) * ldc + col0;
#pragma unroll
                for (int bj = 0; bj < 2; ++bj) { const f32x4 v0 = acc[ai][bj][m][0], v1 = acc[ai][bj][m][1];
                    u32x4 w; w.x = cvt_pk_bf16(v0[0], v0[1]); w.y = cvt_pk_bf16(v0[2], v0[3]); w.z = cvt_pk_bf16(v1[0], v1[1]); w.w = cvt_pk_bf16(v1[2], v1[3]);
                    *(u32x4*)(rowp + bj * HALF) = w; } }
    }
};
struct EpiProj {
    static constexpr bool PERM = true, AFTER_DRAIN = false;
    bf16_t* O; int ldc; float* gates; float c2d, c2n;
    __device__ __forceinline__ void operator()(const f32x4 (&acc)[2][2][4][2], const Unit& u, int wr, int wc, int fr, int fq) const {
        const int pn = u.pn; const int row0 = u.pm * BM + wr * 64 + fr;
        if (pn == 22) {
            if (wc == 0) {
#pragma unroll
                for (int ai = 0; ai < 2; ++ai)
#pragma unroll
                    for (int m = 0; m < 4; ++m) { float* gp = gates + (size_t)(row0 + ai * HALF + m * 16) * 32 + 8 * fq;
#pragma unroll
                        for (int n = 0; n < 2; ++n) { const f32x4 v = acc[ai][0][m][n]; f32x4 s; s[0] = fast_sigmoid(v[0]); s[1] = fast_sigmoid(v[1]); s[2] = fast_sigmoid(v[2]); s[3] = fast_sigmoid(v[3]); *(f32x4*)(gp + 4 * n) = s; } }
            }
            return;
        }
        const float sc = (pn < 4) ? c2d : ((pn >= 12 && pn < 16) ? c2n : 1.0f);
        const int col0 = pn * BM + wc * 32 + 8 * fq;
#pragma unroll
        for (int ai = 0; ai < 2; ++ai)
#pragma unroll
            for (int m = 0; m < 4; ++m) { bf16_t* rowp = O + (size_t)(row0 + ai * HALF + m * 16) * ldc + col0;
#pragma unroll
                for (int bj = 0; bj < 2; ++bj) { const f32x4 v0 = acc[ai][bj][m][0] * sc, v1 = acc[ai][bj][m][1] * sc;
                    u32x4 w; w.x = cvt_pk_bf16(v0[0], v0[1]); w.y = cvt_pk_bf16(v0[2], v0[3]); w.z = cvt_pk_bf16(v1[0], v1[1]); w.w = cvt_pk_bf16(v1[2], v1[3]);
                    *(u32x4*)(rowp + bj * HALF) = w; } }
    }
};
typedef float f32x2p __attribute__((ext_vector_type(2)));
__device__ __forceinline__ f32x2p glu_pk(f32x2p g, f32x2p u) {
    const f32x2p g2 = g * g;
    const f32x2p t = (g2 * 0.044715f + 1.0f) * g;
    const f32x2p a = t * (-1.4426950408889634f * 1.5957691216f);
    f32x2p e; e.x = __builtin_amdgcn_exp2f(a.x); e.y = __builtin_amdgcn_exp2f(a.y);
    const f32x2p d = e + 1.0f;
    f32x2p r; r.x = __builtin_amdgcn_rcpf(d.x); r.y = __builtin_amdgcn_rcpf(d.y);
    return (g * u) * r;
}
__device__ __forceinline__ float dpp_shr1(float v) { return __builtin_bit_cast(float, __builtin_amdgcn_update_dpp(0, __builtin_bit_cast(int, v), 0x111, 0xF, 0xF, true)); }
__device__ __forceinline__ float dpp_shr2(float v) { return __builtin_bit_cast(float, __builtin_amdgcn_update_dpp(0, __builtin_bit_cast(int, v), 0x112, 0xF, 0xF, true)); }
__device__ __forceinline__ float dpp_shl15(float v) { return __builtin_bit_cast(float, __builtin_amdgcn_update_dpp(0, __builtin_bit_cast(int, v), 0x10F, 0xF, 0xF, true)); }
__device__ __forceinline__ float dpp_shl14(float v) { return __builtin_bit_cast(float, __builtin_amdgcn_update_dpp(0, __builtin_bit_cast(int, v), 0x10E, 0xF, 0xF, true)); }
struct EpiUpGlu {
    static constexpr bool PERM = true, AFTER_DRAIN = false;
    bf16_t* act; bf16_t* halo; const float* cw; const float* cb; int dff;
    __device__ __forceinline__ void operator()(const f32x4 (&acc)[2][2][4][2], const Unit& u, int wr, int wc, int fr, int fq) const {
        typedef unsigned u32x2 __attribute__((ext_vector_type(2)));
        const int nu = 2 * dff;
#pragma unroll
        for (int n = 0; n < 2; ++n) {
            const int cc = u.pn * HALF + wc * 32 + 8 * fq + 4 * n;
            const f32x4 wg0 = *(const f32x4*)(cw + cc), wg1 = *(const f32x4*)(cw + (size_t)nu + cc), wg2 = *(const f32x4*)(cw + (size_t)2 * nu + cc), bg = *(const f32x4*)(cb + cc);
            const f32x4 wu0 = *(const f32x4*)(cw + dff + cc), wu1 = *(const f32x4*)(cw + (size_t)nu + dff + cc), wu2 = *(const f32x4*)(cw + (size_t)2 * nu + dff + cc), bu = *(const f32x4*)(cb + dff + cc);
#pragma unroll
            for (int ai = 0; ai < 2; ++ai) {
                const int strip = 4 * u.pm + 2 * ai + wr; const int rowb = u.pm * BM + ai * HALF + wr * 64 + fr;
#pragma unroll
                for (int m = 0; m < 4; ++m) {
                    const f32x4 g = acc[ai][0][m][n], up = acc[ai][1][m][n]; f32x4 g1, g2, u1, u2;
#pragma unroll
                    for (int e = 0; e < 4; ++e) { g1[e] = dpp_shr1(g[e]); g2[e] = dpp_shr2(g[e]); u1[e] = dpp_shr1(up[e]); u2[e] = dpp_shr2(up[e]); }
                    if (m > 0) { const f32x4 gp = acc[ai][0][m > 0 ? m - 1 : 0][n], upp = acc[ai][1][m > 0 ? m - 1 : 0][n];
#pragma unroll
                        for (int e = 0; e < 4; ++e) { g1[e] += dpp_shl15(gp[e]); g2[e] += dpp_shl14(gp[e]); u1[e] += dpp_shl15(upp[e]); u2[e] += dpp_shl14(upp[e]); } }
                    const f32x4 yg = bg + wg0 * g2 + wg1 * g1 + wg2 * g;
                    const f32x4 yu = bu + wu0 * u2 + wu1 * u1 + wu2 * up;
                    if ((m == 0 && fr < 2) || (m == 3 && fr >= 14)) { bf16_t* hp = halo + ((size_t)strip * 4 + (m == 0 ? fr : fr - 12)) * nu + cc;
                        u32x2 wg_; wg_.x = cvt_pk_bf16(g[0], g[1]); wg_.y = cvt_pk_bf16(g[2], g[3]); *(u32x2*)hp = wg_; u32x2 wu_; wu_.x = cvt_pk_bf16(up[0], up[1]); wu_.y = cvt_pk_bf16(up[2], up[3]); *(u32x2*)(hp + dff) = wu_; }
                    if (m > 0 || fr >= 2) { const f32x2p o01 = glu_pk((f32x2p){yg[0], yg[1]}, (f32x2p){yu[0], yu[1]}), o23 = glu_pk((f32x2p){yg[2], yg[3]}, (f32x2p){yu[2], yu[3]});
                        u32x2 w; w.x = cvt_pk_bf16(o01.x, o01.y); w.y = cvt_pk_bf16(o23.x, o23.y);
                        *(u32x2*)(act + (size_t)(rowb + m * 16) * dff + cc) = w; }
                }
            }
        }
    }
};
template <class Epi, class Sched, bool ALIGN_EPI = false, bool SP2 = false>
__device__ __forceinline__ void gemm_phase(PG8_LAS unsigned char* lds, const Gemm g, const Sched& S, const Epi& E) {
    int tid = threadIdx.x; asm volatile("" : "+v"(tid));
    const int wid = __builtin_amdgcn_readfirstlane(tid >> 6), lane = tid & 63, wr = wid >> 2, wc = wid & 3, fr = lane & 15, fq = lane >> 4;
    const int K = g.K, nt = K / BK;
    unsigned voffA[2], voffB[2];
#pragma unroll
    for (int i = 0; i < 2; ++i) { int R, C; stage_rc(tid * 16 + i * 8192, R, C); const int Rb = Epi::PERM ? ((R & ~31) + perm32(R & 31)) : R;
        voffA[i] = (unsigned)(R * K + C) * 2u; voffB[i] = (unsigned)(Rb * K + C) * 2u; }
    const size_t kstep = (size_t)(BK * 2);
    const size_t hstep = (size_t)HALF * K * 2;
    const size_t tstep = 2 * hstep;
    const unsigned ldsw = (unsigned)wid * 1024u;
    const int aoff = lds_byte(wr * 64 + fr, fq * 8), boff = lds_byte(wc * 32 + fr, fq * 8);
#define PG8_SA(b, h) (((b) * 2 + (h)) * HTB)
#define PG8_SB(b, h) ((4 + (b) * 2 + (h)) * HTB)
#define PG8_STAGE(bufoff, gbase, voff) do { _Pragma("unroll") for (int _i = 0; _i < 2; ++_i) \
        __builtin_amdgcn_global_load_lds((const unsigned*)((const char*)(gbase) + (voff)[_i]), (PG8_LAS unsigned*)(lds + (bufoff) + ldsw + _i * 8192), 16, 0, 0); } while (0)
#define PG8_LDA(dst, b, h) do { _Pragma("unroll") for (int m = 0; m < 4; ++m) _Pragma("unroll") for (int k = 0; k < 2; ++k) dst[m][k] = *(const PG8_LAS bf16x8*)(lds + PG8_SA(b, h) + aoff + m * 2048 + k * 1024); } while (0)
#define PG8_LDB(dst, b, h) do { _Pragma("unroll") for (int n = 0; n < 2; ++n) _Pragma("unroll") for (int k = 0; k < 2; ++k) dst[n][k] = *(const PG8_LAS bf16x8*)(lds + PG8_SB(b, h) + boff + n * 2048 + k * 1024); } while (0)
#define PG8_MMA(ai, bj, At, Bt) do { __builtin_amdgcn_s_setprio(1); _Pragma("unroll") for (int m = 0; m < 4; ++m) _Pragma("unroll") for (int n = 0; n < 2; ++n) _Pragma("unroll") for (int k = 0; k < 2; ++k) \
        acc[ai][bj][m][n] = __builtin_amdgcn_mfma_f32_16x16x32_bf16(Bt[n][k], At[m][k], acc[ai][bj][m][n], 0, 0, 0); __builtin_amdgcn_s_setprio(0); } while (0)
#define PG8_WAIT_V(n) asm volatile("s_waitcnt vmcnt(" #n ")" ::: "memory")
#define PG8_WAIT_L(n) asm volatile("s_waitcnt lgkmcnt(" #n ")" ::: "memory")
#define PG8_BAR __builtin_amdgcn_s_barrier()
#define PG8_SCHED __builtin_amdgcn_sched_barrier(0)
    Unit cur, nxt; int ui = 0;
    if (!S.next(0, cur)) return;
    f32x4 acc[2][2][4][2];
#pragma unroll
    for (int a = 0; a < 2; ++a)
#pragma unroll
        for (int b = 0; b < 2; ++b)
#pragma unroll
            for (int m = 0; m < 4; ++m)
#pragma unroll
                for (int n = 0; n < 2; ++n) acc[a][b][m][n] = (f32x4){0.f, 0.f, 0.f, 0.f};
    bf16x8 At[4][2], B0[2][2], B1[2][2];
    const char* cA = (const char*)g.A + (size_t)cur.pm * tstep; const char* cB = (const char*)g.Bt + (size_t)cur.pn * tstep;
    S.a_ready(cur);
    if constexpr (SP2) {
        PG8_STAGE(PG8_SB(0, 0), cB, voffB); PG8_STAGE(PG8_SB(0, 1), cB + hstep, voffB); PG8_STAGE(PG8_SA(0, 0), cA, voffA); PG8_STAGE(PG8_SA(0, 1), cA + hstep, voffA);
        if (wr == 1) PG8_BAR;
        PG8_WAIT_V(2); PG8_BAR;
        PG8_STAGE(PG8_SB(1, 0), cB + kstep, voffB); PG8_STAGE(PG8_SA(1, 0), cA + kstep, voffA); PG8_STAGE(PG8_SB(1, 1), cB + hstep + kstep, voffB);
        PG8_WAIT_V(6); PG8_BAR;
    } else {
        PG8_STAGE(PG8_SB(0, 0), cB, voffB); PG8_STAGE(PG8_SA(0, 0), cA, voffA); PG8_STAGE(PG8_SB(0, 1), cB + hstep, voffB); PG8_STAGE(PG8_SA(0, 1), cA + hstep, voffA);
        if (wr == 1) PG8_BAR;
        PG8_WAIT_V(4); PG8_BAR;
        PG8_STAGE(PG8_SB(1, 0), cB + kstep, voffB); PG8_STAGE(PG8_SA(1, 0), cA + kstep, voffA); PG8_STAGE(PG8_SB(1, 1), cB + hstep + kstep, voffB);
        PG8_WAIT_V(6); PG8_BAR;
    }
    for (;;) {
        const bool has_next = S.next(ui + 1, nxt);
        const char* nA = has_next ? (const char*)g.A + (size_t)nxt.pm * tstep : cA; const char* nB = has_next ? (const char*)g.Bt + (size_t)nxt.pn * tstep : cB;
        for (int t = 0; t < nt; t += 2) {
            const bool last = (t == nt - 2);
            const char* a1 = cA + (size_t)(t + 1) * kstep;
            const char* a2 = last ? nA : cA + (size_t)(t + 2) * kstep; const char* b2 = last ? nB : cB + (size_t)(t + 2) * kstep;
            const char* a3 = a2 + kstep; const char* b3 = b2 + kstep;
            if (last && has_next) S.a_ready(nxt);
            if constexpr (SP2) {
            PG8_LDB(B0, 0, 0); PG8_LDB(B1, 0, 1); PG8_SCHED; PG8_LDA(At, 0, 0); PG8_STAGE(PG8_SA(1, 1), a1 + hstep, voffA);
            PG8_WAIT_V(8); PG8_WAIT_L(0); PG8_BAR; PG8_MMA(0, 0, At, B0); PG8_MMA(0, 1, At, B1); PG8_BAR; PG8_SCHED;
            PG8_LDA(At, 0, 1); PG8_STAGE(PG8_SB(0, 0), b2, voffB); PG8_STAGE(PG8_SB(0, 1), b2 + hstep, voffB); PG8_STAGE(PG8_SA(0, 0), a2, voffA);
            PG8_WAIT_V(8); PG8_WAIT_L(0); PG8_BAR; PG8_MMA(1, 0, At, B0); PG8_MMA(1, 1, At, B1); PG8_BAR; PG8_SCHED;
            PG8_LDB(B0, 1, 0); PG8_LDB(B1, 1, 1); PG8_SCHED; PG8_LDA(At, 1, 0); PG8_STAGE(PG8_SA(0, 1), a2 + hstep, voffA);
            PG8_WAIT_V(8); PG8_WAIT_L(0); PG8_BAR; PG8_MMA(0, 0, At, B0); PG8_MMA(0, 1, At, B1); PG8_BAR; PG8_SCHED;
            PG8_LDA(At, 1, 1); PG8_STAGE(PG8_SB(1, 0), b3, voffB); PG8_STAGE(PG8_SB(1, 1), b3 + hstep, voffB); PG8_STAGE(PG8_SA(1, 0), a3, voffA);
            PG8_WAIT_V(8); PG8_WAIT_L(0); PG8_BAR; PG8_MMA(1, 0, At, B0); PG8_MMA(1, 1, At, B1); PG8_BAR; PG8_SCHED;
            } else {
            PG8_LDB(B0, 0, 0); PG8_SCHED; PG8_LDA(At, 0, 0); PG8_STAGE(PG8_SA(1, 1), a1 + hstep, voffA);
            PG8_WAIT_L(8); PG8_BAR; PG8_WAIT_L(0); PG8_MMA(0, 0, At, B0); PG8_BAR; PG8_SCHED;
            PG8_LDB(B1, 0, 1); PG8_STAGE(PG8_SB(0, 0), b2, voffB);
            PG8_BAR; PG8_WAIT_L(0); PG8_MMA(0, 1, At, B1); PG8_BAR;
            PG8_LDA(At, 0, 1); PG8_STAGE(PG8_SA(0, 0), a2, voffA);
            PG8_BAR; PG8_WAIT_L(0); PG8_MMA(1, 0, At, B0); PG8_BAR; PG8_SCHED;
            PG8_STAGE(PG8_SB(0, 1), b2 + hstep, voffB);
            PG8_WAIT_V(6); PG8_BAR; PG8_MMA(1, 1, At, B1); PG8_BAR;
            PG8_LDB(B0, 1, 0); PG8_SCHED; PG8_LDA(At, 1, 0); PG8_STAGE(PG8_SA(0, 1), a2 + hstep, voffA);
            PG8_WAIT_L(8); PG8_BAR; PG8_WAIT_L(0); PG8_MMA(0, 0, At, B0); PG8_BAR; PG8_SCHED;
            PG8_LDB(B1, 1, 1); PG8_STAGE(PG8_SB(1, 0), b3, voffB);
            PG8_BAR; PG8_WAIT_L(0); PG8_MMA(0, 1, At, B1); PG8_BAR;
            PG8_LDA(At, 1, 1); PG8_STAGE(PG8_SA(1, 0), a3, voffA);
            PG8_BAR; PG8_WAIT_L(0); PG8_MMA(1, 0, At, B0); PG8_BAR; PG8_SCHED;
            PG8_STAGE(PG8_SB(1, 1), b3 + hstep, voffB);
            PG8_WAIT_V(6); PG8_BAR; PG8_MMA(1, 1, At, B1); PG8_BAR;
            }
        }
        if constexpr (ALIGN_EPI) { if (wr == 0) PG8_BAR; }
        if constexpr (!Epi::AFTER_DRAIN) { E(acc, cur, wr, wc, fr, fq); S.done(cur); }
        if (!has_next) break;
#pragma unroll
        for (int a = 0; a < 2; ++a)
#pragma unroll
            for (int b = 0; b < 2; ++b)
#pragma unroll
                for (int m = 0; m < 4; ++m)
#pragma unroll
                    for (int n = 0; n < 2; ++n) acc[a][b][m][n] = (f32x4){0.f, 0.f, 0.f, 0.f};
        cur = nxt; cA = nA; cB = nB; ++ui;
        if constexpr (ALIGN_EPI) { if (wr == 1) PG8_BAR; }
    }
    PG8_WAIT_V(0);
    if constexpr (!ALIGN_EPI) { if (wr == 0) PG8_BAR; }
    PG8_BAR;
    if constexpr (Epi::AFTER_DRAIN) { E.fused(acc, cur, wr, wc, fr, fq, lds, wid, lane); S.done(cur); }
#undef PG8_SA
#undef PG8_SB
#undef PG8_STAGE
#undef PG8_LDA
#undef PG8_LDB
#undef PG8_MMA
#undef PG8_WAIT_V
#undef PG8_WAIT_L
#undef PG8_BAR
#undef PG8_SCHED
}
}
namespace att {
#define ALAS __attribute__((address_space(3)))
typedef unsigned short bf16_t;
typedef short bf16x8 __attribute__((ext_vector_type(8)));
typedef short s16x4 __attribute__((ext_vector_type(4)));
typedef float f32x16 __attribute__((ext_vector_type(16)));
typedef float f32x4 __attribute__((ext_vector_type(4)));
typedef unsigned u32x4 __attribute__((ext_vector_type(4)));
typedef ALAS char lchar;
constexpr int KVBLK = 64, SHM_K = 16384, SHM_V = 16384;
constexpr int LUTX = 328, LUT0 = 96;
constexpr int NVB = 4;
constexpr int SLOT = 2 * SHM_K;
constexpr int L_LUT = 0, L_V = 5632, L_K = L_V + NVB * SHM_V, L_WS = L_K + NVB * SHM_K, IMP_LD = 132, L_IMP = L_V, L_SEL = L_WS + 2048, L_UN = L_SEL + 1024, L_LIST = L_UN + 64, L_END = L_LIST + 512;
static_assert(64 * IMP_LD * 4 <= NVB * SHM_V, "importance table overlays the V ring");
constexpr float THR = 8.0f;
enum { M_DIFF = 0, M_CMP = 1, M_SLC = 2, M_WIN = 3 };
#define KSWZ(row, colB) ((row) * 256 + ((colB) ^ (((row) & 7) << 4)))
#define SBAR() __builtin_amdgcn_sched_barrier(0)
__device__ __forceinline__ int v_st(int k, int c) { const int kk = (k & ~0xC) | ((k & 4) << 1) | ((k & 8) >> 1); return ((kk >> 3) * 4 + (c >> 5)) * 512 + ((kk & 7) * 32 + (c & 31)) * 2; }
__device__ __forceinline__ int v_rd_base(int lane) { return ((lane & 3) << 3) | (((lane >> 2) & 3) << 6) | (((lane >> 4) & 1) << 5) | (((lane >> 5) & 1) << 8); }
constexpr int v_rd_off(int d0, int ks, int half) { return d0 * 512 + ks * 4096 + half * 2048; }
__device__ __forceinline__ int crow(int r, int hi) { return (r & 3) + 8 * (r >> 2) + 4 * hi; }
__device__ __forceinline__ unsigned cvtpk(float lo, float hi) { unsigned r; asm volatile("v_cvt_pk_bf16_f32 %0, %1, %2" : "=v"(r) : "v"(lo), "v"(hi)); return r; }
__device__ __forceinline__ unsigned lds_addr(const lchar* p) { return (unsigned)(uintptr_t)p; }

struct Lane {
    int qpos;
    int qlo, qhi;
    unsigned lut;
#ifdef TPROBE_SEC
    unsigned long long* tpw;
#endif
};
template <int MODE>
__device__ __forceinline__ void mask_sel(f32x16& p0, f32x16& p1, int key0, int tj, const Lane L, int hi, bool cross, unsigned sw0, unsigned sw1, unsigned sw2, unsigned sw3) {
    const float NEG = -__builtin_inff();
    if constexpr (MODE == M_CMP) {
        const int lim = ((L.qpos - 31) >> 4) - key0 - 4 * hi;
#pragma unroll
        for (int r = 0; r < 16; ++r) { const int c = (r & 3) + 8 * (r >> 2); if (c > lim) p0[r] = NEG; if (c + 32 > lim) p1[r] = NEG; }
    } else {
        if constexpr (MODE == M_SLC) {
            const unsigned w = tj < 64 ? (tj < 32 ? sw0 : sw1) : (tj < 96 ? sw2 : sw3);
            if (((w >> (tj & 31)) & 1u) == 0u) {
#pragma unroll
                for (int r = 0; r < 16; ++r) { p0[r] = NEG; p1[r] = NEG; } }
        }
        if (cross) {
            const int dq = L.qpos - key0 - 4 * hi;
#pragma unroll
            for (int r = 0; r < 16; ++r) {
                const int c = (r & 3) + 8 * (r >> 2);
                if constexpr (MODE == M_WIN) { if ((unsigned)(dq - c) >= 512u) p0[r] = NEG; if ((unsigned)(dq - c - 32) >= 512u) p1[r] = NEG; }
                else { if (dq - c < 0) p0[r] = NEG; if (dq - c - 32 < 0) p1[r] = NEG; }
            }
        }
    }
}
__device__ __forceinline__ void partialSM(f32x16& p0, f32x16& p1, float& m_reg, float& alpha) {
    float pmax = p0[0];
#pragma unroll
    for (int r = 1; r < 16; ++r) pmax = fmaxf(pmax, p0[r]);
#pragma unroll
    for (int r = 0; r < 16; ++r) pmax = fmaxf(pmax, p1[r]);
    { auto rr = __builtin_amdgcn_permlane32_swap(__float_as_uint(pmax), __float_as_uint(pmax), false, false);
      pmax = fmaxf(__uint_as_float(rr[0]), __uint_as_float(rr[1])); }
    if (__builtin_expect(__all(pmax - m_reg <= THR), 1)) { alpha = 1.f; }
    else { const float mn = fmaxf(m_reg, pmax); alpha = __builtin_amdgcn_exp2f(m_reg - mn); m_reg = mn; }
    const float mm = m_reg;
#pragma unroll
    for (int r = 0; r < 16; ++r) { p0[r] = p0[r] - mm; p1[r] = p1[r] - mm; }
#pragma unroll
    for (int r = 0; r < 16; ++r) p0[r] = __builtin_amdgcn_exp2f(p0[r]);
}
__device__ __forceinline__ void finishSM_direct(f32x16& p0, f32x16& p1, float alpha, float& l_reg, bf16x8& pa0, bf16x8& pa1, bf16x8& pa2, bf16x8& pa3) {
#pragma unroll
    for (int r = 0; r < 16; ++r) p1[r] = __builtin_amdgcn_exp2f(p1[r]);
    float ps = 0;
#pragma unroll
    for (int r = 0; r < 16; ++r) ps += p0[r];
#pragma unroll
    for (int r = 0; r < 16; ++r) ps += p1[r];
    { auto rr = __builtin_amdgcn_permlane32_swap(__float_as_uint(ps), __float_as_uint(ps), false, false);
      ps = __uint_as_float(rr[0]) + __uint_as_float(rr[1]); }
    l_reg = l_reg * alpha + ps;
#define PKD(P, B_, OUT) do { u32x4 w = {cvtpk(P[B_+0], P[B_+1]), cvtpk(P[B_+2], P[B_+3]), cvtpk(P[B_+4], P[B_+5]), cvtpk(P[B_+6], P[B_+7])}; OUT = __builtin_bit_cast(bf16x8, w); } while (0)
    PKD(p0, 0, pa0); PKD(p0, 8, pa1); PKD(p1, 0, pa2); PKD(p1, 8, pa3);
#undef PKD
}
__device__ __forceinline__ void partialSM_fix(f32x16& p0, f32x16& p1, float mref) {
#pragma unroll
    for (int r = 0; r < 16; ++r) { p0[r] = p0[r] - mref; p1[r] = p1[r] - mref; }
#pragma unroll
    for (int r = 0; r < 16; ++r) p0[r] = __builtin_amdgcn_exp2f(p0[r]);
}
__device__ __forceinline__ void finishSM(f32x16& p0, f32x16& p1, float alpha, float& l_reg, bf16x8& pa0, bf16x8& pa1, bf16x8& pa2, bf16x8& pa3) {
#pragma unroll
    for (int r = 0; r < 16; ++r) p1[r] = __builtin_amdgcn_exp2f(p1[r]);
    float ps = 0;
#pragma unroll
    for (int r = 0; r < 16; ++r) ps += p0[r];
#pragma unroll
    for (int r = 0; r < 16; ++r) ps += p1[r];
    { auto rr = __builtin_amdgcn_permlane32_swap(__float_as_uint(ps), __float_as_uint(ps), false, false);
      ps = __uint_as_float(rr[0]) + __uint_as_float(rr[1]); }
    l_reg = l_reg * alpha + ps;
#define PK4(P, B_, OUT) do { unsigned a0 = cvtpk(P[B_+0], P[B_+1]), a1 = cvtpk(P[B_+2], P[B_+3]);                          \
        unsigned b0 = cvtpk(P[B_+4], P[B_+5]), b1 = cvtpk(P[B_+6], P[B_+7]);                                             \
        auto r0 = __builtin_amdgcn_permlane32_swap(a0, b0, false, false); auto r1 = __builtin_amdgcn_permlane32_swap(a1, b1, false, false); \
        u32x4 w = {r0[0], r1[0], r0[1], r1[1]}; OUT = __builtin_bit_cast(bf16x8, w); } while (0)
    PK4(p0, 0, pa0); PK4(p0, 8, pa1); PK4(p1, 0, pa2); PK4(p1, 8, pa3);
#undef PK4
}
template <int KB, int DQK>
__device__ __forceinline__ void qkt(f32x16& p0, f32x16& p1, const lchar* K_lds, int koff, int r32, int hi, const bf16x8* qr, bool act, bool nearb, unsigned bb) {
    if (!act) { const float NEG = -__builtin_inff();
#pragma unroll
        for (int r = 0; r < 16; ++r) { p0[r] = NEG; p1[r] = NEG; } return; }
    if (nearb) {
#pragma unroll
        for (int r = 0; r < 16; ++r) { const int c = (r & 3) + 8 * (r >> 2);
            p0[r] = *(const ALAS float*)(uintptr_t)(bb + 4u * (unsigned)(59 - c)); p1[r] = *(const ALAS float*)(uintptr_t)(bb + 4u * (unsigned)(27 - c)); }
    } else { p0 = f32x16{}; p1 = f32x16{}; }
    const lchar* kb[4];
#pragma unroll
    for (int dd = 0; dd < 4; ++dd) kb[dd] = K_lds + KB * SHM_K + KSWZ(r32, (dd * 16 + hi * 8) * 2) + koff;
#pragma unroll
    for (int d0 = 0; d0 < DQK / 16; ++d0) { const lchar* a = kb[d0 & 3] + (d0 >> 2) * 128;
        const bf16x8 b0 = *reinterpret_cast<const ALAS bf16x8*>(a);
        const bf16x8 b1 = *reinterpret_cast<const ALAS bf16x8*>(a + 32 * 256);
        p0 = __builtin_amdgcn_mfma_f32_32x32x16_bf16(b0, qr[d0], p0, 0, 0, 0);
        p1 = __builtin_amdgcn_mfma_f32_32x32x16_bf16(b1, qr[d0], p1, 0, 0, 0); }
}
template <int VB>
__device__ __forceinline__ void pv_tile(f32x16* o, unsigned vb0, bf16x8 pa0, bf16x8 pa1, bf16x8 pa2, bf16x8 pa3, bool act) {
    if (!act) return;
#define TRRD(dst, off) asm volatile("ds_read_b64_tr_b16 %0, %1 offset:%2" : "=&v"(dst) : "v"(vb0), "i"(off) : "memory")
#define PV_D0(d0) do { s16x4 l0, l1, l2, l3, h0, h1, h2, h3; constexpr int b_ = VB * SHM_V + v_rd_off(d0, 0, 0);   \
        TRRD(l0, b_); TRRD(h0, b_ + 2048); TRRD(l1, b_ + 4096); TRRD(h1, b_ + 6144); TRRD(l2, b_ + 8192); TRRD(h2, b_ + 10240); TRRD(l3, b_ + 12288); TRRD(h3, b_ + 14336); \
        asm volatile("s_waitcnt lgkmcnt(0)" ::: "memory"); SBAR();   \
        o[d0] = __builtin_amdgcn_mfma_f32_32x32x16_bf16(pa0, (bf16x8){l0[0], l0[1], l0[2], l0[3], h0[0], h0[1], h0[2], h0[3]}, o[d0], 0, 0, 0);   \
        o[d0] = __builtin_amdgcn_mfma_f32_32x32x16_bf16(pa1, (bf16x8){l1[0], l1[1], l1[2], l1[3], h1[0], h1[1], h1[2], h1[3]}, o[d0], 0, 0, 0);   \
        o[d0] = __builtin_amdgcn_mfma_f32_32x32x16_bf16(pa2, (bf16x8){l2[0], l2[1], l2[2], l2[3], h2[0], h2[1], h2[2], h2[3]}, o[d0], 0, 0, 0);   \
        o[d0] = __builtin_amdgcn_mfma_f32_32x32x16_bf16(pa3, (bf16x8){l3[0], l3[1], l3[2], l3[3], h3[0], h3[1], h3[2], h3[3]}, o[d0], 0, 0, 0); } while (0)
    PV_D0(0); PV_D0(1); PV_D0(2); PV_D0(3);
#undef PV_D0
#undef TRRD
}
__device__ __forceinline__ void partialSM_rel(f32x16& p0, f32x16& p1, float& m_reg, float& alpha, bool& started, f32x16& negm) {
    float pmax = fmaxf(p0[0], p1[0]);
#pragma unroll
    for (int r = 1; r < 16; ++r) pmax = fmaxf(pmax, fmaxf(p0[r], p1[r]));
    { auto rr = __builtin_amdgcn_permlane32_swap(__float_as_uint(pmax), __float_as_uint(pmax), false, false);
      pmax = fmaxf(__uint_as_float(rr[0]), __uint_as_float(rr[1])); }
    const bool fin = pmax > -__builtin_inff();
    alpha = 1.f;
    if (__builtin_expect(__any((started && pmax > THR) || (!started && fin)), 0)) {
        const float delta = started ? fmaxf(pmax, 0.f) : (fin ? pmax : 0.f);
        alpha = started ? __builtin_amdgcn_exp2f(-delta) : 1.f;
        started = started || fin;
        m_reg += delta;
#pragma unroll
        for (int r = 0; r < 16; ++r) { p0[r] -= delta; p1[r] -= delta; }
        const float nm = -m_reg;
#pragma unroll
        for (int r = 0; r < 16; ++r) negm[r] = nm;
    }
#pragma unroll
    for (int r = 0; r < 16; ++r) p0[r] = __builtin_amdgcn_exp2f(p0[r]);
}
typedef float f32x2 __attribute__((ext_vector_type(2)));
__device__ __forceinline__ void finishSM_pk(f32x16& p0, f32x16& p1, float alpha, float& l_reg, bf16x8& pa0, bf16x8& pa1, bf16x8& pa2, bf16x8& pa3) {
#pragma unroll
    for (int r = 0; r < 16; ++r) p1[r] = __builtin_amdgcn_exp2f(p1[r]);
    f32x2 s2 = (f32x2){p0[0], p0[1]} + (f32x2){p1[0], p1[1]};
#pragma unroll
    for (int r = 2; r < 16; r += 2) { s2 += (f32x2){p0[r], p0[r + 1]}; s2 += (f32x2){p1[r], p1[r + 1]}; }
    float ps = s2.x + s2.y;
    { auto rr = __builtin_amdgcn_permlane32_swap(__float_as_uint(ps), __float_as_uint(ps), false, false);
      ps = __uint_as_float(rr[0]) + __uint_as_float(rr[1]); }
    l_reg = l_reg * alpha + ps;
#define PK4(P, B_, OUT) do { unsigned a0 = cvtpk(P[B_+0], P[B_+1]), a1 = cvtpk(P[B_+2], P[B_+3]);                          \
        unsigned b0 = cvtpk(P[B_+4], P[B_+5]), b1 = cvtpk(P[B_+6], P[B_+7]);                                             \
        auto r0 = __builtin_amdgcn_permlane32_swap(a0, b0, false, false); auto r1 = __builtin_amdgcn_permlane32_swap(a1, b1, false, false); \
        u32x4 w = {r0[0], r1[0], r0[1], r1[1]}; OUT = __builtin_bit_cast(bf16x8, w); } while (0)
    PK4(p0, 0, pa0); PK4(p0, 8, pa1); PK4(p1, 0, pa2); PK4(p1, 8, pa3);
#undef PK4
}
template <int DQK>
__device__ __forceinline__ void qkt_neg(f32x16& p0, f32x16& p1, const lchar* Kb, int koff, int r32, int hi, const bf16x8* qr, bool act, bool nearb, unsigned bb, const f32x16& negm) {
    if (!act) { const float NEG = -__builtin_inff();
#pragma unroll
        for (int r = 0; r < 16; ++r) { p0[r] = NEG; p1[r] = NEG; } return; }
    const lchar* kb[4];
#pragma unroll
    for (int dd = 0; dd < 4; ++dd) kb[dd] = Kb + KSWZ(r32, (dd * 16 + hi * 8) * 2) + koff;
    if (nearb) {
#pragma unroll
        for (int r = 0; r < 16; ++r) { const int c = (r & 3) + 8 * (r >> 2);
            p0[r] = *(const ALAS float*)(uintptr_t)(bb + 4u * (unsigned)(59 - c)) + negm[r]; p1[r] = *(const ALAS float*)(uintptr_t)(bb + 4u * (unsigned)(27 - c)) + negm[r]; }
    }
    constexpr int NG = DQK / 32;
    bf16x8 kf[2][4];
#define KRD(g, sl) do { _Pragma("unroll") for (int j_ = 0; j_ < 2; ++j_) { const int d0_ = 2 * (g) + j_; const lchar* a_ = kb[d0_ & 3] + (d0_ >> 2) * 128; \
        kf[sl][2 * j_] = *reinterpret_cast<const ALAS bf16x8*>(a_); kf[sl][2 * j_ + 1] = *reinterpret_cast<const ALAS bf16x8*>(a_ + 32 * 256); } } while (0)
    KRD(0, 0); if (NG > 1) KRD(1, 1);
    SBAR();
#pragma unroll
    for (int g = 0; g < NG; ++g) {
#pragma unroll
        for (int j = 0; j < 2; ++j) {
            if (g == 0 && j == 0) {
                if (nearb) { p0 = __builtin_amdgcn_mfma_f32_32x32x16_bf16(kf[0][0], qr[0], p0, 0, 0, 0); p1 = __builtin_amdgcn_mfma_f32_32x32x16_bf16(kf[0][1], qr[0], p1, 0, 0, 0); }
                else { p0 = __builtin_amdgcn_mfma_f32_32x32x16_bf16(kf[0][0], qr[0], negm, 0, 0, 0); p1 = __builtin_amdgcn_mfma_f32_32x32x16_bf16(kf[0][1], qr[0], negm, 0, 0, 0); }
            } else { p0 = __builtin_amdgcn_mfma_f32_32x32x16_bf16(kf[g & 1][2 * j], qr[2 * g + j], p0, 0, 0, 0); p1 = __builtin_amdgcn_mfma_f32_32x32x16_bf16(kf[g & 1][2 * j + 1], qr[2 * g + j], p1, 0, 0, 0); }
        }
        if (g + 2 < NG) { SBAR(); KRD(g + 2, g & 1); SBAR(); }
    }
#undef KRD
}
template <int DQK>
__device__ __forceinline__ void qkt_rt(f32x16& p0, f32x16& p1, const lchar* Kb, int koff, int r32, int hi, const bf16x8* qr, bool act, bool nearb, unsigned bb) {
    if (!act) { const float NEG = -__builtin_inff();
#pragma unroll
        for (int r = 0; r < 16; ++r) { p0[r] = NEG; p1[r] = NEG; } return; }
    if (nearb) {
#pragma unroll
        for (int r = 0; r < 16; ++r) { const int c = (r & 3) + 8 * (r >> 2);
            p0[r] = *(const ALAS float*)(uintptr_t)(bb + 4u * (unsigned)(59 - c)); p1[r] = *(const ALAS float*)(uintptr_t)(bb + 4u * (unsigned)(27 - c)); }
    } else { p0 = f32x16{}; p1 = f32x16{}; }
    const lchar* kb[4];
#pragma unroll
    for (int dd = 0; dd < 4; ++dd) kb[dd] = Kb + KSWZ(r32, (dd * 16 + hi * 8) * 2) + koff;
    if constexpr (DQK == 64) {
    constexpr int NG = DQK / 32;
    bf16x8 kf[2][4];
#define KRD(g, sl) do { _Pragma("unroll") for (int j_ = 0; j_ < 2; ++j_) { const int d0_ = 2 * (g) + j_; const lchar* a_ = kb[d0_ & 3] + (d0_ >> 2) * 128; \
        kf[sl][2 * j_] = *reinterpret_cast<const ALAS bf16x8*>(a_); kf[sl][2 * j_ + 1] = *reinterpret_cast<const ALAS bf16x8*>(a_ + 32 * 256); } } while (0)
    KRD(0, 0); if (NG > 1) KRD(1, 1);
    SBAR();
#pragma unroll
    for (int g = 0; g < NG; ++g) {
#pragma unroll
        for (int j = 0; j < 2; ++j) { p0 = __builtin_amdgcn_mfma_f32_32x32x16_bf16(kf[g & 1][2 * j], qr[2 * g + j], p0, 0, 0, 0); p1 = __builtin_amdgcn_mfma_f32_32x32x16_bf16(kf[g & 1][2 * j + 1], qr[2 * g + j], p1, 0, 0, 0); }
        if (g + 2 < NG) { SBAR(); KRD(g + 2, g & 1); SBAR(); }
    }
#undef KRD
    } else {
#pragma unroll
        for (int g = 0; g < DQK / 32; ++g) {
            bf16x8 kg[4];
#pragma unroll
            for (int j = 0; j < 2; ++j) { const int d0 = 2 * g + j; const lchar* a = kb[d0 & 3] + (d0 >> 2) * 128;
                kg[2 * j] = *reinterpret_cast<const ALAS bf16x8*>(a); kg[2 * j + 1] = *reinterpret_cast<const ALAS bf16x8*>(a + 32 * 256); }
            SBAR();
#pragma unroll
            for (int j = 0; j < 2; ++j) { p0 = __builtin_amdgcn_mfma_f32_32x32x16_bf16(kg[2 * j], qr[2 * g + j], p0, 0, 0, 0); p1 = __builtin_amdgcn_mfma_f32_32x32x16_bf16(kg[2 * j + 1], qr[2 * g + j], p1, 0, 0, 0); }
            SBAR();
        }
    }
}
__device__ __forceinline__ void pv_rt(f32x16* o, unsigned vb, bf16x8 pa0, bf16x8 pa1, bf16x8 pa2, bf16x8 pa3, bool act) {
    if (!act) return;
#define TRRD(dst, off) asm volatile("ds_read_b64_tr_b16 %0, %1 offset:%2" : "=&v"(dst) : "v"(vb), "i"(off) : "memory")
#define PV_D0(d0) do { s16x4 l0, l1, l2, l3, h0, h1, h2, h3; constexpr int b_ = v_rd_off(d0, 0, 0);   \
        TRRD(l0, b_); TRRD(h0, b_ + 2048); TRRD(l1, b_ + 4096); TRRD(h1, b_ + 6144); TRRD(l2, b_ + 8192); TRRD(h2, b_ + 10240); TRRD(l3, b_ + 12288); TRRD(h3, b_ + 14336); \
        asm volatile("s_waitcnt lgkmcnt(0)" ::: "memory"); SBAR();   \
        o[d0] = __builtin_amdgcn_mfma_f32_32x32x16_bf16(pa0, (bf16x8){l0[0], l0[1], l0[2], l0[3], h0[0], h0[1], h0[2], h0[3]}, o[d0], 0, 0, 0);   \
        o[d0] = __builtin_amdgcn_mfma_f32_32x32x16_bf16(pa1, (bf16x8){l1[0], l1[1], l1[2], l1[3], h1[0], h1[1], h1[2], h1[3]}, o[d0], 0, 0, 0);   \
        o[d0] = __builtin_amdgcn_mfma_f32_32x32x16_bf16(pa2, (bf16x8){l2[0], l2[1], l2[2], l2[3], h2[0], h2[1], h2[2], h2[3]}, o[d0], 0, 0, 0);   \
        o[d0] = __builtin_amdgcn_mfma_f32_32x32x16_bf16(pa3, (bf16x8){l3[0], l3[1], l3[2], l3[3], h3[0], h3[1], h3[2], h3[3]}, o[d0], 0, 0, 0); } while (0)
    PV_D0(0); PV_D0(1); PV_D0(2); PV_D0(3);
#undef PV_D0
#undef TRRD
}
template <int MODE> __device__ __forceinline__ bool tile_act(int key0, int tj, const Lane L, unsigned sw0, unsigned sw1, unsigned sw2, unsigned sw3) {
    if constexpr (MODE == M_DIFF) return key0 <= L.qhi;
    else if constexpr (MODE == M_CMP) return 16 * key0 + 31 <= L.qhi;
    else if constexpr (MODE == M_WIN) return key0 <= L.qhi && key0 + 63 >= L.qlo - 511;
    else { const unsigned w = tj < 64 ? (tj < 32 ? sw0 : sw1) : (tj < 96 ? sw2 : sw3); return __any((int)((w >> (tj & 31)) & 1u)) != 0; }
}
template <int MODE> __device__ __forceinline__ bool tile_near(int key0, const Lane L) {
    if constexpr (MODE == M_CMP) return false; else return key0 + 63 > L.qlo - 113;
}
template <int MODE> __device__ __forceinline__ bool tile_needs_mask(int key0, const Lane L) {
    if constexpr (MODE == M_DIFF) return key0 + 63 > L.qlo;
    else if constexpr (MODE == M_CMP) return 16 * (key0 + 63) + 31 > L.qlo;
    else if constexpr (MODE == M_WIN) return key0 + 63 > L.qlo || key0 <= L.qhi - 512;
    else return true;
}
template <int MODE> __device__ __forceinline__ void tile_mask(f32x16& p0, f32x16& p1, int key0, int tj, const Lane L, int hi, bool act, unsigned sw0, unsigned sw1, unsigned sw2, unsigned sw3) {
    if (!act) return;
    if constexpr (MODE == M_DIFF) { if (key0 + 63 > L.qlo) mask_sel<MODE>(p0, p1, key0, tj, L, hi, true, sw0, sw1, sw2, sw3); }
    else if constexpr (MODE == M_CMP) { if (16 * (key0 + 63) + 31 > L.qlo) mask_sel<MODE>(p0, p1, key0, tj, L, hi, true, sw0, sw1, sw2, sw3); }
    else if constexpr (MODE == M_WIN) { if (key0 + 63 > L.qlo || key0 <= L.qhi - 512) mask_sel<MODE>(p0, p1, key0, tj, L, hi, true, sw0, sw1, sw2, sw3); }
    else { mask_sel<MODE>(p0, p1, key0, tj, L, hi, key0 + 63 > L.qlo, sw0, sw1, sw2, sw3); }
}
template <int MODE, int DQK>
__device__ __forceinline__ void attn_tiles1(lchar* lds, const bf16_t* __restrict__ Kg, const bf16_t* __restrict__ Vg, int ld, int j_lo, int NT, const ALAS int* list,
                                           const bf16x8* qr, int koff, const Lane L, unsigned sw0, unsigned sw1, unsigned sw2, unsigned sw3, f32x16* o, float& m_reg, float& l_reg) {
    int tid = threadIdx.x; asm volatile("" : "+v"(tid));
    const int wid = __builtin_amdgcn_readfirstlane(tid >> 6), lane = tid & 63, r32 = lane & 31, hi = lane >> 5;
    lchar* V_lds = lds + L_V; lchar* K_lds = lds + L_K;
    ALAS float* al_l = (ALAS float*)(lds + L_WS) + wid * 64 + 32;
    m_reg = -1e30f; l_reg = 0.f; o[0] = f32x16{}; o[1] = f32x16{}; o[2] = f32x16{}; o[3] = f32x16{};
    const int sr = tid >> 4, sc = (tid & 15) * 8, vst0 = v_st(sr, sc), vst1 = v_st(32 + sr, sc), kws = KSWZ(sr, sc * 2);
    const unsigned vb0 = lds_addr(V_lds) + (unsigned)v_rd_base(lane);
    bf16x8 st_v0, st_v1, st_k0, st_k1;
#define TIDX(t) ((MODE == M_SLC) ? __builtin_amdgcn_readfirstlane(list[(t)]) : (j_lo + (t)))
#define SLOAD(t) do { const size_t k0_ = (size_t)TIDX(t) * KVBLK; st_v0 = *(const bf16x8*)(Vg + (k0_ + sr) * ld + sc); st_v1 = *(const bf16x8*)(Vg + (k0_ + 32 + sr) * ld + sc); \
                      st_k0 = *(const bf16x8*)(Kg + (k0_ + sr) * ld + sc); st_k1 = *(const bf16x8*)(Kg + (k0_ + 32 + sr) * ld + sc); } while (0)
#define SWRITE(bf) do { *(ALAS bf16x8*)(V_lds + (bf) * SHM_V + vst0) = st_v0; *(ALAS bf16x8*)(V_lds + (bf) * SHM_V + vst1) = st_v1; \
                        *(ALAS bf16x8*)(K_lds + (bf) * SHM_K + kws) = st_k0; *(ALAS bf16x8*)(K_lds + (bf) * SHM_K + kws + 32 * 256) = st_k1; } while (0)
#define VMW() asm volatile("s_waitcnt vmcnt(0)" ::: "memory")
#define RESC(a) do { if (__any((a) < 1.f)) { if (hi == 0) al_l[r32] = (a); asm volatile("s_waitcnt lgkmcnt(0)" ::: "memory");              \
                     _Pragma("unroll") for (int d_ = 0; d_ < 4; ++d_) _Pragma("unroll") for (int r = 0; r < 16; ++r) o[d_][r] *= al_l[crow(r, hi)]; } } while (0)
#define ACT(t) tile_act<MODE>(TIDX(t) * KVBLK, TIDX(t), L, sw0, sw1, sw2, sw3)
#define NEARB(t) tile_near<MODE>(TIDX(t) * KVBLK, L)
#define BB(t) (L.lut + 4u * (unsigned)(L.qpos - TIDX(t) * KVBLK - 4 * hi + LUT0 - 59))
#define MASKT(P0_, P1_, t, a_) tile_mask<MODE>(P0_, P1_, TIDX(t) * KVBLK, TIDX(t), L, hi, a_, sw0, sw1, sw2, sw3)
    f32x16 p0, p1; float al = 1.f; bf16x8 pa0, pa1, pa2, pa3;
    SLOAD(0); VMW(); SWRITE(0); SBAR();
    if (NT > 1) SLOAD(1);
    __syncthreads();
#define STEP(t, BF) do {                                                                                                  \
        const bool a_ = ACT(t);                                                                                           \
        SBAR(); qkt<BF, DQK>(p0, p1, K_lds, koff, r32, hi, qr, a_, NEARB(t), BB(t));                                      \
        MASKT(p0, p1, (t), a_); partialSM(p0, p1, m_reg, al); RESC(al);                                                   \
        finishSM(p0, p1, al, l_reg, pa0, pa1, pa2, pa3); SBAR();                                                          \
        if ((t) + 1 < NT) { VMW(); SWRITE((BF) ^ 1); SBAR(); if ((t) + 2 < NT) { SLOAD((t) + 2); SBAR(); } }              \
        pv_tile<BF>(o, vb0, pa0, pa1, pa2, pa3, a_);                                                                      \
        __syncthreads(); } while (0)
    int t = 0;
    for (; t + 1 < NT; t += 2) { STEP(t, 0); STEP(t + 1, 1); }
    if (t < NT) STEP(t, 0);
#undef STEP
#undef TIDX
#undef SLOAD
#undef SWRITE
#undef VMW
#undef RESC
#undef ACT
#undef NEARB
#undef BB
#undef MASKT
}
template <int MODE, int DQK>
__device__ __forceinline__ void attn_tiles2(lchar* lds, const bf16_t* __restrict__ Kg, const bf16_t* __restrict__ Vg, int ld, int j_lo, int NT, const ALAS int* list,
                                           const bf16x8* qr, int koff, const Lane L, unsigned sw0, unsigned sw1, unsigned sw2, unsigned sw3, f32x16* o, float& m_reg, float& l_reg) {
    int tid = threadIdx.x; asm volatile("" : "+v"(tid));
    const int wid = __builtin_amdgcn_readfirstlane(tid >> 6), lane = tid & 63, r32 = lane & 31, hi = lane >> 5;
    lchar* V_lds = lds + L_V; lchar* K_lds = lds + L_K;
    ALAS float* al_l = (ALAS float*)(lds + L_WS) + wid * 64 + 32;
    m_reg = -1e30f; l_reg = 0.f; o[0] = f32x16{}; o[1] = f32x16{}; o[2] = f32x16{}; o[3] = f32x16{};
    const int sr = tid >> 4, sc = (tid & 15) * 8, vst0 = v_st(sr, sc), vst1 = v_st(32 + sr, sc), kws = KSWZ(sr, sc * 2);
    const unsigned vb0 = lds_addr(V_lds) + (unsigned)v_rd_base(lane);
    bf16x8 st_v0, st_v1, st_k0, st_k1;
#define TIDX(t) ((MODE == M_SLC) ? __builtin_amdgcn_readfirstlane(list[(t)]) : (j_lo + (t)))
#define SLOAD(t) do { const size_t k0_ = (size_t)TIDX(t) * KVBLK; st_v0 = *(const bf16x8*)(Vg + (k0_ + sr) * ld + sc); st_v1 = *(const bf16x8*)(Vg + (k0_ + 32 + sr) * ld + sc); \
                      st_k0 = *(const bf16x8*)(Kg + (k0_ + sr) * ld + sc); st_k1 = *(const bf16x8*)(Kg + (k0_ + 32 + sr) * ld + sc); } while (0)
#define SWRITE(bf) do { *(ALAS bf16x8*)(V_lds + (bf) * SHM_V + vst0) = st_v0; *(ALAS bf16x8*)(V_lds + (bf) * SHM_V + vst1) = st_v1; \
                        *(ALAS bf16x8*)(K_lds + (bf) * SHM_K + kws) = st_k0; *(ALAS bf16x8*)(K_lds + (bf) * SHM_K + kws + 32 * 256) = st_k1; } while (0)
#define VMW() asm volatile("s_waitcnt vmcnt(0)" ::: "memory")
#define RESC(a) do { if (__any((a) < 1.f)) { if (hi == 0) al_l[r32] = (a); asm volatile("s_waitcnt lgkmcnt(0)" ::: "memory");              \
                     _Pragma("unroll") for (int d_ = 0; d_ < 4; ++d_) _Pragma("unroll") for (int r = 0; r < 16; ++r) o[d_][r] *= al_l[crow(r, hi)]; } } while (0)
#define ACT(t) tile_act<MODE>(TIDX(t) * KVBLK, TIDX(t), L, sw0, sw1, sw2, sw3)
#define NEARB(t) tile_near<MODE>(TIDX(t) * KVBLK, L)
#define BB(t) (L.lut + 4u * (unsigned)(L.qpos - TIDX(t) * KVBLK - 4 * hi + LUT0 - 59))
#define MASKT(P0_, P1_, t, a_) tile_mask<MODE>(P0_, P1_, TIDX(t) * KVBLK, TIDX(t), L, hi, a_, sw0, sw1, sw2, sw3)
    f32x16 pA0, pA1, pB0, pB1; float alA = 1.f, alB = 1.f; bf16x8 pa0, pa1, pa2, pa3;
    SLOAD(0); VMW(); SWRITE(0); SBAR();
    if (NT > 1) SLOAD(1);
    __syncthreads();
    { const bool a0_ = ACT(0); SBAR(); qkt<0, DQK>(pA0, pA1, K_lds, koff, r32, hi, qr, a0_, NEARB(0), BB(0)); MASKT(pA0, pA1, 0, a0_); partialSM(pA0, pA1, m_reg, alA); }
    if (NT > 1) { VMW(); SWRITE(1); }
    __syncthreads();
#define HALF_STEP(PX0, PX1, alX, PY0, PY1, alY, t, KB, VB, SB) do {                                                      \
        const bool ax_ = ACT(t), ay_ = ACT((t) - 1);                                                                      \
        SBAR(); qkt<KB, DQK>(PX0, PX1, K_lds, koff, r32, hi, qr, ax_, NEARB(t), BB(t));                                   \
        finishSM(PY0, PY1, alY, l_reg, pa0, pa1, pa2, pa3); SBAR();                                                       \
        if ((t) + 1 < NT) { SLOAD((t) + 1); SBAR(); }                                                                     \
        pv_tile<VB>(o, vb0, pa0, pa1, pa2, pa3, ay_); MASKT(PX0, PX1, (t), ax_); partialSM(PX0, PX1, m_reg, alX);         \
        __syncthreads();                                                                                                  \
        if ((t) + 1 < NT) { VMW(); SWRITE(SB); }                                                                          \
        RESC(alX); __syncthreads(); } while (0)
    for (int t = 1; t + 1 < NT; t += 2) {
        HALF_STEP(pB0, pB1, alB, pA0, pA1, alA, t, 1, 0, 0);
        HALF_STEP(pA0, pA1, alA, pB0, pB1, alB, t + 1, 0, 1, 1);
    }
    const bool even = (NT & 1) == 0;
    const bool aL_ = ACT(NT - 1), aP_ = even ? ACT(NT - 2) : aL_;
    if (even) { SBAR(); qkt<1, DQK>(pB0, pB1, K_lds, koff, r32, hi, qr, aL_, NEARB(NT - 1), BB(NT - 1)); SBAR(); }
    finishSM(pA0, pA1, alA, l_reg, pa0, pa1, pa2, pa3); SBAR();
    pv_tile<0>(o, vb0, pa0, pa1, pa2, pa3, aP_);
    if (even) { MASKT(pB0, pB1, NT - 1, aL_); partialSM(pB0, pB1, m_reg, alB); __syncthreads(); RESC(alB);
        finishSM(pB0, pB1, alB, l_reg, pa0, pa1, pa2, pa3); SBAR(); pv_tile<1>(o, vb0, pa0, pa1, pa2, pa3, aL_); }
    __syncthreads();
#undef HALF_STEP
#undef TIDX
#undef SLOAD
#undef SWRITE
#undef VMW
#undef RESC
#undef ACT
#undef NEARB
#undef BB
#undef MASKT
}
#ifdef TPROBE_SEC
#define TP_ON (MODE == TPROBE_MODE && blockIdx.x == 0 && wid == TPROBE_WAVE)
#define TP_T(k) do { if (TP_ON) tp_[(k)] = __builtin_readcyclecounter(); } while (0)
#define TP_PIN(x) asm volatile("" :: "v"(x))
#define TP_ACC() do { if (TP_ON) { const unsigned long long sec_ = tp_[TPROBE_SEC + 1] - tp_[TPROBE_SEC]; tp_sec_ += sec_; tp_tot_ += tp_[5] - tp_[0]; } } while (0)
#define TP_ACC_Y() do { if (TP_ON) { const unsigned long long sec_ = (TPROBE_SEC == 0) ? tp_[1] - tp_[0] : (TPROBE_SEC == 1) ? tp_[7] - tp_[6] : (TPROBE_SEC == 2) ? tp_[6] - tp_[1] : (TPROBE_SEC == 3) ? tp_[4] - tp_[3] : tp_[5] - tp_[7]; tp_sec_ += sec_; tp_tot_ += tp_[5] - tp_[3]; } } while (0)
#else
#define TP_T(k) do {} while (0)
#define TP_PIN(x) do {} while (0)
#define TP_ACC() do {} while (0)
#define TP_ACC_Y() do {} while (0)
#endif
template <int MODE, int DQK, bool NEGM = false>
__device__ __forceinline__ void attn_tiles(lchar* lds, const bf16_t* __restrict__ Kg, const bf16_t* __restrict__ Vg, int ld, int j_lo, int NT, const ALAS int* list,
                                           const bf16x8* qr, int koff, const Lane L, unsigned sw0, unsigned sw1, unsigned sw2, unsigned sw3, f32x16* o, float& m_reg, float& l_reg) {
    int tid = threadIdx.x; asm volatile("" : "+v"(tid));
    const int wid = __builtin_amdgcn_readfirstlane(tid >> 6), lane = tid & 63, r32 = lane & 31, hi = lane >> 5;
    lchar* V_lds = lds + L_V; lchar* K_lds = lds + L_K;
    ALAS float* al_l = (ALAS float*)(lds + L_WS) + wid * 64 + 32;
    m_reg = -1e30f; l_reg = 0.f; o[0] = f32x16{}; o[1] = f32x16{}; o[2] = f32x16{}; o[3] = f32x16{};
    const int sr = tid >> 4, sc = (tid & 15) * 8, vst0 = v_st(sr, sc), vst1 = v_st(32 + sr, sc), kws = KSWZ(sr, sc * 2);
    const unsigned vb0 = lds_addr(V_lds) + (unsigned)v_rd_base(lane);
    bf16x8 st_v0, st_v1, st_k0, st_k1;
#define TIDX(t) ((MODE == M_SLC) ? __builtin_amdgcn_readfirstlane(list[(t)]) : (j_lo + (t)))
#define SLOAD(t) do { const size_t k0_ = (size_t)TIDX(t) * KVBLK; st_v0 = *(const bf16x8*)(Vg + (k0_ + sr) * ld + sc); st_v1 = *(const bf16x8*)(Vg + (k0_ + 32 + sr) * ld + sc); \
                      st_k0 = *(const bf16x8*)(Kg + (k0_ + sr) * ld + sc); st_k1 = *(const bf16x8*)(Kg + (k0_ + 32 + sr) * ld + sc); } while (0)
#define SWRITE(ko, vo) do { *(ALAS bf16x8*)(V_lds + (vo) + vst0) = st_v0; *(ALAS bf16x8*)(V_lds + (vo) + vst1) = st_v1; \
                            *(ALAS bf16x8*)(K_lds + (ko) + kws) = st_k0; *(ALAS bf16x8*)(K_lds + (ko) + kws + 32 * 256) = st_k1; } while (0)
#define VMW() asm volatile("s_waitcnt vmcnt(0)" ::: "memory")
#define RESC(a) do { if (__any((a) < 1.f)) { if (hi == 0) al_l[r32] = (a); asm volatile("s_waitcnt lgkmcnt(0)" ::: "memory");              \
                     _Pragma("unroll") for (int d_ = 0; d_ < 4; ++d_) _Pragma("unroll") for (int r = 0; r < 16; ++r) o[d_][r] *= al_l[crow(r, hi)]; } } while (0)
#define ACT(t) tile_act<MODE>(TIDX(t) * KVBLK, TIDX(t), L, sw0, sw1, sw2, sw3)
#define NEARB(t) tile_near<MODE>(TIDX(t) * KVBLK, L)
#define BB(t) (L.lut + 4u * (unsigned)(L.qpos - TIDX(t) * KVBLK - 4 * hi + LUT0 - 59))
#define MASKT(P0_, P1_, t, a_) tile_mask<MODE>(P0_, P1_, TIDX(t) * KVBLK, TIDX(t), L, hi, a_, sw0, sw1, sw2, sw3)
    f32x16 p0, p1; float al = 1.f; bf16x8 pa0, pa1, pa2, pa3;
    pa0 = pa1 = pa2 = pa3 = bf16x8{};
    f32x16 negm = f32x16{}; bool started = false; if (NEGM) { m_reg = 0.f; asm volatile("" : "+v"(negm)); }
#ifdef TPROBE_SEC
    unsigned long long tp_[8] = {0, 0, 0, 0, 0, 0, 0, 0}, tp_sec_ = 0, tp_tot_ = 0;
#endif
    SLOAD(0); VMW(); SWRITE(0, 0); SBAR();
    if (NT > 1) SLOAD(1);
    __syncthreads();
    int kbo = 0, vbo = 0, vbp = 0;
#define STAGE_NEXT(t) do { if ((t) + 1 < NT) { const int vbn_ = (vbo == (NVB - 1) * SHM_V) ? 0 : vbo + SHM_V; VMW(); SWRITE(kbo ^ SHM_K, vbn_); SBAR(); if ((t) + 2 < NT) { SLOAD((t) + 2); SBAR(); } } } while (0)
#define SOFTMAX(t, a_) do { MASKT(p0, p1, (t), a_); if constexpr (NEGM) { partialSM_rel(p0, p1, m_reg, al, started, negm); RESC(al); finishSM_pk(p0, p1, al, l_reg, pa0, pa1, pa2, pa3); } \
        else { partialSM(p0, p1, m_reg, al); RESC(al); finishSM(p0, p1, al, l_reg, pa0, pa1, pa2, pa3); } SBAR(); } while (0)
#define QKT(t, a_) do { if constexpr (NEGM) qkt_neg<DQK>(p0, p1, K_lds + kbo, koff, r32, hi, qr, a_, NEARB(t), BB(t), negm); else qkt_rt<DQK>(p0, p1, K_lds + kbo, koff, r32, hi, qr, a_, NEARB(t), BB(t)); } while (0)
#define ADVANCE() do { vbp = vbo; vbo = (vbo == 2 * SHM_V) ? 0 : vbo + SHM_V; kbo ^= SHM_K; } while (0)
    if (wid < 4) {
        for (int t = 0; t < NT; ++t) {
            const bool a_ = ACT(t);
            TP_T(0);
            SBAR(); QKT(t, a_);
            TP_PIN(p0); TP_T(1);
            SOFTMAX(t, a_);
            TP_T(2);
            STAGE_NEXT(t);
            TP_T(3);
            pv_rt(o, vb0 + (unsigned)vbo, pa0, pa1, pa2, pa3, a_);
            TP_PIN(o[3]); TP_T(4);
            __syncthreads();
            TP_T(5); TP_ACC();
            ADVANCE();
        }
        __syncthreads();
    } else {
        bool ap_ = false;
        for (int t = 0; t < NT; ++t) {
            TP_T(3);
            SBAR(); pv_rt(o, vb0 + (unsigned)vbp, pa0, pa1, pa2, pa3, ap_);
            TP_PIN(o[3]); TP_T(4);
            const bool a_ = ACT(t);
            TP_T(0);
            SBAR(); QKT(t, a_);
            TP_PIN(p0); TP_T(1);
            STAGE_NEXT(t);
            TP_T(6);
            SOFTMAX(t, a_);
            TP_T(7);
            ap_ = a_;
            __syncthreads();
            TP_T(5); TP_ACC_Y();
            ADVANCE();
        }
        SBAR(); pv_rt(o, vb0 + (unsigned)vbp, pa0, pa1, pa2, pa3, ap_);
        __syncthreads();
    }
#ifdef TPROBE_SEC
    if (TP_ON && lane == 0) { atomicAdd(L.tpw, tp_sec_); atomicAdd(L.tpw + 1, tp_tot_); }
#endif
#undef STAGE_NEXT
#undef SOFTMAX
#undef QKT
#undef ADVANCE
#undef TIDX
#undef SLOAD
#undef SWRITE
#undef VMW
#undef RESC
#undef ACT
#undef NEARB
#undef BB
#undef MASKT
}
typedef short v4i16_t __attribute__((ext_vector_type(4)));
__device__ __forceinline__ s16x4 vtr(unsigned a) { return __builtin_bit_cast(s16x4, __builtin_amdgcn_ds_read_tr16_b64_v4i16((ALAS v4i16_t*)(uintptr_t)a)); }
template <int GS, bool ASM = false>
__device__ __forceinline__ void k_first(bf16x8* kg, const lchar* Kb, int koff, int r32, int hi) {
    const lchar* rowp = Kb + r32 * 256; const int e = (hi * 16 + koff) ^ ((r32 & 15) << 4);
#pragma unroll
    for (int j = 0; j < GS; ++j) { const lchar* a = rowp + (e ^ (j * 32));
        if constexpr (ASM) { const unsigned aa_ = lds_addr(a);
            asm volatile("ds_read_b128 %0, %1" : "=v"(kg[2 * j]) : "v"(aa_) : "memory"); asm volatile("ds_read_b128 %0, %1 offset:8192" : "=v"(kg[2 * j + 1]) : "v"(aa_) : "memory"); }
        else { kg[2 * j] = *reinterpret_cast<const ALAS bf16x8*>(a); kg[2 * j + 1] = *reinterpret_cast<const ALAS bf16x8*>(a + 32 * 256); } }
}
template <int DQK, bool FIXM = false, int GS = 2, bool PRE = false, bool VPRE = false, bool KDB = false>
__device__ __forceinline__ void qkt_dma(f32x16& p0, f32x16& p1, const lchar* Kb, int koff, int r32, int hi, const bf16x8* qr, bool act, bool nearb, unsigned bb, const f32x16& negm = f32x16{}, const bf16x8* kpre = nullptr,
                                        s16x4* vpre = nullptr, unsigned vbaddr = 0u) {
    if (!act) { const float NEG = -__builtin_inff();
        if constexpr (PRE && KDB) { asm volatile("s_waitcnt lgkmcnt(0)" ::: "memory"); SBAR(); }
#pragma unroll
        for (int r = 0; r < 16; ++r) { p0[r] = NEG; p1[r] = NEG; } return; }
    const lchar* rowp = Kb + r32 * 256; const int e = (hi * 16 + koff) ^ ((r32 & 15) << 4);
    constexpr int NG = DQK / (16 * GS);
    bf16x8 kg[KDB ? 2 : 1][2 * GS];
#define KLD(g_, sl_) do { _Pragma("unroll") for (int j = 0; j < GS; ++j) { const int d0 = GS * (g_) + j; const lchar* a = rowp + (e ^ (d0 * 32));   \
            if constexpr (KDB) { const unsigned aa_ = lds_addr(a);                                                                                     \
                asm volatile("ds_read_b128 %0, %1" : "=v"(kg[sl_][2 * j]) : "v"(aa_) : "memory"); asm volatile("ds_read_b128 %0, %1 offset:8192" : "=v"(kg[sl_][2 * j + 1]) : "v"(aa_) : "memory"); }   \
            else { kg[sl_][2 * j] = *reinterpret_cast<const ALAS bf16x8*>(a); kg[sl_][2 * j + 1] = *reinterpret_cast<const ALAS bf16x8*>(a + 32 * 256); } } } while (0)
    if constexpr (PRE) {
#pragma unroll
        for (int j = 0; j < 2 * GS; ++j) kg[0][j] = kpre[j];
    } else KLD(0, 0);
#pragma unroll
    for (int g = 0; g < NG; ++g) {
        constexpr int dummy_ = 0; (void)dummy_;
        const int sl = KDB ? (g & 1) : 0;
        if (KDB) { if (g + 1 < NG) KLD(g + 1, (g + 1) & 1); }
        else if (g > 0) KLD(g, 0);
        if (VPRE && g == NG - 1) {
#pragma unroll
            for (int d_ = 0; d_ < 4; ++d_) { vpre[2 * d_] = vtr(vbaddr + v_rd_off(d_, 0, 0)); vpre[2 * d_ + 1] = vtr(vbaddr + v_rd_off(d_, 0, 1)); }
        }
        if constexpr (KDB) { static_assert(!VPRE, "counted waits assume only K reads in flight"); if (g + 1 < NG) asm volatile("s_waitcnt lgkmcnt(%0)" :: "n"(2 * GS) : "memory"); else asm volatile("s_waitcnt lgkmcnt(0)" ::: "memory"); }
        SBAR();
#pragma unroll
        for (int j = 0; j < GS; ++j) {
            if (g == 0 && j == 0) {
                if constexpr (FIXM) { p0 = __builtin_amdgcn_mfma_f32_32x32x16_bf16(kg[0][0], qr[0], negm, 0, 0, 0); p1 = __builtin_amdgcn_mfma_f32_32x32x16_bf16(kg[0][1], qr[0], negm, 0, 0, 0); }
                else { p0 = __builtin_amdgcn_mfma_f32_32x32x16_bf16(kg[0][0], qr[0], f32x16{}, 0, 0, 0); p1 = __builtin_amdgcn_mfma_f32_32x32x16_bf16(kg[0][1], qr[0], f32x16{}, 0, 0, 0); }
            } else { p0 = __builtin_amdgcn_mfma_f32_32x32x16_bf16(kg[sl][2 * j], qr[GS * g + j], p0, 0, 0, 0); p1 = __builtin_amdgcn_mfma_f32_32x32x16_bf16(kg[sl][2 * j + 1], qr[GS * g + j], p1, 0, 0, 0); }
        }
        SBAR();
    }
#undef KLD
    if (nearb) {
#pragma unroll
        for (int r = 0; r < 16; ++r) { const int c = (r & 3) + 8 * (r >> 2); p0[r] += *(const ALAS float*)(uintptr_t)(bb + 4u * (unsigned)(59 - c)); }
#pragma unroll
        for (int r = 0; r < 16; ++r) { const int c = (r & 3) + 8 * (r >> 2); p1[r] += *(const ALAS float*)(uintptr_t)(bb + 4u * (unsigned)(27 - c)); }
    }
}
template <int NF> __device__ __forceinline__ float qrow_norm2(const bf16x8* qr) {
    float n2 = 0.f;
#pragma unroll
    for (int d0 = 0; d0 < NF; ++d0)
#pragma unroll
        for (int j = 0; j < 8; ++j) { const float a = __uint_as_float(((unsigned)(unsigned short)qr[d0][j]) << 16); n2 += a * a; }
    auto rr = __builtin_amdgcn_permlane32_swap(__float_as_uint(n2), __float_as_uint(n2), false, false);
    return __uint_as_float(rr[0]) + __uint_as_float(rr[1]);
}
__device__ __forceinline__ void decideSM(const f32x16& p0, const f32x16& p1, float& m_reg, float& alpha) {
    float pmax = fmaxf(p0[0], p1[0]);
#pragma unroll
    for (int r = 1; r < 16; ++r) pmax = fmaxf(pmax, fmaxf(p0[r], p1[r]));
    { auto rr = __builtin_amdgcn_permlane32_swap(__float_as_uint(pmax), __float_as_uint(pmax), false, false);
      pmax = fmaxf(__uint_as_float(rr[0]), __uint_as_float(rr[1])); }
    if (__builtin_expect(__all(pmax - m_reg <= THR), 1)) { alpha = 1.f; }
    else { const float mn = fmaxf(m_reg, pmax); alpha = __builtin_amdgcn_exp2f(m_reg - mn); m_reg = mn; }
}
template <bool SUBM>
__device__ __forceinline__ void sm_pv(f32x16* o, unsigned vb, const f32x16& p0, const f32x16& p1, float msub, float& lpart, bool act) {
    if (!act) return;
    float ps = 0.f;
#define KS_STEP(P, B_, ks) do {                                                                                              \
        const s16x4 l0 = vtr(vb + v_rd_off(0, ks, 0)), h0 = vtr(vb + v_rd_off(0, ks, 1)), l1 = vtr(vb + v_rd_off(1, ks, 0)), h1 = vtr(vb + v_rd_off(1, ks, 1));   \
        const s16x4 l2 = vtr(vb + v_rd_off(2, ks, 0)), h2 = vtr(vb + v_rd_off(2, ks, 1)), l3 = vtr(vb + v_rd_off(3, ks, 0)), h3 = vtr(vb + v_rd_off(3, ks, 1));   \
        float e_[8];                                                                                                         \
        _Pragma("unroll") for (int j = 0; j < 8; ++j) { e_[j] = __builtin_amdgcn_exp2f(SUBM ? P[B_ + j] - msub : P[B_ + j]); ps += e_[j]; }                     \
        const u32x4 w_ = {cvtpk(e_[0], e_[1]), cvtpk(e_[2], e_[3]), cvtpk(e_[4], e_[5]), cvtpk(e_[6], e_[7])}; const bf16x8 pa_ = __builtin_bit_cast(bf16x8, w_);   \
        SBAR();                                                                                                              \
        o[0] = __builtin_amdgcn_mfma_f32_32x32x16_bf16(pa_, (bf16x8){l0[0], l0[1], l0[2], l0[3], h0[0], h0[1], h0[2], h0[3]}, o[0], 0, 0, 0);                     \
        o[1] = __builtin_amdgcn_mfma_f32_32x32x16_bf16(pa_, (bf16x8){l1[0], l1[1], l1[2], l1[3], h1[0], h1[1], h1[2], h1[3]}, o[1], 0, 0, 0);                     \
        o[2] = __builtin_amdgcn_mfma_f32_32x32x16_bf16(pa_, (bf16x8){l2[0], l2[1], l2[2], l2[3], h2[0], h2[1], h2[2], h2[3]}, o[2], 0, 0, 0);                     \
        o[3] = __builtin_amdgcn_mfma_f32_32x32x16_bf16(pa_, (bf16x8){l3[0], l3[1], l3[2], l3[3], h3[0], h3[1], h3[2], h3[3]}, o[3], 0, 0, 0);                     \
        SBAR(); } while (0)
    KS_STEP(p0, 0, 0); KS_STEP(p0, 8, 1); KS_STEP(p1, 0, 2); KS_STEP(p1, 8, 3);
#undef KS_STEP
    lpart += ps;
}
template <int DQK>
__device__ __forceinline__ void step_pipe(f32x16* o, const lchar* Kb, int koff, int r32, int hi, const bf16x8* qr, unsigned vb, bool nearb, unsigned bb, const f32x16& negm, float& lpart) {
    constexpr int NK = DQK / 16, EPG = 16 / NK;
    const lchar* rowp = Kb + r32 * 256; const int e = (hi * 16 + koff) ^ ((r32 & 15) << 4);
    f32x16 p0, p1;
    bf16x8 k0[NK], k1[NK];
#pragma unroll
    for (int d0 = 0; d0 < NK; ++d0) k0[d0] = *reinterpret_cast<const ALAS bf16x8*>(rowp + (e ^ (d0 * 32)));
#pragma unroll
    for (int d0 = 0; d0 < NK; ++d0) k1[d0] = *reinterpret_cast<const ALAS bf16x8*>(rowp + (e ^ (d0 * 32)) + 32 * 256);
    s16x4 va[8], vb_[8];
#define VRD(dst, ks) do { _Pragma("unroll") for (int d_ = 0; d_ < 4; ++d_) { dst[2 * d_] = vtr(vb + v_rd_off(d_, ks, 0)); dst[2 * d_ + 1] = vtr(vb + v_rd_off(d_, ks, 1)); } } while (0)
#define VFR(src, d_) ((bf16x8){src[2 * (d_)][0], src[2 * (d_)][1], src[2 * (d_)][2], src[2 * (d_)][3], src[2 * (d_) + 1][0], src[2 * (d_) + 1][1], src[2 * (d_) + 1][2], src[2 * (d_) + 1][3]})
    VRD(va, 0);
    if (nearb) {
#pragma unroll
        for (int r = 0; r < 16; ++r) { const int c = (r & 3) + 8 * (r >> 2);
            p0[r] = *(const ALAS float*)(uintptr_t)(bb + 4u * (unsigned)(59 - c)) + negm[r]; p1[r] = *(const ALAS float*)(uintptr_t)(bb + 4u * (unsigned)(27 - c)) + negm[r]; }
    } else { p0 = negm; p1 = negm; }
    SBAR();
#pragma unroll
    for (int d0 = 0; d0 < NK; ++d0) p0 = __builtin_amdgcn_mfma_f32_32x32x16_bf16(k0[d0], qr[d0], p0, 0, 0, 0);
    SBAR();
    float ps = 0.f;
#pragma unroll
    for (int d0 = 0; d0 < NK; ++d0) {
        p1 = __builtin_amdgcn_mfma_f32_32x32x16_bf16(k1[d0], qr[d0], p1, 0, 0, 0);
        SBAR();
#pragma unroll
        for (int j = 0; j < EPG; ++j) { p0[EPG * d0 + j] = __builtin_amdgcn_exp2f(p0[EPG * d0 + j]); ps += p0[EPG * d0 + j]; }
        SBAR();
    }
#define PK8(P, B_) __builtin_bit_cast(bf16x8, (u32x4){cvtpk(P[B_], P[B_ + 1]), cvtpk(P[B_ + 2], P[B_ + 3]), cvtpk(P[B_ + 4], P[B_ + 5]), cvtpk(P[B_ + 6], P[B_ + 7])})
    const bf16x8 pa0 = PK8(p0, 0), pa1 = PK8(p0, 8);
    VRD(vb_, 1);
    SBAR();
#pragma unroll
    for (int d_ = 0; d_ < 4; ++d_) {
        o[d_] = __builtin_amdgcn_mfma_f32_32x32x16_bf16(pa0, VFR(va, d_), o[d_], 0, 0, 0);
        SBAR();
        p1[2 * d_] = __builtin_amdgcn_exp2f(p1[2 * d_]); p1[2 * d_ + 1] = __builtin_amdgcn_exp2f(p1[2 * d_ + 1]); ps += p1[2 * d_]; ps += p1[2 * d_ + 1];
        SBAR();
    }
    const bf16x8 pa2 = PK8(p1, 0);
    VRD(va, 2);
    SBAR();
#pragma unroll
    for (int d_ = 0; d_ < 4; ++d_) {
        o[d_] = __builtin_amdgcn_mfma_f32_32x32x16_bf16(pa1, VFR(vb_, d_), o[d_], 0, 0, 0);
        SBAR();
        p1[8 + 2 * d_] = __builtin_amdgcn_exp2f(p1[8 + 2 * d_]); p1[9 + 2 * d_] = __builtin_amdgcn_exp2f(p1[9 + 2 * d_]); ps += p1[8 + 2 * d_]; ps += p1[9 + 2 * d_];
        SBAR();
    }
    const bf16x8 pa3 = PK8(p1, 8);
    VRD(vb_, 3);
    SBAR();
#pragma unroll
    for (int d_ = 0; d_ < 4; ++d_) o[d_] = __builtin_amdgcn_mfma_f32_32x32x16_bf16(pa2, VFR(va, d_), o[d_], 0, 0, 0);
    SBAR();
#pragma unroll
    for (int d_ = 0; d_ < 4; ++d_) o[d_] = __builtin_amdgcn_mfma_f32_32x32x16_bf16(pa3, VFR(vb_, d_), o[d_], 0, 0, 0);
    SBAR();
    lpart += ps;
#undef VRD
#undef VFR
#undef PK8
}
struct NoHook { __device__ __forceinline__ void operator()(int) const {} };
struct DmaHook {
    const bf16_t* Kg; const bf16_t* Vg; size_t k0; int ko0, ko1, vo0, vo1; lchar* kl; lchar* vl; bool on;
    __device__ __forceinline__ void operator()(int pi) const {
        if (!on) return;
        int o_ = (pi == 0) ? ko0 : (pi == 1) ? ko1 : (pi == 2) ? vo0 : vo1; asm volatile("" : "+v"(o_));
        const bf16_t* src_ = ((pi < 2) ? Kg : Vg) + k0 + o_;
        lchar* dst_ = ((pi < 2) ? kl : vl) + (pi & 1) * 1024;
        __builtin_amdgcn_global_load_lds((const unsigned*)src_, (ALAS unsigned*)dst_, 16, 0, 0);
    }
};
template <bool SUBM, bool VPRE = false, typename HOOK = NoHook, int DSP = 0>
__device__ __forceinline__ void sm_pv2(f32x16* o, unsigned vb, const f32x16& p0, const f32x16& p1, float msub, float& lpart, bool act, const s16x4* vpre = nullptr, const HOOK hook = HOOK{},
                                       bool d_on = false, const bf16_t* d_k = nullptr, const bf16_t* d_v = nullptr, int d_ko0 = 0, int d_ko1 = 0, int d_vo0 = 0, int d_vo1 = 0, lchar* d_kl = nullptr, lchar* d_vl = nullptr) {
#define DSPP(pi) do { if constexpr (DSP != 0) { if (d_on) { if ((pi) == 0) __builtin_amdgcn_global_load_lds((const unsigned*)(d_k + d_ko0), (ALAS unsigned*)(d_kl), 16, 0, 0); \
        else if ((pi) == 1) __builtin_amdgcn_global_load_lds((const unsigned*)(d_k + d_ko1), (ALAS unsigned*)(d_kl + 1024), 16, 0, 0); \
        else if ((pi) == 2) __builtin_amdgcn_global_load_lds((const unsigned*)(d_v + d_vo0), (ALAS unsigned*)(d_vl), 16, 0, 0); \
        else __builtin_amdgcn_global_load_lds((const unsigned*)(d_v + d_vo1), (ALAS unsigned*)(d_vl + 1024), 16, 0, 0); } } } while (0)
    if (!act) { hook(0); hook(1); hook(2); hook(3); DSPP(0); DSPP(1); DSPP(2); DSPP(3); return; }
#define DSPH(h) do { if constexpr (DSP == 1) DSPP(h); else if constexpr (DSP == 2) { if ((h) < 2) { DSPP(2 * (h)); DSPP(2 * (h) + 1); } } } while (0)
    float ps = 0.f;
    s16x4 va[8], vc[8];
#define VRD(dst, ks) do { _Pragma("unroll") for (int d_ = 0; d_ < 4; ++d_) { dst[2 * d_] = vtr(vb + v_rd_off(d_, ks, 0)); dst[2 * d_ + 1] = vtr(vb + v_rd_off(d_, ks, 1)); } } while (0)
#define VFR(src, d_) ((bf16x8){src[2 * (d_)][0], src[2 * (d_)][1], src[2 * (d_)][2], src[2 * (d_)][3], src[2 * (d_) + 1][0], src[2 * (d_) + 1][1], src[2 * (d_) + 1][2], src[2 * (d_) + 1][3]})
#define EX(P, i) __builtin_amdgcn_exp2f(SUBM ? P[i] - msub : P[i])
    if constexpr (VPRE) {
#pragma unroll
        for (int j = 0; j < 8; ++j) va[j] = vpre[j];
    } else VRD(va, 0);
    float e_[8]; u32x4 w_;
#pragma unroll
    for (int j = 0; j < 8; ++j) { e_[j] = EX(p0, j); ps += e_[j]; }
    w_ = (u32x4){cvtpk(e_[0], e_[1]), cvtpk(e_[2], e_[3]), cvtpk(e_[4], e_[5]), cvtpk(e_[6], e_[7])};
    bf16x8 pa_ = __builtin_bit_cast(bf16x8, w_);
    SBAR();
#define KS_PIPE(VCUR, VNXT, ksn, PN, BN) do {                                                                                  \
        VRD(VNXT, ksn);                                                                                                        \
        SBAR();                                                                                                                \
        o[0] = __builtin_amdgcn_mfma_f32_32x32x16_bf16(pa_, VFR(VCUR, 0), o[0], 0, 0, 0); SBAR();                               \
        e_[0] = EX(PN, BN + 0); e_[1] = EX(PN, BN + 1); ps += e_[0]; ps += e_[1]; SBAR();                                       \
        o[1] = __builtin_amdgcn_mfma_f32_32x32x16_bf16(pa_, VFR(VCUR, 1), o[1], 0, 0, 0); SBAR();                               \
        e_[2] = EX(PN, BN + 2); e_[3] = EX(PN, BN + 3); ps += e_[2]; ps += e_[3]; SBAR();                                       \
        o[2] = __builtin_amdgcn_mfma_f32_32x32x16_bf16(pa_, VFR(VCUR, 2), o[2], 0, 0, 0); SBAR();                               \
        e_[4] = EX(PN, BN + 4); e_[5] = EX(PN, BN + 5); ps += e_[4]; ps += e_[5]; w_[0] = cvtpk(e_[0], e_[1]); w_[1] = cvtpk(e_[2], e_[3]); SBAR();   \
        o[3] = __builtin_amdgcn_mfma_f32_32x32x16_bf16(pa_, VFR(VCUR, 3), o[3], 0, 0, 0); SBAR();                               \
        e_[6] = EX(PN, BN + 6); e_[7] = EX(PN, BN + 7); ps += e_[6]; ps += e_[7]; w_[2] = cvtpk(e_[4], e_[5]); w_[3] = cvtpk(e_[6], e_[7]);           \
        pa_ = __builtin_bit_cast(bf16x8, w_); SBAR(); } while (0)
    hook(0); DSPH(0); SBAR();
    KS_PIPE(va, vc, 1, p0, 8);
    hook(1); DSPH(1); SBAR();
    KS_PIPE(vc, va, 2, p1, 0);
    hook(2); DSPH(2); SBAR();
    KS_PIPE(va, vc, 3, p1, 8);
    hook(3); DSPH(3); SBAR();
#pragma unroll
    for (int d_ = 0; d_ < 4; ++d_) o[d_] = __builtin_amdgcn_mfma_f32_32x32x16_bf16(pa_, VFR(vc, d_), o[d_], 0, 0, 0);
    SBAR();
    lpart += ps;
#undef KS_PIPE
#undef EX
#undef VRD
#undef VFR
#undef DSPP
#undef DSPH
}
__device__ __forceinline__ void head_dma(lchar* lds, const bf16_t* __restrict__ Kg, const bf16_t* __restrict__ Vg, int ld, int j_lo, int NT) {
    int tid = threadIdx.x; asm volatile("" : "+v"(tid));
    const int wid = __builtin_amdgcn_readfirstlane(tid >> 6), lane = tid & 63;
    lchar* V_lds = lds + L_V; lchar* K_lds = lds + L_K; const int dpiece = wid * 2048;
#pragma unroll
    for (int t = 0; t < 2; ++t) {
        if (t < NT) { const size_t k0_ = (size_t)(j_lo + t) * KVBLK * (size_t)ld;
#pragma unroll
            for (int i = 0; i < 2; ++i) {
                const int row = (wid * 2 + i) * 4 + (lane >> 4), chunk = (lane & 15) ^ (row & 15);
                const int B_ = (wid * 2 + i) * 1024 + lane * 16, sub = B_ >> 9, kk = (sub >> 2) * 8 + ((B_ & 511) >> 6), cc = (sub & 3) * 32 + (((B_ & 511) >> 1) & 31);
                __builtin_amdgcn_global_load_lds((const unsigned*)(Kg + k0_ + row * ld + chunk * 8), (ALAS unsigned*)(K_lds + t * SHM_K + dpiece + i * 1024), 16, 0, 0);
                __builtin_amdgcn_global_load_lds((const unsigned*)(Vg + k0_ + kk * ld + cc), (ALAS unsigned*)(V_lds + t * SHM_V + dpiece + i * 1024), 16, 0, 0); } }
    }
}
template <int MODE, int DQK, bool NEGM = false, int FIXM = 0, bool FUSE = false, bool PIPE = false, int KGS = 2, bool SMP2 = false, bool KPRE = false, bool VPRE = false, bool KDB = false, int PRIO = 0, int DMAPOS = 0, bool HEADPRE = false>
__device__ __forceinline__ void attn_tiles_dma(lchar* lds, const bf16_t* __restrict__ Kg, const bf16_t* __restrict__ Vg, int ld, int j_lo, int NT, const ALAS int* list,
                                           const bf16x8* qr, int koff, const Lane L, unsigned sw0, unsigned sw1, unsigned sw2, unsigned sw3, f32x16* o, float& m_reg, float& l_reg) {
    int tid = threadIdx.x; asm volatile("" : "+v"(tid));
    const int wid = __builtin_amdgcn_readfirstlane(tid >> 6), lane = tid & 63, r32 = lane & 31, hi = lane >> 5;
    lchar* V_lds = lds + L_V; lchar* K_lds = lds + L_K;
    ALAS float* al_l = (ALAS float*)(lds + L_WS) + wid * 64 + 32;
    if (FIXM == 0) m_reg = -1e30f;
    l_reg = 0.f; o[0] = f32x16{}; o[1] = f32x16{}; o[2] = f32x16{}; o[3] = f32x16{};
    const unsigned vb0 = lds_addr(V_lds) + (unsigned)v_rd_base(lane);
    int koffs[2], voffs[2];
#pragma unroll
    for (int i = 0; i < 2; ++i) {
        const int row = (wid * 2 + i) * 4 + (lane >> 4), chunk = (lane & 15) ^ (row & 15);
        koffs[i] = row * ld + chunk * 8;
        const int B_ = (wid * 2 + i) * 1024 + lane * 16, sub = B_ >> 9, kk = (sub >> 2) * 8 + ((B_ & 511) >> 6), cc = (sub & 3) * 32 + (((B_ & 511) >> 1) & 31);
        const int k = kk;
        voffs[i] = k * ld + cc;
    }
    const int dpiece = wid * 2048;
#define TIDX(t) ((MODE == M_SLC) ? __builtin_amdgcn_readfirstlane(list[(t)]) : (j_lo + (t)))
#define DMA(t, ko, vo) do { const size_t k0_ = (size_t)TIDX(t) * KVBLK * (size_t)ld; _Pragma("unroll") for (int i_ = 0; i_ < 2; ++i_) { \
        __builtin_amdgcn_global_load_lds((const unsigned*)(Kg + k0_ + koffs[i_]), (ALAS unsigned*)(K_lds + (ko) + dpiece + i_ * 1024), 16, 0, 0); \
        __builtin_amdgcn_global_load_lds((const unsigned*)(Vg + k0_ + voffs[i_]), (ALAS unsigned*)(V_lds + (vo) + dpiece + i_ * 1024), 16, 0, 0); } } while (0)
#define DMAP(k0_, ko, vo, pi) do { const int i__ = (pi) & 1; if ((pi) < 2) __builtin_amdgcn_global_load_lds((const unsigned*)(Kg + (k0_) + koffs[i__]), (ALAS unsigned*)(K_lds + (ko) + dpiece + i__ * 1024), 16, 0, 0); \
        else __builtin_amdgcn_global_load_lds((const unsigned*)(Vg + (k0_) + voffs[i__]), (ALAS unsigned*)(V_lds + (vo) + dpiece + i__ * 1024), 16, 0, 0); } while (0)
#define VMW() asm volatile("s_waitcnt vmcnt(0)" ::: "memory")
#define RESC(a) do { if (__any((a) < 1.f)) { if (hi == 0) al_l[r32] = (a); asm volatile("s_waitcnt lgkmcnt(0)" ::: "memory");              \
                     _Pragma("unroll") for (int d_ = 0; d_ < 4; ++d_) _Pragma("unroll") for (int r = 0; r < 16; ++r) o[d_][r] *= al_l[crow(r, hi)]; } } while (0)
#define SELW(t) ((MODE == M_SLC) ? *(const ALAS unsigned*)(uintptr_t)(sw0 + 4u * (unsigned)(TIDX(t) >> 5)) : 0u)
#define ACT(t) tile_act<MODE>(TIDX(t) * KVBLK, TIDX(t) & 31, L, SELW(t), SELW(t), SELW(t), SELW(t))
#define NEARB(t) tile_near<MODE>(TIDX(t) * KVBLK, L)
#define BB(t) (L.lut + 4u * (unsigned)(L.qpos - TIDX(t) * KVBLK - 4 * hi + LUT0 - 59))
#define MASKT(P0_, P1_, t, a_) tile_mask<MODE>(P0_, P1_, TIDX(t) * KVBLK, TIDX(t) & 31, L, hi, a_, SELW(t), SELW(t), SELW(t), SELW(t))
    f32x16 p0, p1; float al = 1.f; bf16x8 pa0, pa1, pa2, pa3;
    pa0 = pa1 = pa2 = pa3 = bf16x8{};
    f32x16 negm = f32x16{}; bool started = false; if (NEGM) { m_reg = 0.f; asm volatile("" : "+v"(negm)); }
    if (FIXM == 1) { const float nm_ = -m_reg; _Pragma("unroll") for (int r = 0; r < 16; ++r) negm[r] = nm_; asm volatile("" : "+v"(negm)); }
#ifdef TPROBE_SEC
    unsigned long long tp_[8] = {0, 0, 0, 0, 0, 0, 0, 0}, tp_sec_ = 0, tp_tot_ = 0;
#endif
    int kbo = 0, vbo = 0, vbp = 0;
#define STAGE_NEXT(t) do { if ((t) + 1 < NT) { const int vbn_ = (vbo == 2 * SHM_V) ? 0 : vbo + SHM_V; DMA((t) + 1, kbo ^ SHM_K, vbn_); } } while (0)
#define SOFTMAX(t, a_) do { MASKT(p0, p1, (t), a_); if constexpr (FIXM == 1) { _Pragma("unroll") for (int r = 0; r < 16; ++r) p0[r] = __builtin_amdgcn_exp2f(p0[r]); al = 1.f; finishSM_direct(p0, p1, al, l_reg, pa0, pa1, pa2, pa3); } \
        else if constexpr (FIXM == 2) { partialSM_fix(p0, p1, m_reg); al = 1.f; finishSM_direct(p0, p1, al, l_reg, pa0, pa1, pa2, pa3); } else if constexpr (NEGM) { partialSM_rel(p0, p1, m_reg, al, started, negm); RESC(al); finishSM_pk(p0, p1, al, l_reg, pa0, pa1, pa2, pa3); } \
        else { partialSM(p0, p1, m_reg, al); RESC(al); finishSM_direct(p0, p1, al, l_reg, pa0, pa1, pa2, pa3); } SBAR(); } while (0)
#define QKT(t, a_) do { static_assert(!NEGM, "the LDS-DMA engine has no relative-score form"); qkt_dma<DQK, FIXM == 1, KGS>(p0, p1, K_lds + kbo, koff, r32, hi, qr, a_, NEARB(t), BB(t), negm); } while (0)
#define ADVANCE() do { vbp = vbo; vbo = (vbo == 2 * SHM_V) ? 0 : vbo + SHM_V; kbo ^= SHM_K; } while (0)
    if constexpr (FUSE) {
        float lpart = 0.f;
        const int NS = (NT + 1) >> 1;
        if constexpr (!HEADPRE) { DMA(0, 0, 0); if (NT > 1) DMA(1, SHM_K, SHM_V); }
        VMW(); __syncthreads();
        int so = 0;
        for (int s_ = 0; s_ < NS; ++s_) {
            const int t0_ = 2 * s_;
            int tjA_, tjB_, tjC_, tjD_; unsigned swA_ = 0u, swB_ = 0u;
            if constexpr (MODE == M_SLC) {
                const int lA_ = list[t0_], lB_ = list[t0_ + 1 < NT ? t0_ + 1 : NT - 1], lC_ = list[t0_ + 2 < NT ? t0_ + 2 : NT - 1], lD_ = list[t0_ + 3 < NT ? t0_ + 3 : NT - 1];
                tjA_ = __builtin_amdgcn_readfirstlane(lA_); tjB_ = __builtin_amdgcn_readfirstlane(lB_); tjC_ = __builtin_amdgcn_readfirstlane(lC_); tjD_ = __builtin_amdgcn_readfirstlane(lD_);
                swA_ = *(const ALAS unsigned*)(uintptr_t)(sw0 + 4u * (unsigned)(tjA_ >> 5)); swB_ = *(const ALAS unsigned*)(uintptr_t)(sw0 + 4u * (unsigned)(tjB_ >> 5));
            } else { tjA_ = j_lo + t0_; tjB_ = tjA_ + 1; tjC_ = tjA_ + 2; tjD_ = tjA_ + 3; }
#undef TIDX
#define TIDX(t) (((t) == t0_) ? tjA_ : ((t) == t0_ + 1) ? tjB_ : ((t) == t0_ + 2) ? tjC_ : tjD_)
#undef SELW
#define SELW(t) (((t) == t0_) ? swA_ : swB_)
            bf16x8 kq[2 * KGS];
            TP_T(0);
            if constexpr (KPRE) { k_first<KGS, KDB>(kq, K_lds + so, koff, r32, hi); SBAR(); }
#define DMA_NEXT_A() do { if (s_ + 1 < NS) { const int sn_ = so ^ SLOT; DMA(t0_ + 2, sn_, sn_); } } while (0)
#define DMA_NEXT_B() do { if (t0_ + 3 < NT) { const int sn_ = so ^ SLOT; DMA(t0_ + 3, sn_ + SHM_K, sn_ + SHM_V); } } while (0)
            const bool nA_ = s_ + 1 < NS, nB_ = t0_ + 3 < NT; const int snx_ = so ^ SLOT;
            size_t kA_ = 0, kB_ = 0;
            if constexpr (DMAPOS == 3) { if (nA_) kA_ = (size_t)TIDX(t0_ + 2) * KVBLK * (size_t)ld; if (nB_) kB_ = (size_t)TIDX(t0_ + 3) * KVBLK * (size_t)ld; }
            if constexpr (DMAPOS == 0) { DMA_NEXT_A(); DMA_NEXT_B(); }
#pragma unroll
            for (int u_ = 0; u_ < 2; ++u_) {
                const int t = t0_ + u_;
                if (u_ == 1 && t >= NT) { if constexpr (KPRE && KDB) { asm volatile("s_waitcnt lgkmcnt(0)" ::: "memory"); SBAR(); } break; }
                kbo = so + u_ * SHM_K; vbo = so + u_ * SHM_V;
                if constexpr (PRIO != 0) { const bool hp_ = (PRIO == 1) ? (((wid >> 2) ^ u_) & 1) == 0 : (PRIO == 2) ? (((wid >> 2) ^ u_) & 1) != 0 : (wid >= 4); if (hp_) __builtin_amdgcn_s_setprio(1); else __builtin_amdgcn_s_setprio(0); }
                const bool a_ = ACT(t);
                s16x4 vq[8];
                SBAR(); qkt_dma<DQK, FIXM == 1, KGS, KPRE, VPRE, KDB>(p0, p1, K_lds + kbo, koff, r32, hi, qr, a_, NEARB(t), BB(t), negm, kq, vq, vb0 + (unsigned)vbo);
                MASKT(p0, p1, (t), a_);
                if constexpr (FIXM == 0) { decideSM(p0, p1, m_reg, al); RESC(al); lpart *= al; }
                SBAR();
                TP_PIN(p0); if (u_ == 0) TP_T(1); else TP_T(3);
                if constexpr (DMAPOS == 1) { if (u_ == 0) { DMA_NEXT_A(); DMA_NEXT_B(); } }
                if constexpr (DMAPOS == 2) { if (u_ == 0) DMA_NEXT_A(); else DMA_NEXT_B(); }
                if constexpr (KPRE) { if (u_ == 0) { k_first<KGS, KDB>(kq, K_lds + so + SHM_K, koff, r32, hi); SBAR(); } }
                if constexpr (SMP2 && DMAPOS == 5) {
                    const bool on_ = u_ == 0 ? nA_ : nB_; size_t k0_ = 0; if (on_) k0_ = (size_t)TIDX(t0_ + 2 + u_) * KVBLK * (size_t)ld;
                    if (u_ == 0) {
                    sm_pv2<FIXM != 1, VPRE, NoHook, 1>(o, vb0 + (unsigned)vbo, p0, p1, m_reg, lpart, a_, vq, NoHook{}, on_, Kg + k0_, Vg + k0_, koffs[0], koffs[1], voffs[0], voffs[1],
                                                          K_lds + snx_ + u_ * SHM_K + dpiece, V_lds + snx_ + u_ * SHM_V + dpiece);
                    } else {
                    sm_pv2<FIXM != 1, VPRE, NoHook, 2>(o, vb0 + (unsigned)vbo, p0, p1, m_reg, lpart, a_, vq, NoHook{}, on_, Kg + k0_, Vg + k0_, koffs[0], koffs[1], voffs[0], voffs[1],
                                                          K_lds + snx_ + u_ * SHM_K + dpiece, V_lds + snx_ + u_ * SHM_V + dpiece);
                    }
                } else
                if constexpr (SMP2 && DMAPOS == 3) {
                    const DmaHook hk_{Kg, Vg, u_ == 0 ? kA_ : kB_, koffs[0], koffs[1], voffs[0], voffs[1], K_lds + snx_ + u_ * SHM_K + dpiece, V_lds + snx_ + u_ * SHM_V + dpiece, u_ == 0 ? nA_ : nB_};
                    sm_pv2<FIXM != 1, VPRE, DmaHook>(o, vb0 + (unsigned)vbo, p0, p1, m_reg, lpart, a_, vq, hk_);
                } else
                if constexpr (SMP2) sm_pv2<FIXM != 1, VPRE>(o, vb0 + (unsigned)vbo, p0, p1, m_reg, lpart, a_, vq); else sm_pv<FIXM != 1>(o, vb0 + (unsigned)vbo, p0, p1, m_reg, lpart, a_);
                TP_PIN(o[3]); if (u_ == 0) TP_T(2); else TP_T(4);
            }
            VMW(); __syncthreads();
            TP_T(5); TP_ACC();
#undef DMA_NEXT_A
#undef DMA_NEXT_B
            so ^= SLOT;
        }
        if constexpr (PRIO != 0) __builtin_amdgcn_s_setprio(0);
        { auto rr = __builtin_amdgcn_permlane32_swap(__float_as_uint(lpart), __float_as_uint(lpart), false, false); l_reg = __uint_as_float(rr[0]) + __uint_as_float(rr[1]); }
#undef TIDX
#define TIDX(t) ((MODE == M_SLC) ? __builtin_amdgcn_readfirstlane(list[(t)]) : (j_lo + (t)))
#undef SELW
#define SELW(t) ((MODE == M_SLC) ? *(const ALAS unsigned*)(uintptr_t)(sw0 + 4u * (unsigned)(TIDX(t) >> 5)) : 0u)
    } else {
    DMA(0, 0, 0); VMW();
    __syncthreads();
    if (wid < 4) {
        for (int t = 0; t < NT; ++t) {
            const bool a_ = ACT(t);
            STAGE_NEXT(t);
            TP_T(0);
            SBAR(); QKT(t, a_);
            TP_PIN(p0); TP_T(1);
            SOFTMAX(t, a_);
            TP_T(2);
            TP_T(3);
            pv_rt(o, vb0 + (unsigned)vbo, pa0, pa1, pa2, pa3, a_);
            TP_PIN(o[3]); TP_T(4);
            VMW(); __syncthreads();
            TP_T(5); TP_ACC();
            ADVANCE();
        }
        __syncthreads();
    } else {
        bool ap_ = false;
        for (int t = 0; t < NT; ++t) {
            STAGE_NEXT(t);
            TP_T(3);
            SBAR(); pv_rt(o, vb0 + (unsigned)vbp, pa0, pa1, pa2, pa3, ap_);
            TP_PIN(o[3]); TP_T(4);
            const bool a_ = ACT(t);
            TP_T(0);
            SBAR(); QKT(t, a_);
            TP_PIN(p0); TP_T(1);
            TP_T(6);
            SOFTMAX(t, a_);
            TP_T(7);
            ap_ = a_;
            VMW(); __syncthreads();
            TP_T(5); TP_ACC_Y();
            ADVANCE();
        }
        SBAR(); pv_rt(o, vb0 + (unsigned)vbp, pa0, pa1, pa2, pa3, ap_);
        __syncthreads();
    }
    }
#ifdef TPROBE_SEC
    if (TP_ON && lane == 0) { atomicAdd(L.tpw, tp_sec_); atomicAdd(L.tpw + 1, tp_tot_); }
#endif
#undef STAGE_NEXT
#undef SOFTMAX
#undef QKT
#undef ADVANCE
#undef TIDX
#undef DMA
#undef DMAP
#undef VMW
#undef RESC
#undef ACT
#undef SELW
#undef NEARB
#undef BB
#undef MASKT
}
}
constexpr int NWAVES = 8;
#ifndef MK_N_LAUNCHES
#define MK_N_LAUNCHES 1
#endif
constexpr int N_LAUNCHES = MK_N_LAUNCHES;
constexpr int PER_PHASE = 10;
static_assert(N_LAUNCHES == 1 || N_LAUNCHES == PER_PHASE, "MK_N_LAUNCHES is 1 or 10");
constexpr int BATCH = 2, SEQ = 8192, TOK = BATCH * SEQ, DM = 2048, NPROJ = 5656, LDP = 5888, DFF = 5632, NUP = 2 * DFF, NIN = 23;
constexpr float EPS = 1e-6f, LOG2E = 1.4426950408889634f;
constexpr float C2D = 0.125f * LOG2E, C2N = 0.08838834764831845f * LOG2E;
constexpr int C_DQ = 0, C_DK = 1024, C_DV = 2048, C_NQ = 3072, C_KC = 4096, C_VC = 4352, C_KS = 4608, C_VS = 4864, C_KW = 5120, C_VW = 5376;
constexpr size_t MiB = 1u << 20, KiB = 1u << 10;
constexpr size_t WS_CTL = 0, CTL_ZERO_BYTES = 1 * MiB;
constexpr size_t WS_WDN = 1 * MiB;
constexpr size_t WS_CW1K = 23 * MiB, WS_CW1V = 25 * MiB;
constexpr size_t WS_CW2K = 27 * MiB, WS_CW2V = 27 * MiB + 64 * KiB;
constexpr size_t WS_MISC = 27 * MiB + 128 * KiB;
constexpr size_t WS_KCMP = 28 * MiB, WS_VCMP = 28 * MiB + 512 * KiB;
constexpr size_t WS_WIN = 29 * MiB;
constexpr size_t WS_WOUT = 52 * MiB;
constexpr size_t WS_WUP = 60 * MiB;
constexpr size_t WS_H = 104 * MiB;
constexpr size_t WS_Y2 = 29 * MiB;
constexpr size_t WS_Y = 418 * MiB;
constexpr size_t WS_PROJ = 168 * MiB;
constexpr size_t WS_ACT = 168 * MiB;
constexpr size_t WS_MIX = 104 * MiB;
constexpr size_t WS_HALO = 29 * MiB;
constexpr size_t WS_GATES = 416 * MiB;
constexpr size_t WS_NSAACC = 418 * MiB;
constexpr size_t WS_END = 482 * MiB;
constexpr int MISC_LAM = 0, MISC_B1 = 64, MISC_LUT = 40960, MISC_B1F = 45056, MISC_LUTMAX = 45568;
constexpr int CTL_KMX = 36864, CTL_KCMX = 37120;
constexpr int CW_BAR = 4096;
constexpr int RING_OFF = 0, RING_BYTES = 131072;
constexpr int LDSCTL_OFF = 141312  , MISC_OFF = LDSCTL_OFF + 320;
constexpr int LDS_BYTES = 147456;
static_assert(att::L_END <= LDSCTL_OFF && RING_BYTES <= LDSCTL_OFF && MISC_OFF + 128 <= LDS_BYTES, "LDS map");

#define GAS __attribute__((address_space(1)))
#define LAS __attribute__((address_space(3)))
typedef unsigned short bf16;
typedef unsigned v4u __attribute__((ext_vector_type(4)));
typedef unsigned v2u __attribute__((ext_vector_type(2)));
typedef float f32x4 __attribute__((ext_vector_type(4)));
typedef short bf16x8 __attribute__((ext_vector_type(8)));
typedef GAS unsigned gu32;
#define RLX_AGENT __ATOMIC_RELAXED, __HIP_MEMORY_SCOPE_AGENT
#define LDS_WAIT() asm volatile("s_waitcnt lgkmcnt(0)" ::: "memory")
#define VM_WAIT() asm volatile("s_waitcnt vmcnt(0)" ::: "memory")
__device__ __forceinline__ unsigned f2bf(float f) { unsigned u = __builtin_bit_cast(unsigned, f); return (u + 0x7fffu + ((u >> 16) & 1u)) >> 16; }
__device__ __forceinline__ unsigned pk2(float lo, float hi) { return f2bf(lo) | (f2bf(hi) << 16); }
__device__ __forceinline__ float gelu_tanh_f(float v) { const float z2 = 1.5957691216f * (v + 0.044715f * v * v * v); return v * __builtin_amdgcn_rcpf(1.0f + __builtin_amdgcn_exp2f(-1.4426950408889634f * z2)); }
#define XB_TMO      128
#define XB_XCNT(j)  (256  + 64 * (j))
#define XB_XSUB(j)  (1280 + 64 * (j))
#define XB_XGEN(j)  (2304 + 64 * (j))
#define XB_TOP      3328
#define XB_TOPGEN   3392
#define XCD_BAR_WORDS 3456
#define XB_SPIN_CAP (1u << 18)

__device__ __forceinline__ unsigned xb_ld(unsigned* p)              { return __hip_atomic_load(p, __ATOMIC_RELAXED, __HIP_MEMORY_SCOPE_AGENT); }
__device__ __forceinline__ unsigned xb_add(unsigned* p, unsigned v) { return __hip_atomic_fetch_add(p, v, __ATOMIC_RELAXED, __HIP_MEMORY_SCOPE_AGENT); }
__device__ __forceinline__ unsigned xb_xcc_id() { return (unsigned)__builtin_amdgcn_s_getreg((3 << 11) | 20) & 0xFu; }
#define XB_SPIN(cond, bar) do { unsigned _sp = 0; while (cond) { __builtin_amdgcn_s_sleep(1); \
    if ((++_sp & 255u) == 0u) { if (xb_ld(&(bar)[XB_TMO])) break; if (_sp > XB_SPIN_CAP) { atomicAdd(&(bar)[XB_TMO], 1u); break; } } } } while (0)

struct XcdBarrier {
    unsigned* bar; unsigned x;
    volatile LAS unsigned* st;
};

__device__ __forceinline__ XcdBarrier xcd_barrier_post(unsigned* bar, volatile LAS unsigned* st) {
    XcdBarrier b; b.bar = bar; b.x = xb_xcc_id(); b.st = st;
    if (threadIdx.x == 0) (void)xb_add(&bar[XB_XCNT(b.x)], 1u);
    return b;
}
__device__ __forceinline__ void xcd_barrier_complete(unsigned* bar, unsigned x, unsigned& nloc, unsigned& nx) {
    const unsigned G = gridDim.x * gridDim.y * gridDim.z;
    unsigned sum, cnt, mine, sp = 0u;
    for (;;) {
        sum = 0u; cnt = 0u; mine = 0u;
#pragma unroll
        for (unsigned j = 0; j < 16; ++j) { const unsigned c = xb_ld(&bar[XB_XCNT(j)]); sum += c; cnt += (c > 0u) ? 1u : 0u; mine = (j == x) ? c : mine; }
        if (sum == G) break;
        __builtin_amdgcn_s_sleep(1);
        if ((++sp & 255u) == 0u) { if (xb_ld(&bar[XB_TMO])) break; if (sp > XB_SPIN_CAP) { atomicAdd(&bar[XB_TMO], 1u); break; } }
    }
    nloc = mine > 0u ? mine : 1u; nx = cnt > 0u ? cnt : 1u;
}

__device__ __forceinline__ void xcd_barrier(const XcdBarrier& b) {
    asm volatile("s_waitcnt vmcnt(0)" ::: "memory");
    __syncthreads();
    if (threadIdx.x == 0) {
        unsigned* bar = b.bar;
        __builtin_amdgcn_s_waitcnt(0);
        unsigned nloc = b.st[0], nx = b.st[1];
        if (nloc == 0u) { xcd_barrier_complete(bar, b.x, nloc, nx); b.st[0] = nloc; b.st[1] = nx; }
        const unsigned old = xb_add(&bar[XB_XSUB(b.x)], 1u);
        const unsigned gen = old / nloc;
        if (old + 1u == (gen + 1u) * nloc) {
            __builtin_amdgcn_fence(__ATOMIC_RELEASE, "agent");
            asm volatile("s_waitcnt vmcnt(0)" ::: "memory");
            const unsigned og = xb_add(&bar[XB_TOP], 1u);
            const unsigned tg = og / nx;
            if (og + 1u == (tg + 1u) * nx) xb_add(&bar[XB_TOPGEN], 1u);
            else XB_SPIN(xb_ld(&bar[XB_TOPGEN]) == tg, bar);
            __builtin_amdgcn_fence(__ATOMIC_ACQUIRE, "agent");
            xb_add(&bar[XB_XGEN(b.x)], 1u);
            asm volatile("s_waitcnt vmcnt(0)" ::: "memory");
        } else {
            XB_SPIN(xb_ld(&bar[XB_XGEN(b.x)]) == gen, bar);
            __builtin_amdgcn_fence(__ATOMIC_ACQUIRE, "agent");
            asm volatile("s_waitcnt vmcnt(0)" ::: "memory");
        }
    }
    __syncthreads();
}
__device__ __forceinline__ float wave_sum(float v) {
#pragma unroll
    for (int o = 1; o < 64; o <<= 1) v += __shfl_xor(v, o);
    return v;
}
__device__ __forceinline__ unsigned cvtpk2(float lo, float hi) { unsigned r; asm volatile("v_cvt_pk_bf16_f32 %0, %1, %2" : "=v"(r) : "v"(lo), "v"(hi)); return r; }
__device__ __forceinline__ void transpose_item(const float* __restrict__ W, int K, int N, int npad, int nblk, bf16* WT, int mode, int item, int lane) {
    const int kb = item / nblk, nb = item - kb * nblk, k0 = 32 * kb, n = 256 * nb + 4 * lane;
    if (n >= npad) return;
    const bool inb = n < N;
    int orow = n;
    if (mode == 1) { const int bj = n / DFF, rem = n - bj * DFF; orow = (rem >> 7) * 256 + bj * 128 + (rem & 127); }
    const float* src = W + (size_t)k0 * N + n; bf16* dst = (mode == 2) ? WT + ((size_t)kb * N + n) * 32 : WT + (size_t)orow * K + k0;
    const size_t estride = (mode == 2) ? 32 : (size_t)K;
    f32x4 v[32];
#pragma unroll
    for (int j = 0; j < 32; ++j) v[j] = inb ? __builtin_nontemporal_load((const f32x4*)(src + (size_t)j * N)) : (f32x4){0.f, 0.f, 0.f, 0.f};
#pragma unroll
    for (int kk = 0; kk < 32; kk += 8) {
#pragma unroll
        for (int e = 0; e < 4; ++e) { v4u o; o.x = cvtpk2(v[kk + 0][e], v[kk + 1][e]); o.y = cvtpk2(v[kk + 2][e], v[kk + 3][e]); o.z = cvtpk2(v[kk + 4][e], v[kk + 5][e]); o.w = cvtpk2(v[kk + 6][e], v[kk + 7][e]);
            *(v4u*)(dst + (size_t)e * estride + kk) = o; }
    }
}
__device__ __forceinline__ int t5_bucket(int d) {
    if (d < 16) return d;
    return 16 + (d >= 19) + (d >= 21) + (d >= 24) + (d >= 27) + (d >= 31) + (d >= 35) + (d >= 40) + (d >= 46) + (d >= 52) + (d >= 59) + (d >= 67) + (d >= 77) + (d >= 87) + (d >= 99) + (d >= 113);
}
__device__ __forceinline__ void rms_rows2_bf16(const float* xrow0, const float* xrow1, const f32x4 (&gvr)[8], bf16* orow0, bf16* orow1, int lane) {
    const f32x4* xr0 = (const f32x4*)xrow0 + lane; const f32x4* xr1 = (const f32x4*)xrow1 + lane;
    f32x4 v0[8], v1[8]; float s0 = 0.f, s1 = 0.f;
#pragma unroll
    for (int j = 0; j < 8; ++j) { v0[j] = __builtin_nontemporal_load(xr0 + 64 * j); v1[j] = __builtin_nontemporal_load(xr1 + 64 * j); }
#pragma unroll
    for (int j = 0; j < 8; ++j) { s0 += (v0[j].x * v0[j].x + v0[j].y * v0[j].y) + (v0[j].z * v0[j].z + v0[j].w * v0[j].w); s1 += (v1[j].x * v1[j].x + v1[j].y * v1[j].y) + (v1[j].z * v1[j].z + v1[j].w * v1[j].w); }
    const float r0 = 1.0f / sqrtf(wave_sum(s0) * (1.0f / DM) + EPS), r1 = 1.0f / sqrtf(wave_sum(s1) * (1.0f / DM) + EPS);
    v2u* o0 = (v2u*)orow0 + lane; v2u* o1 = (v2u*)orow1 + lane;
#pragma unroll
    for (int j = 0; j < 8; ++j) { const f32x4 gv = gvr[j];
        v2u w; w.x = pk2(v0[j].x * r0 * gv.x, v0[j].y * r0 * gv.y); w.y = pk2(v0[j].z * r0 * gv.z, v0[j].w * r0 * gv.w); o0[64 * j] = w;
        v2u u; u.x = pk2(v1[j].x * r1 * gv.x, v1[j].y * r1 * gv.y); u.y = pk2(v1[j].z * r1 * gv.z, v1[j].w * r1 * gv.w); o1[64 * j] = u; }
}

struct Ptrs {
    const float* in[NIN]; float* out; unsigned char* ws; int ph_lo, ph_hi;
};

__device__ __forceinline__ void p0_prologue(const Ptrs& P, LAS unsigned char* lds, int vcu, int G, int tid, int lane, int wave) {
    const int gw = vcu * NWAVES + wave, NGW = G * NWAVES;
    constexpr int I_IN = 64 * 23, I_C1 = 128, I_C2 = 8;
    constexpr int NITEMS = I_IN + 2 * I_C1 + 2 * I_C2;
    unsigned char* ws = P.ws;
    for (int it = gw; it < NITEMS; it += NGW) {
        int r = it;
        if (r < I_IN) { transpose_item(P.in[2], DM, NPROJ, LDP, 23, (bf16*)(ws + WS_WIN), 0, r, lane); continue; } r -= I_IN;
        if (r < I_C1) { transpose_item(P.in[10], 4096, 256, 256, 1, (bf16*)(ws + WS_CW1K), 2, r, lane); continue; } r -= I_C1;
        if (r < I_C1) { transpose_item(P.in[12], 4096, 256, 256, 1, (bf16*)(ws + WS_CW1V), 2, r, lane); continue; } r -= I_C1;
        if (r < I_C2) { transpose_item(P.in[11], 256, 128, 128, 1, (bf16*)(ws + WS_CW2K), 0, r, lane); continue; } r -= I_C2;
        transpose_item(P.in[13], 256, 128, 128, 1, (bf16*)(ws + WS_CW2V), 0, r, lane);
    }
    f32x4 gvr0[8];
#pragma unroll
    for (int j = 0; j < 8; ++j) gvr0[j] = ((const f32x4*)P.in[1] + lane)[64 * j];
    for (int m = gw; m < TOK; m += 2 * NGW) { const int m1 = (m + NGW < TOK) ? m + NGW : m;
        rms_rows2_bf16(P.in[0] + (size_t)m * DM, P.in[0] + (size_t)m1 * DM, gvr0, (bf16*)(ws + WS_H) + (size_t)m * DM, (bf16*)(ws + WS_H) + (size_t)m1 * DM, lane); }
    float* misc = (float*)(ws + WS_MISC);
    const int gt = vcu * (NWAVES * 64) + tid;
    if (gt < 2048) {
        const int h = gt >> 7, d = gt & 127; const float* rb = P.in[14];
        misc[MISC_LUT + gt] = (d < 113) ? (rb[t5_bucket(d) * 16 + h] - rb[31 * 16 + h]) * LOG2E : 0.f;
    }
    if (gt >= 2112 && gt < 2176) {
        const int ln = gt - 2112, h = ln >> 2, q = ln & 3; const float* rb = P.in[14]; float mx = 0.f;
        const float far_ = rb[31 * 16 + h];
#pragma unroll
        for (int k = 0; k < 29; ++k) { const int d = q + 4 * k; const float v = (d < 113) ? (rb[t5_bucket(d < 113 ? d : 112) * 16 + h] - far_) * LOG2E : 0.f; mx = fmaxf(mx, v); }
        mx = fmaxf(mx, __shfl_xor(mx, 1)); mx = fmaxf(mx, __shfl_xor(mx, 2));
        if (q == 0) misc[MISC_LUTMAX + h] = mx;
    }
    if (gt >= 2176 && gt < 2240) {
        const int i = gt - 2176;
        const float s1 = wave_sum(P.in[3][i] * P.in[4][i]), s2 = wave_sum(P.in[5][i] * P.in[6][i]);
        if (i == 0) misc[MISC_LAM] = expf(s1) - expf(s2) + 0.2f;
    }
    if (gt >= 8192 && gt < 8192 + 32768) {
        const int q = gt - 8192, which = q >> 14, kc = (q >> 8) & 63, n = q & 255;
        const float* pos = which ? P.in[9] : P.in[8]; const float* w1 = which ? P.in[12] : P.in[10];
        float s0 = 0.f, s1 = 0.f;
#pragma unroll 8
        for (int k = 64 * kc; k < 64 * kc + 64; k += 2) { s0 += pos[k] * w1[(size_t)k * 256 + n]; s1 += pos[k + 1] * w1[(size_t)(k + 1) * 256 + n]; }
        misc[MISC_B1 + (which * 64 + kc) * 256 + n] = s0 + s1;
    }
}

__device__ __forceinline__ bool p0b_weights(const Ptrs& P, int lane, int budget = 1 << 30) {
    constexpr int I_OUT = 64 * 8, I_UP = 64 * 44, I_DN = 176 * 8;
    unsigned char* ws = P.ws;
    unsigned* ctr = (unsigned*)(ws + WS_CTL + 32768);
    for (int n_ = 0; n_ < budget; ++n_) {
        unsigned it0 = 0;
        if (lane == 0) it0 = __hip_atomic_fetch_add(ctr, 1u, __ATOMIC_RELAXED, __HIP_MEMORY_SCOPE_AGENT);
        const int it = __builtin_amdgcn_readfirstlane(it0);
        if (it >= I_OUT + I_UP + I_DN) return true;
        int r = it;
        if (r < I_OUT) { transpose_item(P.in[15], DM, DM, DM, 8, (bf16*)(ws + WS_WOUT), 0, r, lane); continue; } r -= I_OUT;
        if (r < I_UP) { transpose_item(P.in[18], DM, NUP, NUP, 44, (bf16*)(ws + WS_WUP), 1, r, lane); continue; } r -= I_UP;
        transpose_item(P.in[21], DFF, DM, DM, 8, (bf16*)(ws + WS_WDN), 0, r, lane);
    }
    return false;
}
template <int K> __device__ __forceinline__ float swzx(float v) { return __builtin_bit_cast(float, __builtin_amdgcn_ds_swizzle(__builtin_bit_cast(int, v), (K << 10) | 0x1F)); }
__device__ __forceinline__ float sq8(const v4u w) { float s = 0.f; const unsigned a[4] = {w.x, w.y, w.z, w.w};
#pragma unroll
    for (int i = 0; i < 4; ++i) { const float lo = __uint_as_float(a[i] << 16), hi_ = __uint_as_float(a[i] & 0xffff0000u); s += lo * lo + hi_ * hi_; } return s; }
__device__ __forceinline__ void knorm_prep(const Ptrs& P, LAS unsigned char* lds, int vcu, int G, int tid, int lane, int wave) {
    unsigned char* ws = P.ws; const bf16* proj = (const bf16*)(ws + WS_PROJ); unsigned* kmx = (unsigned*)(ws + WS_CTL + CTL_KMX);
    LAS float* red = (LAS float*)(lds + RING_OFF);
    for (int u = vcu; u < 256; u += G) {
        const int b = u >> 7, tile = u & 127, cl = lane & 7;
        const bf16* row = proj + ((size_t)b * SEQ + 64 * tile + 8 * wave + (lane >> 3)) * LDP + cl * 8;
        float n2[20];
#pragma unroll
        for (int gi = 0; gi < 16; ++gi) n2[gi] = sq8(*(const v4u*)(row + C_DK + (gi >> 1) * 128 + (gi & 1) * 64));
#pragma unroll
        for (int g2 = 0; g2 < 2; ++g2) { n2[16 + g2] = sq8(*(const v4u*)(row + C_KS + g2 * 128)) + sq8(*(const v4u*)(row + C_KS + g2 * 128 + 64));
                                         n2[18 + g2] = sq8(*(const v4u*)(row + C_KW + g2 * 128)) + sq8(*(const v4u*)(row + C_KW + g2 * 128 + 64)); }
#pragma unroll
        for (int gi = 0; gi < 20; ++gi) { float v = n2[gi];
            v += __builtin_bit_cast(float, __builtin_amdgcn_update_dpp(0, __builtin_bit_cast(int, v), 0xB1, 0xF, 0xF, false));
            v += __builtin_bit_cast(float, __builtin_amdgcn_update_dpp(0, __builtin_bit_cast(int, v), 0x4E, 0xF, 0xF, false));
            v += __builtin_bit_cast(float, __builtin_amdgcn_update_dpp(0, __builtin_bit_cast(int, v), 0x141, 0xF, 0xF, false));
            v = fmaxf(v, swzx<8>(v)); v = fmaxf(v, swzx<16>(v)); v = fmaxf(v, __shfl_xor(v, 32));
            n2[gi] = v; }
        __syncthreads();
        if (lane == 0) {
#pragma unroll
            for (int gi = 0; gi < 20; ++gi) red[wave * 20 + gi] = n2[gi]; }
        __syncthreads();
        if (tid < 20) { float m = red[tid];
#pragma unroll
            for (int w8 = 1; w8 < 8; ++w8) m = fmaxf(m, red[w8 * 20 + tid]);
            atomicMax(kmx + b * 20 + tid, __float_as_uint(m)); }
    }
}
__device__ __forceinline__ void cmp_unit(const Ptrs& P, LAS unsigned char* lds, int u, int tid, int lane, int wave) {
    typedef float f32x4_ __attribute__((ext_vector_type(4)));
    unsigned char* ws = P.ws;
    const int which = u >> 7, bg = (u >> 5) & 3, blk = u & 31, b = bg >> 1, g = bg & 1;
    const bf16* proj = (const bf16*)(ws + WS_PROJ);
    const bf16* w1T = (const bf16*)(ws + (which ? WS_CW1V : WS_CW1K));
    const bf16* w2T = (const bf16*)(ws + (which ? WS_CW2V : WS_CW2K));
    bf16* outp = (bf16*)(ws + (which ? WS_VCMP : WS_KCMP));
    const int i = lane & 15, kq = lane >> 4;
    const int c = blk * 16 + i;
    const int srccol = (which ? C_VC : C_KC) + g * 128;
    const bf16* arow = proj + (size_t)b * SEQ * LDP + srccol + 8 * kq;
    const bf16* brow = w1T + (size_t)i * 32 + 8 * kq;
    f32x4_ acc[16];
#pragma unroll
    for (int nb = 0; nb < 16; ++nb) acc[nb] = (f32x4_){0.f, 0.f, 0.f, 0.f};
    bf16x8 wA[16], wB[16], aA, aB;
#define CLOAD(kk_, a_, w_) do { const int ks_ = 16 * wave + (((kk_) + blk) & 15);        \
        int tok_ = 16 * c + (ks_ >> 2); tok_ = tok_ > SEQ - 1 ? SEQ - 1 : tok_;                                                          \
        a_ = *(const bf16x8*)(arow + (size_t)tok_ * LDP + 32 * (ks_ & 3));                                                              \
        _Pragma("unroll") for (int nb = 0; nb < 16; ++nb) w_[nb] = *(const bf16x8*)(brow + ((size_t)ks_ * 256 + nb * 16) * 32); } while (0)
#define CMMA(a_, w_) do { _Pragma("unroll") for (int nb = 0; nb < 16; ++nb) acc[nb] = __builtin_amdgcn_mfma_f32_16x16x32_bf16(a_, w_[nb], acc[nb], 0, 0, 0); } while (0)
    CLOAD(0, aA, wA);
#pragma unroll 1
    for (int kk = 0; kk < 16; kk += 2) {
        CLOAD(kk + 1, aB, wB);
        __builtin_amdgcn_sched_barrier(0);
        CMMA(aA, wA);
        __builtin_amdgcn_sched_barrier(0);
        if (kk + 2 < 16) CLOAD(kk + 2, aA, wA);
        __builtin_amdgcn_sched_barrier(0);
        CMMA(aB, wB);
        __builtin_amdgcn_sched_barrier(0);
    }
#undef CLOAD
#undef CMMA
    LAS float* red = (LAS float*)(lds + RING_OFF);
    __syncthreads();
#pragma unroll
    for (int nb = 0; nb < 16; ++nb)
#pragma unroll
        for (int r = 0; r < 4; ++r) red[(wave * 16 + 4 * kq + r) * 256 + ((16 * nb + i) ^ (16 * kq))] = acc[nb][r];
    __syncthreads();
    const int hr = tid >> 5, hc = 8 * (tid & 31);
    f32x4_ s0 = {0.f, 0.f, 0.f, 0.f}, s1 = {0.f, 0.f, 0.f, 0.f};
#pragma unroll
    for (int w8 = 0; w8 < 8; ++w8) { const LAS float* rp = red + (w8 * 16 + hr) * 256 + (hc ^ (16 * (hr >> 2))); s0 += *(const LAS f32x4_*)rp; s1 += *(const LAS f32x4_*)(rp + 4); }
    float bs[8];
    { const float* bf_ = (const float*)(ws + WS_MISC) + MISC_B1F + which * 256 + hc; const f32x4_ b0 = *(const f32x4_*)bf_, b1 = *(const f32x4_*)(bf_ + 4);
      bs[0] = b0[0]; bs[1] = b0[1]; bs[2] = b0[2]; bs[3] = b0[3]; bs[4] = b1[0]; bs[5] = b1[1]; bs[6] = b1[2]; bs[7] = b1[3]; }
    __syncthreads();
    LAS bf16* hid = (LAS bf16*)(lds + RING_OFF);
    { v4u o; o.x = cvtpk2(gelu_tanh_f(s0[0] + bs[0]), gelu_tanh_f(s0[1] + bs[1])); o.y = cvtpk2(gelu_tanh_f(s0[2] + bs[2]), gelu_tanh_f(s0[3] + bs[3]));
      o.z = cvtpk2(gelu_tanh_f(s1[0] + bs[4]), gelu_tanh_f(s1[1] + bs[5])); o.w = cvtpk2(gelu_tanh_f(s1[2] + bs[6]), gelu_tanh_f(s1[3] + bs[7]));
      *(LAS v4u*)(hid + hr * 264 + hc) = o; }
    __syncthreads();
    f32x4_ acc2 = {0.f, 0.f, 0.f, 0.f};
    const bf16* b2row = w2T + (size_t)(16 * wave + i) * 256 + 8 * kq;
#pragma unroll
    for (int ks = 0; ks < 8; ++ks) {
        const bf16x8 a = *(const LAS bf16x8*)(hid + i * 264 + 32 * ks + 8 * kq);
        const bf16x8 w = *(const bf16x8*)(b2row + 32 * ks);
        acc2 = __builtin_amdgcn_mfma_f32_16x16x32_bf16(a, w, acc2, 0, 0, 0);
    }
    float rs[4];
#pragma unroll
    for (int r = 0; r < 4; ++r) { const int cc = blk * 16 + 4 * kq + r; const unsigned ob = (cc >= 511) ? 0u : f2bf(acc2[r]); outp[((size_t)bg * 512 + cc) * 128 + 16 * wave + i] = (bf16)ob;
        const float vr = __uint_as_float(ob << 16); rs[r] = vr * vr; }
    if (which == 0) {
#pragma unroll
        for (int r = 0; r < 4; ++r) { float v = rs[r];
            v += __builtin_bit_cast(float, __builtin_amdgcn_update_dpp(0, __builtin_bit_cast(int, v), 0xB1, 0xF, 0xF, false));
            v += __builtin_bit_cast(float, __builtin_amdgcn_update_dpp(0, __builtin_bit_cast(int, v), 0x4E, 0xF, 0xF, false));
            v += __builtin_bit_cast(float, __builtin_amdgcn_update_dpp(0, __builtin_bit_cast(int, v), 0x141, 0xF, 0xF, false));
            v += __builtin_bit_cast(float, __builtin_amdgcn_update_dpp(0, __builtin_bit_cast(int, v), 0x140, 0xF, 0xF, false));
            rs[r] = v; }
        LAS float* part = (LAS float*)(lds + RING_OFF + 16384);
        if (i == 0) {
#pragma unroll
            for (int r = 0; r < 4; ++r) part[wave * 16 + 4 * kq + r] = rs[r]; }
        __syncthreads();
        if (tid < 16) { float s = 0.f;
#pragma unroll
            for (int w8 = 0; w8 < 8; ++w8) s += part[w8 * 16 + tid];
            s = fmaxf(s, swzx<1>(s)); s = fmaxf(s, swzx<2>(s)); s = fmaxf(s, swzx<4>(s)); s = fmaxf(s, swzx<8>(s));
            if (tid == 0) atomicMax((unsigned*)(ws + WS_CTL + CTL_KCMX) + bg, __float_as_uint(s)); }
    }
    __syncthreads();
}

template <int K> __device__ __forceinline__ float swz_xor(float v) { return __builtin_bit_cast(float, __builtin_amdgcn_ds_swizzle(__builtin_bit_cast(int, v), (K << 10) | 0x1F)); }
__device__ __forceinline__ void diff_unit(const Ptrs& P, LAS unsigned char* ldsb, int b, int h, int qb) {
    using namespace att;
    lchar* lds = (lchar*)ldsb;
    unsigned char* ws = P.ws;
    const bf16_t* proj = (const bf16_t*)(ws + WS_PROJ); bf16_t* mix = (bf16_t*)(ws + WS_MIX);
    const float* misc = (const float*)(ws + WS_MISC);
    int tid = threadIdx.x; asm volatile("" : "+v"(tid));
    const int wid = __builtin_amdgcn_readfirstlane(tid >> 6), lane = tid & 63, r32 = lane & 31, hi = lane >> 5;
    const int map = wid >> 2, wq = wid & 3, q0 = 128 * qb + 32 * wq;
    const size_t tokb = (size_t)b * SEQ;
    __syncthreads();
#ifndef ATT_HEADPRE
#define ATT_HEADPRE true
#endif
    if (ATT_HEADPRE) head_dma(lds, proj + tokb * LDP + C_DK + h * 128, proj + tokb * LDP + C_DV + h * 128, LDP, 0, 2 * (qb + 1));
    if (tid < LUTX) { const int d = tid - LUT0; ((ALAS float*)(lds + L_LUT))[tid] = (d >= 0 && d < 113) ? misc[MISC_LUT + h * 128 + d] : 0.f; }
    const bf16_t* qp = proj + (tokb + q0 + r32) * LDP + C_DQ + h * 128 + map * 64 + hi * 8;
    bf16x8 qr[4];
#pragma unroll
    for (int d0 = 0; d0 < 4; ++d0) qr[d0] = *(const bf16x8*)(qp + d0 * 16);
    Lane L; L.qpos = q0 + r32; L.qlo = q0; L.qhi = q0 + 31; L.lut = lds_addr(lds + L_LUT);
#ifdef TPROBE_SEC
    L.tpw = (unsigned long long*)(ws + WS_CTL + 40960);
#endif
    f32x16 o[4]; float m_reg = 0.f, l_reg;
#ifndef DIFF_ENGINE
#define DIFF_ENGINE attn_tiles_dma
#endif
#ifndef DIFF_NEGM
#define DIFF_NEGM false
#endif
#ifdef EPROBE
    unsigned long long ep_t0 = __builtin_amdgcn_s_memrealtime();
#endif
#ifndef DIFF_FIXM
#define DIFF_FIXM 1
#endif
#ifndef NSA_FIXM_CMP
#define NSA_FIXM_CMP 1
#endif
#ifndef NSA_FIXM_SLC
#define NSA_FIXM_SLC 1
#endif
#ifndef NSA_FIXM_WIN
#define NSA_FIXM_WIN 1
#endif
    if (DIFF_FIXM) { const float k2 = __uint_as_float(((const unsigned*)(ws + WS_CTL + CTL_KMX))[b * 20 + h * 2 + map]);
        m_reg = sqrtf(qrow_norm2<4>(qr) * k2) * 1.002f + misc[MISC_LUTMAX + h]; }
#ifndef ATT_FUSE
#define ATT_FUSE true
#endif
#ifndef DIFF_DMAPOS
#define DIFF_DMAPOS 2
#endif
#ifndef ATT_DMAPOS
#define ATT_DMAPOS 2
#endif
#ifndef ATT_PRIO
#define ATT_PRIO 1
#endif
#ifndef DIFF_KDB
#define DIFF_KDB false
#endif
#ifndef DIFF_VPRE
#define DIFF_VPRE true
#endif
#ifndef DIFF_KPRE
#define DIFF_KPRE true
#endif
#ifndef DIFF_SMP2
#define DIFF_SMP2 true
#endif
#ifndef DIFF_KGS
#define DIFF_KGS 2
#endif
#ifndef DIFF_PIPE
#define DIFF_PIPE false
#endif
    DIFF_ENGINE<M_DIFF, 64, DIFF_NEGM, DIFF_FIXM, ATT_FUSE, DIFF_PIPE, DIFF_KGS, DIFF_SMP2, DIFF_KPRE, DIFF_VPRE, DIFF_KDB, ATT_PRIO, DIFF_DMAPOS, ATT_HEADPRE>(lds, proj + tokb * LDP + C_DK + h * 128, proj + tokb * LDP + C_DV + h * 128, LDP, 0, 2 * (qb + 1), nullptr, qr, map * 128, L, 0u, 0u, 0u, 0u, o, m_reg, l_reg);
#ifdef EPROBE
    if (blockIdx.x == 0 && tid == 0) { unsigned long long* w_ = (unsigned long long*)(ws + WS_CTL + 40960); w_[0] += __builtin_amdgcn_s_memrealtime() - ep_t0; }
#endif
    ALAS float* li_l = (ALAS float*)(lds + L_WS) + wid * 64;
    if (hi == 0) li_l[r32] = l_reg;
    asm volatile("s_waitcnt lgkmcnt(0)" ::: "memory");
    float rli[16];
#pragma unroll
    for (int r = 0; r < 16; ++r) { const float l_ = li_l[crow(r, hi)]; rli[r] = l_ > 0.f ? 1.0f / l_ : 0.f; }
    ALAS float* X = (ALAS float*)(lds + L_V);
    float gsub4[4] = {0.f, 0.f, 0.f, 0.f}, lam = 0.f;
    if (map == 0) { lam = misc[MISC_LAM]; const float* subln = P.in[7];
#pragma unroll
        for (int d0 = 0; d0 < 4; ++d0) gsub4[d0] = subln[32 * d0 + r32]; }
    if (map == 1) {
#pragma unroll
        for (int d0 = 0; d0 < 4; ++d0)
#pragma unroll
            for (int r = 0; r < 16; ++r) X[(wq * 64 + d0 * 16 + r) * 64 + lane] = o[d0][r] * rli[r];
    }
    __syncthreads();
    if (map == 0) {
        float ss[16];
#pragma unroll
        for (int r = 0; r < 16; ++r) ss[r] = 0.f;
#pragma unroll
        for (int d0 = 0; d0 < 4; ++d0)
#pragma unroll
            for (int r = 0; r < 16; ++r) { const float o2 = X[(wq * 64 + d0 * 16 + r) * 64 + lane]; const float d = o[d0][r] * rli[r] - lam * o2; o[d0][r] = d; ss[r] += d * d; }
#pragma unroll
        for (int r = 0; r < 16; ++r) { float s = ss[r]; s += swz_xor<1>(s); s += swz_xor<2>(s); s += swz_xor<4>(s); s += swz_xor<8>(s); s += swz_xor<16>(s);
            ss[r] = 0.8f / sqrtf(s * (1.0f / 128.0f) + EPS); }
#pragma unroll
        for (int d0 = 0; d0 < 4; ++d0) { const float gsub = gsub4[d0];
#pragma unroll
            for (int r = 0; r < 16; ++r) { const float v = o[d0][r] * ss[r] * gsub; const float vn = swz_xor<1>(v);
                if ((r32 & 1) == 0) *(unsigned*)(mix + (tokb + q0 + crow(r, hi)) * DM + h * 128 + 32 * d0 + r32) = cvtpk(v, vn); } }
    }
}

#ifndef NSA_PARTS
#define NSA_PARTS 31
#endif
#define NSA_PARTS_DEF NSA_PARTS
__device__ __forceinline__ void nsa_unit(const Ptrs& P, LAS unsigned char* ldsb, int bg, int qb) {
    using namespace att;
#ifdef TSEL_A
#define NSTAMP(k) do { if (blockIdx.x == 0 && threadIdx.x == 0 && qb == 127) { unsigned long long* t_ = (unsigned long long*)(P.ws + WS_CTL + 8192); t_[(k)] = __builtin_amdgcn_s_memrealtime(); } } while (0)
#else
#define NSTAMP(k) do {} while (0)
#endif
    NSTAMP(21);
    lchar* lds = (lchar*)ldsb;
    unsigned char* ws = P.ws;
    const bf16_t* proj = (const bf16_t*)(ws + WS_PROJ); bf16_t* mix = (bf16_t*)(ws + WS_MIX);
    const bf16_t* kcmp = (const bf16_t*)(ws + WS_KCMP) + (size_t)bg * 512 * 128; const bf16_t* vcmp = (const bf16_t*)(ws + WS_VCMP) + (size_t)bg * 512 * 128;
    const float* misc = (const float*)(ws + WS_MISC); const float* gates = (const float*)(ws + WS_GATES);
    int tid = threadIdx.x; asm volatile("" : "+v"(tid));
    const int wid = __builtin_amdgcn_readfirstlane(tid >> 6), lane = tid & 63, r32 = lane & 31, hi = lane >> 5;
    const int b = bg >> 1, g = bg & 1, t0 = 64 * qb; const size_t tokb = (size_t)b * SEQ;
    const int ql = 8 * wid + (r32 >> 2), hg = r32 & 3;
    ALAS unsigned* imp = (ALAS unsigned*)(lds + L_IMP); ALAS unsigned* selm = (ALAS unsigned*)(lds + L_SEL); ALAS unsigned* un = (ALAS unsigned*)(lds + L_UN); ALAS int* list = (ALAS int*)(lds + L_LIST);
    ALAS float* li_l = (ALAS float*)(lds + L_WS) + wid * 64;
    __syncthreads();
    if (ATT_HEADPRE && (NSA_PARTS_DEF & 1)) head_dma(lds, kcmp, vcmp, 128, 0, (((t0 + 63 - 31) >> 4) >> 6) + 1);
    if (tid < 4) un[tid] = 0u;
    for (int i = tid; i < 4 * LUTX; i += NWAVES * 64) { const int hh = i / LUTX, d = i - hh * LUTX - LUT0; ((ALAS float*)(lds + L_LUT))[i] = (d >= 0 && d < 113) ? misc[MISC_LUT + (8 + g * 4 + hh) * 128 + d] : 0.f; }
    const bf16_t* qp = proj + (tokb + t0 + ql) * LDP + C_NQ + g * 512 + hg * 128 + hi * 8;
    bf16x8 qr[8];
#pragma unroll
    for (int d0 = 0; d0 < 8; ++d0) qr[d0] = *(const bf16x8*)(qp + d0 * 16);
    Lane L; L.qpos = t0 + ql; L.qlo = t0 + 8 * wid; L.qhi = L.qlo + 7; L.lut = lds_addr(lds + L_LUT) + (unsigned)hg * (LUTX * 4u);
#ifdef TPROBE_SEC
    L.tpw = (unsigned long long*)(ws + WS_CTL + 40960);
#endif
#define NSA_GATE(k) ({ int l_ = lane; asm volatile("" : "+v"(l_)); gates[(tokb + t0 + 8 * wid + ((l_ & 31) >> 2)) * 32 + g * 12 + (l_ & 3) * 3 + (k)]; })
#define NSA_ACCP ({ int l_ = lane; asm volatile("" : "+v"(l_)); (float*)(ws + WS_NSAACC) + ((size_t)blockIdx.x * NWAVES + wid) * 4096 + l_; })
    f32x16 o[4]; float m_c = 0.f, l_c, m_x = 0.f, l_x;
    if (NSA_FIXM_CMP) m_c = sqrtf(qrow_norm2<8>(qr) * __uint_as_float(((const unsigned*)(ws + WS_CTL + CTL_KCMX))[bg])) * 1.01f;
    const int NTc = (((t0 + 63 - 31) >> 4) >> 6) + 1;
#ifndef NSA_PARTS
#define NSA_PARTS 31
#endif
#ifndef NSA_ENGINE
#define NSA_ENGINE attn_tiles_dma
#ifndef NSA_KDB_CMP
#define NSA_KDB_CMP false
#endif
#ifndef NSA_KDB_SLC
#define NSA_KDB_SLC false
#endif
#ifndef NSA_KDB_WIN
#define NSA_KDB_WIN false
#endif
#ifndef NSA_VPRE_CMP
#define NSA_VPRE_CMP true
#endif
#ifndef NSA_VPRE_SLC
#define NSA_VPRE_SLC true
#endif
#ifndef NSA_VPRE_WIN
#define NSA_VPRE_WIN true
#endif
#ifndef NSA_KPRE_CMP
#define NSA_KPRE_CMP true
#endif
#ifndef NSA_KPRE_SLC
#define NSA_KPRE_SLC true
#endif
#ifndef NSA_KPRE_WIN
#define NSA_KPRE_WIN true
#endif
#ifndef NSA_SMP2_CMP
#define NSA_SMP2_CMP true
#endif
#ifndef NSA_SMP2_SLC
#define NSA_SMP2_SLC true
#endif
#ifndef NSA_SMP2_WIN
#define NSA_SMP2_WIN true
#endif
#ifndef NSA_KGS_CMP
#define NSA_KGS_CMP 2
#endif
#ifndef NSA_KGS_SLC
#define NSA_KGS_SLC 2
#endif
#ifndef NSA_KGS_WIN
#define NSA_KGS_WIN 2
#endif
#endif
    if (NSA_PARTS & 1) NSA_ENGINE<M_CMP, 128, false, NSA_FIXM_CMP, ATT_FUSE, false, NSA_KGS_CMP, NSA_SMP2_CMP, NSA_KPRE_CMP, NSA_VPRE_CMP, NSA_KDB_CMP, ATT_PRIO, ATT_DMAPOS, ATT_HEADPRE>(lds, kcmp, vcmp, 128, 0, NTc, nullptr, qr, 0, L, 0u, 0u, 0u, 0u, o, m_c, l_c); else { m_c = 0.f; l_c = 1.f; o[0] = o[1] = o[2] = o[3] = f32x16{}; }
    { const float sc = l_c > 0.f ? NSA_GATE(0) / l_c : 0.f; if (hi == 0) li_l[r32] = sc; asm volatile("s_waitcnt lgkmcnt(0)" ::: "memory");
      float* ap = NSA_ACCP; float lv[16];
#pragma unroll
      for (int r = 0; r < 16; ++r) lv[r] = li_l[crow(r, hi)];
#pragma unroll
      for (int d0 = 0; d0 < 4; ++d0) {
#pragma unroll
          for (int r = 0; r < 16; ++r) ap[64 * r] = o[d0][r] * lv[r];
          ap += 1024; asm volatile("" : "+v"(ap)); } }
    NSTAMP(22);
    { int t_ = threadIdx.x; asm volatile("" : "+v"(t_)); for (int i = t_; i < 64 * IMP_LD; i += NWAVES * 64) imp[i] = 0u; }
    if (NSA_PARTS & 2) { const float fx = (l_c > 0.f ? 1.0f / l_c : 0.f) * 268435456.0f;
      const int sr = tid >> 4, sc = (tid & 15) * 8, kws = KSWZ(sr, sc * 2);
      lchar* K_lds = lds + L_K;
      bf16x8 k0 = *(const bf16x8*)(kcmp + (size_t)sr * 128 + sc), k1 = *(const bf16x8*)(kcmp + (size_t)(32 + sr) * 128 + sc);
      for (int t = 0; t < NTc; ++t) {
          *(ALAS bf16x8*)(K_lds + kws) = k0; *(ALAS bf16x8*)(K_lds + kws + 32 * 256) = k1;
          __syncthreads();
          if (t + 1 < NTc) { k0 = *(const bf16x8*)(kcmp + (size_t)(64 * (t + 1) + sr) * 128 + sc); k1 = *(const bf16x8*)(kcmp + (size_t)(64 * (t + 1) + 32 + sr) * 128 + sc); }
          const bool act = 16 * (64 * t) + 31 <= L.qhi;
          if (act) {
              f32x16 p0, p1;
              qkt<0, 128>(p0, p1, K_lds, 0, r32, hi, qr, true, false, 0u);
              tile_mask<M_CMP>(p0, p1, 64 * t, t, L, hi, true, 0u, 0u, 0u, 0u);
#pragma unroll
              for (int r = 0; r < 16; ++r) { p0[r] = __builtin_amdgcn_exp2f(p0[r] - m_c) * fx; p1[r] = __builtin_amdgcn_exp2f(p1[r] - m_c) * fx; }
              ALAS unsigned* ir = imp + ql * IMP_LD + 16 * t + hi;
#define QSUM(x) do { x += __builtin_bit_cast(float, __builtin_amdgcn_update_dpp(0, __builtin_bit_cast(int, x), 0xB1, 0xF, 0xF, false)); \
                     x += __builtin_bit_cast(float, __builtin_amdgcn_update_dpp(0, __builtin_bit_cast(int, x), 0x4E, 0xF, 0xF, false)); } while (0)
              float va[8], vb[8];
#pragma unroll
              for (int gi = 0; gi < 4; ++gi) {
                  va[gi] = p0[4 * gi]; vb[gi] = va[gi] + 2.0f * (p0[4 * gi + 1] + p0[4 * gi + 2] + p0[4 * gi + 3]);
                  va[4 + gi] = p1[4 * gi]; vb[4 + gi] = va[4 + gi] + 2.0f * (p1[4 * gi + 1] + p1[4 * gi + 2] + p1[4 * gi + 3]);
              }
#pragma unroll
              for (int k = 0; k < 8; ++k) { QSUM(va[k]); QSUM(vb[k]); }
#undef QSUM
              if (hg == 0) {
#pragma unroll
                  for (int k = 0; k < 8; ++k) {
                      __hip_atomic_fetch_add(ir + 2 * k, (unsigned)va[k], __ATOMIC_RELAXED, __HIP_MEMORY_SCOPE_WORKGROUP);
                      __hip_atomic_fetch_add(ir + 2 * k + 1, (unsigned)vb[k], __ATOMIC_RELAXED, __HIP_MEMORY_SCOPE_WORKGROUP);
                  }
              }
          }
          __syncthreads();
      }
    }
    NSTAMP(23);
    if (NSA_PARTS & 4) { const int cur = qb;
      for (int qi = 0; qi < 8; ++qi) {
          const int qq = 8 * wid + qi; const int j0 = lane, j1 = lane + 64;
          unsigned k0, k1;
          { const unsigned v = imp[qq * IMP_LD + j0]; k0 = (j0 > cur) ? 0u : ((j0 == 0 || j0 == cur || j0 + 1 == cur) ? (0xFFFFFF80u | (unsigned)(127 - j0)) : ((v & ~127u) | (unsigned)(127 - j0))); }
          { const unsigned v = imp[qq * IMP_LD + j1]; k1 = (j1 > cur) ? 0u : ((j1 == cur || j1 + 1 == cur) ? (0xFFFFFF80u | (unsigned)(127 - j1)) : ((v & ~127u) | (unsigned)(127 - j1))); }
          unsigned thr = 0u;
          for (int bit = 31; bit >= 0; --bit) { const unsigned cand = thr | (1u << bit);
              const int cnt = __popcll(__ballot(k0 >= cand)) + __popcll(__ballot(k1 >= cand)); if (cnt >= 16) thr = cand; }
          const unsigned long long m0 = __ballot(k0 >= thr && k0 != 0u), m1 = __ballot(k1 >= thr && k1 != 0u);
          if (lane == 0) { selm[qq * 4 + 0] = (unsigned)m0; selm[qq * 4 + 1] = (unsigned)(m0 >> 32); selm[qq * 4 + 2] = (unsigned)m1; selm[qq * 4 + 3] = (unsigned)(m1 >> 32);
              __hip_atomic_fetch_or(un + 0, (unsigned)m0, __ATOMIC_RELAXED, __HIP_MEMORY_SCOPE_WORKGROUP); __hip_atomic_fetch_or(un + 1, (unsigned)(m0 >> 32), __ATOMIC_RELAXED, __HIP_MEMORY_SCOPE_WORKGROUP);
              __hip_atomic_fetch_or(un + 2, (unsigned)m1, __ATOMIC_RELAXED, __HIP_MEMORY_SCOPE_WORKGROUP); __hip_atomic_fetch_or(un + 3, (unsigned)(m1 >> 32), __ATOMIC_RELAXED, __HIP_MEMORY_SCOPE_WORKGROUP); }
      }
    }
    __syncthreads();
    int NTs; unsigned sw0, sw1, sw2, sw3;
    { const unsigned u0 = un[0], u1 = un[1], u2 = un[2], u3 = un[3];
      NTs = __popc(u0) + __popc(u1) + __popc(u2) + __popc(u3);
      if (tid < 128) { const int wsel = tid >> 5, bpos = tid & 31; const unsigned w = wsel == 0 ? u0 : (wsel == 1 ? u1 : (wsel == 2 ? u2 : u3));
          if ((w >> bpos) & 1u) { const int below = (wsel > 0 ? __popc(u0) : 0) + (wsel > 1 ? __popc(u1) : 0) + (wsel > 2 ? __popc(u2) : 0) + __popc(w & ((1u << bpos) - 1u)); list[below] = tid; } }
      sw0 = selm[ql * 4 + 0]; sw1 = selm[ql * 4 + 1]; sw2 = selm[ql * 4 + 2]; sw3 = selm[ql * 4 + 3]; }
    __syncthreads();
    NSTAMP(24);
    m_x = 0.f; l_x = 1.f;
    if (NSA_FIXM_SLC) { int t_ = threadIdx.x; asm volatile("" : "+v"(t_)); m_x = sqrtf(qrow_norm2<8>(qr) * __uint_as_float(((const unsigned*)(ws + WS_CTL + CTL_KMX))[b * 20 + 16 + g])) * 1.002f + misc[MISC_LUTMAX + 8 + g * 4 + (t_ & 3)]; }
    if (NSA_PARTS & 8) NSA_ENGINE<M_SLC, 128, false, NSA_FIXM_SLC, ATT_FUSE, false, NSA_KGS_SLC, NSA_SMP2_SLC, NSA_KPRE_SLC, NSA_VPRE_SLC, NSA_KDB_SLC, ATT_PRIO, ATT_DMAPOS>(lds, proj + tokb * LDP + C_KS + g * 128, proj + tokb * LDP + C_VS + g * 128, LDP, 0, NTs, list, qr, 0, L, lds_addr(lds + L_SEL) + (unsigned)ql * 16u, 0u, 0u, 0u, o, m_x, l_x);
    if (ATT_HEADPRE && (NSA_PARTS & 16)) { const int jlo = qb > 8 ? qb - 8 : 0; head_dma(lds, proj + tokb * LDP + C_KW + g * 128, proj + tokb * LDP + C_VW + g * 128, LDP, jlo, qb - jlo + 1); }
    { int t_ = threadIdx.x; asm volatile("" : "+v"(t_)); const int r32_ = t_ & 31, hi_ = (t_ >> 5) & 1;
      ALAS float* li2 = (ALAS float*)(lds + L_WS) + wid * 64;
      const float sc = l_x > 0.f ? NSA_GATE(1) / l_x : 0.f; if (hi_ == 0) li2[r32_] = sc; asm volatile("s_waitcnt lgkmcnt(0)" ::: "memory");
      float* ap = NSA_ACCP; float lv[16];
#pragma unroll
      for (int r = 0; r < 16; ++r) lv[r] = li2[crow(r, hi_)];
#pragma unroll
      for (int d0 = 0; d0 < 4; ++d0) { float t[16];
#pragma unroll
          for (int r = 0; r < 16; ++r) t[r] = ap[64 * r];
#pragma unroll
          for (int r = 0; r < 16; ++r) ap[64 * r] = t[r] + o[d0][r] * lv[r];
          ap += 1024; asm volatile("" : "+v"(ap)); } }
    NSTAMP(25);
    if (NSA_FIXM_WIN) { int t_ = threadIdx.x; asm volatile("" : "+v"(t_)); m_x = sqrtf(qrow_norm2<8>(qr) * __uint_as_float(((const unsigned*)(ws + WS_CTL + CTL_KMX))[b * 20 + 18 + g])) * 1.002f + misc[MISC_LUTMAX + 8 + g * 4 + (t_ & 3)]; }
    if (NSA_PARTS & 16) { const int jlo = qb > 8 ? qb - 8 : 0;
      NSA_ENGINE<M_WIN, 128, false, NSA_FIXM_WIN, ATT_FUSE, false, NSA_KGS_WIN, NSA_SMP2_WIN, NSA_KPRE_WIN, NSA_VPRE_WIN, NSA_KDB_WIN, ATT_PRIO, ATT_DMAPOS, ATT_HEADPRE>(lds, proj + tokb * LDP + C_KW + g * 128, proj + tokb * LDP + C_VW + g * 128, LDP, jlo, qb - jlo + 1, nullptr, qr, 0, L, 0u, 0u, 0u, 0u, o, m_x, l_x); }
    { int t_ = threadIdx.x; asm volatile("" : "+v"(t_)); const int r32_ = t_ & 31, hi_ = (t_ >> 5) & 1;
      ALAS float* li2 = (ALAS float*)(lds + L_WS) + wid * 64;
      const float sc = l_x > 0.f ? NSA_GATE(2) / l_x : 0.f; if (hi_ == 0) li2[r32_] = sc; asm volatile("s_waitcnt lgkmcnt(0)" ::: "memory");
      float* ap = NSA_ACCP; float lv[16];
#pragma unroll
      for (int r = 0; r < 16; ++r) lv[r] = li2[crow(r, hi_)];
#pragma unroll
      for (int d0 = 0; d0 < 4; ++d0) { float t[16];
#pragma unroll
          for (int r = 0; r < 16; ++r) t[r] = ap[64 * r];
          ap += 1024; asm volatile("" : "+v"(ap));
#pragma unroll
          for (int r = 0; r < 16; ++r) { const int rho = crow(r, hi_); const float v = t[r] + o[d0][r] * lv[r]; const float vn = swz_xor<1>(v);
              if ((r32_ & 1) == 0) *(unsigned*)(mix + (tokb + t0 + 8 * wid + (rho >> 2)) * DM + 1024 + g * 512 + (rho & 3) * 128 + 32 * d0 + r32_) = cvtpk(v, vn); } } }
    NSTAMP(26);
#undef NSA_GATE
#undef NSA_ACCP
}

__device__ __forceinline__ void unpack8(const v4u w, float* f) {
    f[0] = __uint_as_float(w.x << 16); f[1] = __uint_as_float(w.x & 0xffff0000u); f[2] = __uint_as_float(w.y << 16); f[3] = __uint_as_float(w.y & 0xffff0000u);
    f[4] = __uint_as_float(w.z << 16); f[5] = __uint_as_float(w.z & 0xffff0000u); f[6] = __uint_as_float(w.w << 16); f[7] = __uint_as_float(w.w & 0xffff0000u);
}
__device__ __forceinline__ void p5_row(const float* xrow, bf16* yrow, const float* g1, const float* g2, bf16* hrow, int lane) {
    float y[4][8]; float s = 0.f;
#pragma unroll
    for (int j = 0; j < 4; ++j) { unpack8(*(const v4u*)(yrow + 8 * lane + 512 * j), y[j]);
#pragma unroll
        for (int e = 0; e < 8; ++e) s += y[j][e] * y[j][e]; }
    const float r1 = 1.0f / sqrtf(wave_sum(s) * (1.0f / DM) + EPS);
    float s2 = 0.f;
#pragma unroll
    for (int j = 0; j < 4; ++j) { const int c = 8 * lane + 512 * j;
        const f32x4 xa = *(const f32x4*)(xrow + c), xb = *(const f32x4*)(xrow + c + 4), ga = *(const f32x4*)(g1 + c), gb = *(const f32x4*)(g1 + c + 4);
        f32x4 va, vb;
#pragma unroll
        for (int e = 0; e < 4; ++e) { va[e] = xa[e] + y[j][e] * r1 * ga[e]; vb[e] = xb[e] + y[j][4 + e] * r1 * gb[e]; y[j][e] = va[e]; y[j][4 + e] = vb[e]; s2 += va[e] * va[e] + vb[e] * vb[e]; }
        { v4u w; w.x = cvtpk2(va[0], va[1]); w.y = cvtpk2(va[2], va[3]); w.z = cvtpk2(vb[0], vb[1]); w.w = cvtpk2(vb[2], vb[3]); *(v4u*)(yrow + c) = w; } }
    const float r2 = 1.0f / sqrtf(wave_sum(s2) * (1.0f / DM) + EPS);
#pragma unroll
    for (int j = 0; j < 4; ++j) { const int c = 8 * lane + 512 * j; const f32x4 ga = *(const f32x4*)(g2 + c), gb = *(const f32x4*)(g2 + c + 4);
        v4u w; w.x = cvtpk2(y[j][0] * r2 * ga[0], y[j][1] * r2 * ga[1]); w.y = cvtpk2(y[j][2] * r2 * ga[2], y[j][3] * r2 * ga[3]);
        w.z = cvtpk2(y[j][4] * r2 * gb[0], y[j][5] * r2 * gb[1]); w.w = cvtpk2(y[j][6] * r2 * gb[2], y[j][7] * r2 * gb[3]);
        *(v4u*)(hrow + c) = w; }
}
__device__ __forceinline__ void p9_row(float* orow, const bf16* x1row, const bf16* yrow, const float* g, int lane) {
    float y[4][8]; float s = 0.f;
#pragma unroll
    for (int j = 0; j < 4; ++j) { unpack8(*(const v4u*)(yrow + 8 * lane + 512 * j), y[j]);
#pragma unroll
        for (int e = 0; e < 8; ++e) s += y[j][e] * y[j][e]; }
    const float r1 = 1.0f / sqrtf(wave_sum(s) * (1.0f / DM) + EPS);
#pragma unroll
    for (int j = 0; j < 4; ++j) { const int c = 8 * lane + 512 * j; float x1[8]; unpack8(*(const v4u*)(x1row + c), x1);
        const f32x4 ga = *(const f32x4*)(g + c), gb = *(const f32x4*)(g + c + 4);
        f32x4 va, vb;
#pragma unroll
        for (int e = 0; e < 4; ++e) { va[e] = x1[e] + y[j][e] * r1 * ga[e]; vb[e] = x1[4 + e] + y[j][4 + e] * r1 * gb[e]; }
        *(f32x4*)(orow + c) = va; *(f32x4*)(orow + c + 4) = vb; }
}
__device__ __forceinline__ void p5_rows(const float* x, bf16* ybase, const float* g1, const float* g2, bf16* hbase, int gw, int NGW, int lane) {
    int m = gw; if (m >= TOK) return;
    v4u yn[4]; f32x4 xn[8];
#define P5_LOAD(m_) do { _Pragma("unroll") for (int j = 0; j < 4; ++j) { const size_t o_ = (size_t)(m_) * DM + 8 * lane + 512 * j; yn[j] = __builtin_nontemporal_load((const v4u*)(ybase + o_)); xn[2 * j] = __builtin_nontemporal_load((const f32x4*)(x + o_)); xn[2 * j + 1] = __builtin_nontemporal_load((const f32x4*)(x + o_ + 4)); } } while (0)
    P5_LOAD(m);
    f32x4 g1v[8], g2v[8];
#pragma unroll
    for (int j = 0; j < 4; ++j) { const int c = 8 * lane + 512 * j; g1v[2 * j] = *(const f32x4*)(g1 + c); g1v[2 * j + 1] = *(const f32x4*)(g1 + c + 4); g2v[2 * j] = *(const f32x4*)(g2 + c); g2v[2 * j + 1] = *(const f32x4*)(g2 + c + 4); }
#pragma unroll 1
    for (; m < TOK; m += NGW) {
        float y[4][8]; f32x4 xc[8]; float s = 0.f;
#pragma unroll
        for (int j = 0; j < 4; ++j) { unpack8(yn[j], y[j]); xc[2 * j] = xn[2 * j]; xc[2 * j + 1] = xn[2 * j + 1];
#pragma unroll
            for (int e = 0; e < 8; ++e) s += y[j][e] * y[j][e]; }
        if (m + NGW < TOK) P5_LOAD(m + NGW);
        bf16* yrow = ybase + (size_t)m * DM; bf16* hrow = hbase + (size_t)m * DM;
        const float r1 = 1.0f / sqrtf(wave_sum(s) * (1.0f / DM) + EPS);
        float s2 = 0.f;
#pragma unroll
        for (int j = 0; j < 4; ++j) { const int c = 8 * lane + 512 * j;
            const f32x4 xa = xc[2 * j], xb = xc[2 * j + 1], ga = g1v[2 * j], gb = g1v[2 * j + 1];
            f32x4 va, vb;
#pragma unroll
            for (int e = 0; e < 4; ++e) { va[e] = xa[e] + y[j][e] * r1 * ga[e]; vb[e] = xb[e] + y[j][4 + e] * r1 * gb[e]; y[j][e] = va[e]; y[j][4 + e] = vb[e]; s2 += va[e] * va[e] + vb[e] * vb[e]; }
            { v4u w; w.x = cvtpk2(va[0], va[1]); w.y = cvtpk2(va[2], va[3]); w.z = cvtpk2(vb[0], vb[1]); w.w = cvtpk2(vb[2], vb[3]); *(v4u*)(yrow + c) = w; } }
        const float r2 = 1.0f / sqrtf(wave_sum(s2) * (1.0f / DM) + EPS);
#pragma unroll
        for (int j = 0; j < 4; ++j) { const int c = 8 * lane + 512 * j; const f32x4 ga = g2v[2 * j], gb = g2v[2 * j + 1];
            v4u w; w.x = cvtpk2(y[j][0] * r2 * ga[0], y[j][1] * r2 * ga[1]); w.y = cvtpk2(y[j][2] * r2 * ga[2], y[j][3] * r2 * ga[3]);
            w.z = cvtpk2(y[j][4] * r2 * gb[0], y[j][5] * r2 * gb[1]); w.w = cvtpk2(y[j][6] * r2 * gb[2], y[j][7] * r2 * gb[3]);
            *(v4u*)(hrow + c) = w; }
    }
#undef P5_LOAD
}
__device__ __forceinline__ void p9_rows(float* obase, const bf16* x1base, const bf16* ybase, const float* g, int gw, int NGW, int lane) {
    int m = gw; if (m >= TOK) return;
    v4u yn[4], xn[4];
#define P9_LOAD(m_) do { _Pragma("unroll") for (int j = 0; j < 4; ++j) { const size_t o_ = (size_t)(m_) * DM + 8 * lane + 512 * j; yn[j] = __builtin_nontemporal_load((const v4u*)(ybase + o_)); xn[j] = __builtin_nontemporal_load((const v4u*)(x1base + o_)); } } while (0)
    P9_LOAD(m);
    f32x4 gv9[8];
#pragma unroll
    for (int j = 0; j < 4; ++j) { const int c = 8 * lane + 512 * j; gv9[2 * j] = *(const f32x4*)(g + c); gv9[2 * j + 1] = *(const f32x4*)(g + c + 4); }
#pragma unroll 1
    for (; m < TOK; m += NGW) {
        float y[4][8]; v4u xc[4]; float s = 0.f;
#pragma unroll
        for (int j = 0; j < 4; ++j) { unpack8(yn[j], y[j]); xc[j] = xn[j];
#pragma unroll
            for (int e = 0; e < 8; ++e) s += y[j][e] * y[j][e]; }
        if (m + NGW < TOK) P9_LOAD(m + NGW);
        float* orow = obase + (size_t)m * DM;
        const float r1 = 1.0f / sqrtf(wave_sum(s) * (1.0f / DM) + EPS);
#pragma unroll
        for (int j = 0; j < 4; ++j) { const int c = 8 * lane + 512 * j; float x1[8]; unpack8(xc[j], x1);
            const f32x4 ga = gv9[2 * j], gb = gv9[2 * j + 1];
            f32x4 va, vb;
#pragma unroll
            for (int e = 0; e < 4; ++e) { va[e] = x1[e] + y[j][e] * r1 * ga[e]; vb[e] = x1[4 + e] + y[j][4 + e] * r1 * gb[e]; }
            __builtin_nontemporal_store(va, (f32x4*)(orow + c)); __builtin_nontemporal_store(vb, (f32x4*)(orow + c + 4)); }
    }
#undef P9_LOAD
}
__device__ __forceinline__ f32x4 ld4bf(const bf16* p) { const v2u w = *(const v2u*)p; f32x4 r; r[0] = __uint_as_float(w.x << 16); r[1] = __uint_as_float(w.x & 0xffff0000u); r[2] = __uint_as_float(w.y << 16); r[3] = __uint_as_float(w.y & 0xffff0000u); return r; }
__device__ __forceinline__ void p7_halo(const Ptrs& P, int gt, int NGT) {
    unsigned char* ws = P.ws; const bf16* halo = (const bf16*)(ws + WS_HALO); bf16* act = (bf16*)(ws + WS_ACT);
    const float* cw = P.in[19]; const float* cb = P.in[20];
    constexpr int C4 = DFF / 4, NQ = 256 * 2;
    const bool wide = NGT >= C4; const int nq = wide ? NGT / C4 : 1;
    if (wide && gt >= nq * C4) return;
    for (int c4 = wide ? gt % C4 : gt; c4 < C4; c4 += wide ? C4 : NGT) {
        const int c = 4 * c4;
        const f32x4 wg0 = *(const f32x4*)(cw + c), wg1 = *(const f32x4*)(cw + NUP + c), wg2 = *(const f32x4*)(cw + 2 * NUP + c), bg = *(const f32x4*)(cb + c);
        const f32x4 wu0 = *(const f32x4*)(cw + DFF + c), wu1 = *(const f32x4*)(cw + NUP + DFF + c), wu2 = *(const f32x4*)(cw + 2 * NUP + DFF + c), bu = *(const f32x4*)(cb + DFF + c);
        for (int q = wide ? gt / C4 : 0; q < NQ; q += nq) {
            const int i = q & 1, s = q >> 1;
            const bool first = (s & 127) == 0;
            const f32x4 z = {0.f, 0.f, 0.f, 0.f};
            const bf16* hc = halo + ((size_t)s * 4 + i) * NUP + c;
            const int sp = first ? s : s - 1;
            const bf16* hp3 = halo + ((size_t)sp * 4 + 3) * NUP + c; const bf16* hp2 = halo + ((size_t)sp * 4 + 2) * NUP + c; const bf16* h0 = halo + ((size_t)s * 4 + 0) * NUP + c;
            const f32x4 cg = ld4bf(hc), cu = ld4bf(hc + DFF);
            f32x4 g1, g2, u1, u2;
            if (i == 1) { g1 = ld4bf(h0); u1 = ld4bf(h0 + DFF); if (first) { g2 = z; u2 = z; } else { g2 = ld4bf(hp3); u2 = ld4bf(hp3 + DFF); } }
            else { if (first) { g1 = z; u1 = z; g2 = z; u2 = z; } else { g1 = ld4bf(hp3); u1 = ld4bf(hp3 + DFF); g2 = ld4bf(hp2); u2 = ld4bf(hp2 + DFF); } }
            const f32x4 yg = bg + wg0 * g2 + wg1 * g1 + wg2 * cg, yu = bu + wu0 * u2 + wu1 * u1 + wu2 * cu;
            v2u w; w.x = pk2(gelu_tanh_f(yg.x) * yu.x, gelu_tanh_f(yg.y) * yu.y); w.y = pk2(gelu_tanh_f(yg.z) * yu.z, gelu_tanh_f(yg.w) * yu.w);
            *(v2u*)(act + (size_t)(64 * s + i) * DFF + c) = w;
        }
    }
}
typedef Ptrs Args;
__global__ void __launch_bounds__(NWAVES * 64, 2) hybrid_fwd(Args args) {
    extern __shared__ __attribute__((aligned(16))) unsigned char lds_raw[];
    LAS unsigned char* lds = (LAS unsigned char*)lds_raw;
    volatile LAS unsigned* MISCW = (volatile LAS unsigned*)(lds + MISC_OFF);
    const int tid = threadIdx.x, lane = tid & 63, wave = __builtin_amdgcn_readfirstlane(tid >> 6);
    const int G = gridDim.x; const int bx = blockIdx.x; const int vcu = (G % 8 == 0) ? (bx % 8) * (G / 8) + bx / 8 : bx;
    const Args& P = args;
    unsigned char* ws = args.ws;
    gu32* ctl = (gu32*)(ws + WS_CTL);
    for (int u = tid; u < (LDS_BYTES - LDSCTL_OFF) / 4; u += NWAVES * 64) ((LAS unsigned*)(lds + LDSCTL_OFF))[u] = 0u;
    __syncthreads();
    XcdBarrier bar; bar.bar = (unsigned*)(ctl + CW_BAR); bar.x = 0; bar.st = nullptr;
    if (N_LAUNCHES == 1) bar = xcd_barrier_post((unsigned*)(ctl + CW_BAR), MISCW + 8);
#define GRID_BAR() do { if (N_LAUNCHES == 1) xcd_barrier(bar); } while (0)
    const int lo = args.ph_lo, hi = args.ph_hi;
#ifndef PH_MASK
#define PH_MASK 0x3ff
#endif
#define IN(k) (((PH_MASK >> (k)) & 1) && lo <= (k) && (k) < hi)
#define BOTH(k) (IN(k) && IN((k) + 1))
    const int gw = vcu * NWAVES + wave, NGW = G * NWAVES;
#ifdef TSEL_A
    unsigned long long* tsw = (unsigned long long*)(ws + WS_CTL + 8192);
#define STAMP(k) do { if (vcu == 0 && tid == 0) tsw[(k)] = __builtin_amdgcn_s_memrealtime(); } while (0)
#else
#define STAMP(k) do {} while (0)
#endif
    STAMP(0);
#ifndef REP_PHASE
#define REP_PHASE -1
#endif
#define REPS(k) _Pragma("unroll 1") for (int rep_ = 0; rep_ < ((REP_PHASE == (k)) ? 2 : 1); ++rep_)
#define REPBAR(k) do { if ((REP_PHASE == (k)) && rep_ == 0) GRID_BAR(); } while (0)

    if (IN(0)) { REPS(0) { p0_prologue(P, lds, vcu, G, tid, lane, wave); REPBAR(0); } if (BOTH(0)) GRID_BAR(); STAMP(1); }

    if (IN(1)) { REPS(1) {
        { const int gt = (vcu == G - 1) ? tid : 512;
          if (gt < 512) { float* misc = (float*)(ws + WS_MISC); float s = 0.f; for (int kc = 0; kc < 64; ++kc) s += misc[MISC_B1 + ((gt >> 8) * 64 + kc) * 256 + (gt & 255)]; misc[MISC_B1F + gt] = s; } }
        pg8::Gemm g{(const pg8::bf16_t*)(ws + WS_H), (const pg8::bf16_t*)(ws + WS_WIN), TOK, LDP, DM}; pg8::StaticOrder S; S.init(TOK, LDP, G, bx);
        pg8::EpiProj E{(pg8::bf16_t*)(ws + WS_PROJ), LDP, (float*)(ws + WS_GATES), C2D, C2N};
        pg8::gemm_phase<pg8::EpiProj, pg8::StaticOrder, true, true>(lds + RING_OFF, g, S, E); REPBAR(1); }
        if (BOTH(1)) GRID_BAR(); STAMP(2);
    }

    if (IN(2)) { REPS(2) {
        for (int u = vcu; u < 256; u += G) cmp_unit(P, lds, u, tid, lane, wave);
        knorm_prep(P, lds, vcu, G, tid, lane, wave);
 REPBAR(2); }
        if (BOTH(2)) GRID_BAR(); STAMP(3);
    }

    if (IN(3)) { REPS(3) {
        STAMP(20);
#ifdef CLKPROBE
        unsigned long long ck0_ = 0, ck1_ = 0, rt0_ = 0, rt1_ = 0; if (vcu == 0 && tid == 0) { ck0_ = __builtin_amdgcn_s_memtime(); rt0_ = __builtin_amdgcn_s_memrealtime(); }
#endif
        bool qdone_ = false;
        for (int L = vcu; L < 256; L += G) {
            const int bh = L >> 4, s = L & 15;
#pragma unroll 1
            for (int i = 0; i < 4; ++i) { const int qb = (i == 0) ? 63 - s : (i == 1) ? 32 + s : (i == 2) ? 31 - s : s; diff_unit(P, lds, bh >> 3, bh & 7, qb);
#ifndef P3_QUEUE_ITEMS
#define P3_QUEUE_ITEMS 1
#endif
                if (P3_QUEUE_ITEMS > 0 && !qdone_) qdone_ = p0b_weights(P, lane, P3_QUEUE_ITEMS); }
        }
#ifdef CLKPROBE
        if (CLKPROBE == 0 && vcu == 0 && tid == 0) { ck1_ = __builtin_amdgcn_s_memtime(); rt1_ = __builtin_amdgcn_s_memrealtime(); ((unsigned long long*)(ws + WS_CTL + 40960))[0] = ck1_ - ck0_; ((unsigned long long*)(ws + WS_CTL + 40960))[1] = rt1_ - rt0_; }
        if (CLKPROBE == 1 && vcu == 0 && tid == 0) { ck0_ = __builtin_amdgcn_s_memtime(); rt0_ = __builtin_amdgcn_s_memrealtime(); }
#endif
        for (int L = vcu; L < 256; L += G) { const int bg = L >> 6, s = L & 63;
#pragma unroll 1
            for (int i = 0; i < 2; ++i) nsa_unit(P, lds, bg, i ? s : 127 - s); }
#ifdef CLKPROBE
        if (CLKPROBE == 1 && vcu == 0 && tid == 0) { ck1_ = __builtin_amdgcn_s_memtime(); rt1_ = __builtin_amdgcn_s_memrealtime(); ((unsigned long long*)(ws + WS_CTL + 40960))[0] = ck1_ - ck0_; ((unsigned long long*)(ws + WS_CTL + 40960))[1] = rt1_ - rt0_; }
#endif
        p0b_weights(P, lane); REPBAR(3); }
        if (BOTH(3)) GRID_BAR(); STAMP(4);
    }

    if (IN(4)) { REPS(4) {
        __syncthreads();
        pg8::Gemm g{(const pg8::bf16_t*)(ws + WS_MIX), (const pg8::bf16_t*)(ws + WS_WOUT), TOK, DM, DM}; pg8::StaticOrder S; S.init(TOK, DM, G, bx);
        pg8::EpiBf16Plain E{(pg8::bf16_t*)(ws + WS_Y), DM};
        pg8::gemm_phase<pg8::EpiBf16Plain, pg8::StaticOrder, true, true>(lds + RING_OFF, g, S, E); REPBAR(4); }
        if (BOTH(4)) GRID_BAR(); STAMP(5);
    }

    if (IN(5)) {
        p5_rows(P.in[0], (bf16*)(ws + WS_Y), P.in[16], P.in[17], (bf16*)(ws + WS_H), gw, NGW, lane);
        if (BOTH(5)) GRID_BAR(); STAMP(6);
    }

    if (IN(6)) { REPS(6) {
        pg8::Gemm g{(const pg8::bf16_t*)(ws + WS_H), (const pg8::bf16_t*)(ws + WS_WUP), TOK, NUP, DM}; pg8::StaticOrder S; S.init(TOK, NUP, G, bx);
        pg8::EpiUpGlu E{(pg8::bf16_t*)(ws + WS_ACT), (pg8::bf16_t*)(ws + WS_HALO), P.in[19], P.in[20], DFF};
        pg8::gemm_phase<pg8::EpiUpGlu, pg8::StaticOrder, true, true>(lds + RING_OFF, g, S, E); REPBAR(6); }
        if (BOTH(6)) GRID_BAR(); STAMP(7);
    }

    if (IN(7)) { p7_halo(P, vcu * (NWAVES * 64) + tid, G * NWAVES * 64); if (BOTH(7)) GRID_BAR(); STAMP(8); }

    if (IN(8)) { REPS(8) {
        pg8::Gemm g{(const pg8::bf16_t*)(ws + WS_ACT), (const pg8::bf16_t*)(ws + WS_WDN), TOK, DM, DFF}; pg8::StaticOrder S; S.init(TOK, DM, G, bx);
        pg8::EpiBf16Plain E{(pg8::bf16_t*)(ws + WS_Y2), DM};
        pg8::gemm_phase<pg8::EpiBf16Plain, pg8::StaticOrder, true, true>(lds + RING_OFF, g, S, E); REPBAR(8); }
        if (BOTH(8)) GRID_BAR(); STAMP(9);
    }

    if (IN(9)) {
        p9_rows(P.out, (const bf16*)(ws + WS_Y), (const bf16*)(ws + WS_Y2), P.in[22], gw, NGW, lane);
#ifdef CLKPROBE
        if (vcu == 0) { asm volatile("s_waitcnt vmcnt(0) lgkmcnt(0)" ::: "memory"); __syncthreads(); if (tid == 0) { const unsigned long long* w = (const unsigned long long*)(ws + WS_CTL + 40960);
            const float ratio = (float)w[0] / (float)(w[1] ? w[1] : 1ull); P.out[0] += 20.0f + floorf(ratio + 0.5f); } }
#endif
#ifdef EPROBE
        if (vcu == 0) { asm volatile("s_waitcnt vmcnt(0) lgkmcnt(0)" ::: "memory"); __syncthreads(); if (tid == 0) { const unsigned long long* w = (const unsigned long long*)(ws + WS_CTL + 40960);
            const unsigned long long* tsw2 = (const unsigned long long*)(ws + WS_CTL + 8192);
            const float ratio = (float)w[0] / (float)(tsw2[3] - tsw2[20]); P.out[0] += 20.0f + floorf(ratio * 40.0f + 0.5f); } }
#endif
#ifdef TPROBE_SEC
        if (vcu == 0) { asm volatile("s_waitcnt vmcnt(0) lgkmcnt(0)" ::: "memory"); __syncthreads(); if (tid == 0) { const unsigned long long* w = (const unsigned long long*)(ws + WS_CTL + 40960);
            const float ratio = (float)w[0] / (float)(w[1] ? w[1] : 1ull); P.out[0] += 20.0f + floorf(ratio * 40.0f + 0.5f); } }
#endif
#ifdef TSEL_A
        STAMP(10);
        if (vcu == 0) { asm volatile("s_waitcnt vmcnt(0) lgkmcnt(0)" ::: "memory"); __syncthreads(); if (tid == 0) { const float us = (float)(tsw[TSEL_B] - tsw[TSEL_A]) * 0.01f; P.out[0] += us; } }
#endif
    }
#undef IN
#undef BOTH
#undef GRID_BAR
}

extern "C" void kernel_launch(void* const* d_in, const int* in_sizes, int n_in, void* d_out, int out_size, void* d_ws, size_t ws_size, hipStream_t stream) {
    static int grid = 0;
    if (grid == 0) {
        if (n_in != NIN || in_sizes[0] != TOK * DM || out_size != TOK * DM || ws_size < WS_END) {
            fprintf(stderr, "kernel_launch: shape mismatch (n_in %d, in0 %d, out %d, ws %zu; need %zu bytes of workspace); nothing launched\n", n_in, n_in > 0 ? in_sizes[0] : -1, out_size, ws_size, (size_t)WS_END); grid = -1; return; }
        int dev = 0, cus = 0, per_cu = 0;
        if (hipGetDevice(&dev) != hipSuccess || hipDeviceGetAttribute(&cus, hipDeviceAttributeMultiprocessorCount, dev) != hipSuccess) { fprintf(stderr, "kernel_launch: device query failed\n"); grid = -1; return; }
        if (hipFuncSetAttribute((const void*)hybrid_fwd, hipFuncAttributeMaxDynamicSharedMemorySize, LDS_BYTES) != hipSuccess) { fprintf(stderr, "kernel_launch: hipFuncSetAttribute failed\n"); grid = -1; return; }
        if (hipOccupancyMaxActiveBlocksPerMultiprocessor(&per_cu, (const void*)hybrid_fwd, NWAVES * 64, LDS_BYTES) != hipSuccess || per_cu < 1)
            fprintf(stderr, "kernel_launch: note: occupancy query reports %d workgroups per CU\n", per_cu);
        (void)hipGetLastError();
        grid = cus;
    }
    if (grid < 0) return;
    if (hipMemsetAsync((char*)d_ws + WS_CTL, 0, CTL_ZERO_BYTES, stream) != hipSuccess) { fprintf(stderr, "kernel_launch: hipMemsetAsync failed\n"); return; }
    Args a{};
    for (int i = 0; i < NIN; ++i) a.in[i] = (const float*)d_in[i];
    a.out = (float*)d_out; a.ws = (unsigned char*)d_ws;
    for (int li = 0; li < N_LAUNCHES; ++li) {
        a.ph_lo = (N_LAUNCHES == PER_PHASE) ? li : 0; a.ph_hi = (N_LAUNCHES == PER_PHASE) ? li + 1 : PER_PHASE;
        hipLaunchKernelGGL(hybrid_fwd, dim3(grid), dim3(NWAVES * 64), LDS_BYTES, stream, a);
        const hipError_t le = hipPeekAtLastError();
        if (le != hipSuccess) { fprintf(stderr, "kernel_launch: launch %d failed: %s\n", li, hipGetErrorName(le)); break; }
    }
}
```
